# Optimizing an MI355X kernel written in HIP

```python
import jax
import jax.numpy as jnp
from jax import lax
import numpy as np

D_MODEL = 1024
BATCH = 8
SEQ = 2048
DEPTH = 4
DEC_BATCH = 128
DEC_SEQ = 1
PAST_LEN = 2048
PAGE_SIZE = 128

N_META = 16
N_EVEN = (DEPTH + 1) // 2
N_ODD = DEPTH // 2
A_HEADS = 4
A_DK = 128
A_DV = 128
A_WIDTH = A_HEADS * A_DV
A_CHUNK = 64
B_HEADS = 8
B_KV_HEADS = 2
B_HEAD_DIM = 64
B_WIDTH = B_HEADS * B_HEAD_DIM
B_KV_WIDTH = B_KV_HEADS * B_HEAD_DIM
IDX_HEADS = 8
IDX_DIM = 64
TOPK_MAX = 256
Q_BLOCK = 128
ROPE_THETA = 10000.0
C_WIDTH = 512
C_CONV = 31
D_WIDTH = 512
D_CONV = 4
D_BLOCKS = 8
D_BLOCK_W = D_WIDTH // D_BLOCKS
LRU_C = 8.0
N_GROUPS = 4
EXPERTS_PER_GROUP = 4
N_EXPERTS = N_GROUPS * EXPERTS_PER_GROUP
TOP_E = 2
EXPERT_FF = 256
DN_ALPHA = (2 * DEPTH) ** 0.25
DN_BETA = (8 * DEPTH) ** -0.25
LN_EPS = 1e-5
RMS_EPS = 1e-6
NEG_BIG = -1e30
LB_TINY = 1e-30
EVEN_PARTS = (A_HEADS * A_DK, A_HEADS * A_DK, A_WIDTH, A_WIDTH, B_WIDTH, B_KV_WIDTH, B_KV_WIDTH, IDX_HEADS * IDX_DIM, IDX_DIM, IDX_HEADS)
EVEN_INIT_SCALE = (1.0, 1.0, DN_BETA, 1.0, 1.0, 1.0, DN_BETA, 1.0, 1.0, 1.0)
EVEN_IN = sum(EVEN_PARTS)
MIX_EVEN = A_WIDTH + B_WIDTH
ODD_PARTS = (C_WIDTH, C_WIDTH, D_WIDTH, D_WIDTH)
ODD_IN = sum(ODD_PARTS)
MIX_ODD = C_WIDTH + D_WIDTH

kernel_name = 'hybrid_hgrn2_dsa_conformer_rglru_hmoe_step'

F32 = jnp.float32


def split_cols(h, parts):
    cuts = [int(c) for c in np.cumsum(parts)[:-1]]
    return jnp.split(h, cuts, axis=-1)


def layer_norm(x, g, b):
    xf = x.astype(F32)
    mu = jnp.mean(xf, axis=-1, keepdims=True)
    var = jnp.mean(jnp.square(xf - mu), axis=-1, keepdims=True)
    return ((xf - mu) * lax.rsqrt(var + LN_EPS) * g.astype(F32) + b.astype(F32)).astype(x.dtype)


def post_norm(x, sub, g, b):
    return layer_norm(DN_ALPHA * x + sub.astype(x.dtype), g, b)


def rope(x, pos):
    half = x.shape[-1] // 2
    inv = ROPE_THETA ** (-jnp.arange(half, dtype=F32) / half)
    ang = pos.astype(F32)[:, None] * inv[None, :]
    cos = jnp.cos(ang)[:, None, :]
    sin = jnp.sin(ang)[:, None, :]
    xf = x.astype(F32)
    x1, x2 = xf[..., :half], xf[..., half:]
    return jnp.concatenate([x1 * cos - x2 * sin, x2 * cos + x1 * sin], axis=-1).astype(x.dtype)


def causal_dwconv(x_ext, w, b):
    ch = x_ext.shape[-1]
    y = lax.conv_general_dilated(x_ext, w[:, None, :].astype(x_ext.dtype), window_strides=(1,), padding='VALID',
                                 dimension_numbers=('NWC', 'WIO', 'NWC'), feature_group_count=ch)
    return y + b.astype(y.dtype)


def even_project(x, w_in, lb, pos):
    bsz, t, _ = x.shape
    qa, fa, ia, ga, qb, kb, vb, qi, ki, wi = split_cols(x @ w_in, EVEN_PARTS)
    heads = lambda a, h: a.reshape(bsz, t, h, -1)
    lbh = lb.astype(F32).reshape(A_HEADS, A_DK)
    zf = heads(fa, A_HEADS).astype(F32)
    log_f = jnp.logaddexp(jnp.log(jnp.maximum(lbh, LB_TINY)), jnp.log1p(-lbh) + jax.nn.log_sigmoid(zf))
    k_a = (1.0 - lbh) * jax.nn.sigmoid(-zf)
    q_a = jax.nn.silu(heads(qa, A_HEADS).astype(F32))
    v_a = heads(ia, A_HEADS).astype(F32)
    q_b = rope(heads(qb, B_HEADS), pos)
    k_b = rope(heads(kb, B_KV_HEADS), pos)
    v_b = heads(vb, B_KV_HEADS)
    q_i = rope(heads(qi, IDX_HEADS), pos)
    k_i = rope(ki[:, :, None, :], pos)[:, :, 0]
    return (q_a, k_a, v_a, log_f), ga, (q_b, k_b, v_b, q_i, k_i, wi)


def hgrn_chunk(s, q, k, v, log_f):
    c = q.shape[1]
    b = jnp.cumsum(log_f, axis=1)
    causal = jnp.tril(jnp.ones((c, c), dtype=bool))[None, :, :, None, None]
    diff = b[:, :, None] - b[:, None, :]
    decay = jnp.where(causal, jnp.exp(jnp.where(causal, diff, 0.0)), 0.0)
    scores = jnp.einsum('bthk,bshk,btshk->bhts', q, k, decay)
    o_intra = jnp.einsum('bhts,bshv->bthv', scores, v)
    o_inter = jnp.einsum('bthk,bhkv->bthv', q * jnp.exp(b), s)
    b_last = b[:, -1]
    k_dec = k * jnp.exp(b_last[:, None] - b)
    s_new = jnp.exp(b_last)[..., None] * s + jnp.einsum('bshk,bshv->bhkv', k_dec, v)
    return s_new, o_intra + o_inter


def hgrn_prompt(q, k, v, log_f):
    bsz, t = q.shape[:2]
    s0 = jnp.zeros((bsz, A_HEADS, A_DK, A_DV), F32)
    s, o_meta = hgrn_chunk(s0, q[:, :N_META], k[:, :N_META], v[:, :N_META], log_f[:, :N_META])
    n_chunk = (t - N_META) // A_CHUNK
    def chunks(a):
        return jnp.moveaxis(a[:, N_META:].reshape((bsz, n_chunk, A_CHUNK) + a.shape[2:]), 1, 0)
    s, o_rest = lax.scan(lambda st, c: hgrn_chunk(st, *c), s, (chunks(q), chunks(k), chunks(v), chunks(log_f)))
    o_rest = jnp.moveaxis(o_rest, 0, 1).reshape(bsz, t - N_META, A_HEADS, A_DV)
    return jnp.concatenate([o_meta, o_rest], axis=1), s


def hgrn_sample(s0, q, k, v, log_f):
    def step(s, inp):
        qt, kt, vt, lft = inp
        s = jnp.exp(lft)[..., None] * s + kt[..., None] * vt[..., None, :]
        return s, jnp.einsum('bhk,bhkv->bhv', qt, s)
    tm = lambda a: jnp.moveaxis(a, 1, 0)
    s, o = lax.scan(step, s0.astype(F32), (tm(q), tm(k), tm(v), tm(log_f)))
    return jnp.moveaxis(o, 0, 1), s


def index_scores(qi, wi, ki):
    dots = jnp.einsum('bqhd,bsd->bqhs', qi.astype(F32), ki.astype(F32)) * (IDX_DIM ** -0.5)
    return jnp.einsum('bqh,bqhs->bqs', wi.astype(F32) * (IDX_HEADS ** -0.5), jax.nn.relu(dots))


def select_keys(score, visible, n_sel):
    _, idx = lax.top_k(jnp.where(visible, score, NEG_BIG), n_sel)
    return idx


def sparse_attend(q, k_sel, v_sel, valid):
    bsz, nq = q.shape[:2]
    qg = q.reshape(bsz, nq, B_KV_HEADS, B_HEADS // B_KV_HEADS, B_HEAD_DIM).astype(F32)
    logits = jnp.einsum('bqkgd,bqnkd->bqkgn', qg, k_sel.astype(F32)) * (B_HEAD_DIM ** -0.5)
    logits = jnp.where(valid[:, :, None, None, :], logits, NEG_BIG)
    p = jax.nn.softmax(logits, axis=-1)
    o = jnp.einsum('bqkgn,bqnkd->bqkgd', p, v_sel.astype(F32))
    return o.reshape(bsz, nq, B_WIDTH)


def dsa_prompt(q, k, v, qi, ki, wi):
    bsz, t = q.shape[:2]
    n_sel = min(TOPK_MAX, t // 4)
    n_blk = -(-t // Q_BLOCK)
    t_pad = n_blk * Q_BLOCK
    def blocks(a):
        a = jnp.pad(a, [(0, 0), (0, t_pad - t)] + [(0, 0)] * (a.ndim - 2))
        return jnp.moveaxis(a.reshape((bsz, n_blk, Q_BLOCK) + a.shape[2:]), 1, 0)
    key_pos = jnp.arange(t)
    b_idx = jnp.arange(bsz)[:, None, None]
    def one_block(blk):
        qb, qib, wib, qpos = blk
        score = index_scores(qib, wib, ki)
        sel = select_keys(score, key_pos[None, :] <= qpos[:, None], n_sel)
        valid = sel <= qpos[None, :, None]
        return sparse_attend(qb, k[b_idx, sel], v[b_idx, sel], valid)
    qpos_blocks = jnp.arange(t_pad).reshape(n_blk, Q_BLOCK)
    out = lax.map(one_block, (blocks(q), blocks(qi), blocks(wi), qpos_blocks))
    return jnp.moveaxis(out, 0, 1).reshape(bsz, t_pad, B_WIDTH)[:, :t]


def dsa_sample(q, k, v, qi, ki, wi, cache_k, cache_v, cache_kidx, page_table, layer):
    dbsz, dseq = q.shape[:2]
    past = page_table.shape[1] * PAGE_SIZE
    n_keys = past + dseq
    n_sel = min(TOPK_MAX, n_keys // 4)
    ki_past = cache_kidx[page_table, :, layer].reshape(dbsz, past, IDX_DIM)
    ki_all = jnp.concatenate([ki_past.astype(ki.dtype), ki], axis=1)
    score = index_scores(qi, wi, ki_all)
    qpos = past + jnp.arange(dseq)
    sel = select_keys(score, jnp.arange(n_keys)[None, :] <= qpos[:, None], n_sel)
    from_past = (sel < past)[..., None, None]
    sp = jnp.minimum(sel, past - 1)
    b_idx = jnp.arange(dbsz)[:, None, None]
    phys = page_table[b_idx, sp // PAGE_SIZE]
    off = sp % PAGE_SIZE
    sn = jnp.clip(sel - past, 0, dseq - 1)
    k_sel = jnp.where(from_past, cache_k[phys, off, layer].astype(k.dtype), k[b_idx, sn])
    v_sel = jnp.where(from_past, cache_v[phys, off, layer].astype(v.dtype), v[b_idx, sn])
    valid = sel <= qpos[None, :, None]
    return sparse_attend(q, k_sel, v_sel, valid)


def even_output(o_a, g_a, o_b, norm_g, w_out):
    bsz, t = o_a.shape[:2]
    o_a = o_a * lax.rsqrt(jnp.mean(jnp.square(o_a), axis=-1, keepdims=True) + RMS_EPS) * norm_g.astype(F32)
    o_a = o_a.reshape(bsz, t, A_WIDTH) * jax.nn.silu(g_a.astype(F32))
    mixed = jnp.concatenate([o_a, o_b.astype(F32)], axis=-1).astype(w_out.dtype)
    return mixed @ w_out


def lru_scan(h0, a, u):
    def step(h, au):
        h = au[0] * h + au[1]
        return h, h
    h, hs = lax.scan(step, h0, (jnp.moveaxis(a, 1, 0), jnp.moveaxis(u, 1, 0)))
    return jnp.moveaxis(hs, 0, 1), h


def odd_mixer(x, buf_c, buf_d, h0, w_in, w_out, cw, cb, lng, lnb, dw, db, wa, ba, wx, bx, lam):
    ca, cg, dx, dg = split_cols(x @ w_in, ODD_PARTS)
    bsz, t = x.shape[:2]
    u = ca * jax.nn.sigmoid(cg)
    ext_c = jnp.concatenate([buf_c.astype(u.dtype), u], axis=1)
    yc = jax.nn.silu(layer_norm(causal_dwconv(ext_c, cw, cb), lng, lnb).astype(F32))
    ext_d = jnp.concatenate([buf_d.astype(dx.dtype), dx], axis=1)
    xc = causal_dwconv(ext_d, dw, db).astype(F32)
    xb = xc.reshape(bsz, t, D_BLOCKS, D_BLOCK_W)
    r = jax.nn.sigmoid(jnp.einsum('btni,nij->btnj', xb, wa.astype(F32)).reshape(bsz, t, D_WIDTH) + ba.astype(F32))
    ig = jax.nn.sigmoid(jnp.einsum('btni,nij->btnj', xb, wx.astype(F32)).reshape(bsz, t, D_WIDTH) + bx.astype(F32))
    log_a = -LRU_C * r * jax.nn.softplus(-lam.astype(F32))
    a = jnp.exp(log_a)
    drive = jnp.sqrt(jnp.maximum(-jnp.expm1(2.0 * log_a), 0.0)) * ig * xc
    hs, h_last = lru_scan(h0.astype(F32), a, drive)
    yd = hs * jax.nn.gelu(dg.astype(F32))
    out = jnp.concatenate([yc, yd], axis=-1).astype(w_out.dtype) @ w_out
    return out, ext_c[:, -(C_CONV - 1):], ext_d[:, -(D_CONV - 1):], h_last


def hier_moe(x, rg_w, rg_b, re_w, re_b, w_gate, w_up, w_down):
    n = x.shape[0]
    xf = x.astype(F32)
    g_prob = jax.nn.softmax(xf @ rg_w.astype(F32) + rg_b.astype(F32), axis=-1)
    g_val, g_idx = lax.top_k(g_prob, 1)
    e_logits = (xf @ re_w.astype(F32) + re_b.astype(F32)).reshape(n, N_GROUPS, EXPERTS_PER_GROUP)
    e_logits = jnp.take_along_axis(e_logits, g_idx[:, :, None], axis=1)[:, 0]
    e_val, e_idx = lax.top_k(jax.nn.softmax(e_logits, axis=-1), TOP_E)
    e_val = e_val / jnp.sum(e_val, axis=-1, keepdims=True)
    expert = g_idx * EXPERTS_PER_GROUP + e_idx
    gates = jnp.sum(jax.nn.one_hot(expert, N_EXPERTS, dtype=F32) * (g_val * e_val)[..., None], axis=1)
    hg = jnp.einsum('nd,edf->nef', x, w_gate).astype(F32)
    hu = jnp.einsum('nd,edf->nef', x, w_up).astype(F32)
    act = (jax.nn.silu(hg) * hu * gates[..., None]).astype(x.dtype)
    return jnp.einsum('nef,efd->nd', act, w_down)


def setup_inputs(seed: int = 0) -> dict:
    key = jax.random.key(seed)
    keys = iter(jax.random.split(key, 48))
    def nrm(shape, scale):
        return jax.random.normal(next(keys), shape, jnp.float32) * scale
    n_pages = PAST_LEN // PAGE_SIZE
    n_phys = (DEC_BATCH * n_pages * 5 + 3) // 4
    x_prompt = nrm((BATCH, SEQ, D_MODEL), 1.0)
    x_sample = nrm((DEC_BATCH, DEC_SEQ, D_MODEL), 1.0)
    cache_k = nrm((n_phys, PAGE_SIZE, N_EVEN, B_KV_HEADS, B_HEAD_DIM), 1.0)
    cache_v = nrm((n_phys, PAGE_SIZE, N_EVEN, B_KV_HEADS, B_HEAD_DIM), DN_BETA)
    cache_kidx = nrm((n_phys, PAGE_SIZE, N_EVEN, IDX_DIM), 1.0)
    state_hgrn = nrm((DEC_BATCH, N_EVEN, A_HEADS, A_DK, A_DV), 0.1)
    state_conv_c = nrm((DEC_BATCH, N_ODD, C_CONV - 1, C_WIDTH), 0.5)
    state_conv_d = nrm((DEC_BATCH, N_ODD, D_CONV - 1, D_WIDTH), 1.0)
    state_lru = nrm((DEC_BATCH, N_ODD, D_WIDTH), 0.5)
    perm = jax.random.permutation(next(keys), n_phys)
    page_table = perm[:DEC_BATCH * n_pages].reshape(DEC_BATCH, n_pages).astype(jnp.int32)
    meta_tokens = nrm((N_META, D_MODEL), 1.0)
    even_scale = jnp.concatenate([jnp.full((p,), s, jnp.float32) for p, s in zip(EVEN_PARTS, EVEN_INIT_SCALE)])
    w_in_even = nrm((N_EVEN, D_MODEL, EVEN_IN), D_MODEL ** -0.5) * even_scale
    w_out_even = nrm((N_EVEN, MIX_EVEN, D_MODEL), MIX_EVEN ** -0.5) * DN_BETA
    hgrn_lb_logits = nrm((N_EVEN, A_HEADS * A_DK), 1.0)
    hgrn_norm_g = 1.0 + nrm((N_EVEN, A_DV), 0.02)
    w_in_odd = nrm((N_ODD, D_MODEL, ODD_IN), D_MODEL ** -0.5)
    w_out_odd = nrm((N_ODD, MIX_ODD, D_MODEL), MIX_ODD ** -0.5) * DN_BETA
    conv_c_w = nrm((N_ODD, C_CONV, C_WIDTH), C_CONV ** -0.5)
    conv_c_b = nrm((N_ODD, C_WIDTH), 0.02)
    conv_c_ln_g = 1.0 + nrm((N_ODD, C_WIDTH), 0.02)
    conv_c_ln_b = nrm((N_ODD, C_WIDTH), 0.02)
    conv_d_w = nrm((N_ODD, D_CONV, D_WIDTH), D_CONV ** -0.5)
    conv_d_b = nrm((N_ODD, D_WIDTH), 0.02)
    lru_wa = nrm((N_ODD, D_BLOCKS, D_BLOCK_W, D_BLOCK_W), D_BLOCK_W ** -0.5)
    lru_ba = nrm((N_ODD, D_WIDTH), 0.02)
    lru_wx = nrm((N_ODD, D_BLOCKS, D_BLOCK_W, D_BLOCK_W), D_BLOCK_W ** -0.5)
    lru_bx = nrm((N_ODD, D_WIDTH), 0.02)
    a_target = jax.random.uniform(next(keys), (N_ODD, D_WIDTH), jnp.float32, 0.9, 0.999) ** (1.0 / LRU_C)
    lru_lambda = jnp.log(a_target) - jnp.log1p(-a_target)
    ln1_g = 1.0 + nrm((DEPTH, D_MODEL), 0.02)
    ln1_b = nrm((DEPTH, D_MODEL), 0.02)
    ln2_g = 1.0 + nrm((DEPTH, D_MODEL), 0.02)
    ln2_b = nrm((DEPTH, D_MODEL), 0.02)
    router_g_w = nrm((DEPTH, D_MODEL, N_GROUPS), D_MODEL ** -0.5)
    router_g_b = nrm((DEPTH, N_GROUPS), 0.01)
    router_e_w = nrm((DEPTH, D_MODEL, N_EXPERTS), D_MODEL ** -0.5)
    router_e_b = nrm((DEPTH, N_EXPERTS), 0.01)
    w_gate = nrm((DEPTH, N_EXPERTS, D_MODEL, EXPERT_FF), D_MODEL ** -0.5)
    w_up = nrm((DEPTH, N_EXPERTS, D_MODEL, EXPERT_FF), D_MODEL ** -0.5) * DN_BETA
    w_down = nrm((DEPTH, N_EXPERTS, EXPERT_FF, D_MODEL), EXPERT_FF ** -0.5) * DN_BETA
    return {'x_prompt': x_prompt, 'x_sample': x_sample, 'cache_k': cache_k, 'cache_v': cache_v,
            'cache_kidx': cache_kidx, 'state_hgrn': state_hgrn, 'state_conv_c': state_conv_c,
            'state_conv_d': state_conv_d, 'state_lru': state_lru, 'page_table': page_table,
            'meta_tokens': meta_tokens, 'w_in_even': w_in_even, 'w_out_even': w_out_even,
            'hgrn_lb_logits': hgrn_lb_logits, 'hgrn_norm_g': hgrn_norm_g, 'w_in_odd': w_in_odd,
            'w_out_odd': w_out_odd, 'conv_c_w': conv_c_w, 'conv_c_b': conv_c_b, 'conv_c_ln_g': conv_c_ln_g,
            'conv_c_ln_b': conv_c_ln_b, 'conv_d_w': conv_d_w, 'conv_d_b': conv_d_b, 'lru_wa': lru_wa,
            'lru_ba': lru_ba, 'lru_wx': lru_wx, 'lru_bx': lru_bx, 'lru_lambda': lru_lambda,
            'ln1_g': ln1_g, 'ln1_b': ln1_b, 'ln2_g': ln2_g, 'ln2_b': ln2_b,
            'router_g_w': router_g_w, 'router_g_b': router_g_b, 'router_e_w': router_e_w,
            'router_e_b': router_e_b, 'w_gate': w_gate, 'w_up': w_up, 'w_down': w_down}


def reference(x_prompt, x_sample, cache_k, cache_v, cache_kidx, state_hgrn, state_conv_c, state_conv_d, state_lru,
              page_table, meta_tokens, w_in_even, w_out_even, hgrn_lb_logits, hgrn_norm_g, w_in_odd, w_out_odd,
              conv_c_w, conv_c_b, conv_c_ln_g, conv_c_ln_b, conv_d_w, conv_d_b, lru_wa, lru_ba, lru_wx, lru_bx,
              lru_lambda, ln1_g, ln1_b, ln2_g, ln2_b, router_g_w, router_g_b, router_e_w, router_e_b,
              w_gate, w_up, w_down):
    bsz, seq, _ = x_prompt.shape
    dbsz, dseq, _ = x_sample.shape
    past_len = page_table.shape[1] * PAGE_SIZE
    meta = jnp.broadcast_to(meta_tokens.astype(x_prompt.dtype)[None], (bsz, N_META, D_MODEL))
    xp = jnp.concatenate([meta, x_prompt], axis=1)
    xs = x_sample
    pos_p = jnp.arange(N_META + seq)
    pos_s = past_len + jnp.arange(dseq)
    sm = jax.nn.softmax(hgrn_lb_logits.astype(F32), axis=0)
    lower_bounds = jnp.cumsum(sm, axis=0) - sm[0]

    kp, vp, ip, hp, cp, dp, lp = [], [], [], [], [], [], []
    ks, vs, iks, hsm, csm, dsm, lsm = [], [], [], [], [], [], []
    for layer in range(DEPTH):
        li = layer // 2
        if layer % 2 == 0:
            hg_p, g_p, at_p = even_project(xp, w_in_even[li], lower_bounds[li], pos_p)
            oa_p, s_p = hgrn_prompt(*hg_p)
            ob_p = dsa_prompt(*at_p)
            mix_p = even_output(oa_p, g_p, ob_p, hgrn_norm_g[li], w_out_even[li])
            hg_s, g_s, at_s = even_project(xs, w_in_even[li], lower_bounds[li], pos_s)
            oa_s, s_s = hgrn_sample(state_hgrn[:, li], *hg_s)
            ob_s = dsa_sample(*at_s, cache_k, cache_v, cache_kidx, page_table, li)
            mix_s = even_output(oa_s, g_s, ob_s, hgrn_norm_g[li], w_out_even[li])
            kp.append(at_p[1]); vp.append(at_p[2]); ip.append(at_p[4]); hp.append(s_p)
            ks.append(at_s[1]); vs.append(at_s[2]); iks.append(at_s[4]); hsm.append(s_s)
        else:
            odd_w = (w_in_odd[li], w_out_odd[li], conv_c_w[li], conv_c_b[li], conv_c_ln_g[li], conv_c_ln_b[li],
                     conv_d_w[li], conv_d_b[li], lru_wa[li], lru_ba[li], lru_wx[li], lru_bx[li], lru_lambda[li])
            zc = jnp.zeros((bsz, C_CONV - 1, C_WIDTH), xp.dtype)
            zd = jnp.zeros((bsz, D_CONV - 1, D_WIDTH), xp.dtype)
            zh = jnp.zeros((bsz, D_WIDTH), F32)
            mix_p, bc_p, bd_p, h_p = odd_mixer(xp, zc, zd, zh, *odd_w)
            mix_s, bc_s, bd_s, h_s = odd_mixer(xs, state_conv_c[:, li], state_conv_d[:, li], state_lru[:, li], *odd_w)
            cp.append(bc_p); dp.append(bd_p); lp.append(h_p)
            csm.append(bc_s); dsm.append(bd_s); lsm.append(h_s)
        xp = post_norm(xp, mix_p, ln1_g[layer], ln1_b[layer])
        xs = post_norm(xs, mix_s, ln1_g[layer], ln1_b[layer])
        moe_w = (router_g_w[layer], router_g_b[layer], router_e_w[layer], router_e_b[layer],
                 w_gate[layer], w_up[layer], w_down[layer])
        xp = post_norm(xp, hier_moe(xp.reshape(-1, D_MODEL), *moe_w).reshape(xp.shape), ln2_g[layer], ln2_b[layer])
        xs = post_norm(xs, hier_moe(xs.reshape(-1, D_MODEL), *moe_w).reshape(xs.shape), ln2_g[layer], ln2_b[layer])

    y_prompt = xp[:, N_META:]
    y_sample = xs
    new_k_prompt = jnp.stack(kp, axis=2)
    new_v_prompt = jnp.stack(vp, axis=2)
    new_kidx_prompt = jnp.stack(ip, axis=2)
    new_hgrn_prompt = jnp.stack(hp, axis=1)
    new_conv_c_prompt = jnp.stack(cp, axis=1)
    new_conv_d_prompt = jnp.stack(dp, axis=1)
    new_lru_prompt = jnp.stack(lp, axis=1)
    new_k_sample = jnp.stack(ks, axis=2)
    new_v_sample = jnp.stack(vs, axis=2)
    new_kidx_sample = jnp.stack(iks, axis=2)
    new_hgrn_sample = jnp.stack(hsm, axis=1)
    new_conv_c_sample = jnp.stack(csm, axis=1)
    new_conv_d_sample = jnp.stack(dsm, axis=1)
    new_lru_sample = jnp.stack(lsm, axis=1)
    return (y_prompt, y_sample, new_k_prompt, new_v_prompt, new_kidx_prompt, new_hgrn_prompt, new_conv_c_prompt,
            new_conv_d_prompt, new_lru_prompt, new_k_sample, new_v_sample, new_kidx_sample, new_hgrn_sample,
            new_conv_c_sample, new_conv_d_sample, new_lru_sample)
```

```cpp
#include <hip/hip_runtime.h>
#include <cstdio>
#include <cstdint>
#include <cstring>

#define GAS __attribute__((address_space(1)))
#define LAS __attribute__((address_space(3)))
typedef unsigned short bf16;
typedef short bf16x8 __attribute__((ext_vector_type(8)));
typedef float f32x4 __attribute__((ext_vector_type(4)));
typedef float f32x2 __attribute__((ext_vector_type(2)));
typedef float f32x16 __attribute__((ext_vector_type(16)));
typedef unsigned u32x4 __attribute__((ext_vector_type(4)));
typedef unsigned u32x2 __attribute__((ext_vector_type(2)));
typedef unsigned long long u64;
#define DI __device__ __forceinline__

constexpr int D = 1024, NB = 8, SEQ = 2048, NMETA = 16, T = NMETA + SEQ  , NPR = NB * T  , NSM = 128, M = NPR + NSM  ;
constexpr int PAST = 2048, PAGE = 128, NPAGES = 16, NPHYS = 2560;
constexpr int EVEN_IN = 3400, EVEN_PAD = 3584, ODD_IN = 2048;
constexpr int NCLS = 24, CLS_CAP = M, MAXPAN = 96;
constexpr float DN_ALPHA = 1.681792830507429f;
constexpr float LN_EPS = 1e-5f, RMS_EPS = 1e-6f;

constexpr size_t O_YP = 0, O_YS = O_YP + (size_t)NB * SEQ * D, O_KP = O_YS + (size_t)NSM * D, O_VP = O_KP + (size_t)NPR * 256, O_IP = O_VP + (size_t)NPR * 256,
    O_HP = O_IP + (size_t)NPR * 128, O_CP = O_HP + (size_t)NB * 2 * 4 * 128 * 128, O_DP = O_CP + (size_t)NB * 2 * 30 * 512, O_LP = O_DP + (size_t)NB * 2 * 3 * 512,
    O_KS = O_LP + (size_t)NB * 2 * 512, O_VS = O_KS + (size_t)NSM * 256, O_IS = O_VS + (size_t)NSM * 256, O_HS = O_IS + (size_t)NSM * 128,
    O_CS = O_HS + (size_t)NSM * 2 * 4 * 128 * 128, O_DS = O_CS + (size_t)NSM * 2 * 30 * 512, O_LS = O_DS + (size_t)NSM * 2 * 3 * 512, O_END = O_LS + (size_t)NSM * 2 * 512;

constexpr size_t MiB = 1u << 20;
constexpr size_t WS_CTL = 0, CTL_BYTES = 1 * MiB;
constexpr size_t WS_WINE = 2 * MiB;
constexpr size_t WS_WOUTE = WS_WINE + 2ull * EVEN_PAD * 1024 * 2;
constexpr size_t WS_WINO = WS_WOUTE + 2ull * 1024 * 1024 * 2;
constexpr size_t WS_WOUTO = WS_WINO + 2ull * 2048 * 1024 * 2;
constexpr size_t WS_WGU = WS_WOUTO + 2ull * 1024 * 1024 * 2;
constexpr size_t WS_WD = WS_WGU + 64ull * 512 * 1024 * 2;
constexpr size_t WS_X = WS_WD + 64ull * 1024 * 256 * 2;
constexpr size_t WS_XB = WS_X + (size_t)M * D * 4;
constexpr size_t WS_MIX = WS_XB + (size_t)M * D * 2;
constexpr size_t WS_A0 = WS_MIX + (size_t)M * D * 2;
constexpr size_t WS_A1 = WS_A0 + (size_t)M * 512 * 2;
constexpr size_t WS_A2 = WS_A1 + (size_t)M * 512 * 2;
constexpr size_t WS_A3 = WS_A2 + (size_t)M * 512 * 2;
constexpr size_t WS_LF = WS_A3 + (size_t)M * 512 * 2;
constexpr size_t WS_QB = WS_LF + (size_t)M * 512 * 4;
constexpr size_t WS_QI = WS_QB + (size_t)M * 512 * 2;
constexpr size_t WS_KBB = WS_QI + (size_t)M * 512 * 2;
constexpr size_t WS_KIB = WS_KBB + (size_t)M * 128 * 2;
constexpr size_t WS_WI = WS_KIB + (size_t)M * 64 * 2;
constexpr int TP = 2112;
constexpr size_t WS_VT = WS_WI + (size_t)M * 8 * 4;
constexpr size_t WS_ROPE = WS_VT + 8ull * 2 * 64 * TP * 2;
constexpr size_t WS_LB = WS_ROPE + 2ull * T * 32 * 4;
constexpr size_t WS_H = WS_LB + 2ull * 3 * 512 * 4;
constexpr size_t WS_TOK = WS_H + (size_t)MAXPAN * 256 * 512 * 2;
constexpr size_t WS_GATE = WS_TOK + (size_t)NCLS * CLS_CAP * 4;
constexpr size_t WS_SC = (WS_GATE + (size_t)M * 2 * 4 + 4095) / 4096 * 4096;
constexpr size_t WS_END = WS_SC + 256ull * 64 * TP * 4;

constexpr int CW_BAR = 4096;
constexpr int CW_Q = 8192;
constexpr int CW_CNT = 12288;

constexpr int RING_BYTES = 131072, MISC_OFF = RING_BYTES, LDS_BYTES = 147456;

DI unsigned f2bf(float f) { unsigned u = __builtin_bit_cast(unsigned, f); return (u + 0x7fffu + ((u >> 16) & 1u)) >> 16; }
DI unsigned pk2(float lo, float hi) { return f2bf(lo) | (f2bf(hi) << 16); }
DI float bf2f(unsigned b) { return __builtin_bit_cast(float, b << 16); }
DI float sigmoidf_(float x) { return 1.0f / (1.0f + __expf(-x)); }
DI float siluf_(float x) { return x / (1.0f + __expf(-x)); }
DI float gelu_tanh(float x) { const float u = 0.7978845608028654f * (x + 0.044715f * x * x * x); const float e = __expf(2.0f * u); const float th = 1.0f - 2.0f / (e + 1.0f); return 0.5f * x * (1.0f + th); }
DI float wave_sum(float v) {
#pragma unroll
    for (int o = 1; o < 64; o <<= 1) v += __shfl_xor(v, o);
    return v;
}

#define XB_TMO      128
#define XB_XCNT(j)  (256  + 64 * (j))
#define XB_XSUB(j)  (1280 + 64 * (j))
#define XB_XGEN(j)  (2304 + 64 * (j))
#define XB_TOP      3328
#define XB_TOPGEN   3392
#define XCD_BAR_WORDS 3456
#define XB_SPIN_CAP (1u << 18)
__device__ __forceinline__ unsigned xb_ld(unsigned* p)              { return __hip_atomic_load(p, __ATOMIC_RELAXED, __HIP_MEMORY_SCOPE_AGENT); }
__device__ __forceinline__ unsigned xb_add(unsigned* p, unsigned v) { return __hip_atomic_fetch_add(p, v, __ATOMIC_RELAXED, __HIP_MEMORY_SCOPE_AGENT); }
__device__ __forceinline__ unsigned xb_xcc_id() { return (unsigned)__builtin_amdgcn_s_getreg((3 << 11) | 20) & 0xFu; }
#define XB_SPIN(cond, bar) do { unsigned _sp = 0; while (cond) { __builtin_amdgcn_s_sleep(1); \
    if ((++_sp & 255u) == 0u) { if (xb_ld(&(bar)[XB_TMO])) break; if (_sp > XB_SPIN_CAP) { atomicAdd(&(bar)[XB_TMO], 1u); break; } } } } while (0)
struct XcdBarrier { unsigned* bar; unsigned x; volatile LAS unsigned* st; };
__device__ __forceinline__ XcdBarrier xcd_barrier_post(unsigned* bar, volatile LAS unsigned* st) {
    XcdBarrier b; b.bar = bar; b.x = xb_xcc_id(); b.st = st;
    if (threadIdx.x == 0) (void)xb_add(&bar[XB_XCNT(b.x)], 1u);
    return b;
}
__device__ __forceinline__ void xcd_barrier_complete(unsigned* bar, unsigned x, unsigned& nloc, unsigned& nx) {
    const unsigned G = gridDim.x * gridDim.y * gridDim.z;
    unsigned sum, cnt, mine, sp = 0u;
    for (;;) {
        sum = 0u; cnt = 0u; mine = 0u;
#pragma unroll
        for (unsigned j = 0; j < 16; ++j) { const unsigned c = xb_ld(&bar[XB_XCNT(j)]); sum += c; cnt += (c > 0u) ? 1u : 0u; mine = (j == x) ? c : mine; }
        if (sum == G) break;
        __builtin_amdgcn_s_sleep(1);
        if ((++sp & 255u) == 0u) { if (xb_ld(&bar[XB_TMO])) break; if (sp > XB_SPIN_CAP) { atomicAdd(&bar[XB_TMO], 1u); break; } }
    }
    nloc = mine > 0u ? mine : 1u; nx = cnt > 0u ? cnt : 1u;
}
__device__ __forceinline__ void xcd_barrier(const XcdBarrier& b) {
    asm volatile("s_waitcnt vmcnt(0)" ::: "memory");
    __syncthreads();
    if (threadIdx.x == 0) {
        unsigned* bar = b.bar;
        __builtin_amdgcn_s_waitcnt(0);
        unsigned nloc = b.st[0], nx = b.st[1];
        if (nloc == 0u) { xcd_barrier_complete(bar, b.x, nloc, nx); b.st[0] = nloc; b.st[1] = nx; }
        const unsigned old = xb_add(&bar[XB_XSUB(b.x)], 1u);
        const unsigned gen = old / nloc;
        if (old + 1u == (gen + 1u) * nloc) {
            __builtin_amdgcn_fence(__ATOMIC_RELEASE, "agent");
            asm volatile("s_waitcnt vmcnt(0)" ::: "memory");
            const unsigned og = xb_add(&bar[XB_TOP], 1u);
            const unsigned tg = og / nx;
            if (og + 1u == (tg + 1u) * nx) xb_add(&bar[XB_TOPGEN], 1u);
            else XB_SPIN(xb_ld(&bar[XB_TOPGEN]) == tg, bar);
            __builtin_amdgcn_fence(__ATOMIC_ACQUIRE, "agent");
            xb_add(&bar[XB_XGEN(b.x)], 1u);
            asm volatile("s_waitcnt vmcnt(0)" ::: "memory");
        } else {
            XB_SPIN(xb_ld(&bar[XB_XGEN(b.x)]) == gen, bar);
            __builtin_amdgcn_fence(__ATOMIC_ACQUIRE, "agent");
            asm volatile("s_waitcnt vmcnt(0)" ::: "memory");
        }
    }
    __syncthreads();
}

__device__ __attribute__((noinline)) void xcd_barrier_call(unsigned* bar, unsigned x, volatile LAS unsigned* st) { XcdBarrier b; b.bar = bar; b.x = x; b.st = st; xcd_barrier(b); }
struct Args { const float* in[39]; float* out; unsigned char* ws; int ph_lo, ph_hi; };
#define GIN(k) ((const GAS float*)F.in[(k)])
#define LAUNDER_F(F) asm volatile("" : "+s"((F).in), "+s"((F).ws), "+s"((F).out), "+s"((F).ctl), "+s"((F).vcu), "+s"((F).G), "+s"((F).wg))
struct Frame {
    LAS unsigned char* lds; volatile LAS unsigned* MISC; unsigned* ctl;
    int tid, lane, wave, G, wg, vcu;
    const float* const* in; GAS float* out; GAS unsigned char* ws;
};
extern __shared__ __attribute__((aligned(16))) unsigned char lds_raw[];
#define NOINL __device__ __attribute__((noinline))
DI int rfl(int v) { return __builtin_amdgcn_readfirstlane(v); }
template <class Pt> DI Pt rfl_ptr(Pt p) { const u64 v = (u64)p; const unsigned lo = (unsigned)rfl((int)(unsigned)v), hi = (unsigned)rfl((int)(unsigned)(v >> 32)); return (Pt)(((u64)hi << 32) | lo); }
DI void frame_fix(Frame& F) {
    F.lds = (LAS unsigned char*)lds_raw; F.MISC = (volatile LAS unsigned*)(F.lds + MISC_OFF);
    F.tid = threadIdx.x; F.lane = F.tid & 63; F.wave = rfl(F.tid >> 6);
    F.G = rfl(F.G); F.wg = rfl(F.wg); F.vcu = rfl(F.vcu);
    F.ctl = rfl_ptr(F.ctl); F.in = rfl_ptr(F.in); F.out = rfl_ptr(F.out); F.ws = rfl_ptr(F.ws);
}

namespace pg8 {
constexpr int BM = 256, BK = 64, HALF = 128, HTB = HALF * BK * 2, STAGE_BYTES = 8 * HTB, NXCD = 8, WGM = 8;
__host__ __device__ __forceinline__ int lds_byte(int r, int c) { const int st = (r >> 4) * 2 + (c >> 5), rr = r & 15, cc = c & 31, ob = rr * 64 + cc * 2; return st * 1024 + (ob ^ (((ob >> 9) & 1) << 5)); }
__host__ __device__ __forceinline__ void stage_rc(int b, int& R, int& C) { const int st = b / 1024, sb = b % 1024, swz = sb ^ (((sb >> 9) & 1) << 5); R = (st >> 1) * 16 + swz / 64; C = (st & 1) * 32 + (swz % 64) / 2; }
struct Unit { int pm, pn; const GAS char* B0; const GAS char* B1; int aux; };
template <int nM, int nN> DI bool static_next(int G, int c, int i, int& pm, int& pn) {
    const int L = i * G + c; if (L >= nM * nN) return false;
    pm = L / nN; pn = L % nN; return true;
}
template <class P>
__device__ __forceinline__ void gemm_phase(LAS unsigned char* lds, const P& pb) {
    int tid_ = threadIdx.x; asm volatile("" : "+v"(tid_));
    const int tid = tid_, wid = __builtin_amdgcn_readfirstlane(tid >> 6), lane = tid & 63, wr = wid >> 2, wc = wid & 3, fr = lane & 15, fq = lane >> 4;
    constexpr int K = P::K, nt = K / BK;
    int sR[2], sC[2]; unsigned voffA[2], voffB[2];
#pragma unroll
    for (int i = 0; i < 2; ++i) { stage_rc(tid * 16 + i * 8192, sR[i], sC[i]); voffB[i] = (unsigned)(sR[i] * P::ldb + sC[i]) * 2u; voffA[i] = (unsigned)(sR[i] * P::lda + sC[i]) * 2u; }
    constexpr size_t kstep = (size_t)(BK * 2);
    constexpr size_t hstepB = (size_t)HALF * P::ldb * 2, hstepA = (size_t)HALF * P::lda * 2, tstepA = 2 * hstepA;
    const unsigned ldsw = (unsigned)wid * 1024u;
    const int aoff = lds_byte(wr * 64 + fr, fq * 8), boff = lds_byte(wc * 32 + fr, fq * 8);
#define PG8_SA(b, h) (((b) * 2 + (h)) * HTB)
#define PG8_SB(b, h) ((4 + (b) * 2 + (h)) * HTB)
#define PG8_STAGE(bufoff, gbase, voff) do { _Pragma("unroll") for (int _i = 0; _i < 2; ++_i) \
        __builtin_amdgcn_global_load_lds((const GAS unsigned*)((const GAS char*)(gbase) + (voff)[_i]), (LAS unsigned*)(lds + (bufoff) + ldsw + _i * 8192), 16, 0, 0); } while (0)
#define PG8_STAGE_A(bufoff, gbase, h, G_) do { if constexpr (P::GATHER) { PG8_STAGE(bufoff, gbase, (G_)[h]); } else { PG8_STAGE(bufoff, (gbase) + (h) * hstepA, voffA); } } while (0)
#define PG8_LDA(dst, b, h) do { _Pragma("unroll") for (int m = 0; m < 4; ++m) _Pragma("unroll") for (int k = 0; k < 2; ++k) dst[m][k] = *(const LAS bf16x8*)(lds + PG8_SA(b, h) + aoff + m * 2048 + k * 1024); } while (0)
#define PG8_LDB(dst, b, h) do { _Pragma("unroll") for (int n = 0; n < 2; ++n) _Pragma("unroll") for (int k = 0; k < 2; ++k) dst[n][k] = *(const LAS bf16x8*)(lds + PG8_SB(b, h) + boff + n * 2048 + k * 1024); } while (0)
#define PG8_MMA(ai, bj, At, Bt) do { __builtin_amdgcn_s_setprio(1); _Pragma("unroll") for (int m = 0; m < 4; ++m) _Pragma("unroll") for (int n = 0; n < 2; ++n) _Pragma("unroll") for (int k = 0; k < 2; ++k) \
        acc[ai][bj][m][n] = __builtin_amdgcn_mfma_f32_16x16x32_bf16(Bt[n][k], At[m][k], acc[ai][bj][m][n], 0, 0, 0); __builtin_amdgcn_s_setprio(0); } while (0)
#define PG8_WAIT_V(n) asm volatile("s_waitcnt vmcnt(" #n ")" ::: "memory")
#define PG8_WAIT_L(n) asm volatile("s_waitcnt lgkmcnt(" #n ")" ::: "memory")
#define PG8_BAR __builtin_amdgcn_s_barrier()
#define PG8_SCHED __builtin_amdgcn_sched_barrier(0)
    Unit cur, nxt; int ui = 0;
    if (!pb.next(0, cur)) return;
    f32x4 acc[2][2][4][2];
#pragma unroll
    for (int a = 0; a < 2; ++a)
#pragma unroll
        for (int b = 0; b < 2; ++b)
#pragma unroll
            for (int m = 0; m < 4; ++m)
#pragma unroll
                for (int n = 0; n < 2; ++n) acc[a][b][m][n] = (f32x4){0.f, 0.f, 0.f, 0.f};
    bf16x8 At[4][2], B0[2][2], B1[2][2];
    unsigned gA[2][2] = {{0u, 0u}, {0u, 0u}};
    if constexpr (P::GATHER) {
#pragma unroll
        for (int h = 0; h < 2; ++h)
#pragma unroll
            for (int i = 0; i < 2; ++i) gA[h][i] = pb.a_row(cur, 128 * h + sR[i]) + (unsigned)sC[i] * 2u;
    }
    const GAS char* cA = (const GAS char*)pb.A + (P::GATHER ? (size_t)0 : (size_t)cur.pm * tstepA);
    PG8_STAGE(PG8_SB(0, 0), cur.B0, voffB); PG8_STAGE_A(PG8_SA(0, 0), cA, 0, gA); PG8_STAGE(PG8_SB(0, 1), cur.B0 + hstepB, voffB); PG8_STAGE_A(PG8_SA(0, 1), cA, 1, gA);
    if (wr == 1) PG8_BAR;
    PG8_WAIT_V(4); PG8_BAR;
    PG8_STAGE(PG8_SB(1, 0), cur.B0 + kstep, voffB); PG8_STAGE_A(PG8_SA(1, 0), cA + kstep, 0, gA); PG8_STAGE(PG8_SB(1, 1), cur.B0 + hstepB + kstep, voffB);
    PG8_WAIT_V(6); PG8_BAR;
    for (;;) {
        const bool has_next = pb.next(ui + 1, nxt);
        if (!has_next) nxt = cur;
        const GAS char* nA = (const GAS char*)pb.A + (P::GATHER ? (size_t)0 : (size_t)nxt.pm * tstepA);
#pragma unroll 1
        for (int t = 0; t < nt; t += 2) {
            const bool last = (t == nt - 2);
            const GAS char* a1 = cA + (size_t)(t + 1) * kstep;
            const GAS char* a2 = last ? nA : cA + (size_t)(t + 2) * kstep;
            const GAS char* a3 = a2 + kstep;
            const GAS char* b2;
            if constexpr (P::SPLITB) b2 = last ? nxt.B0 : ((t + 2 < pb.KSPLIT) ? cur.B0 : cur.B1) + (size_t)(t + 2) * kstep;
            else b2 = last ? nxt.B0 : cur.B0 + (size_t)(t + 2) * kstep;
            const GAS char* b3 = b2 + kstep;
            PG8_LDB(B0, 0, 0); PG8_SCHED; PG8_LDA(At, 0, 0); PG8_STAGE_A(PG8_SA(1, 1), a1, 1, gA);
            PG8_WAIT_L(8); PG8_BAR; PG8_WAIT_L(0); PG8_MMA(0, 0, At, B0); PG8_BAR; PG8_SCHED;
            if constexpr (P::GATHER) { if (last) {
#pragma unroll
                for (int h = 0; h < 2; ++h)
#pragma unroll
                    for (int i = 0; i < 2; ++i) gA[h][i] = pb.a_row(nxt, 128 * h + sR[i]) + (unsigned)sC[i] * 2u; } }
            PG8_LDB(B1, 0, 1); PG8_STAGE(PG8_SB(0, 0), b2, voffB);
            PG8_BAR; PG8_WAIT_L(0); PG8_MMA(0, 1, At, B1); PG8_BAR;
            PG8_LDA(At, 0, 1); PG8_STAGE_A(PG8_SA(0, 0), a2, 0, gA);
            PG8_BAR; PG8_WAIT_L(0); PG8_MMA(1, 0, At, B0); PG8_BAR; PG8_SCHED;
            PG8_STAGE(PG8_SB(0, 1), b2 + hstepB, voffB);
            PG8_WAIT_V(6); PG8_BAR; PG8_MMA(1, 1, At, B1); PG8_BAR;
            PG8_LDB(B0, 1, 0); PG8_SCHED; PG8_LDA(At, 1, 0); PG8_STAGE_A(PG8_SA(0, 1), a2, 1, gA);
            PG8_WAIT_L(8); PG8_BAR; PG8_WAIT_L(0); PG8_MMA(0, 0, At, B0); PG8_BAR; PG8_SCHED;
            PG8_LDB(B1, 1, 1); PG8_STAGE(PG8_SB(1, 0), b3, voffB);
            PG8_BAR; PG8_WAIT_L(0); PG8_MMA(0, 1, At, B1); PG8_BAR;
            PG8_LDA(At, 1, 1); PG8_STAGE_A(PG8_SA(1, 0), a3, 0, gA);
            PG8_BAR; PG8_WAIT_L(0); PG8_MMA(1, 0, At, B0); PG8_BAR; PG8_SCHED;
            PG8_STAGE(PG8_SB(1, 1), b3 + hstepB, voffB);
            PG8_WAIT_V(6); PG8_BAR; PG8_MMA(1, 1, At, B1); PG8_BAR;
        }
        pb.epi(acc, cur, wr, wc, fr, fq);
        if (!has_next) break;
#pragma unroll
        for (int a = 0; a < 2; ++a)
#pragma unroll
            for (int b = 0; b < 2; ++b)
#pragma unroll
                for (int m = 0; m < 4; ++m)
#pragma unroll
                    for (int n = 0; n < 2; ++n) acc[a][b][m][n] = (f32x4){0.f, 0.f, 0.f, 0.f};
        cur = nxt; cA = nA; ++ui;
    }
    PG8_WAIT_V(0);
    if (wr == 0) PG8_BAR;
    PG8_BAR;
#undef PG8_SA
#undef PG8_SB
#undef PG8_STAGE
#undef PG8_STAGE_A
#undef PG8_LDA
#undef PG8_LDB
#undef PG8_MMA
#undef PG8_WAIT_V
#undef PG8_WAIT_L
#undef PG8_BAR
#undef PG8_SCHED
}
}
typedef f32x4 AccT[2][2][4][2];

DI int swap45(int s) { return (s & ~48) | ((s & 16) << 1) | ((s & 32) >> 1); }
DI int map_even(int s) {
    if (s < 2048) return s;
    if (s < 2688) { const int r = s - 2048; return 2048 + (r & ~63) + swap45(r & 63); }
    if (s < 2816) return s;
    if (s < 3392) { const int r = s - 2816; return 2816 + (r & ~63) + swap45(r & 63); }
    if (s < EVEN_IN) return s;
    return -1;
}
DI int map_odd(int s) {
    if (s >= 1024) return s;
    const int u = s >> 8, r = s & 255; return r < 128 ? 128 * u + r : 512 + 128 * u + (r - 128);
}
DI void transpose_item(const GAS float* W, int ldn, int K, GAS bf16* WT, int k0, int n0, int mode, int coloff, LAS float* scr, int lane) {
    int col = n0 + (lane & 31);
    if (mode == 1) col = map_even(col); else if (mode == 2) col = map_odd(col); else col += coloff;
#pragma unroll 8
    for (int i = 0; i < 32; ++i) { const int kk = 2 * i + (lane >> 5); scr[kk * 33 + (lane & 31)] = col >= 0 ? W[(size_t)(k0 + kk) * ldn + col] : 0.f; }
    asm volatile("s_waitcnt lgkmcnt(0)" ::: "memory");
    const int c = lane & 7;
#pragma unroll
    for (int j = 0; j < 4; ++j) { const int n = (lane >> 3) + 8 * j; const LAS float* s = scr + (8 * c) * 33 + n;
        u32x4 o; o.x = pk2(s[0 * 33], s[1 * 33]); o.y = pk2(s[2 * 33], s[3 * 33]); o.z = pk2(s[4 * 33], s[5 * 33]); o.w = pk2(s[6 * 33], s[7 * 33]);
        *(GAS u32x4*)(WT + (size_t)(n0 + n) * K + k0 + 8 * c) = o; }
    asm volatile("s_waitcnt lgkmcnt(0)" ::: "memory");
}
DI void p_prologue(Frame& F) {
    LAUNDER_F(F);
    LAS float* scr = (LAS float*)(F.lds + F.wave * 16384);
    const int gw = F.wg * 8 + F.wave, NGW = F.G * 8, lane = F.lane;
    constexpr int I_WINE = 2 * 16 * (EVEN_PAD / 32), I_WOUT = 2 * 16 * 32, I_WINO = 2 * 16 * 64, I_WGU = 64 * 16 * 16, I_WD = 64 * 4 * 32;
    constexpr int NIT = I_WINE + I_WOUT + I_WINO + I_WOUT + I_WGU + I_WD;
    for (int it = gw; it < NIT; it += NGW) {
        asm volatile("" ::: "memory");
        int r = it; asm volatile("" : "+v"(r));
        const GAS float* W; GAS bf16* WT; int ldn, K, k0, n0, mode = 0, coloff = 0;
        if (r < I_WINE) { const int li = r / (I_WINE / 2); r %= (I_WINE / 2); const int kb = r / (EVEN_PAD / 32), nb = r % (EVEN_PAD / 32);
            W = GIN(11) + (size_t)li * 1024 * EVEN_IN; ldn = EVEN_IN; K = 1024; WT = (GAS bf16*)(F.ws + WS_WINE) + (size_t)li * EVEN_PAD * 1024; k0 = 64 * kb; n0 = 32 * nb; mode = 1; }
        else if ((r -= I_WINE) < I_WOUT) { const int li = r / (I_WOUT / 2); r %= (I_WOUT / 2); const int kb = r / 32, nb = r % 32;
            W = GIN(12) + (size_t)li * 1024 * 1024; ldn = 1024; K = 1024; WT = (GAS bf16*)(F.ws + WS_WOUTE) + (size_t)li * 1024 * 1024; k0 = 64 * kb; n0 = 32 * nb; }
        else if ((r -= I_WOUT) < I_WINO) { const int li = r / (I_WINO / 2); r %= (I_WINO / 2); const int kb = r / 64, nb = r % 64;
            W = GIN(15) + (size_t)li * 1024 * 2048; ldn = 2048; K = 1024; WT = (GAS bf16*)(F.ws + WS_WINO) + (size_t)li * 2048 * 1024; k0 = 64 * kb; n0 = 32 * nb; mode = 2; }
        else if ((r -= I_WINO) < I_WOUT) { const int li = r / (I_WOUT / 2); r %= (I_WOUT / 2); const int kb = r / 32, nb = r % 32;
            W = GIN(16) + (size_t)li * 1024 * 1024; ldn = 1024; K = 1024; WT = (GAS bf16*)(F.ws + WS_WOUTO) + (size_t)li * 1024 * 1024; k0 = 64 * kb; n0 = 32 * nb; }
        else if ((r -= I_WOUT) < I_WGU) { const int le = r / 256; r %= 256; const int kb = r / 16, nb = r % 16;
            const int s0 = 32 * nb, jj = s0 >> 8, rr = s0 & 255; const bool up = rr >= 128; const int c0 = 128 * jj + (up ? rr - 128 : rr);
            W = (up ? GIN(37) : GIN(36)) + (size_t)le * 1024 * 256; ldn = 256; K = 1024; WT = (GAS bf16*)(F.ws + WS_WGU) + (size_t)le * 512 * 1024; k0 = 64 * kb; n0 = s0; coloff = c0 - s0; }
        else { r -= I_WGU; const int le = r / 128; r %= 128; const int kb = r / 32, nb = r % 32;
            W = GIN(38) + (size_t)le * 256 * 1024; ldn = 1024; K = 256; WT = (GAS bf16*)(F.ws + WS_WD) + (size_t)le * 1024 * 256; k0 = 64 * kb; n0 = 32 * nb; }
        transpose_item(W, ldn, K, WT, k0, n0, mode, coloff, scr, lane);
    }
    GAS float* X = (GAS float*)(F.ws + WS_X); GAS bf16* XB = (GAS bf16*)(F.ws + WS_XB);
    for (int m = gw; m < M; m += NGW) {
        const GAS float* src;
        if (m < NPR) { const int b = m / T, t = m % T; src = t < NMETA ? GIN(10) + (size_t)t * D : GIN(0) + ((size_t)b * SEQ + (t - NMETA)) * D; }
        else src = GIN(1) + (size_t)(m - NPR) * D;
#pragma unroll
        for (int j = 0; j < 4; ++j) { const f32x4 v = *((const GAS f32x4*)src + lane + 64 * j); *((GAS f32x4*)(X + (size_t)m * D) + lane + 64 * j) = v;
            u32x2 o; o.x = pk2(v.x, v.y); o.y = pk2(v.z, v.w); *((GAS u32x2*)(XB + (size_t)m * D) + lane + 64 * j) = o; }
    }
    GAS float* RC = (GAS float*)(F.ws + WS_ROPE); GAS float* RS = RC + T * 32;
    for (int e = F.wg * 512 + F.tid; e < T * 32; e += F.G * 512) {
        const int pos = e >> 5, i = e & 31;
        const float inv = exp2f(-(float)i * (13.287712379549449f / 32.0f));
        const double ang = (double)((float)pos * inv);
        const double kq = rint(ang * 0.15915494309189535);
        const double rr = fma(-kq, 6.283185307179586, ang) - kq * 2.4492935982947064e-16;
        const float rf = (float)rr;
        RC[e] = cosf(rf); RS[e] = sinf(rf);
    }
    GAS float* LB = (GAS float*)(F.ws + WS_LB);
    for (int e = F.wg * 512 + F.tid; e < 2 * 512; e += F.G * 512) {
        const int li = e >> 9, c = e & 511;
        const float l0 = GIN(13)[c], l1 = GIN(13)[512 + c];
        const float lb = li == 0 ? 0.f : 1.0f / (1.0f + expf(l0 - l1));
        LB[(li * 3 + 0) * 512 + c] = logf(fmaxf(lb, 1e-30f)); LB[(li * 3 + 1) * 512 + c] = log1pf(-lb); LB[(li * 3 + 2) * 512 + c] = 1.0f - lb;
    }
}

template <bool ROPE> struct EvenIn {
    static constexpr bool GATHER = false, SPLITB = false; static constexpr int KSPLIT = 0, K = 1024, lda = 1024, ldb = 1024;
    const GAS bf16* A; const GAS bf16* Bt; int G, c, li; GAS unsigned char* ws; GAS float* out;
    DI bool next(int i, pg8::Unit& u) const { if (!pg8::static_next<M / 256, (ROPE ? 6 : 8)>(G, c, i, u.pm, u.pn)) return false;
        if (ROPE) u.pn += 8;
        u.B0 = (const GAS char*)(Bt + (size_t)u.pn * 256 * 1024); u.B1 = u.B0; u.aux = 0; return true; }
    DI void epi(const AccT& acc, const pg8::Unit& u, int wr, int wc, int fr, int fq) const {
        asm volatile("" : "+v"(fr), "+v"(fq));
        const int pn = u.pn;
        const int rbase = u.pm * 256 + wr * 64 + fr;
        if constexpr (!ROPE) {
            GAS bf16* dst = (GAS bf16*)(ws + (pn < 2 ? WS_A0 : pn < 4 ? WS_A1 : pn < 6 ? WS_A2 : WS_A3));
            GAS float* LF = (GAS float*)(ws + WS_LF); const GAS float* LB = (const GAS float*)(ws + WS_LB) + li * 3 * 512;
#pragma unroll
            for (int bj = 0; bj < 2; ++bj)
#pragma unroll
                for (int n = 0; n < 2; ++n) {
                    const int col = (pn & 1) * 256 + bj * 128 + wc * 32 + n * 16 + 4 * fq;
                    f32x4 la = {0, 0, 0, 0}, lb1 = {0, 0, 0, 0}, lc = {0, 0, 0, 0};
                    if (pn == 2 || pn == 3) { la = *(const GAS f32x4*)(LB + col); lb1 = *(const GAS f32x4*)(LB + 512 + col); lc = *(const GAS f32x4*)(LB + 1024 + col); }
#pragma unroll
                    for (int ai = 0; ai < 2; ++ai)
#pragma unroll
                        for (int m = 0; m < 4; ++m) {
                            const int row = rbase + ai * 128 + m * 16; const f32x4 v = acc[ai][bj][m][n]; float o[4];
                            if (pn < 2 || pn >= 6) {
#pragma unroll
                                for (int j = 0; j < 4; ++j) o[j] = siluf_(v[j]);
                            } else if (pn < 4) {
                                f32x4 lf;
#pragma unroll
                                for (int j = 0; j < 4; ++j) { const float z = v[j]; const float e = __expf(-fabsf(z)); const float l1p = __logf(1.0f + e);
                                    const float ls = fminf(z, 0.f) - l1p;
                                    const float bb = lb1[j] + ls, aa = la[j]; const float mx = fmaxf(aa, bb);
                                    lf[j] = mx + __logf(1.0f + __expf(-fabsf(aa - bb)));
                                    const float sg = (z >= 0.f ? e : 1.0f) / (1.0f + e);
                                    o[j] = lc[j] * sg; }
                                *(GAS f32x4*)(LF + (unsigned)row * 512 + col) = lf;
                            } else {
#pragma unroll
                                for (int j = 0; j < 4; ++j) o[j] = v[j];
                            }
                            u32x2 w; w.x = pk2(o[0], o[1]); w.y = pk2(o[2], o[3]); *(GAS u32x2*)(dst + (unsigned)row * 512 + col) = w;
                        }
                    asm volatile("" ::: "memory");
                }
        } else {
        const GAS float* RC = (const GAS float*)(ws + WS_ROPE); const GAS float* RS = RC + T * 32;
        const int i0 = 16 * (wc & 1) + 4 * fq;
#pragma unroll
        for (int ai = 0; ai < 2; ++ai)
#pragma unroll
            for (int m = 0; m < 4; ++m) {
                const int row = rbase + ai * 128 + m * 16;
                const int pos = row < NPR ? row % T : PAST;
                const f32x4 cs = *(const GAS f32x4*)(RC + pos * 32 + i0), sn = *(const GAS f32x4*)(RS + pos * 32 + i0);
#pragma unroll
                for (int bj = 0; bj < 2; ++bj) {
                    const f32x4 x1 = acc[ai][bj][m][0], x2 = acc[ai][bj][m][1];
                    const f32x4 r1 = x1 * cs - x2 * sn, r2 = x2 * cs + x1 * sn;
                    const int hd = bj * 2 + (wc >> 1);
                    if (pn == 8 || pn == 9) {
                        GAS bf16* Q = (GAS bf16*)(ws + WS_QB) + (unsigned)row * 512 + (pn - 8) * 256 + hd * 64 + i0;
                        u32x2 w; w.x = pk2(r1[0] * 0.125f, r1[1] * 0.125f); w.y = pk2(r1[2] * 0.125f, r1[3] * 0.125f); *(GAS u32x2*)Q = w;
                        w.x = pk2(r2[0] * 0.125f, r2[1] * 0.125f); w.y = pk2(r2[2] * 0.125f, r2[3] * 0.125f); *(GAS u32x2*)(Q + 32) = w;
                    } else if (pn == 11 || pn == 12) {
                        GAS bf16* Q = (GAS bf16*)(ws + WS_QI) + (unsigned)row * 512 + (pn - 11) * 256 + hd * 64 + i0;
                        u32x2 w; w.x = pk2(r1[0], r1[1]); w.y = pk2(r1[2], r1[3]); *(GAS u32x2*)Q = w;
                        w.x = pk2(r2[0], r2[1]); w.y = pk2(r2[2], r2[3]); *(GAS u32x2*)(Q + 32) = w;
                    } else if (pn == 10) {
                        if (bj == 0) {
                            const int g = wc >> 1;
                            GAS float* KO = row < NPR ? out + O_KP + ((unsigned)row * 2 + li) * 128 + g * 64 + i0 : out + O_KS + ((unsigned)(row - NPR) * 2 + li) * 128 + g * 64 + i0;
                            *(GAS f32x4*)KO = r1; *(GAS f32x4*)(KO + 32) = r2;
                            GAS bf16* KB = (GAS bf16*)(ws + WS_KBB) + (unsigned)row * 128 + g * 64 + i0;
                            u32x2 w; w.x = pk2(r1[0], r1[1]); w.y = pk2(r1[2], r1[3]); *(GAS u32x2*)KB = w;
                            w.x = pk2(r2[0], r2[1]); w.y = pk2(r2[2], r2[3]); *(GAS u32x2*)(KB + 32) = w;
                        } else {
#pragma unroll
                            for (int n = 0; n < 2; ++n) {
                                const int sl = wc * 32 + n * 16 + 4 * fq; const f32x4 v = n ? x2 : x1;
                                GAS float* VO = row < NPR ? out + O_VP + ((unsigned)row * 2 + li) * 128 + sl : out + O_VS + ((unsigned)(row - NPR) * 2 + li) * 128 + sl;
                                *(GAS f32x4*)VO = v;
                                if (row < NPR) { const int b = row / T, t = row % T; GAS bf16* VT = (GAS bf16*)(ws + WS_VT) + ((unsigned)(b * 2 + (sl >> 6)) * 64 + (sl & 63)) * TP + t;
#pragma unroll
                                    for (int j = 0; j < 4; ++j) VT[(unsigned)j * TP] = (bf16)f2bf(v[j]); }
                            }
                        }
                    } else {
                        if (bj == 0 && wc < 2) {
                            GAS float* KO = row < NPR ? out + O_IP + ((unsigned)row * 2 + li) * 64 + i0 : out + O_IS + ((unsigned)(row - NPR) * 2 + li) * 64 + i0;
                            *(GAS f32x4*)KO = r1; *(GAS f32x4*)(KO + 32) = r2;
                            GAS bf16* KB = (GAS bf16*)(ws + WS_KIB) + (unsigned)row * 64 + i0;
                            u32x2 w; w.x = pk2(r1[0], r1[1]); w.y = pk2(r1[2], r1[3]); *(GAS u32x2*)KB = w;
                            w.x = pk2(r2[0], r2[1]); w.y = pk2(r2[2], r2[3]); *(GAS u32x2*)(KB + 32) = w;
                        } else if (bj == 0 && wc == 2 && fq < 2) {
                            const float sc = 0.125f * 0.35355339059327373f;
                            *(GAS f32x4*)((GAS float*)(ws + WS_WI) + (unsigned)row * 8 + 4 * fq) = x1 * sc;
                        }
                    }
                }
                asm volatile("" ::: "memory");
            }
        }
    }
};

DI int q_pop(Frame& F, int qidx) {
    __syncthreads();
    if (F.tid == 0) F.MISC[0] = __hip_atomic_fetch_add(F.ctl + CW_Q + 64 * qidx, 1u, __ATOMIC_RELAXED, __HIP_MEMORY_SCOPE_AGENT);
    __syncthreads();
    return (int)F.MISC[0];
}
#define MFMA16(a, b, c) __builtin_amdgcn_mfma_f32_16x16x32_bf16((a), (b), (c), 0, 0, 0)
#define MFMA32(a, b, c) __builtin_amdgcn_mfma_f32_32x32x16_bf16((a), (b), (c), 0, 0, 0)
DI bf16x8 pack8(const float (&v)[8]) { u32x4 p; p.x = pk2(v[0], v[1]); p.y = pk2(v[2], v[3]); p.z = pk2(v[4], v[5]); p.w = pk2(v[6], v[7]); return __builtin_bit_cast(bf16x8, p); }

DI void hgrn_prompt_item(Frame& F, int li, int b, int h) {
    constexpr int P1 = 136, P2 = 40;
    LAS bf16* QS = (LAS bf16*)(F.lds + 0);
    LAS bf16* KH = (LAS bf16*)(F.lds + 8704);
    LAS bf16* KDT = (LAS bf16*)(F.lds + 17408);
    LAS bf16* VTL = (LAS bf16*)(F.lds + 27648);
    LAS bf16* PM = (LAS bf16*)(F.lds + 37888);
    LAS bf16* ST = (LAS bf16*)(F.lds + 40448);
    LAS float* OF = (LAS float*)(F.lds + 75264);
    LAS float* BSEG = (LAS float*)(F.lds + 92160);
    LAS float* DF = (LAS float*)(F.lds + 94208);
    int tid_ = F.tid; asm volatile("" : "+v"(tid_)); LAUNDER_F(F);
    const int tid = tid_, lane = tid & 63, w = __builtin_amdgcn_readfirstlane(tid >> 6), k = tid & 127, seg = tid >> 7, l15 = lane & 15, l4 = lane >> 4;
    const GAS bf16* QA = (const GAS bf16*)(F.ws + WS_A0); const GAS bf16* KA = (const GAS bf16*)(F.ws + WS_A1); const GAS bf16* VA = (const GAS bf16*)(F.ws + WS_A2); const GAS bf16* GA = (const GAS bf16*)(F.ws + WS_A3);
    const GAS float* LF = (const GAS float*)(F.ws + WS_LF); GAS bf16* MIX = (GAS bf16*)(F.ws + WS_MIX);
    const GAS float* NG = GIN(14) + li * 128;
    f32x4 S[8];
#pragma unroll
    for (int i = 0; i < 8; ++i) S[i] = (f32x4){0.f, 0.f, 0.f, 0.f};
    float clf[8], cq[8], ck[8], cv[8];
    const size_t colb = (size_t)h * 128 + k;
#define HG_LOAD(c) do { _Pragma("unroll") for (int i = 0; i < 8; ++i) { const int t = 32 * (c) + 8 * seg + i; if (t < T) { const size_t o = (size_t)(b * T + t) * 512 + colb; \
        clf[i] = LF[o]; cq[i] = bf2f(QA[o]); ck[i] = bf2f(KA[o]); cv[i] = bf2f(VA[o]); } else { clf[i] = 0.f; cq[i] = 0.f; ck[i] = 0.f; cv[i] = 0.f; } } } while (0)
    HG_LOAD(0);
    constexpr int NCH = (T + 31) / 32;
    for (int c = 0; c < NCH; ++c) {
        float cs[8]; float run = 0.f;
#pragma unroll
        for (int i = 0; i < 8; ++i) { run += clf[i]; cs[i] = run; }
        BSEG[seg * 128 + k] = run;
        __syncthreads();
        float pre = 0.f, tot = 0.f;
#pragma unroll
        for (int sgi = 0; sgi < 4; ++sgi) { const float v = BSEG[sgi * 128 + k]; tot += v; if (sgi < seg) pre += v; }
        float kd[8];
#pragma unroll
        for (int i = 0; i < 8; ++i) { const float bb = pre + cs[i]; const int t = 8 * seg + i;
            QS[t * P1 + k] = (bf16)f2bf(cq[i] * __expf(bb)); KH[t * P1 + k] = (bf16)f2bf(ck[i] * __expf(-bb)); kd[i] = ck[i] * __expf(tot - bb); }
        *(LAS bf16x8*)(KDT + k * P2 + 8 * seg) = pack8(kd);
        *(LAS bf16x8*)(VTL + k * P2 + 8 * seg) = pack8(cv);
        if (seg == 0) DF[k] = __expf(tot);
#pragma unroll
        for (int i = 0; i < 8; ++i) { u32x2 o; o.x = pk2(S[i][0], S[i][1]); o.y = pk2(S[i][2], S[i][3]); *(LAS u32x2*)(ST + (16 * w + l15) * P1 + 16 * i + 4 * l4) = o; }
        if (c + 1 < NCH) HG_LOAD(c + 1);
        __syncthreads();
        if (w < 4) {
            const int ti = w >> 1, tj = w & 1; f32x4 pacc = {0.f, 0.f, 0.f, 0.f};
            if (tj <= ti) {
#pragma unroll
                for (int ks = 0; ks < 4; ++ks) { const bf16x8 a = *(const LAS bf16x8*)(QS + (16 * ti + l15) * P1 + 32 * ks + 8 * l4); const bf16x8 bb = *(const LAS bf16x8*)(KH + (16 * tj + l15) * P1 + 32 * ks + 8 * l4); pacc = MFMA16(a, bb, pacc); }
            }
#pragma unroll
            for (int r = 0; r < 4; ++r) { const int t = 16 * ti + 4 * l4 + r, sidx = 16 * tj + l15; PM[t * P2 + sidx] = (bf16)f2bf(sidx <= t ? pacc[r] : 0.f); }
        }
        __syncthreads();
        {
            const bf16x8 bv = *(const LAS bf16x8*)(VTL + (16 * w + l15) * P2 + 8 * l4);
#pragma unroll
            for (int ti = 0; ti < 2; ++ti) {
                f32x4 o = {0.f, 0.f, 0.f, 0.f};
                o = MFMA16(*(const LAS bf16x8*)(PM + (16 * ti + l15) * P2 + 8 * l4), bv, o);
#pragma unroll
                for (int ks = 0; ks < 4; ++ks) o = MFMA16(*(const LAS bf16x8*)(QS + (16 * ti + l15) * P1 + 32 * ks + 8 * l4), *(const LAS bf16x8*)(ST + (16 * w + l15) * P1 + 32 * ks + 8 * l4), o);
#pragma unroll
                for (int r = 0; r < 4; ++r) OF[(16 * ti + 4 * l4 + r) * 132 + 16 * w + l15] = o[r];
            }
#pragma unroll
            for (int i = 0; i < 8; ++i) { const f32x4 d = *(const LAS f32x4*)(DF + 16 * i + 4 * l4); f32x4 sc = S[i] * d;
                S[i] = MFMA16(*(const LAS bf16x8*)(KDT + (16 * i + l15) * P2 + 8 * l4), bv, sc); }
        }
        __syncthreads();
        {
            const int t = tid >> 4, part = tid & 15, tg = 32 * c + t;
            float o[8]; float ss = 0.f;
#pragma unroll
            for (int j = 0; j < 8; ++j) { o[j] = OF[t * 132 + 8 * part + j]; ss += o[j] * o[j]; }
            ss += __shfl_xor(ss, 1); ss += __shfl_xor(ss, 2); ss += __shfl_xor(ss, 4); ss += __shfl_xor(ss, 8);
            if (tg < T) { const float rs = rsqrtf(ss * (1.0f / 128.0f) + RMS_EPS); const size_t ro = (size_t)(b * T + tg) * 512 + h * 128 + 8 * part;
                const u32x4 g4 = *(const GAS u32x4*)(GA + ro); const unsigned gw[4] = {g4.x, g4.y, g4.z, g4.w}; float r8[8];
#pragma unroll
                for (int j = 0; j < 8; ++j) { const float gv = bf2f((gw[j >> 1] >> (16 * (j & 1))) & 0xffffu); r8[j] = o[j] * rs * NG[8 * part + j] * gv; }
                *(GAS bf16x8*)(MIX + (size_t)(b * T + tg) * 1024 + h * 128 + 8 * part) = pack8(r8); }
        }
    }
#undef HG_LOAD
    GAS float* HO = F.out + O_HP + ((size_t)((b * 2 + li) * 4 + h) * 128) * 128;
#pragma unroll
    for (int i = 0; i < 8; ++i)
#pragma unroll
        for (int r = 0; r < 4; ++r) HO[(size_t)(16 * i + 4 * l4 + r) * 128 + 16 * w + l15] = S[i][r];
}

DI void hgrn_sample_item(Frame& F, int li, int s) {
    LAS float* RED = (LAS float*)(F.lds + 0);
    int tid_ = F.tid; asm volatile("" : "+v"(tid_)); LAUNDER_F(F);
    const int tid = tid_, lane = tid & 63, kg = tid >> 5, v4 = tid & 31, row = NPR + s;
    const GAS bf16* QA = (const GAS bf16*)(F.ws + WS_A0); const GAS bf16* KA = (const GAS bf16*)(F.ws + WS_A1); const GAS bf16* VA = (const GAS bf16*)(F.ws + WS_A2); const GAS bf16* GA = (const GAS bf16*)(F.ws + WS_A3);
    const GAS float* LF = (const GAS float*)(F.ws + WS_LF); GAS bf16* MIX = (GAS bf16*)(F.ws + WS_MIX); const GAS float* NG = GIN(14) + li * 128;
    for (int h = 0; h < 4; ++h) {
        const GAS float* S0 = GIN(5) + ((size_t)((s * 2 + li) * 4 + h) * 128) * 128; GAS float* S1 = F.out + O_HS + ((size_t)((s * 2 + li) * 4 + h) * 128) * 128;
        const size_t ro = (size_t)row * 512 + h * 128;
        f32x4 vv; { const u32x2 vr = *(const GAS u32x2*)(VA + ro + 4 * v4); vv = (f32x4){bf2f(vr.x & 0xffffu), bf2f(vr.x >> 16), bf2f(vr.y & 0xffffu), bf2f(vr.y >> 16)}; }
        f32x4 o4 = {0.f, 0.f, 0.f, 0.f};
#pragma unroll
        for (int kk = 0; kk < 8; ++kk) { const int k = 8 * kg + kk; const float dec = __expf(LF[ro + k]), ka = bf2f(KA[ro + k]), q = bf2f(QA[ro + k]);
            const f32x4 sv = *(const GAS f32x4*)(S0 + (size_t)k * 128 + 4 * v4); const f32x4 nv = sv * dec + vv * ka; *(GAS f32x4*)(S1 + (size_t)k * 128 + 4 * v4) = nv; o4 += nv * q; }
        __syncthreads();
        *(LAS f32x4*)(RED + kg * 128 + 4 * v4) = o4;
        __syncthreads();
        if (tid < 64) {
            float oa = 0.f, ob = 0.f;
#pragma unroll
            for (int g = 0; g < 16; ++g) { oa += RED[g * 128 + lane]; ob += RED[g * 128 + 64 + lane]; }
            const float ss = wave_sum(oa * oa + ob * ob); const float rs = rsqrtf(ss * (1.0f / 128.0f) + RMS_EPS);
            MIX[(size_t)row * 1024 + h * 128 + lane] = (bf16)f2bf(oa * rs * NG[lane] * bf2f(GA[ro + lane]));
            MIX[(size_t)row * 1024 + h * 128 + 64 + lane] = (bf16)f2bf(ob * rs * NG[64 + lane] * bf2f(GA[ro + 64 + lane]));
        }
    }
}

DI unsigned ord_key(float v) { const unsigned bits = __builtin_bit_cast(unsigned, v); return (bits & 0x80000000u) ? ~bits : (bits | 0x80000000u); }
DI u64 select256(const unsigned (&u)[33], int lane) {
    unsigned Tv = 0u;
    for (int bit = 31; bit >= 0; --bit) {
        const unsigned cand = Tv | (1u << bit); int cnt = 0;
#pragma unroll
        for (int j = 0; j < 33; ++j) cnt += __builtin_popcountll(__ballot(u[j] >= cand));
        if (cnt >= 256) Tv = cand;
    }
    int ngt = 0;
#pragma unroll
    for (int j = 0; j < 33; ++j) ngt += __builtin_popcountll(__ballot(u[j] > Tv));
    int need = 256 - ngt; u64 my = 0ull;
#pragma unroll
    for (int j = 0; j < 33; ++j) {
        const u64 gt = __ballot(u[j] > Tv), eq = __ballot(u[j] == Tv); const int c = __builtin_popcountll(eq); u64 take;
        if (c <= need) { take = eq; need -= c; }
        else { take = 0ull; u64 e = eq; for (int z = 0; z < need; ++z) { const u64 low = e & (~e + 1ull); take |= low; e ^= low; } need = 0; }
        const u64 wd = gt | take; my = (lane == j) ? wd : my;
    }
    return my;
}

DI void dsa_prompt_item(Frame& F, int b, int qblk) {
    constexpr int QP = 520;
    LAS bf16* QIL = (LAS bf16*)(F.lds + 0);
    LAS u64* MASK = (LAS u64*)(F.lds + 66560);
    int tid_ = F.tid; asm volatile("" : "+v"(tid_)); LAUNDER_F(F);
    const int tid = tid_, lane = tid & 63, w = __builtin_amdgcn_readfirstlane(tid >> 6), l31 = lane & 31, hh = lane >> 5;
    const int q0 = 64 * qblk, nq = (T - q0) < 64 ? (T - q0) : 64, tmax = q0 + nq - 1, nkt = tmax / 32 + 1;
    const GAS bf16* QI = (const GAS bf16*)(F.ws + WS_QI); const GAS bf16* KIB = (const GAS bf16*)(F.ws + WS_KIB); const GAS float* WI = (const GAS float*)(F.ws + WS_WI);
    const GAS bf16* QB = (const GAS bf16*)(F.ws + WS_QB); const GAS bf16* KBB = (const GAS bf16*)(F.ws + WS_KBB); const GAS bf16* VT = (const GAS bf16*)(F.ws + WS_VT); GAS bf16* MIX = (GAS bf16*)(F.ws + WS_MIX);
    GAS float* SC = (GAS float*)(F.ws + WS_SC) + (size_t)F.wg * 64 * TP;
    const size_t rb = (size_t)b * T;
#pragma unroll
    for (int i = 0; i < 8; ++i) { const int e = tid + 512 * i, r = e >> 6, c8 = e & 63; const int t = q0 + r < T ? q0 + r : T - 1;
        *(LAS u32x4*)(QIL + r * QP + 8 * c8) = *(const GAS u32x4*)(QI + (rb + t) * 512 + 8 * c8); }
    __syncthreads();
    {
        const int qh = w & 1, tq = q0 + 32 * qh + l31, tqc = tq < T ? tq : T - 1;
        float wq[8]; { const f32x4 a = *(const GAS f32x4*)(WI + (rb + tqc) * 8), c = *(const GAS f32x4*)(WI + (rb + tqc) * 8 + 4); wq[0] = a[0]; wq[1] = a[1]; wq[2] = a[2]; wq[3] = a[3]; wq[4] = c[0]; wq[5] = c[1]; wq[6] = c[2]; wq[7] = c[3]; }
        const int tlast = (q0 + 32 * qh + 31) < tmax ? (q0 + 32 * qh + 31) : tmax;
        if (q0 + 32 * qh <= tmax)
        for (int kt = (w >> 1); 32 * kt <= tlast; kt += 4) {
            const int key = 32 * kt + l31, keyc = key < T ? key : T - 1;
            bf16x8 ka[4];
#pragma unroll
            for (int ks = 0; ks < 4; ++ks) ka[ks] = *(const GAS bf16x8*)(KIB + (rb + keyc) * 64 + 16 * ks + 8 * hh);
            f32x16 tot;
#pragma unroll
            for (int r = 0; r < 16; ++r) tot[r] = 0.f;
#pragma unroll
            for (int hd = 0; hd < 8; ++hd) {
                asm volatile("" ::: "memory");
                f32x16 a;
#pragma unroll
                for (int r = 0; r < 16; ++r) a[r] = 0.f;
#pragma unroll
                for (int ks = 0; ks < 4; ++ks) a = MFMA32(ka[ks], *(const LAS bf16x8*)(QIL + (32 * qh + l31) * QP + hd * 64 + 16 * ks + 8 * hh), a);
#pragma unroll
                for (int r = 0; r < 16; ++r) tot[r] += wq[hd] * fmaxf(a[r], 0.f);
            }
            if (tq < T) {
#pragma unroll
                for (int g = 0; g < 4; ++g) *(GAS f32x4*)(SC + (size_t)(32 * qh + l31) * TP + 32 * kt + 8 * g + 4 * hh) = (f32x4){tot[4 * g], tot[4 * g + 1], tot[4 * g + 2], tot[4 * g + 3]};
            }
        }
    }
    __syncthreads();
    for (int i = 0; i < 8; ++i) {
        const int q = w * 8 + i, t = q0 + q; LAS u64* mrow = MASK + q * 34;
        if (t >= T) { if (lane < 34) mrow[lane] = 0ull; continue; }
        const int jfull = t >> 6, rem = t & 63;
        if (t + 1 <= 256) { if (lane < 34) mrow[lane] = lane < jfull ? ~0ull : (lane == jfull ? ((2ull << rem) - 1ull) : 0ull); continue; }
        unsigned u[33];
#pragma unroll
        for (int j = 0; j < 33; ++j) { const int sidx = 64 * j + lane; u[j] = sidx <= t ? ord_key(SC[(size_t)q * TP + sidx]) : 0u; }
        const u64 my = select256(u, lane);
        if (lane < 34) mrow[lane] = lane < 33 ? my : 0ull;
    }
    __syncthreads();
    {
        const int hd = w, g = hd >> 2;
        const LAS unsigned* M32 = (const LAS unsigned*)MASK;
        for (int qh = 0; qh < 2; ++qh) {
            if (q0 + 32 * qh > tmax) break;
            const int tq = q0 + 32 * qh + l31, tqc = tq < T ? tq : T - 1;
            bf16x8 qf[4];
#pragma unroll
            for (int ks = 0; ks < 4; ++ks) qf[ks] = *(const GAS bf16x8*)(QB + (rb + tqc) * 512 + hd * 64 + 16 * ks + 8 * hh);
            f32x16 O[2]; float mrun = -INFINITY, lrun = 0.f;
#pragma unroll
            for (int dt = 0; dt < 2; ++dt)
#pragma unroll
                for (int r = 0; r < 16; ++r) O[dt][r] = 0.f;
            const int tlast = (q0 + 32 * qh + 31) < tmax ? (q0 + 32 * qh + 31) : tmax;
            for (int kt = 0; 32 * kt <= tlast; ++kt) {
                const int key = 32 * kt + l31, keyc = key < T ? key : T - 1;
                bf16x8 kf[4];
#pragma unroll
                for (int ks = 0; ks < 4; ++ks) kf[ks] = *(const GAS bf16x8*)(KBB + (rb + keyc) * 128 + g * 64 + 16 * ks + 8 * hh);
                bf16x8 vf[2][2];
#pragma unroll
                for (int dt = 0; dt < 2; ++dt)
#pragma unroll
                    for (int s2 = 0; s2 < 2; ++s2) { const GAS bf16* vp = VT + ((size_t)(b * 2 + g) * 64 + 32 * dt + l31) * TP + 32 * kt + 16 * s2 + 4 * hh;
                        const u32x2 lo = *(const GAS u32x2*)vp, hi = *(const GAS u32x2*)(vp + 8); u32x4 pk; pk.x = lo.x; pk.y = lo.y; pk.z = hi.x; pk.w = hi.y; vf[dt][s2] = __builtin_bit_cast(bf16x8, pk); }
                f32x16 sa;
#pragma unroll
                for (int r = 0; r < 16; ++r) sa[r] = 0.f;
#pragma unroll
                for (int ks = 0; ks < 4; ++ks) sa = MFMA32(kf[ks], qf[ks], sa);
                const unsigned mw = M32[(32 * qh + l31) * 68 + kt] >> (4 * hh);
                float mx = -INFINITY;
#pragma unroll
                for (int r = 0; r < 16; ++r) { const bool on = (mw >> ((r & 3) + 8 * (r >> 2))) & 1u; sa[r] = on ? sa[r] : -INFINITY; mx = fmaxf(mx, sa[r]); }
                mx = fmaxf(mx, __shfl_xor(mx, 32));
                const float mnew = fmaxf(mrun, mx);
                const float msafe = mnew == -INFINITY ? 0.f : mnew;
                const float alpha = __expf(mrun - msafe);
                float pr[16]; float rs = 0.f;
#pragma unroll
                for (int r = 0; r < 16; ++r) { pr[r] = __expf(sa[r] - msafe); rs += pr[r]; }
                rs += __shfl_xor(rs, 32);
                lrun = lrun * alpha + rs; mrun = mnew;
#pragma unroll
                for (int dt = 0; dt < 2; ++dt)
#pragma unroll
                    for (int r = 0; r < 16; ++r) O[dt][r] *= alpha;
#pragma unroll
                for (int s2 = 0; s2 < 2; ++s2) {
                    const float pv[8] = {pr[8 * s2], pr[8 * s2 + 1], pr[8 * s2 + 2], pr[8 * s2 + 3], pr[8 * s2 + 4], pr[8 * s2 + 5], pr[8 * s2 + 6], pr[8 * s2 + 7]};
                    const bf16x8 pf = pack8(pv);
#pragma unroll
                    for (int dt = 0; dt < 2; ++dt) O[dt] = MFMA32(vf[dt][s2], pf, O[dt]);
                }
            }
            if (tq < T) { const float inv = 1.0f / lrun;
#pragma unroll
                for (int dt = 0; dt < 2; ++dt)
#pragma unroll
                    for (int g4 = 0; g4 < 4; ++g4) { u32x2 o; o.x = pk2(O[dt][4 * g4] * inv, O[dt][4 * g4 + 1] * inv); o.y = pk2(O[dt][4 * g4 + 2] * inv, O[dt][4 * g4 + 3] * inv);
                        *(GAS u32x2*)(MIX + (rb + tq) * 1024 + 512 + hd * 64 + 32 * dt + 8 * g4 + 4 * hh) = o; } }
        }
    }
}

DI void dsa_sample_item(Frame& F, int li, int s) {
    LAS float* QIF = (LAS float*)(F.lds + 0);
    LAS float* QBF = (LAS float*)(F.lds + 2048);
    LAS float* WIF = (LAS float*)(F.lds + 4096);
    LAS float* SCL = (LAS float*)(F.lds + 4352);
    LAS int* SEL = (LAS int*)(F.lds + 12800);
    LAS float* LG = (LAS float*)(F.lds + 13824);
    int tid_ = F.tid; asm volatile("" : "+v"(tid_)); LAUNDER_F(F);
    const int tid = tid_, lane = tid & 63, wv = __builtin_amdgcn_readfirstlane(tid >> 6), row = NPR + s;
    const GAS int* PT = (const GAS int*)GIN(9) + s * NPAGES;
    QIF[tid] = bf2f(((const GAS bf16*)(F.ws + WS_QI))[(size_t)row * 512 + tid]);
    QBF[tid] = bf2f(((const GAS bf16*)(F.ws + WS_QB))[(size_t)row * 512 + tid]);
    if (tid < 8) WIF[tid] = ((const GAS float*)(F.ws + WS_WI))[(size_t)row * 8 + tid];
    __syncthreads();
    {
        const GAS float* kp[4];
#pragma unroll
        for (int i = 0; i < 4; ++i) { const int n = tid + 512 * i; const int pg = PT[n >> 7]; kp[i] = GIN(4) + ((size_t)(pg * PAGE + (n & 127)) * 2 + li) * 64; }
        float acc[4][8];
#pragma unroll
        for (int i = 0; i < 4; ++i)
#pragma unroll
            for (int hd = 0; hd < 8; ++hd) acc[i][hd] = 0.f;
#pragma unroll 2
        for (int dq = 0; dq < 16; ++dq) {
            f32x4 kv[4];
#pragma unroll
            for (int i = 0; i < 4; ++i) kv[i] = *(const GAS f32x4*)(kp[i] + 4 * dq);
#pragma unroll
            for (int hd = 0; hd < 8; ++hd) { const f32x4 qv = *(const LAS f32x4*)(QIF + hd * 64 + 4 * dq);
#pragma unroll
                for (int i = 0; i < 4; ++i) acc[i][hd] += kv[i][0] * qv[0] + kv[i][1] * qv[1] + kv[i][2] * qv[2] + kv[i][3] * qv[3]; }
        }
#pragma unroll
        for (int i = 0; i < 4; ++i) { float sc = 0.f;
#pragma unroll
            for (int hd = 0; hd < 8; ++hd) sc += WIF[hd] * fmaxf(acc[i][hd], 0.f);
            SCL[tid + 512 * i] = sc; }
        if (tid < 64) {
            const float kvn = F.out[O_IS + ((size_t)s * 2 + li) * 64 + lane]; float sc = 0.f;
#pragma unroll
            for (int hd = 0; hd < 8; ++hd) { const float d = wave_sum(kvn * QIF[hd * 64 + lane]); sc += WIF[hd] * fmaxf(d, 0.f); }
            if (lane == 0) SCL[2048] = sc;
        }
    }
    __syncthreads();
    if (wv == 0) {
        unsigned u[33];
#pragma unroll
        for (int j = 0; j < 33; ++j) { const int sidx = 64 * j + lane; u[j] = sidx <= PAST ? ord_key(SCL[sidx]) : 0u; }
        const u64 my = select256(u, lane);
        int base = 0;
#pragma unroll
        for (int j = 0; j < 33; ++j) { const u64 wd = __shfl(my, j); const bool on = (wd >> lane) & 1ull; const int pos = base + __builtin_popcountll(wd & ((1ull << lane) - 1ull));
            if (on && pos < 256) SEL[pos] = 64 * j + lane; base += __builtin_popcountll(wd); }
    }
    __syncthreads();
    {
        const int n = tid >> 1, g = tid & 1, idx = SEL[n];
        const GAS float* kp = idx < PAST ? GIN(2) + ((size_t)(PT[idx >> 7] * PAGE + (idx & 127)) * 2 + li) * 128 + g * 64 : F.out + O_KS + ((size_t)s * 2 + li) * 128 + g * 64;
        float a4[4] = {0.f, 0.f, 0.f, 0.f};
#pragma unroll 4
        for (int dq = 0; dq < 16; ++dq) { const f32x4 kv = *(const GAS f32x4*)(kp + 4 * dq);
#pragma unroll
            for (int i = 0; i < 4; ++i) { const f32x4 qv = *(const LAS f32x4*)(QBF + (4 * g + i) * 64 + 4 * dq); a4[i] += kv[0] * qv[0] + kv[1] * qv[1] + kv[2] * qv[2] + kv[3] * qv[3]; } }
#pragma unroll
        for (int i = 0; i < 4; ++i) LG[(4 * g + i) * 256 + n] = a4[i];
    }
    __syncthreads();
    {
        const int hd = wv; float v[4]; float mx = -INFINITY;
#pragma unroll
        for (int i = 0; i < 4; ++i) { v[i] = LG[hd * 256 + lane + 64 * i]; mx = fmaxf(mx, v[i]); }
#pragma unroll
        for (int o = 1; o < 64; o <<= 1) mx = fmaxf(mx, __shfl_xor(mx, o));
        float sm = 0.f;
#pragma unroll
        for (int i = 0; i < 4; ++i) { v[i] = __expf(v[i] - mx); sm += v[i]; }
        sm = wave_sum(sm); const float inv = 1.0f / sm;
#pragma unroll
        for (int i = 0; i < 4; ++i) LG[hd * 256 + lane + 64 * i] = v[i] * inv;
    }
    __syncthreads();
    {
        const int hd = tid >> 6, g = hd >> 2; float o = 0.f;
        for (int n = 0; n < 256; ++n) { const int idx = SEL[n];
            const GAS float* vp = idx < PAST ? GIN(3) + ((size_t)(PT[idx >> 7] * PAGE + (idx & 127)) * 2 + li) * 128 + g * 64 : F.out + O_VS + ((size_t)s * 2 + li) * 128 + g * 64;
            o += LG[hd * 256 + n] * vp[lane]; }
        ((GAS bf16*)(F.ws + WS_MIX))[(size_t)row * 1024 + 512 + hd * 64 + lane] = (bf16)f2bf(o);
    }
}

struct OutProj {
    static constexpr bool GATHER = false, SPLITB = false; static constexpr int KSPLIT = 0, K = 1024, lda = 1024, ldb = 1024;
    const GAS bf16* A; const GAS bf16* Bt; int G, c; GAS float* X;
    DI bool next(int i, pg8::Unit& u) const { if (!pg8::static_next<M / 256, 4>(G, c, i, u.pm, u.pn)) return false;
        u.B0 = (const GAS char*)(Bt + (size_t)u.pn * 256 * 1024); u.B1 = u.B0; u.aux = 0; return true; }
    DI void epi(const AccT& acc, const pg8::Unit& u, int wr, int wc, int fr, int fq) const {
        asm volatile("" : "+v"(fr), "+v"(fq));
#pragma unroll
        for (int ai = 0; ai < 2; ++ai)
#pragma unroll
            for (int m = 0; m < 4; ++m) { GAS float* rp = X + (unsigned)(u.pm * 256 + ai * 128 + wr * 64 + m * 16 + fr) * D + u.pn * 256 + wc * 32 + 4 * fq;
#pragma unroll
                for (int bj = 0; bj < 2; ++bj)
#pragma unroll
                    for (int n = 0; n < 2; ++n) { GAS f32x4* q = (GAS f32x4*)(rp + bj * 128 + n * 16); *q = *q * DN_ALPHA + acc[ai][bj][m][n]; }
                asm volatile("" ::: "memory"); }
    }
};

DI void p_ln(Frame& F, int layer, bool second, bool final_) {
    int tid_ = F.tid; asm volatile("" : "+v"(tid_)); LAUNDER_F(F);
    const int tid = tid_, lane = tid & 63, wv = __builtin_amdgcn_readfirstlane(tid >> 6);
    const bool route = !second;
    LAS float* RW = (LAS float*)(F.lds + 0);
    if (route) {
        const GAS float* gw = GIN(32) + (size_t)layer * 1024 * 4; const GAS float* ew = GIN(34) + (size_t)layer * 1024 * 16;
        for (int e = tid; e < 1024 * 4; e += 512) RW[(e >> 2) * 20 + (e & 3)] = gw[e];
        for (int e = tid; e < 1024 * 16; e += 512) RW[(e >> 4) * 20 + 4 + (e & 15)] = ew[e];
        __syncthreads();
    }
    const GAS float* lg = GIN(second ? 30 : 28) + layer * D; const GAS float* lb = GIN(second ? 31 : 29) + layer * D;
    f32x4 g4[4], b4[4];
#pragma unroll
    for (int j = 0; j < 4; ++j) { g4[j] = *((const GAS f32x4*)lg + lane + 64 * j); b4[j] = *((const GAS f32x4*)lb + lane + 64 * j); }
    GAS float* X = (GAS float*)(F.ws + WS_X); GAS bf16* XB = (GAS bf16*)(F.ws + WS_XB);
    for (int m = F.wg * 8 + wv; m < M; m += F.G * 8) {
        asm volatile("" ::: "memory");
        f32x4 v[4]; float sm = 0.f;
#pragma unroll
        for (int j = 0; j < 4; ++j) { v[j] = *((const GAS f32x4*)(X + (size_t)m * D) + lane + 64 * j); sm += (v[j][0] + v[j][1]) + (v[j][2] + v[j][3]); }
        const float mean = wave_sum(sm) * (1.0f / D); float s2 = 0.f;
#pragma unroll
        for (int j = 0; j < 4; ++j) { v[j] = v[j] - mean; s2 += (v[j][0] * v[j][0] + v[j][1] * v[j][1]) + (v[j][2] * v[j][2] + v[j][3] * v[j][3]); }
        const float rstd = rsqrtf(wave_sum(s2) * (1.0f / D) + LN_EPS);
#pragma unroll
        for (int j = 0; j < 4; ++j) v[j] = v[j] * rstd * g4[j] + b4[j];
        if (final_) {
            GAS float* dst = nullptr;
            if (m < NPR) { const int b = m / T, t = m % T; if (t >= NMETA) dst = F.out + O_YP + ((size_t)b * SEQ + (t - NMETA)) * D; }
            else dst = F.out + O_YS + (size_t)(m - NPR) * D;
            if (dst) {
#pragma unroll
                for (int j = 0; j < 4; ++j) *((GAS f32x4*)dst + lane + 64 * j) = v[j]; }
        } else {
#pragma unroll
            for (int j = 0; j < 4; ++j) { *((GAS f32x4*)(X + (size_t)m * D) + lane + 64 * j) = v[j]; u32x2 o; o.x = pk2(v[j][0], v[j][1]); o.y = pk2(v[j][2], v[j][3]); *((GAS u32x2*)(XB + (size_t)m * D) + lane + 64 * j) = o; }
        }
        if (route) {
            float pl[20];
#pragma unroll
            for (int e = 0; e < 20; ++e) pl[e] = 0.f;
#pragma unroll
            for (int j = 0; j < 4; ++j)
#pragma unroll
                for (int i = 0; i < 4; ++i) { const LAS float* wp = RW + (4 * lane + 256 * j + i) * 20; const float xv = v[j][i];
#pragma unroll
                    for (int q = 0; q < 5; ++q) { const f32x4 wq = *(const LAS f32x4*)(wp + 4 * q); pl[4 * q] += xv * wq[0]; pl[4 * q + 1] += xv * wq[1]; pl[4 * q + 2] += xv * wq[2]; pl[4 * q + 3] += xv * wq[3]; } }
#pragma unroll
            for (int e = 0; e < 20; ++e) pl[e] = wave_sum(pl[e]);
            const GAS float* gb = GIN(33) + layer * 4; const GAS float* eb = GIN(35) + layer * 16;
            float l0 = pl[0] + gb[0], l1 = pl[1] + gb[1], l2 = pl[2] + gb[2], l3 = pl[3] + gb[3];
            int g = 0; float lm = l0; if (l1 > lm) { lm = l1; g = 1; } if (l2 > lm) { lm = l2; g = 2; } if (l3 > lm) { lm = l3; g = 3; }
            const float gval = 1.0f / (__expf(l0 - lm) + __expf(l1 - lm) + __expf(l2 - lm) + __expf(l3 - lm));
            float le[4];
#pragma unroll
            for (int i = 0; i < 4; ++i) le[i] = (g == 0 ? pl[4 + i] : g == 1 ? pl[8 + i] : g == 2 ? pl[12 + i] : pl[16 + i]) + eb[4 * g + i];
            int ea = 0; float la = le[0];
#pragma unroll
            for (int i = 1; i < 4; ++i) if (le[i] > la) { la = le[i]; ea = i; }
            int e2 = -1; float l2b = -INFINITY;
#pragma unroll
            for (int i = 0; i < 4; ++i) if (i != ea && le[i] > l2b) { l2b = le[i]; e2 = i; }
            const float p1 = 1.0f / (1.0f + __expf(l2b - la)), p2 = 1.0f - p1;
            const int lo = ea < e2 ? ea : e2, hi = ea < e2 ? e2 : ea;
            const float glo = gval * (ea < e2 ? p1 : p2), ghi = gval * (ea < e2 ? p2 : p1);
            const int pr = lo == 0 ? hi - 1 : (lo == 1 ? hi + 1 : 5), cls = g * 6 + pr;
            if (lane == 0) {
                const unsigned pos = __hip_atomic_fetch_add(F.ctl + CW_CNT + layer * 64 + cls, 1u, __ATOMIC_RELAXED, __HIP_MEMORY_SCOPE_AGENT);
                ((GAS int*)(F.ws + WS_TOK))[(size_t)cls * CLS_CAP + pos] = m;
                *(GAS f32x2*)((GAS float*)(F.ws + WS_GATE) + (size_t)m * 2) = (f32x2){glo, ghi};
            }
        }
    }
}

DI void moe_setup(Frame& F, int layer) {
    int tid = F.tid; asm volatile("" : "+v"(tid));
    __syncthreads();
    if (tid < NCLS) F.MISC[48 + tid] = __hip_atomic_load(F.ctl + CW_CNT + layer * 64 + tid, __ATOMIC_RELAXED, __HIP_MEMORY_SCOPE_AGENT);
    __syncthreads();
    if (tid == 0) { unsigned run = 0; for (int c = 0; c < NCLS; ++c) { F.MISC[16 + c] = run; run += (F.MISC[48 + c] + 255u) >> 8; } F.MISC[16 + NCLS] = run; }
    __syncthreads();
}
DI void cls_experts(int cls, int& elo, int& ehi) { const int g = cls / 6, pr = cls % 6; const int lo = pr < 3 ? 0 : (pr < 5 ? 1 : 2), hi = pr < 3 ? pr + 1 : (pr < 5 ? pr - 1 : 3); elo = g * 4 + lo; ehi = g * 4 + hi; }
DI bool moe_next(const volatile LAS unsigned* MISC, int G, int c, int i, int& cp, int& pn, int& cls) {
    const int npan = __builtin_amdgcn_readfirstlane((int)MISC[16 + NCLS]); const long L = (long)i * G + c; if (L >= 4L * npan) return false;
    cp = (int)(L >> 2); pn = (int)(L & 3); cls = 0;
    for (int k = 1; k < NCLS; ++k) if (__builtin_amdgcn_readfirstlane((int)MISC[16 + k]) <= cp) cls = k;
    return true;
}
struct MoeUp {
    static constexpr bool GATHER = true, SPLITB = false; static constexpr int KSPLIT = 0, K = 1024, lda = 1024, ldb = 1024;
    const GAS bf16* A; int G, c, layer; GAS unsigned char* ws; const volatile LAS unsigned* MISC;
    DI bool next(int i, pg8::Unit& u) const { int cp, pn, cls; if (!moe_next(MISC, G, c, i, cp, pn, cls)) return false;
        int elo, ehi; cls_experts(cls, elo, ehi); const int e = pn < 2 ? elo : ehi;
        u.pm = cp; u.pn = pn; u.aux = cls; u.B0 = (const GAS char*)((const GAS bf16*)(ws + WS_WGU) + ((size_t)(layer * 16 + e) * 512 + (pn & 1) * 256) * 1024); u.B1 = u.B0; return true; }
    DI unsigned a_row(const pg8::Unit& u, int r) const { const int cls = u.aux, cnt = __builtin_amdgcn_readfirstlane((int)MISC[48 + cls]); int slot = (u.pm - __builtin_amdgcn_readfirstlane((int)MISC[16 + cls])) * 256 + r; slot = slot < cnt ? slot : cnt - 1;
        const int tok = ((const GAS int*)(ws + WS_TOK))[(size_t)cls * CLS_CAP + slot]; return (unsigned)tok * 2048u; }
    DI void epi(const AccT& acc, const pg8::Unit& u, int wr, int wc, int fr, int fq) const {
        asm volatile("" : "+v"(fr), "+v"(fq));
        const int cls = u.aux, cnt = __builtin_amdgcn_readfirstlane((int)MISC[48 + cls]), sbase = (u.pm - __builtin_amdgcn_readfirstlane((int)MISC[16 + cls])) * 256;
        GAS bf16* H = (GAS bf16*)(ws + WS_H);
#pragma unroll
        for (int ai = 0; ai < 2; ++ai)
#pragma unroll
            for (int m = 0; m < 4; ++m) { const int r = ai * 128 + wr * 64 + m * 16 + fr; int slot = sbase + r; slot = slot < cnt ? slot : cnt - 1;
                const int tok = ((const GAS int*)(ws + WS_TOK))[(unsigned)cls * CLS_CAP + slot]; const float gate = ((const GAS float*)(ws + WS_GATE))[(unsigned)tok * 2 + (u.pn >> 1)];
#pragma unroll
                for (int n = 0; n < 2; ++n) { const f32x4 gv = acc[ai][0][m][n], uv = acc[ai][1][m][n]; u32x2 o;
                    o.x = pk2(siluf_(gv[0]) * uv[0] * gate, siluf_(gv[1]) * uv[1] * gate); o.y = pk2(siluf_(gv[2]) * uv[2] * gate, siluf_(gv[3]) * uv[3] * gate);
                    *(GAS u32x2*)(H + (unsigned)(u.pm * 256 + r) * 512 + u.pn * 128 + wc * 32 + n * 16 + 4 * fq) = o; } }
    }
};
struct MoeDown {
    static constexpr bool GATHER = false, SPLITB = true; static constexpr int KSPLIT = 4, K = 512, lda = 512, ldb = 256;
    const GAS bf16* A; int G, c, layer; GAS unsigned char* ws; const volatile LAS unsigned* MISC;
    DI bool next(int i, pg8::Unit& u) const { int cp, pn, cls; if (!moe_next(MISC, G, c, i, cp, pn, cls)) return false;
        int elo, ehi; cls_experts(cls, elo, ehi);
        u.pm = cp; u.pn = pn; u.aux = cls; const GAS bf16* WD = (const GAS bf16*)(ws + WS_WD);
        u.B0 = (const GAS char*)(WD + ((size_t)(layer * 16 + elo) * 1024 + pn * 256) * 256); u.B1 = (const GAS char*)(WD + ((size_t)(layer * 16 + ehi) * 1024 + pn * 256) * 256) - 4 * 128; return true; }
    DI void epi(const AccT& acc, const pg8::Unit& u, int wr, int wc, int fr, int fq) const {
        asm volatile("" : "+v"(fr), "+v"(fq));
        const int cls = u.aux, cnt = __builtin_amdgcn_readfirstlane((int)MISC[48 + cls]), sbase = (u.pm - __builtin_amdgcn_readfirstlane((int)MISC[16 + cls])) * 256;
        GAS float* X = (GAS float*)(ws + WS_X);
#pragma unroll
        for (int ai = 0; ai < 2; ++ai)
#pragma unroll
            for (int m = 0; m < 4; ++m) { const int r = ai * 128 + wr * 64 + m * 16 + fr, slot = sbase + r;
                if (slot < cnt) { const int tok = ((const GAS int*)(ws + WS_TOK))[(unsigned)cls * CLS_CAP + slot]; GAS float* rp = X + (unsigned)tok * D + u.pn * 256 + wc * 32 + 4 * fq;
#pragma unroll
                    for (int bj = 0; bj < 2; ++bj)
#pragma unroll
                        for (int n = 0; n < 2; ++n) { GAS f32x4* q = (GAS f32x4*)(rp + bj * 128 + n * 16); *q = *q * DN_ALPHA + acc[ai][bj][m][n]; } }
                asm volatile("" ::: "memory"); }
    }
};

struct OddIn {
    static constexpr bool GATHER = false, SPLITB = false; static constexpr int KSPLIT = 0, K = 1024, lda = 1024, ldb = 1024;
    const GAS bf16* A; const GAS bf16* Bt; int G, c, li; GAS unsigned char* ws; GAS float* out;
    DI bool next(int i, pg8::Unit& u) const { if (!pg8::static_next<M / 256, ODD_IN / 256>(G, c, i, u.pm, u.pn)) return false;
        u.B0 = (const GAS char*)(Bt + (size_t)u.pn * 256 * 1024); u.B1 = u.B0; u.aux = 0; return true; }
    DI void epi(const AccT& acc, const pg8::Unit& u, int wr, int wc, int fr, int fq) const {
        asm volatile("" : "+v"(fr), "+v"(fq));
        const int pn = u.pn;
#pragma unroll
        for (int ai = 0; ai < 2; ++ai)
#pragma unroll
            for (int m = 0; m < 4; ++m) {
                const int row = u.pm * 256 + ai * 128 + wr * 64 + m * 16 + fr;
                int b = 0, t = 0, sidx = 0; const bool pr = row < NPR; if (pr) { b = row / T; t = row % T; } else sidx = row - NPR;
                if (pn < 4) {
                    GAS float* so = nullptr;
                    if (pr) { if (t >= T - 30) so = out + O_CP + ((unsigned)(b * 2 + li) * 30 + (t - (T - 30))) * 512; } else so = out + O_CS + ((unsigned)(sidx * 2 + li) * 30 + 29) * 512;
#pragma unroll
                    for (int n = 0; n < 2; ++n) { const int ch = 128 * pn + wc * 32 + n * 16 + 4 * fq; const f32x4 a = acc[ai][0][m][n], g = acc[ai][1][m][n]; f32x4 uv;
#pragma unroll
                        for (int j = 0; j < 4; ++j) uv[j] = a[j] * sigmoidf_(g[j]);
                        u32x2 o; o.x = pk2(uv[0], uv[1]); o.y = pk2(uv[2], uv[3]); *(GAS u32x2*)((GAS bf16*)(ws + WS_A0) + (unsigned)row * 512 + ch) = o;
                        if (so) *(GAS f32x4*)(so + ch) = uv; }
                } else if (pn < 6) {
                    GAS float* so = nullptr;
                    if (pr) { if (t >= T - 3) so = out + O_DP + ((unsigned)(b * 2 + li) * 3 + (t - (T - 3))) * 512; } else so = out + O_DS + ((unsigned)(sidx * 2 + li) * 3 + 2) * 512;
#pragma unroll
                    for (int bj = 0; bj < 2; ++bj)
#pragma unroll
                        for (int n = 0; n < 2; ++n) { const int ch = (pn - 4) * 256 + bj * 128 + wc * 32 + n * 16 + 4 * fq; const f32x4 v = acc[ai][bj][m][n];
                            u32x2 o; o.x = pk2(v[0], v[1]); o.y = pk2(v[2], v[3]); *(GAS u32x2*)((GAS bf16*)(ws + WS_A1) + (unsigned)row * 512 + ch) = o;
                            if (so) *(GAS f32x4*)(so + ch) = v; }
                } else {
#pragma unroll
                    for (int bj = 0; bj < 2; ++bj)
#pragma unroll
                        for (int n = 0; n < 2; ++n) { const int ch = (pn - 6) * 256 + bj * 128 + wc * 32 + n * 16 + 4 * fq; const f32x4 v = acc[ai][bj][m][n];
                            u32x2 o; o.x = pk2(gelu_tanh(v[0]), gelu_tanh(v[1])); o.y = pk2(gelu_tanh(v[2]), gelu_tanh(v[3])); *(GAS u32x2*)((GAS bf16*)(ws + WS_A2) + (unsigned)row * 512 + ch) = o; }
                }
            }
    }
};

DI float lru_sp8(float lam) { return 8.0f * log1pf(__expf(-lam)); }
DI void lru_chain_item(Frame& F, int li, int b, int n) {
    int tid_ = F.tid; asm volatile("" : "+v"(tid_)); LAUNDER_F(F);
    const int tid = tid_, lane = tid & 63, w = __builtin_amdgcn_readfirstlane(tid >> 6), l15 = lane & 15, l4 = lane >> 4;
    LAS bf16* XC = (LAS bf16*)(F.lds + 0);
    LAS bf16* WB = (LAS bf16*)(F.lds + 9216);
    LAS float* GT = (LAS float*)(F.lds + 27648);
    LAS float* AA = (LAS float*)(F.lds + 61440);
    LAS float* UU = (LAS float*)(F.lds + 77824);
    LAS float* SEGP = (LAS float*)(F.lds + 94208);
    LAS float* SEGH = (LAS float*)(F.lds + 96256);
    LAS float* HC = (LAS float*)(F.lds + 98304);
    const GAS bf16* DX = (const GAS bf16*)(F.ws + WS_A1); const GAS bf16* DG = (const GAS bf16*)(F.ws + WS_A2); GAS bf16* MIX = (GAS bf16*)(F.ws + WS_MIX);
    const GAS float* wa = GIN(23) + ((size_t)(li * 8 + n) * 64) * 64; const GAS float* wx = GIN(25) + ((size_t)(li * 8 + n) * 64) * 64;
    __syncthreads();
    for (int e = tid; e < 4096; e += 512) { const int i = e >> 6, j = e & 63; WB[j * 72 + i] = (bf16)f2bf(wa[e]); WB[(64 + j) * 72 + i] = (bf16)f2bf(wx[e]); }
    if (tid < 64) HC[tid] = 0.f;
    const int t = tid >> 3, c8 = tid & 7, cb = 64 * n + 8 * c8;
    float dw[4][8], dbv[8], bav[8], bxv[8], sp[8];
#pragma unroll
    for (int j = 0; j < 8; ++j) { dbv[j] = GIN(22)[li * 512 + cb + j]; bav[j] = GIN(24)[li * 512 + cb + j]; bxv[j] = GIN(26)[li * 512 + cb + j]; sp[j] = lru_sp8(GIN(27)[li * 512 + cb + j]);
#pragma unroll
        for (int q = 0; q < 4; ++q) dw[q][j] = GIN(21)[(li * 4 + q) * 512 + cb + j]; }
    constexpr int NCH = (T + 63) / 64;
    for (int c = 0; c < NCH; ++c) {
        const int tg = 64 * c + t;
        float xc[8];
#pragma unroll
        for (int j = 0; j < 8; ++j) xc[j] = dbv[j];
#pragma unroll
        for (int q = 0; q < 4; ++q) { const int ts = tg - 3 + q;
            if (ts >= 0 && ts < T) { const u32x4 raw = *(const GAS u32x4*)(DX + (size_t)(b * T + ts) * 512 + cb); const unsigned rw[4] = {raw.x, raw.y, raw.z, raw.w};
#pragma unroll
                for (int j = 0; j < 8; ++j) xc[j] += dw[q][j] * bf2f((rw[j >> 1] >> (16 * (j & 1))) & 0xffffu); } }
        *(LAS bf16x8*)(XC + t * 72 + 8 * c8) = pack8(xc);
        __syncthreads();
        {
            const bf16x8 b0 = *(const LAS bf16x8*)(WB + (16 * w + l15) * 72 + 8 * l4), b1 = *(const LAS bf16x8*)(WB + (16 * w + l15) * 72 + 32 + 8 * l4);
#pragma unroll
            for (int tt = 0; tt < 4; ++tt) { f32x4 a = {0.f, 0.f, 0.f, 0.f};
                a = MFMA16(*(const LAS bf16x8*)(XC + (16 * tt + l15) * 72 + 8 * l4), b0, a); a = MFMA16(*(const LAS bf16x8*)(XC + (16 * tt + l15) * 72 + 32 + 8 * l4), b1, a);
#pragma unroll
                for (int r = 0; r < 4; ++r) GT[(16 * tt + 4 * l4 + r) * 132 + 16 * w + l15] = a[r]; }
        }
        __syncthreads();
#pragma unroll
        for (int j = 0; j < 8; ++j) { const float r = sigmoidf_(GT[t * 132 + 8 * c8 + j] + bav[j]), ig = sigmoidf_(GT[t * 132 + 64 + 8 * c8 + j] + bxv[j]);
            const float la = -r * sp[j]; float a = __expf(la); float dr = sqrtf(fmaxf(-expm1f(2.0f * la), 0.f)) * ig * xc[j];
            if (tg >= T) { a = 1.0f; dr = 0.f; }
            AA[t * 64 + 8 * c8 + j] = a; UU[t * 64 + 8 * c8 + j] = dr; }
        __syncthreads();
        {
            const int ch = tid & 63, sg = tid >> 6;
            float av[8], uv[8]; float P = 1.0f, H = 0.f;
#pragma unroll
            for (int i = 0; i < 8; ++i) { av[i] = AA[(8 * sg + i) * 64 + ch]; uv[i] = UU[(8 * sg + i) * 64 + ch]; H = av[i] * H + uv[i]; P *= av[i]; }
            SEGP[sg * 64 + ch] = P; SEGH[sg * 64 + ch] = H;
            __syncthreads();
            float h = HC[(c & 1) * 64 + ch];
            for (int q = 0; q < sg; ++q) h = SEGP[q * 64 + ch] * h + SEGH[q * 64 + ch];
#pragma unroll
            for (int i = 0; i < 8; ++i) { h = av[i] * h + uv[i]; UU[(8 * sg + i) * 64 + ch] = h; }
            if (sg == 7) HC[((c + 1) & 1) * 64 + ch] = h;
        }
        __syncthreads();
        if (tg < T) { const u32x4 raw = *(const GAS u32x4*)(DG + (size_t)(b * T + tg) * 512 + cb); const unsigned rw[4] = {raw.x, raw.y, raw.z, raw.w}; float y[8];
#pragma unroll
            for (int j = 0; j < 8; ++j) y[j] = UU[t * 64 + 8 * c8 + j] * bf2f((rw[j >> 1] >> (16 * (j & 1))) & 0xffffu);
            *(GAS bf16x8*)(MIX + (size_t)(b * T + tg) * 1024 + 512 + cb) = pack8(y); }
    }
    __syncthreads();
    if (tid < 64) F.out[O_LP + (size_t)(b * 2 + li) * 512 + 64 * n + tid] = HC[(NCH & 1) * 64 + tid];
}

template <int NV> DI void block_sum2(float (&a)[NV], float (&bq)[NV], LAS float* RED, int wv, int lane) {
#pragma unroll
    for (int i = 0; i < NV; ++i) { a[i] = wave_sum(a[i]); bq[i] = wave_sum(bq[i]); }
    __syncthreads();
    if (lane == 0) {
#pragma unroll
        for (int i = 0; i < NV; ++i) { RED[wv * 2 * NV + i] = a[i]; RED[wv * 2 * NV + NV + i] = bq[i]; } }
    __syncthreads();
#pragma unroll
    for (int i = 0; i < NV; ++i) { float x = 0.f, y = 0.f;
#pragma unroll
        for (int q = 0; q < 8; ++q) { x += RED[q * 2 * NV + i]; y += RED[q * 2 * NV + NV + i]; }
        a[i] = x; bq[i] = y; }
}
DI void convc_item(Frame& F, int li, int b, int blk) {
    int tid_ = F.tid; asm volatile("" : "+v"(tid_)); LAUNDER_F(F);
    const int tid = tid_, lane = tid & 63, wv = __builtin_amdgcn_readfirstlane(tid >> 6), c = tid;
    LAS float* RED = (LAS float*)(F.lds + 0);
    const GAS bf16* U = (const GAS bf16*)(F.ws + WS_A0); GAS bf16* MIX = (GAS bf16*)(F.ws + WS_MIX);
    float cw[31];
#pragma unroll
    for (int j = 0; j < 31; ++j) cw[j] = GIN(17)[(size_t)(li * 31 + j) * 512 + c];
    const float cbv = GIN(18)[li * 512 + c], gln = GIN(19)[li * 512 + c], bln = GIN(20)[li * 512 + c];
    for (int g8 = 0; g8 < 8; ++g8) {
        const int t0 = 64 * blk + 8 * g8; if (t0 >= T) break;
        float val[38];
#pragma unroll
        for (int i = 0; i < 38; ++i) { const int ts = t0 - 30 + i; val[i] = (ts >= 0 && ts < T) ? bf2f(U[(size_t)(b * T + ts) * 512 + c]) : 0.f; }
        float y[8], y2[8];
#pragma unroll
        for (int o = 0; o < 8; ++o) { float a = cbv;
#pragma unroll
            for (int j = 0; j < 31; ++j) a += cw[j] * val[o + j];
            y[o] = a; y2[o] = a * a; }
        float s1[8];
#pragma unroll
        for (int o = 0; o < 8; ++o) s1[o] = y[o];
        block_sum2<8>(s1, y2, RED, wv, lane);
#pragma unroll
        for (int o = 0; o < 8; ++o) { const int tg = t0 + o; if (tg < T) { const float mean = s1[o] * (1.0f / 512.0f); const float var = fmaxf(y2[o] * (1.0f / 512.0f) - mean * mean, 0.f);
            const float z = (y[o] - mean) * rsqrtf(var + LN_EPS) * gln + bln; MIX[(size_t)(b * T + tg) * 1024 + c] = (bf16)f2bf(siluf_(z)); } }
    }
}
DI void odd_sample_item(Frame& F, int li, int s) {
    int tid_ = F.tid; asm volatile("" : "+v"(tid_)); LAUNDER_F(F);
    const int tid = tid_, lane = tid & 63, wv = __builtin_amdgcn_readfirstlane(tid >> 6), c = tid, row = NPR + s;
    LAS float* RED = (LAS float*)(F.lds + 0); LAS float* XS = (LAS float*)(F.lds + 1024);
    GAS bf16* MIX = (GAS bf16*)(F.ws + WS_MIX);
    const GAS float* st = GIN(6) + ((size_t)(s * 2 + li) * 30) * 512 + c; GAS float* so = F.out + O_CS + ((size_t)(s * 2 + li) * 30) * 512 + c;
    float a = GIN(18)[li * 512 + c];
#pragma unroll
    for (int j = 0; j < 30; ++j) { const float v = st[(size_t)j * 512]; a += GIN(17)[(size_t)(li * 31 + j) * 512 + c] * v; if (j >= 1) so[(size_t)(j - 1) * 512] = v; }
    a += GIN(17)[(size_t)(li * 31 + 30) * 512 + c] * so[(size_t)29 * 512];
    float s1[1] = {a}, s2[1] = {a * a};
    block_sum2<1>(s1, s2, RED, wv, lane);
    { const float mean = s1[0] * (1.0f / 512.0f), var = fmaxf(s2[0] * (1.0f / 512.0f) - mean * mean, 0.f);
      const float z = (a - mean) * rsqrtf(var + LN_EPS) * GIN(19)[li * 512 + c] + GIN(20)[li * 512 + c]; MIX[(size_t)row * 1024 + c] = (bf16)f2bf(siluf_(z)); }
    const GAS float* sd = GIN(7) + ((size_t)(s * 2 + li) * 3) * 512 + c; GAS float* sdo = F.out + O_DS + ((size_t)(s * 2 + li) * 3) * 512 + c;
    const float d0 = sd[0], d1 = sd[512], d2 = sd[1024], d3 = sdo[1024];
    sdo[0] = d1; sdo[512] = d2;
    const float xc = GIN(22)[li * 512 + c] + GIN(21)[(li * 4 + 0) * 512 + c] * d0 + GIN(21)[(li * 4 + 1) * 512 + c] * d1 + GIN(21)[(li * 4 + 2) * 512 + c] * d2 + GIN(21)[(li * 4 + 3) * 512 + c] * d3;
    __syncthreads();
    XS[c] = xc;
    __syncthreads();
    const int n = c >> 6, j = c & 63; const GAS float* wa = GIN(23) + ((size_t)(li * 8 + n) * 64) * 64 + j; const GAS float* wx = GIN(25) + ((size_t)(li * 8 + n) * 64) * 64 + j;
    float ra = GIN(24)[li * 512 + c], ia = GIN(26)[li * 512 + c];
#pragma unroll 8
    for (int i = 0; i < 64; ++i) { const float xv = XS[64 * n + i]; ra += xv * wa[(size_t)i * 64]; ia += xv * wx[(size_t)i * 64]; }
    const float r = sigmoidf_(ra), ig = sigmoidf_(ia), la = -r * lru_sp8(GIN(27)[li * 512 + c]);
    const float h = __expf(la) * GIN(8)[(size_t)(s * 2 + li) * 512 + c] + sqrtf(fmaxf(-expm1f(2.0f * la), 0.f)) * ig * xc;
    F.out[O_LS + (size_t)(s * 2 + li) * 512 + c] = h;
    MIX[(size_t)row * 1024 + 512 + c] = (bf16)f2bf(h * bf2f(((const GAS bf16*)(F.ws + WS_A2))[(size_t)row * 512 + c]));
}
NOINL void ph_prologue(Frame F) { frame_fix(F); p_prologue(F); }
DI void ph_evenin(Frame F, int li) { LAUNDER_F(F);
    { EvenIn<false> P; P.A = (const GAS bf16*)(F.ws + WS_XB); P.Bt = (const GAS bf16*)(F.ws + WS_WINE) + (size_t)li * EVEN_PAD * 1024; P.G = F.G; P.c = F.vcu; P.li = li; P.ws = F.ws; P.out = F.out;
      pg8::gemm_phase(F.lds, P); }
    LAUNDER_F(F);
    { EvenIn<true> P; P.A = (const GAS bf16*)(F.ws + WS_XB); P.Bt = (const GAS bf16*)(F.ws + WS_WINE) + (size_t)li * EVEN_PAD * 1024; P.G = F.G; P.c = F.vcu; P.li = li; P.ws = F.ws; P.out = F.out;
      pg8::gemm_phase(F.lds, P); } }
DI void ph_oddin(Frame F, int li) { LAUNDER_F(F);
    OddIn P; P.A = (const GAS bf16*)(F.ws + WS_XB); P.Bt = (const GAS bf16*)(F.ws + WS_WINO) + (size_t)li * ODD_IN * 1024; P.G = F.G; P.c = F.vcu; P.li = li; P.ws = F.ws; P.out = F.out;
    pg8::gemm_phase(F.lds, P); }
DI void ph_outproj(Frame F, int layer) { LAUNDER_F(F);
    OutProj P; P.A = (const GAS bf16*)(F.ws + WS_MIX); P.Bt = (const GAS bf16*)(F.ws + ((layer & 1) ? WS_WOUTO : WS_WOUTE)) + (size_t)(layer >> 1) * 1024 * 1024; P.G = F.G; P.c = F.vcu; P.X = (GAS float*)(F.ws + WS_X);
    pg8::gemm_phase(F.lds, P); }
DI void ph_moeup(Frame F, int layer) { LAUNDER_F(F); moe_setup(F, layer);
    MoeUp P; P.A = (const GAS bf16*)(F.ws + WS_XB); P.G = F.G; P.c = F.vcu; P.layer = layer; P.ws = F.ws; P.MISC = F.MISC;
    pg8::gemm_phase(F.lds, P); }
DI void ph_moedown(Frame F, int layer) { LAUNDER_F(F); moe_setup(F, layer);
    MoeDown P; P.A = (const GAS bf16*)(F.ws + WS_H); P.G = F.G; P.c = F.vcu; P.layer = layer; P.ws = F.ws; P.MISC = F.MISC;
    pg8::gemm_phase(F.lds, P); }
NOINL void ph_ln1(Frame F, int layer) { frame_fix(F); p_ln(F, rfl(layer), false, false); }
NOINL void ph_ln2(Frame F, int layer, int fin) { frame_fix(F); p_ln(F, rfl(layer), true, rfl(fin) != 0); }
NOINL void it_hgrn_prompt(Frame F, int li, int b, int h) { frame_fix(F); hgrn_prompt_item(F, rfl(li), rfl(b), rfl(h)); }
NOINL void it_hgrn_sample(Frame F, int li, int sq) { frame_fix(F); hgrn_sample_item(F, rfl(li), rfl(sq)); }
DI void it_dsa_prompt(Frame F, int b, int qblk) { dsa_prompt_item(F, b, qblk); }
DI void it_dsa_sample(Frame F, int li, int sq) { dsa_sample_item(F, li, sq); }
DI void it_lru_chain(Frame F, int li, int b, int n) { lru_chain_item(F, li, b, n); }
DI void it_convc(Frame F, int li, int b, int blk) { convc_item(F, li, b, blk); }
NOINL void it_odd_sample(Frame F, int li, int sq) { frame_fix(F); odd_sample_item(F, rfl(li), rfl(sq)); }
DI void p_even_mixer(Frame& F, int li, int qidx) {
    constexpr int E0 = 32, E1 = E0 + 8 * 33, E2 = E1 + NSM, E3 = E2 + NSM;
    int it = q_pop(F, qidx);
    while (it < E0) { it_hgrn_prompt(F, li, it >> 2, it & 3); it = q_pop(F, qidx); }
    while (it < E1) { const int j = it - E0; it_dsa_prompt(F, j & 7, 32 - (j >> 3)); it = q_pop(F, qidx); }
    while (it < E2) { it_dsa_sample(F, li, it - E1); it = q_pop(F, qidx); }
    while (it < E3) { it_hgrn_sample(F, li, it - E2); it = q_pop(F, qidx); }
}
DI void p_odd_mixer(Frame& F, int li, int qidx) {
    constexpr int E0 = 64, E1 = E0 + 8 * 33, E2 = E1 + NSM;
    int it = q_pop(F, qidx);
    while (it < E0) { it_lru_chain(F, li, it >> 3, it & 7); it = q_pop(F, qidx); }
    while (it < E1) { const int j = it - E0; it_convc(F, li, j & 7, j >> 3); it = q_pop(F, qidx); }
    while (it < E2) { it_odd_sample(F, li, it - E1); it = q_pop(F, qidx); }
}

constexpr int NPHASE = 29;
__global__ void __launch_bounds__(512, 2) mega(Args args) {
    Frame F;
    F.lds = (LAS unsigned char*)lds_raw; F.MISC = (volatile LAS unsigned*)(F.lds + MISC_OFF);
    F.tid = threadIdx.x; F.lane = F.tid & 63; F.wave = __builtin_amdgcn_readfirstlane(F.tid >> 6);
    F.G = gridDim.x; F.wg = blockIdx.x; F.vcu = (F.G % 8 == 0) ? (F.wg % 8) * (F.G / 8) + F.wg / 8 : F.wg;
    F.in = ((const Args*)__builtin_amdgcn_kernarg_segment_ptr())->in; F.out = (GAS float*)args.out; F.ws = (GAS unsigned char*)args.ws; F.ctl = (unsigned*)(args.ws + WS_CTL);
    for (int u = F.tid; u < (LDS_BYTES - MISC_OFF) / 4; u += 512) ((LAS unsigned*)(F.lds + MISC_OFF))[u] = 0u;
    __syncthreads();
    const int lo = args.ph_lo, hi = args.ph_hi;
    const bool multi = (hi - lo) > 1;
    XcdBarrier bar; bar.bar = F.ctl + CW_BAR; bar.x = 0; bar.st = nullptr;
    if (multi) bar = xcd_barrier_post(F.ctl + CW_BAR, F.MISC + 8);
#define IN(k) (lo <= (k) && (k) < hi)
#define SEAM(k) do { if (IN(k) && IN((k) + 1)) xcd_barrier_call(bar.bar, bar.x, bar.st); } while (0)
    if (IN(0)) ph_prologue(F);
    SEAM(0);
    for (int layer = 0; layer < 4; ++layer) {
        const int pb = 1 + layer * 7, li = layer >> 1;
        if (IN(pb + 0)) { if (!(layer & 1)) ph_evenin(F, li); else ph_oddin(F, li); }
        SEAM(pb + 0);
        if (IN(pb + 1)) { if (!(layer & 1)) p_even_mixer(F, li, layer); else p_odd_mixer(F, li, layer); }
        SEAM(pb + 1);
        if (IN(pb + 2)) ph_outproj(F, layer);
        SEAM(pb + 2);
        if (IN(pb + 3)) ph_ln1(F, layer);
        SEAM(pb + 3);
        if (IN(pb + 4)) ph_moeup(F, layer);
        SEAM(pb + 4);
        if (IN(pb + 5)) ph_moedown(F, layer);
        SEAM(pb + 5);
        if (IN(pb + 6)) ph_ln2(F, layer, layer == 3 ? 1 : 0);
        SEAM(pb + 6);
    }
}

extern "C" void kernel_launch(void* const* d_in, const int* in_sizes, int n_in, void* d_out, int out_size, void* d_ws, size_t ws_size, hipStream_t stream) {
    static int grid = 0;
    if (!grid) {
        int dev = 0, cus = 0, per_cu = 0;
        (void)hipGetDevice(&dev); (void)hipDeviceGetAttribute(&cus, hipDeviceAttributeMultiprocessorCount, dev);
        (void)hipFuncSetAttribute((const void*)mega, hipFuncAttributeMaxDynamicSharedMemorySize, LDS_BYTES);
        (void)hipOccupancyMaxActiveBlocksPerMultiprocessor(&per_cu, (const void*)mega, 512, LDS_BYTES);
        if (per_cu < 1) fprintf(stderr, "occupancy query says %d\n", per_cu);
        grid = cus > 0 ? cus : 256;
        if (n_in != 39 || (size_t)out_size != O_END || ws_size < WS_END) fprintf(stderr, "kernel_launch: unexpected sizes n_in %d out %d ws %zu (need %zu)\n", n_in, out_size, ws_size, (size_t)WS_END);
    }
    (void)hipMemsetAsync((char*)d_ws + WS_CTL, 0, CTL_BYTES, stream);
    (void)hipMemsetAsync(d_out, 0, (size_t)out_size * 4, stream);
    Args a; memset(&a, 0, sizeof(a));
    for (int i = 0; i < 39; ++i) a.in[i] = (const float*)d_in[i];
    a.out = (float*)d_out; a.ws = (unsigned char*)d_ws;
    const int NRUN = NPHASE;
    for (int p = 0; p < NRUN; ++p) { a.ph_lo = p; a.ph_hi = p + 1; hipLaunchKernelGGL(mega, dim3(grid), dim3(512), LDS_BYTES, stream, a); }
}
```

```cpp
#include <hip/hip_runtime.h>
#include <cstdio>
#include <cstdint>
#include <cstring>

#define GAS __attribute__((address_space(1)))
#define LAS __attribute__((address_space(3)))
typedef unsigned short bf16;
typedef short bf16x8 __attribute__((ext_vector_type(8)));
typedef float f32x4 __attribute__((ext_vector_type(4)));
typedef float f32x2 __attribute__((ext_vector_type(2)));
typedef float f32x16 __attribute__((ext_vector_type(16)));
typedef unsigned u32x4 __attribute__((ext_vector_type(4)));
typedef unsigned u32x2 __attribute__((ext_vector_type(2)));
typedef unsigned long long u64;
#define DI __device__ __forceinline__

constexpr int D = 1024, NB = 8, SEQ = 2048, NMETA = 16, T = NMETA + SEQ  , NPR = NB * T  , NSM = 128, M = NPR + NSM  ;
constexpr int PAST = 2048, PAGE = 128, NPAGES = 16, NPHYS = 2560;
constexpr int EVEN_IN = 3400, EVEN_PAD = 3584, ODD_IN = 2048;
constexpr int NCLS = 24, CLS_CAP = M, MAXPAN = 96;
constexpr float DN_ALPHA = 1.681792830507429f;
constexpr float LN_EPS = 1e-5f, RMS_EPS = 1e-6f;

constexpr size_t O_YP = 0, O_YS = O_YP + (size_t)NB * SEQ * D, O_KP = O_YS + (size_t)NSM * D, O_VP = O_KP + (size_t)NPR * 256, O_IP = O_VP + (size_t)NPR * 256,
    O_HP = O_IP + (size_t)NPR * 128, O_CP = O_HP + (size_t)NB * 2 * 4 * 128 * 128, O_DP = O_CP + (size_t)NB * 2 * 30 * 512, O_LP = O_DP + (size_t)NB * 2 * 3 * 512,
    O_KS = O_LP + (size_t)NB * 2 * 512, O_VS = O_KS + (size_t)NSM * 256, O_IS = O_VS + (size_t)NSM * 256, O_HS = O_IS + (size_t)NSM * 128,
    O_CS = O_HS + (size_t)NSM * 2 * 4 * 128 * 128, O_DS = O_CS + (size_t)NSM * 2 * 30 * 512, O_LS = O_DS + (size_t)NSM * 2 * 3 * 512, O_END = O_LS + (size_t)NSM * 2 * 512;

constexpr size_t MiB = 1u << 20;
constexpr size_t WS_CTL = 0, CTL_BYTES = 1 * MiB;
constexpr size_t WS_WINE = 2 * MiB;
constexpr size_t WS_WOUTE = WS_WINE + 2ull * EVEN_PAD * 1024 * 2;
constexpr size_t WS_WINO = WS_WOUTE + 2ull * 1024 * 1024 * 2;
constexpr size_t WS_WOUTO = WS_WINO + 2ull * 2048 * 1024 * 2;
constexpr size_t WS_WGU = WS_WOUTO + 2ull * 1024 * 1024 * 2;
constexpr size_t WS_WD = WS_WGU + 64ull * 512 * 1024 * 2;
constexpr size_t WS_X = WS_WD + 64ull * 1024 * 256 * 2;
constexpr size_t WS_XB = WS_X + (size_t)M * D * 4;
constexpr size_t WS_MIX = WS_XB + (size_t)M * D * 2;
constexpr size_t WS_A0 = WS_MIX + (size_t)M * D * 2;
constexpr size_t WS_A1 = WS_A0 + (size_t)M * 512 * 2;
constexpr size_t WS_A2 = WS_A1 + (size_t)M * 512 * 2;
constexpr size_t WS_A3 = WS_A2 + (size_t)M * 512 * 2;
constexpr size_t WS_LF = WS_A3 + (size_t)M * 512 * 2;
constexpr size_t WS_QB = WS_LF + (size_t)M * 512 * 4;
constexpr size_t WS_QI = WS_QB + (size_t)M * 512 * 2;
constexpr size_t WS_KBB = WS_QI + (size_t)M * 512 * 2;
constexpr size_t WS_KIB = WS_KBB + (size_t)M * 128 * 2;
constexpr size_t WS_WI = WS_KIB + (size_t)M * 64 * 2;
constexpr int TP = 2112;
constexpr size_t WS_VT = WS_WI + (size_t)M * 8 * 4;
constexpr size_t WS_ROPE = WS_VT + 8ull * 2 * 64 * TP * 2;
constexpr size_t WS_LB = WS_ROPE + 2ull * T * 32 * 4;
constexpr size_t WS_H = WS_LB + 2ull * 3 * 512 * 4;
constexpr size_t WS_TOK = WS_H + (size_t)MAXPAN * 256 * 512 * 2;
constexpr size_t WS_GATE = WS_TOK + (size_t)NCLS * CLS_CAP * 4;
constexpr size_t WS_SC = (WS_GATE + (size_t)M * 2 * 4 + 4095) / 4096 * 4096;
constexpr size_t WS_END = WS_SC + 256ull * 64 * TP * 4;

constexpr int CW_BAR = 4096;
constexpr int CW_Q = 8192;
constexpr int CW_CNT = 12288;

constexpr int RING_BYTES = 131072, MISC_OFF = RING_BYTES, LDS_BYTES = 147456;

DI unsigned f2bf(float f) { unsigned u = __builtin_bit_cast(unsigned, f); return (u + 0x7fffu + ((u >> 16) & 1u)) >> 16; }
DI unsigned pk2(float lo, float hi) { return f2bf(lo) | (f2bf(hi) << 16); }
DI float bf2f(unsigned b) { return __builtin_bit_cast(float, b << 16); }
DI float sigmoidf_(float x) { return 1.0f / (1.0f + __expf(-x)); }
DI float siluf_(float x) { return x / (1.0f + __expf(-x)); }
DI float gelu_tanh(float x) { const float u = 0.7978845608028654f * (x + 0.044715f * x * x * x); const float e = __expf(2.0f * u); const float th = 1.0f - 2.0f / (e + 1.0f); return 0.5f * x * (1.0f + th); }
DI float wave_sum(float v) {
#pragma unroll
    for (int o = 1; o < 64; o <<= 1) v += __shfl_xor(v, o);
    return v;
}

#define XB_TMO      128
#define XB_XCNT(j)  (256  + 64 * (j))
#define XB_XSUB(j)  (1280 + 64 * (j))
#define XB_XGEN(j)  (2304 + 64 * (j))
#define XB_TOP      3328
#define XB_TOPGEN   3392
#define XCD_BAR_WORDS 3456
#define XB_SPIN_CAP (1u << 18)
__device__ __forceinline__ unsigned xb_ld(unsigned* p)              { return __hip_atomic_load(p, __ATOMIC_RELAXED, __HIP_MEMORY_SCOPE_AGENT); }
__device__ __forceinline__ unsigned xb_add(unsigned* p, unsigned v) { return __hip_atomic_fetch_add(p, v, __ATOMIC_RELAXED, __HIP_MEMORY_SCOPE_AGENT); }
__device__ __forceinline__ unsigned xb_xcc_id() { return (unsigned)__builtin_amdgcn_s_getreg((3 << 11) | 20) & 0xFu; }
#define XB_SPIN(cond, bar) do { unsigned _sp = 0; while (cond) { __builtin_amdgcn_s_sleep(1); \
    if ((++_sp & 255u) == 0u) { if (xb_ld(&(bar)[XB_TMO])) break; if (_sp > XB_SPIN_CAP) { atomicAdd(&(bar)[XB_TMO], 1u); break; } } } } while (0)
struct XcdBarrier { unsigned* bar; unsigned x; volatile LAS unsigned* st; };
__device__ __forceinline__ XcdBarrier xcd_barrier_post(unsigned* bar, volatile LAS unsigned* st) {
    XcdBarrier b; b.bar = bar; b.x = xb_xcc_id(); b.st = st;
    if (threadIdx.x == 0) (void)xb_add(&bar[XB_XCNT(b.x)], 1u);
    return b;
}
__device__ __forceinline__ void xcd_barrier_complete(unsigned* bar, unsigned x, unsigned& nloc, unsigned& nx) {
    const unsigned G = gridDim.x * gridDim.y * gridDim.z;
    unsigned sum, cnt, mine, sp = 0u;
    for (;;) {
        sum = 0u; cnt = 0u; mine = 0u;
#pragma unroll
        for (unsigned j = 0; j < 16; ++j) { const unsigned c = xb_ld(&bar[XB_XCNT(j)]); sum += c; cnt += (c > 0u) ? 1u : 0u; mine = (j == x) ? c : mine; }
        if (sum == G) break;
        __builtin_amdgcn_s_sleep(1);
        if ((++sp & 255u) == 0u) { if (xb_ld(&bar[XB_TMO])) break; if (sp > XB_SPIN_CAP) { atomicAdd(&bar[XB_TMO], 1u); break; } }
    }
    nloc = mine > 0u ? mine : 1u; nx = cnt > 0u ? cnt : 1u;
}
__device__ __forceinline__ void xcd_barrier(const XcdBarrier& b) {
    asm volatile("s_waitcnt vmcnt(0)" ::: "memory");
    __syncthreads();
    if (threadIdx.x == 0) {
        unsigned* bar = b.bar;
        __builtin_amdgcn_s_waitcnt(0);
        unsigned nloc = b.st[0], nx = b.st[1];
        if (nloc == 0u) { xcd_barrier_complete(bar, b.x, nloc, nx); b.st[0] = nloc; b.st[1] = nx; }
        const unsigned old = xb_add(&bar[XB_XSUB(b.x)], 1u);
        const unsigned gen = old / nloc;
        if (old + 1u == (gen + 1u) * nloc) {
            __builtin_amdgcn_fence(__ATOMIC_RELEASE, "agent");
            asm volatile("s_waitcnt vmcnt(0)" ::: "memory");
            const unsigned og = xb_add(&bar[XB_TOP], 1u);
            const unsigned tg = og / nx;
            if (og + 1u == (tg + 1u) * nx) xb_add(&bar[XB_TOPGEN], 1u);
            else XB_SPIN(xb_ld(&bar[XB_TOPGEN]) == tg, bar);
            __builtin_amdgcn_fence(__ATOMIC_ACQUIRE, "agent");
            xb_add(&bar[XB_XGEN(b.x)], 1u);
            asm volatile("s_waitcnt vmcnt(0)" ::: "memory");
        } else {
            XB_SPIN(xb_ld(&bar[XB_XGEN(b.x)]) == gen, bar);
            __builtin_amdgcn_fence(__ATOMIC_ACQUIRE, "agent");
            asm volatile("s_waitcnt vmcnt(0)" ::: "memory");
        }
    }
    __syncthreads();
}

__device__ __attribute__((noinline)) void xcd_barrier_call(unsigned* bar, unsigned x, volatile LAS unsigned* st) { XcdBarrier b; b.bar = bar; b.x = x; b.st = st; xcd_barrier(b); }
struct Args { const float* in[39]; float* out; unsigned char* ws; int ph_lo, ph_hi; };
#define GIN(k) ((const GAS float*)F.in[(k)])
#define LAUNDER_F(F) asm volatile("" : "+s"((F).in), "+s"((F).ws), "+s"((F).out), "+s"((F).ctl), "+s"((F).vcu), "+s"((F).G), "+s"((F).wg))
struct Frame {
    LAS unsigned char* lds; volatile LAS unsigned* MISC; unsigned* ctl;
    int tid, lane, wave, G, wg, vcu;
    const float* const* in; GAS float* out; GAS unsigned char* ws;
};
extern __shared__ __attribute__((aligned(16))) unsigned char lds_raw[];
#define NOINL __device__ __attribute__((noinline))
DI int rfl(int v) { return __builtin_amdgcn_readfirstlane(v); }
template <class Pt> DI Pt rfl_ptr(Pt p) { const u64 v = (u64)p; const unsigned lo = (unsigned)rfl((int)(unsigned)v), hi = (unsigned)rfl((int)(unsigned)(v >> 32)); return (Pt)(((u64)hi << 32) | lo); }
DI void frame_fix(Frame& F) {
    F.lds = (LAS unsigned char*)lds_raw; F.MISC = (volatile LAS unsigned*)(F.lds + MISC_OFF);
    F.tid = threadIdx.x; F.lane = F.tid & 63; F.wave = rfl(F.tid >> 6);
    F.G = rfl(F.G); F.wg = rfl(F.wg); F.vcu = rfl(F.vcu);
    F.ctl = rfl_ptr(F.ctl); F.in = rfl_ptr(F.in); F.out = rfl_ptr(F.out); F.ws = rfl_ptr(F.ws);
}

namespace pg8 {
constexpr int BM = 256, BK = 64, HALF = 128, HTB = HALF * BK * 2, STAGE_BYTES = 8 * HTB, NXCD = 8, WGM = 8;
__host__ __device__ __forceinline__ int lds_byte(int r, int c) { const int st = (r >> 4) * 2 + (c >> 5), rr = r & 15, cc = c & 31, ob = rr * 64 + cc * 2; return st * 1024 + (ob ^ (((ob >> 9) & 1) << 5)); }
__host__ __device__ __forceinline__ void stage_rc(int b, int& R, int& C) { const int st = b / 1024, sb = b % 1024, swz = sb ^ (((sb >> 9) & 1) << 5); R = (st >> 1) * 16 + swz / 64; C = (st & 1) * 32 + (swz % 64) / 2; }
struct Unit { int pm, pn; const GAS char* B0; const GAS char* B1; int aux; };
template <int nM, int nN> DI bool static_next(int G, int c, int i, int& pm, int& pn) {
    const int L = i * G + c; if (L >= nM * nN) return false;
    pm = L / nN; pn = L % nN; return true;
}
template <class P>
__device__ __forceinline__ void gemm_phase(LAS unsigned char* lds, const P& pb) {
    int tid_ = threadIdx.x; asm volatile("" : "+v"(tid_));
    const int tid = tid_, wid = __builtin_amdgcn_readfirstlane(tid >> 6), lane = tid & 63, wr = wid >> 2, wc = wid & 3, fr = lane & 15, fq = lane >> 4;
    constexpr int K = P::K, nt = K / BK;
    int sR[2], sC[2]; unsigned voffA[2], voffB[2];
#pragma unroll
    for (int i = 0; i < 2; ++i) { stage_rc(tid * 16 + i * 8192, sR[i], sC[i]); voffB[i] = (unsigned)(sR[i] * P::ldb + sC[i]) * 2u; voffA[i] = (unsigned)(sR[i] * P::lda + sC[i]) * 2u; }
    constexpr size_t kstep = (size_t)(BK * 2);
    constexpr size_t hstepB = (size_t)HALF * P::ldb * 2, hstepA = (size_t)HALF * P::lda * 2, tstepA = 2 * hstepA;
    const unsigned ldsw = (unsigned)wid * 1024u;
    const int aoff = lds_byte(wr * 64 + fr, fq * 8), boff = lds_byte(wc * 32 + fr, fq * 8);
#define PG8_SA(b, h) (((b) * 2 + (h)) * HTB)
#define PG8_SB(b, h) ((4 + (b) * 2 + (h)) * HTB)
#define PG8_STAGE(bufoff, gbase, voff) do { _Pragma("unroll") for (int _i = 0; _i < 2; ++_i) \
        __builtin_amdgcn_global_load_lds((const GAS unsigned*)((const GAS char*)(gbase) + (voff)[_i]), (LAS unsigned*)(lds + (bufoff) + ldsw + _i * 8192), 16, 0, 0); } while (0)
#define PG8_STAGE_A(bufoff, gbase, h, G_) do { if constexpr (P::GATHER) { PG8_STAGE(bufoff, gbase, (G_)[h]); } else { PG8_STAGE(bufoff, (gbase) + (h) * hstepA, voffA); } } while (0)
#define PG8_LDA(dst, b, h) do { _Pragma("unroll") for (int m = 0; m < 4; ++m) _Pragma("unroll") for (int k = 0; k < 2; ++k) dst[m][k] = *(const LAS bf16x8*)(lds + PG8_SA(b, h) + aoff + m * 2048 + k * 1024); } while (0)
#define PG8_LDB(dst, b, h) do { _Pragma("unroll") for (int n = 0; n < 2; ++n) _Pragma("unroll") for (int k = 0; k < 2; ++k) dst[n][k] = *(const LAS bf16x8*)(lds + PG8_SB(b, h) + boff + n * 2048 + k * 1024); } while (0)
#define PG8_MMA(ai, bj, At, Bt) do { __builtin_amdgcn_s_setprio(1); _Pragma("unroll") for (int m = 0; m < 4; ++m) _Pragma("unroll") for (int n = 0; n < 2; ++n) _Pragma("unroll") for (int k = 0; k < 2; ++k) \
        acc[ai][bj][m][n] = __builtin_amdgcn_mfma_f32_16x16x32_bf16(Bt[n][k], At[m][k], acc[ai][bj][m][n], 0, 0, 0); __builtin_amdgcn_s_setprio(0); } while (0)
#define PG8_WAIT_V(n) asm volatile("s_waitcnt vmcnt(" #n ")" ::: "memory")
#define PG8_WAIT_L(n) asm volatile("s_waitcnt lgkmcnt(" #n ")" ::: "memory")
#define PG8_BAR __builtin_amdgcn_s_barrier()
#define PG8_SCHED __builtin_amdgcn_sched_barrier(0)
    Unit cur, nxt; int ui = 0;
    if (!pb.next(0, cur)) return;
    f32x4 acc[2][2][4][2];
#pragma unroll
    for (int a = 0; a < 2; ++a)
#pragma unroll
        for (int b = 0; b < 2; ++b)
#pragma unroll
            for (int m = 0; m < 4; ++m)
#pragma unroll
                for (int n = 0; n < 2; ++n) acc[a][b][m][n] = (f32x4){0.f, 0.f, 0.f, 0.f};
    bf16x8 At[4][2], B0[2][2], B1[2][2];
    unsigned gA[2][2] = {{0u, 0u}, {0u, 0u}};
    if constexpr (P::GATHER) {
#pragma unroll
        for (int h = 0; h < 2; ++h)
#pragma unroll
            for (int i = 0; i < 2; ++i) gA[h][i] = pb.a_row(cur, 128 * h + sR[i]) + (unsigned)sC[i] * 2u;
    }
    const GAS char* cA = (const GAS char*)pb.A + (P::GATHER ? (size_t)0 : (size_t)cur.pm * tstepA);
    PG8_STAGE(PG8_SB(0, 0), cur.B0, voffB); PG8_STAGE_A(PG8_SA(0, 0), cA, 0, gA); PG8_STAGE(PG8_SB(0, 1), cur.B0 + hstepB, voffB); PG8_STAGE_A(PG8_SA(0, 1), cA, 1, gA);
    if (wr == 1) PG8_BAR;
    PG8_WAIT_V(4); PG8_BAR;
    PG8_STAGE(PG8_SB(1, 0), cur.B0 + kstep, voffB); PG8_STAGE_A(PG8_SA(1, 0), cA + kstep, 0, gA); PG8_STAGE(PG8_SB(1, 1), cur.B0 + hstepB + kstep, voffB);
    PG8_WAIT_V(6); PG8_BAR;
    for (;;) {
        const bool has_next = pb.next(ui + 1, nxt);
        if (!has_next) nxt = cur;
        const GAS char* nA = (const GAS char*)pb.A + (P::GATHER ? (size_t)0 : (size_t)nxt.pm * tstepA);
#pragma unroll 1
        for (int t = 0; t < nt; t += 2) {
            const bool last = (t == nt - 2);
            const GAS char* a1 = cA + (size_t)(t + 1) * kstep;
            const GAS char* a2 = last ? nA : cA + (size_t)(t + 2) * kstep;
            const GAS char* a3 = a2 + kstep;
            const GAS char* b2;
            if constexpr (P::SPLITB) b2 = last ? nxt.B0 : ((t + 2 < pb.KSPLIT) ? cur.B0 : cur.B1) + (size_t)(t + 2) * kstep;
            else b2 = last ? nxt.B0 : cur.B0 + (size_t)(t + 2) * kstep;
            const GAS char* b3 = b2 + kstep;
            PG8_LDB(B0, 0, 0); PG8_SCHED; PG8_LDA(At, 0, 0); PG8_STAGE_A(PG8_SA(1, 1), a1, 1, gA);
            PG8_WAIT_L(8); PG8_BAR; PG8_WAIT_L(0); PG8_MMA(0, 0, At, B0); PG8_BAR; PG8_SCHED;
            if constexpr (P::GATHER) { if (last) {
#pragma unroll
                for (int h = 0; h < 2; ++h)
#pragma unroll
                    for (int i = 0; i < 2; ++i) gA[h][i] = pb.a_row(nxt, 128 * h + sR[i]) + (unsigned)sC[i] * 2u; } }
            PG8_LDB(B1, 0, 1); PG8_STAGE(PG8_SB(0, 0), b2, voffB);
            PG8_BAR; PG8_WAIT_L(0); PG8_MMA(0, 1, At, B1); PG8_BAR;
            PG8_LDA(At, 0, 1); PG8_STAGE_A(PG8_SA(0, 0), a2, 0, gA);
            PG8_BAR; PG8_WAIT_L(0); PG8_MMA(1, 0, At, B0); PG8_BAR; PG8_SCHED;
            PG8_STAGE(PG8_SB(0, 1), b2 + hstepB, voffB);
            PG8_WAIT_V(6); PG8_BAR; PG8_MMA(1, 1, At, B1); PG8_BAR;
            PG8_LDB(B0, 1, 0); PG8_SCHED; PG8_LDA(At, 1, 0); PG8_STAGE_A(PG8_SA(0, 1), a2, 1, gA);
            PG8_WAIT_L(8); PG8_BAR; PG8_WAIT_L(0); PG8_MMA(0, 0, At, B0); PG8_BAR; PG8_SCHED;
            PG8_LDB(B1, 1, 1); PG8_STAGE(PG8_SB(1, 0), b3, voffB);
            PG8_BAR; PG8_WAIT_L(0); PG8_MMA(0, 1, At, B1); PG8_BAR;
            PG8_LDA(At, 1, 1); PG8_STAGE_A(PG8_SA(1, 0), a3, 0, gA);
            PG8_BAR; PG8_WAIT_L(0); PG8_MMA(1, 0, At, B0); PG8_BAR; PG8_SCHED;
            PG8_STAGE(PG8_SB(1, 1), b3 + hstepB, voffB);
            PG8_WAIT_V(6); PG8_BAR; PG8_MMA(1, 1, At, B1); PG8_BAR;
        }
        pb.epi(acc, cur, wr, wc, fr, fq);
        if (!has_next) break;
#pragma unroll
        for (int a = 0; a < 2; ++a)
#pragma unroll
            for (int b = 0; b < 2; ++b)
#pragma unroll
                for (int m = 0; m < 4; ++m)
#pragma unroll
                    for (int n = 0; n < 2; ++n) acc[a][b][m][n] = (f32x4){0.f, 0.f, 0.f, 0.f};
        cur = nxt; cA = nA; ++ui;
    }
    PG8_WAIT_V(0);
    if (wr == 0) PG8_BAR;
    PG8_BAR;
#undef PG8_SA
#undef PG8_SB
#undef PG8_STAGE
#undef PG8_STAGE_A
#undef PG8_LDA
#undef PG8_LDB
#undef PG8_MMA
#undef PG8_WAIT_V
#undef PG8_WAIT_L
#undef PG8_BAR
#undef PG8_SCHED
}
}
typedef f32x4 AccT[2][2][4][2];

DI int swap45(int s) { return (s & ~48) | ((s & 16) << 1) | ((s & 32) >> 1); }
DI int map_even(int s) {
    if (s < 2048) return s;
    if (s < 2688) { const int r = s - 2048; return 2048 + (r & ~63) + swap45(r & 63); }
    if (s < 2816) return s;
    if (s < 3392) { const int r = s - 2816; return 2816 + (r & ~63) + swap45(r & 63); }
    if (s < EVEN_IN) return s;
    return -1;
}
DI int map_odd(int s) {
    if (s >= 1024) return s;
    const int u = s >> 8, r = s & 255; return r < 128 ? 128 * u + r : 512 + 128 * u + (r - 128);
}
DI void transpose_item(const GAS float* W, int ldn, int K, GAS bf16* WT, int k0, int n0, int mode, int coloff, LAS float* scr, int lane) {
    int col = n0 + (lane & 31);
    if (mode == 1) col = map_even(col); else if (mode == 2) col = map_odd(col); else col += coloff;
#pragma unroll 8
    for (int i = 0; i < 32; ++i) { const int kk = 2 * i + (lane >> 5); scr[kk * 33 + (lane & 31)] = col >= 0 ? W[(size_t)(k0 + kk) * ldn + col] : 0.f; }
    asm volatile("s_waitcnt lgkmcnt(0)" ::: "memory");
    const int c = lane & 7;
#pragma unroll
    for (int j = 0; j < 4; ++j) { const int n = (lane >> 3) + 8 * j; const LAS float* s = scr + (8 * c) * 33 + n;
        u32x4 o; o.x = pk2(s[0 * 33], s[1 * 33]); o.y = pk2(s[2 * 33], s[3 * 33]); o.z = pk2(s[4 * 33], s[5 * 33]); o.w = pk2(s[6 * 33], s[7 * 33]);
        *(GAS u32x4*)(WT + (size_t)(n0 + n) * K + k0 + 8 * c) = o; }
    asm volatile("s_waitcnt lgkmcnt(0)" ::: "memory");
}
DI void p_prologue(Frame& F) {
    LAUNDER_F(F);
    LAS float* scr = (LAS float*)(F.lds + F.wave * 16384);
    const int gw = F.wg * 8 + F.wave, NGW = F.G * 8, lane = F.lane;
    constexpr int I_WINE = 2 * 16 * (EVEN_PAD / 32), I_WOUT = 2 * 16 * 32, I_WINO = 2 * 16 * 64, I_WGU = 64 * 16 * 16, I_WD = 64 * 4 * 32;
    constexpr int NIT = I_WINE + I_WOUT + I_WINO + I_WOUT + I_WGU + I_WD;
    for (int it = gw; it < NIT; it += NGW) {
        asm volatile("" ::: "memory");
        int r = it; asm volatile("" : "+v"(r));
        const GAS float* W; GAS bf16* WT; int ldn, K, k0, n0, mode = 0, coloff = 0;
        if (r < I_WINE) { const int li = r / (I_WINE / 2); r %= (I_WINE / 2); const int kb = r / (EVEN_PAD / 32), nb = r % (EVEN_PAD / 32);
            W = GIN(11) + (size_t)li * 1024 * EVEN_IN; ldn = EVEN_IN; K = 1024; WT = (GAS bf16*)(F.ws + WS_WINE) + (size_t)li * EVEN_PAD * 1024; k0 = 64 * kb; n0 = 32 * nb; mode = 1; }
        else if ((r -= I_WINE) < I_WOUT) { const int li = r / (I_WOUT / 2); r %= (I_WOUT / 2); const int kb = r / 32, nb = r % 32;
            W = GIN(12) + (size_t)li * 1024 * 1024; ldn = 1024; K = 1024; WT = (GAS bf16*)(F.ws + WS_WOUTE) + (size_t)li * 1024 * 1024; k0 = 64 * kb; n0 = 32 * nb; }
        else if ((r -= I_WOUT) < I_WINO) { const int li = r / (I_WINO / 2); r %= (I_WINO / 2); const int kb = r / 64, nb = r % 64;
            W = GIN(15) + (size_t)li * 1024 * 2048; ldn = 2048; K = 1024; WT = (GAS bf16*)(F.ws + WS_WINO) + (size_t)li * 2048 * 1024; k0 = 64 * kb; n0 = 32 * nb; mode = 2; }
        else if ((r -= I_WINO) < I_WOUT) { const int li = r / (I_WOUT / 2); r %= (I_WOUT / 2); const int kb = r / 32, nb = r % 32;
            W = GIN(16) + (size_t)li * 1024 * 1024; ldn = 1024; K = 1024; WT = (GAS bf16*)(F.ws + WS_WOUTO) + (size_t)li * 1024 * 1024; k0 = 64 * kb; n0 = 32 * nb; }
        else if ((r -= I_WOUT) < I_WGU) { const int le = r / 256; r %= 256; const int kb = r / 16, nb = r % 16;
            const int s0 = 32 * nb, jj = s0 >> 8, rr = s0 & 255; const bool up = rr >= 128; const int c0 = 128 * jj + (up ? rr - 128 : rr);
            W = (up ? GIN(37) : GIN(36)) + (size_t)le * 1024 * 256; ldn = 256; K = 1024; WT = (GAS bf16*)(F.ws + WS_WGU) + (size_t)le * 512 * 1024; k0 = 64 * kb; n0 = s0; coloff = c0 - s0; }
        else { r -= I_WGU; const int le = r / 128; r %= 128; const int kb = r / 32, nb = r % 32;
            W = GIN(38) + (size_t)le * 256 * 1024; ldn = 1024; K = 256; WT = (GAS bf16*)(F.ws + WS_WD) + (size_t)le * 1024 * 256; k0 = 64 * kb; n0 = 32 * nb; }
        transpose_item(W, ldn, K, WT, k0, n0, mode, coloff, scr, lane);
    }
    GAS float* X = (GAS float*)(F.ws + WS_X); GAS bf16* XB = (GAS bf16*)(F.ws + WS_XB);
    for (int m = gw; m < M; m += NGW) {
        const GAS float* src;
        if (m < NPR) { const int b = m / T, t = m % T; src = t < NMETA ? GIN(10) + (size_t)t * D : GIN(0) + ((size_t)b * SEQ + (t - NMETA)) * D; }
        else src = GIN(1) + (size_t)(m - NPR) * D;
#pragma unroll
        for (int j = 0; j < 4; ++j) { const f32x4 v = *((const GAS f32x4*)src + lane + 64 * j); *((GAS f32x4*)(X + (size_t)m * D) + lane + 64 * j) = v;
            u32x2 o; o.x = pk2(v.x, v.y); o.y = pk2(v.z, v.w); *((GAS u32x2*)(XB + (size_t)m * D) + lane + 64 * j) = o; }
    }
    GAS float* RC = (GAS float*)(F.ws + WS_ROPE); GAS float* RS = RC + T * 32;
    for (int e = F.wg * 512 + F.tid; e < T * 32; e += F.G * 512) {
        const int pos = e >> 5, i = e & 31;
        const float inv = exp2f(-(float)i * (13.287712379549449f / 32.0f));
        const double ang = (double)((float)pos * inv);
        const double kq = rint(ang * 0.15915494309189535);
        const double rr = fma(-kq, 6.283185307179586, ang) - kq * 2.4492935982947064e-16;
        const float rf = (float)rr;
        RC[e] = cosf(rf); RS[e] = sinf(rf);
    }
    GAS float* LB = (GAS float*)(F.ws + WS_LB);
    for (int e = F.wg * 512 + F.tid; e < 2 * 512; e += F.G * 512) {
        const int li = e >> 9, c = e & 511;
        const float l0 = GIN(13)[c], l1 = GIN(13)[512 + c];
        const float lb = li == 0 ? 0.f : 1.0f / (1.0f + expf(l0 - l1));
        LB[(li * 3 + 0) * 512 + c] = logf(fmaxf(lb, 1e-30f)); LB[(li * 3 + 1) * 512 + c] = log1pf(-lb); LB[(li * 3 + 2) * 512 + c] = 1.0f - lb;
    }
}

template <bool ROPE> struct EvenIn {
    static constexpr bool GATHER = false, SPLITB = false; static constexpr int KSPLIT = 0, K = 1024, lda = 1024, ldb = 1024;
    const GAS bf16* A; const GAS bf16* Bt; int G, c, li; GAS unsigned char* ws; GAS float* out;
    DI bool next(int i, pg8::Unit& u) const { if (!pg8::static_next<M / 256, (ROPE ? 6 : 8)>(G, c, i, u.pm, u.pn)) return false;
        if (ROPE) u.pn += 8;
        u.B0 = (const GAS char*)(Bt + (size_t)u.pn * 256 * 1024); u.B1 = u.B0; u.aux = 0; return true; }
    DI void epi(const AccT& acc, const pg8::Unit& u, int wr, int wc, int fr, int fq) const {
        asm volatile("" : "+v"(fr), "+v"(fq));
        const int pn = u.pn;
        const int rbase = u.pm * 256 + wr * 64 + fr;
        if constexpr (!ROPE) {
            GAS bf16* dst = (GAS bf16*)(ws + (pn < 2 ? WS_A0 : pn < 4 ? WS_A1 : pn < 6 ? WS_A2 : WS_A3));
            GAS float* LF = (GAS float*)(ws + WS_LF); const GAS float* LB = (const GAS float*)(ws + WS_LB) + li * 3 * 512;
#pragma unroll
            for (int bj = 0; bj < 2; ++bj)
#pragma unroll
                for (int n = 0; n < 2; ++n) {
                    const int col = (pn & 1) * 256 + bj * 128 + wc * 32 + n * 16 + 4 * fq;
                    f32x4 la = {0, 0, 0, 0}, lb1 = {0, 0, 0, 0}, lc = {0, 0, 0, 0};
                    if (pn == 2 || pn == 3) { la = *(const GAS f32x4*)(LB + col); lb1 = *(const GAS f32x4*)(LB + 512 + col); lc = *(const GAS f32x4*)(LB + 1024 + col); }
#pragma unroll
                    for (int ai = 0; ai < 2; ++ai)
#pragma unroll
                        for (int m = 0; m < 4; ++m) {
                            const int row = rbase + ai * 128 + m * 16; const f32x4 v = acc[ai][bj][m][n]; float o[4];
                            if (pn < 2 || pn >= 6) {
#pragma unroll
                                for (int j = 0; j < 4; ++j) o[j] = siluf_(v[j]);
                            } else if (pn < 4) {
                                f32x4 lf;
#pragma unroll
                                for (int j = 0; j < 4; ++j) { const float z = v[j]; const float e = __expf(-fabsf(z)); const float l1p = __logf(1.0f + e);
                                    const float ls = fminf(z, 0.f) - l1p;
                                    const float bb = lb1[j] + ls, aa = la[j]; const float mx = fmaxf(aa, bb);
                                    lf[j] = mx + __logf(1.0f + __expf(-fabsf(aa - bb)));
                                    const float sg = (z >= 0.f ? e : 1.0f) / (1.0f + e);
                                    o[j] = lc[j] * sg; }
                                *(GAS f32x4*)(LF + (unsigned)row * 512 + col) = lf;
                            } else {
#pragma unroll
                                for (int j = 0; j < 4; ++j) o[j] = v[j];
                            }
                            u32x2 w; w.x = pk2(o[0], o[1]); w.y = pk2(o[2], o[3]); *(GAS u32x2*)(dst + (unsigned)row * 512 + col) = w;
                        }
                    asm volatile("" ::: "memory");
                }
        } else {
        const GAS float* RC = (const GAS float*)(ws + WS_ROPE); const GAS float* RS = RC + T * 32;
        const int i0 = 16 * (wc & 1) + 4 * fq;
#pragma unroll
        for (int ai = 0; ai < 2; ++ai)
#pragma unroll
            for (int m = 0; m < 4; ++m) {
                const int row = rbase + ai * 128 + m * 16;
                const int pos = row < NPR ? row % T : PAST;
                const f32x4 cs = *(const GAS f32x4*)(RC + pos * 32 + i0), sn = *(const GAS f32x4*)(RS + pos * 32 + i0);
#pragma unroll
                for (int bj = 0; bj < 2; ++bj) {
                    const f32x4 x1 = acc[ai][bj][m][0], x2 = acc[ai][bj][m][1];
                    const f32x4 r1 = x1 * cs - x2 * sn, r2 = x2 * cs + x1 * sn;
                    const int hd = bj * 2 + (wc >> 1);
                    if (pn == 8 || pn == 9) {
                        GAS bf16* Q = (GAS bf16*)(ws + WS_QB) + (unsigned)row * 512 + (pn - 8) * 256 + hd * 64 + i0;
                        u32x2 w; w.x = pk2(r1[0] * 0.125f, r1[1] * 0.125f); w.y = pk2(r1[2] * 0.125f, r1[3] * 0.125f); *(GAS u32x2*)Q = w;
                        w.x = pk2(r2[0] * 0.125f, r2[1] * 0.125f); w.y = pk2(r2[2] * 0.125f, r2[3] * 0.125f); *(GAS u32x2*)(Q + 32) = w;
                    } else if (pn == 11 || pn == 12) {
                        GAS bf16* Q = (GAS bf16*)(ws + WS_QI) + (unsigned)row * 512 + (pn - 11) * 256 + hd * 64 + i0;
                        u32x2 w; w.x = pk2(r1[0], r1[1]); w.y = pk2(r1[2], r1[3]); *(GAS u32x2*)Q = w;
                        w.x = pk2(r2[0], r2[1]); w.y = pk2(r2[2], r2[3]); *(GAS u32x2*)(Q + 32) = w;
                    } else if (pn == 10) {
                        if (bj == 0) {
                            const int g = wc >> 1;
                            GAS float* KO = row < NPR ? out + O_KP + ((unsigned)row * 2 + li) * 128 + g * 64 + i0 : out + O_KS + ((unsigned)(row - NPR) * 2 + li) * 128 + g * 64 + i0;
                            *(GAS f32x4*)KO = r1; *(GAS f32x4*)(KO + 32) = r2;
                            GAS bf16* KB = (GAS bf16*)(ws + WS_KBB) + (unsigned)row * 128 + g * 64 + i0;
                            u32x2 w; w.x = pk2(r1[0], r1[1]); w.y = pk2(r1[2], r1[3]); *(GAS u32x2*)KB = w;
                            w.x = pk2(r2[0], r2[1]); w.y = pk2(r2[2], r2[3]); *(GAS u32x2*)(KB + 32) = w;
                        } else {
#pragma unroll
                            for (int n = 0; n < 2; ++n) {
                                const int sl = wc * 32 + n * 16 + 4 * fq; const f32x4 v = n ? x2 : x1;
                                GAS float* VO = row < NPR ? out + O_VP + ((unsigned)row * 2 + li) * 128 + sl : out + O_VS + ((unsigned)(row - NPR) * 2 + li) * 128 + sl;
                                *(GAS f32x4*)VO = v;
                                if (row < NPR) { const int b = row / T, t = row % T; GAS bf16* VT = (GAS bf16*)(ws + WS_VT) + ((unsigned)(b * 2 + (sl >> 6)) * 64 + (sl & 63)) * TP + t;
#pragma unroll
                                    for (int j = 0; j < 4; ++j) VT[(unsigned)j * TP] = (bf16)f2bf(v[j]); }
                            }
                        }
                    } else {
                        if (bj == 0 && wc < 2) {
                            GAS float* KO = row < NPR ? out + O_IP + ((unsigned)row * 2 + li) * 64 + i0 : out + O_IS + ((unsigned)(row - NPR) * 2 + li) * 64 + i0;
                            *(GAS f32x4*)KO = r1; *(GAS f32x4*)(KO + 32) = r2;
                            GAS bf16* KB = (GAS bf16*)(ws + WS_KIB) + (unsigned)row * 64 + i0;
                            u32x2 w; w.x = pk2(r1[0], r1[1]); w.y = pk2(r1[2], r1[3]); *(GAS u32x2*)KB = w;
                            w.x = pk2(r2[0], r2[1]); w.y = pk2(r2[2], r2[3]); *(GAS u32x2*)(KB + 32) = w;
                        } else if (bj == 0 && wc == 2 && fq < 2) {
                            const float sc = 0.125f * 0.35355339059327373f;
                            *(GAS f32x4*)((GAS float*)(ws + WS_WI) + (unsigned)row * 8 + 4 * fq) = x1 * sc;
                        }
                    }
                }
                asm volatile("" ::: "memory");
            }
        }
    }
};

DI int q_pop(Frame& F, int qidx) {
    __syncthreads();
    if (F.tid == 0) F.MISC[0] = __hip_atomic_fetch_add(F.ctl + CW_Q + 64 * qidx, 1u, __ATOMIC_RELAXED, __HIP_MEMORY_SCOPE_AGENT);
    __syncthreads();
    return (int)F.MISC[0];
}
#define MFMA16(a, b, c) __builtin_amdgcn_mfma_f32_16x16x32_bf16((a), (b), (c), 0, 0, 0)
#define MFMA32(a, b, c) __builtin_amdgcn_mfma_f32_32x32x16_bf16((a), (b), (c), 0, 0, 0)
DI bf16x8 pack8(const float (&v)[8]) { u32x4 p; p.x = pk2(v[0], v[1]); p.y = pk2(v[2], v[3]); p.z = pk2(v[4], v[5]); p.w = pk2(v[6], v[7]); return __builtin_bit_cast(bf16x8, p); }

DI void hgrn_prompt_item(Frame& F, int li, int b, int h) {
    constexpr int P1 = 136, P2 = 40;
    LAS bf16* QS = (LAS bf16*)(F.lds + 0);
    LAS bf16* KH = (LAS bf16*)(F.lds + 8704);
    LAS bf16* KDT = (LAS bf16*)(F.lds + 17408);
    LAS bf16* VTL = (LAS bf16*)(F.lds + 27648);
    LAS bf16* PM = (LAS bf16*)(F.lds + 37888);
    LAS bf16* ST = (LAS bf16*)(F.lds + 40448);
    LAS float* OF = (LAS float*)(F.lds + 75264);
    LAS float* BSEG = (LAS float*)(F.lds + 92160);
    LAS float* DF = (LAS float*)(F.lds + 94208);
    int tid_ = F.tid; asm volatile("" : "+v"(tid_)); LAUNDER_F(F);
    const int tid = tid_, lane = tid & 63, w = __builtin_amdgcn_readfirstlane(tid >> 6), k = tid & 127, seg = tid >> 7, l15 = lane & 15, l4 = lane >> 4;
    const GAS bf16* QA = (const GAS bf16*)(F.ws + WS_A0); const GAS bf16* KA = (const GAS bf16*)(F.ws + WS_A1); const GAS bf16* VA = (const GAS bf16*)(F.ws + WS_A2); const GAS bf16* GA = (const GAS bf16*)(F.ws + WS_A3);
    const GAS float* LF = (const GAS float*)(F.ws + WS_LF); GAS bf16* MIX = (GAS bf16*)(F.ws + WS_MIX);
    const GAS float* NG = GIN(14) + li * 128;
    f32x4 S[8];
#pragma unroll
    for (int i = 0; i < 8; ++i) S[i] = (f32x4){0.f, 0.f, 0.f, 0.f};
    float clf[8], cq[8], ck[8], cv[8];
    const size_t colb = (size_t)h * 128 + k;
#define HG_LOAD(c) do { _Pragma("unroll") for (int i = 0; i < 8; ++i) { const int t = 32 * (c) + 8 * seg + i; if (t < T) { const size_t o = (size_t)(b * T + t) * 512 + colb; \
        clf[i] = LF[o]; cq[i] = bf2f(QA[o]); ck[i] = bf2f(KA[o]); cv[i] = bf2f(VA[o]); } else { clf[i] = 0.f; cq[i] = 0.f; ck[i] = 0.f; cv[i] = 0.f; } } } while (0)
    HG_LOAD(0);
    constexpr int NCH = (T + 31) / 32;
    for (int c = 0; c < NCH; ++c) {
        float cs[8]; float run = 0.f;
#pragma unroll
        for (int i = 0; i < 8; ++i) { run += clf[i]; cs[i] = run; }
        BSEG[seg * 128 + k] = run;
        __syncthreads();
        float pre = 0.f, tot = 0.f;
#pragma unroll
        for (int sgi = 0; sgi < 4; ++sgi) { const float v = BSEG[sgi * 128 + k]; tot += v; if (sgi < seg) pre += v; }
        float kd[8];
#pragma unroll
        for (int i = 0; i < 8; ++i) { const float bb = pre + cs[i]; const int t = 8 * seg + i;
            QS[t * P1 + k] = (bf16)f2bf(cq[i] * __expf(bb)); KH[t * P1 + k] = (bf16)f2bf(ck[i] * __expf(-bb)); kd[i] = ck[i] * __expf(tot - bb); }
        *(LAS bf16x8*)(KDT + k * P2 + 8 * seg) = pack8(kd);
        *(LAS bf16x8*)(VTL + k * P2 + 8 * seg) = pack8(cv);
        if (seg == 0) DF[k] = __expf(tot);
#pragma unroll
        for (int i = 0; i < 8; ++i) { u32x2 o; o.x = pk2(S[i][0], S[i][1]); o.y = pk2(S[i][2], S[i][3]); *(LAS u32x2*)(ST + (16 * w + l15) * P1 + 16 * i + 4 * l4) = o; }
        if (c + 1 < NCH) HG_LOAD(c + 1);
        __syncthreads();
        if (w < 4) {
            const int ti = w >> 1, tj = w & 1; f32x4 pacc = {0.f, 0.f, 0.f, 0.f};
            if (tj <= ti) {
#pragma unroll
                for (int ks = 0; ks < 4; ++ks) { const bf16x8 a = *(const LAS bf16x8*)(QS + (16 * ti + l15) * P1 + 32 * ks + 8 * l4); const bf16x8 bb = *(const LAS bf16x8*)(KH + (16 * tj + l15) * P1 + 32 * ks + 8 * l4); pacc = MFMA16(a, bb, pacc); }
            }
#pragma unroll
            for (int r = 0; r < 4; ++r) { const int t = 16 * ti + 4 * l4 + r, sidx = 16 * tj + l15; PM[t * P2 + sidx] = (bf16)f2bf(sidx <= t ? pacc[r] : 0.f); }
        }
        __syncthreads();
        {
            const bf16x8 bv = *(const LAS bf16x8*)(VTL + (16 * w + l15) * P2 + 8 * l4);
#pragma unroll
            for (int ti = 0; ti < 2; ++ti) {
                f32x4 o = {0.f, 0.f, 0.f, 0.f};
                o = MFMA16(*(const LAS bf16x8*)(PM + (16 * ti + l15) * P2 + 8 * l4), bv, o);
#pragma unroll
                for (int ks = 0; ks < 4; ++ks) o = MFMA16(*(const LAS bf16x8*)(QS + (16 * ti + l15) * P1 + 32 * ks + 8 * l4), *(const LAS bf16x8*)(ST + (16 * w + l15) * P1 + 32 * ks + 8 * l4), o);
#pragma unroll
                for (int r = 0; r < 4; ++r) OF[(16 * ti + 4 * l4 + r) * 132 + 16 * w + l15] = o[r];
            }
#pragma unroll
            for (int i = 0; i < 8; ++i) { const f32x4 d = *(const LAS f32x4*)(DF + 16 * i + 4 * l4); f32x4 sc = S[i] * d;
                S[i] = MFMA16(*(const LAS bf16x8*)(KDT + (16 * i + l15) * P2 + 8 * l4), bv, sc); }
        }
        __syncthreads();
        {
            const int t = tid >> 4, part = tid & 15, tg = 32 * c + t;
            float o[8]; float ss = 0.f;
#pragma unroll
            for (int j = 0; j < 8; ++j) { o[j] = OF[t * 132 + 8 * part + j]; ss += o[j] * o[j]; }
            ss += __shfl_xor(ss, 1); ss += __shfl_xor(ss, 2); ss += __shfl_xor(ss, 4); ss += __shfl_xor(ss, 8);
            if (tg < T) { const float rs = rsqrtf(ss * (1.0f / 128.0f) + RMS_EPS); const size_t ro = (size_t)(b * T + tg) * 512 + h * 128 + 8 * part;
                const u32x4 g4 = *(const GAS u32x4*)(GA + ro); const unsigned gw[4] = {g4.x, g4.y, g4.z, g4.w}; float r8[8];
#pragma unroll
                for (int j = 0; j < 8; ++j) { const float gv = bf2f((gw[j >> 1] >> (16 * (j & 1))) & 0xffffu); r8[j] = o[j] * rs * NG[8 * part + j] * gv; }
                *(GAS bf16x8*)(MIX + (size_t)(b * T + tg) * 1024 + h * 128 + 8 * part) = pack8(r8); }
        }
    }
#undef HG_LOAD
    GAS float* HO = F.out + O_HP + ((size_t)((b * 2 + li) * 4 + h) * 128) * 128;
#pragma unroll
    for (int i = 0; i < 8; ++i)
#pragma unroll
        for (int r = 0; r < 4; ++r) HO[(size_t)(16 * i + 4 * l4 + r) * 128 + 16 * w + l15] = S[i][r];
}

DI void hgrn_sample_item(Frame& F, int li, int s) {
    LAS float* RED = (LAS float*)(F.lds + 0);
    int tid_ = F.tid; asm volatile("" : "+v"(tid_)); LAUNDER_F(F);
    const int tid = tid_, lane = tid & 63, kg = tid >> 5, v4 = tid & 31, row = NPR + s;
    const GAS bf16* QA = (const GAS bf16*)(F.ws + WS_A0); const GAS bf16* KA = (const GAS bf16*)(F.ws + WS_A1); const GAS bf16* VA = (const GAS bf16*)(F.ws + WS_A2); const GAS bf16* GA = (const GAS bf16*)(F.ws + WS_A3);
    const GAS float* LF = (const GAS float*)(F.ws + WS_LF); GAS bf16* MIX = (GAS bf16*)(F.ws + WS_MIX); const GAS float* NG = GIN(14) + li * 128;
    for (int h = 0; h < 4; ++h) {
        const GAS float* S0 = GIN(5) + ((size_t)((s * 2 + li) * 4 + h) * 128) * 128; GAS float* S1 = F.out + O_HS + ((size_t)((s * 2 + li) * 4 + h) * 128) * 128;
        const size_t ro = (size_t)row * 512 + h * 128;
        f32x4 vv; { const u32x2 vr = *(const GAS u32x2*)(VA + ro + 4 * v4); vv = (f32x4){bf2f(vr.x & 0xffffu), bf2f(vr.x >> 16), bf2f(vr.y & 0xffffu), bf2f(vr.y >> 16)}; }
        f32x4 o4 = {0.f, 0.f, 0.f, 0.f};
#pragma unroll
        for (int kk = 0; kk < 8; ++kk) { const int k = 8 * kg + kk; const float dec = __expf(LF[ro + k]), ka = bf2f(KA[ro + k]), q = bf2f(QA[ro + k]);
            const f32x4 sv = *(const GAS f32x4*)(S0 + (size_t)k * 128 + 4 * v4); const f32x4 nv = sv * dec + vv * ka; *(GAS f32x4*)(S1 + (size_t)k * 128 + 4 * v4) = nv; o4 += nv * q; }
        __syncthreads();
        *(LAS f32x4*)(RED + kg * 128 + 4 * v4) = o4;
        __syncthreads();
        if (tid < 64) {
            float oa = 0.f, ob = 0.f;
#pragma unroll
            for (int g = 0; g < 16; ++g) { oa += RED[g * 128 + lane]; ob += RED[g * 128 + 64 + lane]; }
            const float ss = wave_sum(oa * oa + ob * ob); const float rs = rsqrtf(ss * (1.0f / 128.0f) + RMS_EPS);
            MIX[(size_t)row * 1024 + h * 128 + lane] = (bf16)f2bf(oa * rs * NG[lane] * bf2f(GA[ro + lane]));
            MIX[(size_t)row * 1024 + h * 128 + 64 + lane] = (bf16)f2bf(ob * rs * NG[64 + lane] * bf2f(GA[ro + 64 + lane]));
        }
    }
}

DI unsigned ord_key(float v) { const unsigned bits = __builtin_bit_cast(unsigned, v); return (bits & 0x80000000u) ? ~bits : (bits | 0x80000000u); }
DI u64 select256(const unsigned (&u)[33], int lane) {
    unsigned Tv = 0u;
    for (int bit = 31; bit >= 0; --bit) {
        const unsigned cand = Tv | (1u << bit); int cnt = 0;
#pragma unroll
        for (int j = 0; j < 33; ++j) cnt += __builtin_popcountll(__ballot(u[j] >= cand));
        if (cnt >= 256) Tv = cand;
    }
    int ngt = 0;
#pragma unroll
    for (int j = 0; j < 33; ++j) ngt += __builtin_popcountll(__ballot(u[j] > Tv));
    int need = 256 - ngt; u64 my = 0ull;
#pragma unroll
    for (int j = 0; j < 33; ++j) {
        const u64 gt = __ballot(u[j] > Tv), eq = __ballot(u[j] == Tv); const int c = __builtin_popcountll(eq); u64 take;
        if (c <= need) { take = eq; need -= c; }
        else { take = 0ull; u64 e = eq; for (int z = 0; z < need; ++z) { const u64 low = e & (~e + 1ull); take |= low; e ^= low; } need = 0; }
        const u64 wd = gt | take; my = (lane == j) ? wd : my;
    }
    return my;
}

DI void dsa_prompt_item(Frame& F, int b, int qblk) {
    constexpr int QP = 520;
    LAS bf16* QIL = (LAS bf16*)(F.lds + 0);
    LAS u64* MASK = (LAS u64*)(F.lds + 66560);
    int tid_ = F.tid; asm volatile("" : "+v"(tid_)); LAUNDER_F(F);
    const int tid = tid_, lane = tid & 63, w = __builtin_amdgcn_readfirstlane(tid >> 6), l31 = lane & 31, hh = lane >> 5;
    const int q0 = 64 * qblk, nq = (T - q0) < 64 ? (T - q0) : 64, tmax = q0 + nq - 1, nkt = tmax / 32 + 1;
    const GAS bf16* QI = (const GAS bf16*)(F.ws + WS_QI); const GAS bf16* KIB = (const GAS bf16*)(F.ws + WS_KIB); const GAS float* WI = (const GAS float*)(F.ws + WS_WI);
    const GAS bf16* QB = (const GAS bf16*)(F.ws + WS_QB); const GAS bf16* KBB = (const GAS bf16*)(F.ws + WS_KBB); const GAS bf16* VT = (const GAS bf16*)(F.ws + WS_VT); GAS bf16* MIX = (GAS bf16*)(F.ws + WS_MIX);
    GAS float* SC = (GAS float*)(F.ws + WS_SC) + (size_t)F.wg * 64 * TP;
    const size_t rb = (size_t)b * T;
#pragma unroll
    for (int i = 0; i < 8; ++i) { const int e = tid + 512 * i, r = e >> 6, c8 = e & 63; const int t = q0 + r < T ? q0 + r : T - 1;
        *(LAS u32x4*)(QIL + r * QP + 8 * c8) = *(const GAS u32x4*)(QI + (rb + t) * 512 + 8 * c8); }
    __syncthreads();
    {
        const int qh = w & 1, tq = q0 + 32 * qh + l31, tqc = tq < T ? tq : T - 1;
        float wq[8]; { const f32x4 a = *(const GAS f32x4*)(WI + (rb + tqc) * 8), c = *(const GAS f32x4*)(WI + (rb + tqc) * 8 + 4); wq[0] = a[0]; wq[1] = a[1]; wq[2] = a[2]; wq[3] = a[3]; wq[4] = c[0]; wq[5] = c[1]; wq[6] = c[2]; wq[7] = c[3]; }
        const int tlast = (q0 + 32 * qh + 31) < tmax ? (q0 + 32 * qh + 31) : tmax;
        if (q0 + 32 * qh <= tmax)
        for (int kt = (w >> 1); 32 * kt <= tlast; kt += 4) {
            const int key = 32 * kt + l31, keyc = key < T ? key : T - 1;
            bf16x8 ka[4];
#pragma unroll
            for (int ks = 0; ks < 4; ++ks) ka[ks] = *(const GAS bf16x8*)(KIB + (rb + keyc) * 64 + 16 * ks + 8 * hh);
            f32x16 tot;
#pragma unroll
            for (int r = 0; r < 16; ++r) tot[r] = 0.f;
#pragma unroll
            for (int hd = 0; hd < 8; ++hd) {
                asm volatile("" ::: "memory");
                f32x16 a;
#pragma unroll
                for (int r = 0; r < 16; ++r) a[r] = 0.f;
#pragma unroll
                for (int ks = 0; ks < 4; ++ks) a = MFMA32(ka[ks], *(const LAS bf16x8*)(QIL + (32 * qh + l31) * QP + hd * 64 + 16 * ks + 8 * hh), a);
#pragma unroll
                for (int r = 0; r < 16; ++r) tot[r] += wq[hd] * fmaxf(a[r], 0.f);
            }
            if (tq < T) {
#pragma unroll
                for (int g = 0; g < 4; ++g) *(GAS f32x4*)(SC + (size_t)(32 * qh + l31) * TP + 32 * kt + 8 * g + 4 * hh) = (f32x4){tot[4 * g], tot[4 * g + 1], tot[4 * g + 2], tot[4 * g + 3]};
            }
        }
    }
    __syncthreads();
    for (int i = 0; i < 8; ++i) {
        const int q = w * 8 + i, t = q0 + q; LAS u64* mrow = MASK + q * 34;
        if (t >= T) { if (lane < 34) mrow[lane] = 0ull; continue; }
        const int jfull = t >> 6, rem = t & 63;
        if (t + 1 <= 256) { if (lane < 34) mrow[lane] = lane < jfull ? ~0ull : (lane == jfull ? ((2ull << rem) - 1ull) : 0ull); continue; }
        unsigned u[33];
#pragma unroll
        for (int j = 0; j < 33; ++j) { const int sidx = 64 * j + lane; u[j] = sidx <= t ? ord_key(SC[(size_t)q * TP + sidx]) : 0u; }
        const u64 my = select256(u, lane);
        if (lane < 34) mrow[lane] = lane < 33 ? my : 0ull;
    }
    __syncthreads();
    {
        const int hd = w, g = hd >> 2;
        const LAS unsigned* M32 = (const LAS unsigned*)MASK;
        for (int qh = 0; qh < 2; ++qh) {
            if (q0 + 32 * qh > tmax) break;
            const int tq = q0 + 32 * qh + l31, tqc = tq < T ? tq : T - 1;
            bf16x8 qf[4];
#pragma unroll
            for (int ks = 0; ks < 4; ++ks) qf[ks] = *(const GAS bf16x8*)(QB + (rb + tqc) * 512 + hd * 64 + 16 * ks + 8 * hh);
            f32x16 O[2]; float mrun = -INFINITY, lrun = 0.f;
#pragma unroll
            for (int dt = 0; dt < 2; ++dt)
#pragma unroll
                for (int r = 0; r < 16; ++r) O[dt][r] = 0.f;
            const int tlast = (q0 + 32 * qh + 31) < tmax ? (q0 + 32 * qh + 31) : tmax;
            for (int kt = 0; 32 * kt <= tlast; ++kt) {
                const int key = 32 * kt + l31, keyc = key < T ? key : T - 1;
                bf16x8 kf[4];
#pragma unroll
                for (int ks = 0; ks < 4; ++ks) kf[ks] = *(const GAS bf16x8*)(KBB + (rb + keyc) * 128 + g * 64 + 16 * ks + 8 * hh);
                bf16x8 vf[2][2];
#pragma unroll
                for (int dt = 0; dt < 2; ++dt)
#pragma unroll
                    for (int s2 = 0; s2 < 2; ++s2) { const GAS bf16* vp = VT + ((size_t)(b * 2 + g) * 64 + 32 * dt + l31) * TP + 32 * kt + 16 * s2 + 4 * hh;
                        const u32x2 lo = *(const GAS u32x2*)vp, hi = *(const GAS u32x2*)(vp + 8); u32x4 pk; pk.x = lo.x; pk.y = lo.y; pk.z = hi.x; pk.w = hi.y; vf[dt][s2] = __builtin_bit_cast(bf16x8, pk); }
                f32x16 sa;
#pragma unroll
                for (int r = 0; r < 16; ++r) sa[r] = 0.f;
#pragma unroll
                for (int ks = 0; ks < 4; ++ks) sa = MFMA32(kf[ks], qf[ks], sa);
                const unsigned mw = M32[(32 * qh + l31) * 68 + kt] >> (4 * hh);
                float mx = -INFINITY;
#pragma unroll
                for (int r = 0; r < 16; ++r) { const bool on = (mw >> ((r & 3) + 8 * (r >> 2))) & 1u; sa[r] = on ? sa[r] : -INFINITY; mx = fmaxf(mx, sa[r]); }
                mx = fmaxf(mx, __shfl_xor(mx, 32));
                const float mnew = fmaxf(mrun, mx);
                const float msafe = mnew == -INFINITY ? 0.f : mnew;
                const float alpha = __expf(mrun - msafe);
                float pr[16]; float rs = 0.f;
#pragma unroll
                for (int r = 0; r < 16; ++r) { pr[r] = __expf(sa[r] - msafe); rs += pr[r]; }
                rs += __shfl_xor(rs, 32);
                lrun = lrun * alpha + rs; mrun = mnew;
#pragma unroll
                for (int dt = 0; dt < 2; ++dt)
#pragma unroll
                    for (int r = 0; r < 16; ++r) O[dt][r] *= alpha;
#pragma unroll
                for (int s2 = 0; s2 < 2; ++s2) {
                    const float pv[8] = {pr[8 * s2], pr[8 * s2 + 1], pr[8 * s2 + 2], pr[8 * s2 + 3], pr[8 * s2 + 4], pr[8 * s2 + 5], pr[8 * s2 + 6], pr[8 * s2 + 7]};
                    const bf16x8 pf = pack8(pv);
#pragma unroll
                    for (int dt = 0; dt < 2; ++dt) O[dt] = MFMA32(vf[dt][s2], pf, O[dt]);
                }
            }
            if (tq < T) { const float inv = 1.0f / lrun;
#pragma unroll
                for (int dt = 0; dt < 2; ++dt)
#pragma unroll
                    for (int g4 = 0; g4 < 4; ++g4) { u32x2 o; o.x = pk2(O[dt][4 * g4] * inv, O[dt][4 * g4 + 1] * inv); o.y = pk2(O[dt][4 * g4 + 2] * inv, O[dt][4 * g4 + 3] * inv);
                        *(GAS u32x2*)(MIX + (rb + tq) * 1024 + 512 + hd * 64 + 32 * dt + 8 * g4 + 4 * hh) = o; } }
        }
    }
}

DI void dsa_sample_item(Frame& F, int li, int s) {
    LAS float* QIF = (LAS float*)(F.lds + 0);
    LAS float* QBF = (LAS float*)(F.lds + 2048);
    LAS float* WIF = (LAS float*)(F.lds + 4096);
    LAS float* SCL = (LAS float*)(F.lds + 4352);
    LAS int* SEL = (LAS int*)(F.lds + 12800);
    LAS float* LG = (LAS float*)(F.lds + 13824);
    int tid_ = F.tid; asm volatile("" : "+v"(tid_)); LAUNDER_F(F);
    const int tid = tid_, lane = tid & 63, wv = __builtin_amdgcn_readfirstlane(tid >> 6), row = NPR + s;
    const GAS int* PT = (const GAS int*)GIN(9) + s * NPAGES;
    QIF[tid] = bf2f(((const GAS bf16*)(F.ws + WS_QI))[(size_t)row * 512 + tid]);
    QBF[tid] = bf2f(((const GAS bf16*)(F.ws + WS_QB))[(size_t)row * 512 + tid]);
    if (tid < 8) WIF[tid] = ((const GAS float*)(F.ws + WS_WI))[(size_t)row * 8 + tid];
    __syncthreads();
    {
        const GAS float* kp[4];
#pragma unroll
        for (int i = 0; i < 4; ++i) { const int n = tid + 512 * i; const int pg = PT[n >> 7]; kp[i] = GIN(4) + ((size_t)(pg * PAGE + (n & 127)) * 2 + li) * 64; }
        float acc[4][8];
#pragma unroll
        for (int i = 0; i < 4; ++i)
#pragma unroll
            for (int hd = 0; hd < 8; ++hd) acc[i][hd] = 0.f;
#pragma unroll 2
        for (int dq = 0; dq < 16; ++dq) {
            f32x4 kv[4];
#pragma unroll
            for (int i = 0; i < 4; ++i) kv[i] = *(const GAS f32x4*)(kp[i] + 4 * dq);
#pragma unroll
            for (int hd = 0; hd < 8; ++hd) { const f32x4 qv = *(const LAS f32x4*)(QIF + hd * 64 + 4 * dq);
#pragma unroll
                for (int i = 0; i < 4; ++i) acc[i][hd] += kv[i][0] * qv[0] + kv[i][1] * qv[1] + kv[i][2] * qv[2] + kv[i][3] * qv[3]; }
        }
#pragma unroll
        for (int i = 0; i < 4; ++i) { float sc = 0.f;
#pragma unroll
            for (int hd = 0; hd < 8; ++hd) sc += WIF[hd] * fmaxf(acc[i][hd], 0.f);
            SCL[tid + 512 * i] = sc; }
        if (tid < 64) {
            const float kvn = F.out[O_IS + ((size_t)s * 2 + li) * 64 + lane]; float sc = 0.f;
#pragma unroll
            for (int hd = 0; hd < 8; ++hd) { const float d = wave_sum(kvn * QIF[hd * 64 + lane]); sc += WIF[hd] * fmaxf(d, 0.f); }
            if (lane == 0) SCL[2048] = sc;
        }
    }
    __syncthreads();
    if (wv == 0) {
        unsigned u[33];
#pragma unroll
        for (int j = 0; j < 33; ++j) { const int sidx = 64 * j + lane; u[j] = sidx <= PAST ? ord_key(SCL[sidx]) : 0u; }
        const u64 my = select256(u, lane);
        int base = 0;
#pragma unroll
        for (int j = 0; j < 33; ++j) { const u64 wd = __shfl(my, j); const bool on = (wd >> lane) & 1ull; const int pos = base + __builtin_popcountll(wd & ((1ull << lane) - 1ull));
            if (on && pos < 256) SEL[pos] = 64 * j + lane; base += __builtin_popcountll(wd); }
    }
    __syncthreads();
    {
        const int n = tid >> 1, g = tid & 1, idx = SEL[n];
        const GAS float* kp = idx < PAST ? GIN(2) + ((size_t)(PT[idx >> 7] * PAGE + (idx & 127)) * 2 + li) * 128 + g * 64 : F.out + O_KS + ((size_t)s * 2 + li) * 128 + g * 64;
        float a4[4] = {0.f, 0.f, 0.f, 0.f};
#pragma unroll 4
        for (int dq = 0; dq < 16; ++dq) { const f32x4 kv = *(const GAS f32x4*)(kp + 4 * dq);
#pragma unroll
            for (int i = 0; i < 4; ++i) { const f32x4 qv = *(const LAS f32x4*)(QBF + (4 * g + i) * 64 + 4 * dq); a4[i] += kv[0] * qv[0] + kv[1] * qv[1] + kv[2] * qv[2] + kv[3] * qv[3]; } }
#pragma unroll
        for (int i = 0; i < 4; ++i) LG[(4 * g + i) * 256 + n] = a4[i];
    }
    __syncthreads();
    {
        const int hd = wv; float v[4]; float mx = -INFINITY;
#pragma unroll
        for (int i = 0; i < 4; ++i) { v[i] = LG[hd * 256 + lane + 64 * i]; mx = fmaxf(mx, v[i]); }
#pragma unroll
        for (int o = 1; o < 64; o <<= 1) mx = fmaxf(mx, __shfl_xor(mx, o));
        float sm = 0.f;
#pragma unroll
        for (int i = 0; i < 4; ++i) { v[i] = __expf(v[i] - mx); sm += v[i]; }
        sm = wave_sum(sm); const float inv = 1.0f / sm;
#pragma unroll
        for (int i = 0; i < 4; ++i) LG[hd * 256 + lane + 64 * i] = v[i] * inv;
    }
    __syncthreads();
    {
        const int hd = tid >> 6, g = hd >> 2; float o = 0.f;
        for (int n = 0; n < 256; ++n) { const int idx = SEL[n];
            const GAS float* vp = idx < PAST ? GIN(3) + ((size_t)(PT[idx >> 7] * PAGE + (idx & 127)) * 2 + li) * 128 + g * 64 : F.out + O_VS + ((size_t)s * 2 + li) * 128 + g * 64;
            o += LG[hd * 256 + n] * vp[lane]; }
        ((GAS bf16*)(F.ws + WS_MIX))[(size_t)row * 1024 + 512 + hd * 64 + lane] = (bf16)f2bf(o);
    }
}

struct OutProj {
    static constexpr bool GATHER = false, SPLITB = false; static constexpr int KSPLIT = 0, K = 1024, lda = 1024, ldb = 1024;
    const GAS bf16* A; const GAS bf16* Bt; int G, c; GAS float* X;
    DI bool next(int i, pg8::Unit& u) const { if (!pg8::static_next<M / 256, 4>(G, c, i, u.pm, u.pn)) return false;
        u.B0 = (const GAS char*)(Bt + (size_t)u.pn * 256 * 1024); u.B1 = u.B0; u.aux = 0; return true; }
    DI void epi(const AccT& acc, const pg8::Unit& u, int wr, int wc, int fr, int fq) const {
        asm volatile("" : "+v"(fr), "+v"(fq));
#pragma unroll
        for (int ai = 0; ai < 2; ++ai)
#pragma unroll
            for (int m = 0; m < 4; ++m) { GAS float* rp = X + (unsigned)(u.pm * 256 + ai * 128 + wr * 64 + m * 16 + fr) * D + u.pn * 256 + wc * 32 + 4 * fq;
#pragma unroll
                for (int bj = 0; bj < 2; ++bj)
#pragma unroll
                    for (int n = 0; n < 2; ++n) { GAS f32x4* q = (GAS f32x4*)(rp + bj * 128 + n * 16); *q = *q * DN_ALPHA + acc[ai][bj][m][n]; }
                asm volatile("" ::: "memory"); }
    }
};

DI void p_ln(Frame& F, int layer, bool second, bool final_) {
    int tid_ = F.tid; asm volatile("" : "+v"(tid_)); LAUNDER_F(F);
    const int tid = tid_, lane = tid & 63, wv = __builtin_amdgcn_readfirstlane(tid >> 6);
    const bool route = !second;
    LAS float* RW = (LAS float*)(F.lds + 0);
    if (route) {
        const GAS float* gw = GIN(32) + (size_t)layer * 1024 * 4; const GAS float* ew = GIN(34) + (size_t)layer * 1024 * 16;
        for (int e = tid; e < 1024 * 4; e += 512) RW[(e >> 2) * 20 + (e & 3)] = gw[e];
        for (int e = tid; e < 1024 * 16; e += 512) RW[(e >> 4) * 20 + 4 + (e & 15)] = ew[e];
        __syncthreads();
    }
    const GAS float* lg = GIN(second ? 30 : 28) + layer * D; const GAS float* lb = GIN(second ? 31 : 29) + layer * D;
    f32x4 g4[4], b4[4];
#pragma unroll
    for (int j = 0; j < 4; ++j) { g4[j] = *((const GAS f32x4*)lg + lane + 64 * j); b4[j] = *((const GAS f32x4*)lb + lane + 64 * j); }
    GAS float* X = (GAS float*)(F.ws + WS_X); GAS bf16* XB = (GAS bf16*)(F.ws + WS_XB);
    for (int m = F.wg * 8 + wv; m < M; m += F.G * 8) {
        asm volatile("" ::: "memory");
        f32x4 v[4]; float sm = 0.f;
#pragma unroll
        for (int j = 0; j < 4; ++j) { v[j] = *((const GAS f32x4*)(X + (size_t)m * D) + lane + 64 * j); sm += (v[j][0] + v[j][1]) + (v[j][2] + v[j][3]); }
        const float mean = wave_sum(sm) * (1.0f / D); float s2 = 0.f;
#pragma unroll
        for (int j = 0; j < 4; ++j) { v[j] = v[j] - mean; s2 += (v[j][0] * v[j][0] + v[j][1] * v[j][1]) + (v[j][2] * v[j][2] + v[j][3] * v[j][3]); }
        const float rstd = rsqrtf(wave_sum(s2) * (1.0f / D) + LN_EPS);
#pragma unroll
        for (int j = 0; j < 4; ++j) v[j] = v[j] * rstd * g4[j] + b4[j];
        if (final_) {
            GAS float* dst = nullptr;
            if (m < NPR) { const int b = m / T, t = m % T; if (t >= NMETA) dst = F.out + O_YP + ((size_t)b * SEQ + (t - NMETA)) * D; }
            else dst = F.out + O_YS + (size_t)(m - NPR) * D;
            if (dst) {
#pragma unroll
                for (int j = 0; j < 4; ++j) *((GAS f32x4*)dst + lane + 64 * j) = v[j]; }
        } else {
#pragma unroll
            for (int j = 0; j < 4; ++j) { *((GAS f32x4*)(X + (size_t)m * D) + lane + 64 * j) = v[j]; u32x2 o; o.x = pk2(v[j][0], v[j][1]); o.y = pk2(v[j][2], v[j][3]); *((GAS u32x2*)(XB + (size_t)m * D) + lane + 64 * j) = o; }
        }
        if (route) {
            float pl[20];
#pragma unroll
            for (int e = 0; e < 20; ++e) pl[e] = 0.f;
#pragma unroll
            for (int j = 0; j < 4; ++j)
#pragma unroll
                for (int i = 0; i < 4; ++i) { const LAS float* wp = RW + (4 * lane + 256 * j + i) * 20; const float xv = v[j][i];
#pragma unroll
                    for (int q = 0; q < 5; ++q) { const f32x4 wq = *(const LAS f32x4*)(wp + 4 * q); pl[4 * q] += xv * wq[0]; pl[4 * q + 1] += xv * wq[1]; pl[4 * q + 2] += xv * wq[2]; pl[4 * q + 3] += xv * wq[3]; } }
#pragma unroll
            for (int e = 0; e < 20; ++e) pl[e] = wave_sum(pl[e]);
            const GAS float* gb = GIN(33) + layer * 4; const GAS float* eb = GIN(35) + layer * 16;
            float l0 = pl[0] + gb[0], l1 = pl[1] + gb[1], l2 = pl[2] + gb[2], l3 = pl[3] + gb[3];
            int g = 0; float lm = l0; if (l1 > lm) { lm = l1; g = 1; } if (l2 > lm) { lm = l2; g = 2; } if (l3 > lm) { lm = l3; g = 3; }
            const float gval = 1.0f / (__expf(l0 - lm) + __expf(l1 - lm) + __expf(l2 - lm) + __expf(l3 - lm));
            float le[4];
#pragma unroll
            for (int i = 0; i < 4; ++i) le[i] = (g == 0 ? pl[4 + i] : g == 1 ? pl[8 + i] : g == 2 ? pl[12 + i] : pl[16 + i]) + eb[4 * g + i];
            int ea = 0; float la = le[0];
#pragma unroll
            for (int i = 1; i < 4; ++i) if (le[i] > la) { la = le[i]; ea = i; }
            int e2 = -1; float l2b = -INFINITY;
#pragma unroll
            for (int i = 0; i < 4; ++i) if (i != ea && le[i] > l2b) { l2b = le[i]; e2 = i; }
            const float p1 = 1.0f / (1.0f + __expf(l2b - la)), p2 = 1.0f - p1;
            const int lo = ea < e2 ? ea : e2, hi = ea < e2 ? e2 : ea;
            const float glo = gval * (ea < e2 ? p1 : p2), ghi = gval * (ea < e2 ? p2 : p1);
            const int pr = lo == 0 ? hi - 1 : (lo == 1 ? hi + 1 : 5), cls = g * 6 + pr;
            if (lane == 0) {
                const unsigned pos = __hip_atomic_fetch_add(F.ctl + CW_CNT + layer * 64 + cls, 1u, __ATOMIC_RELAXED, __HIP_MEMORY_SCOPE_AGENT);
                ((GAS int*)(F.ws + WS_TOK))[(size_t)cls * CLS_CAP + pos] = m;
                *(GAS f32x2*)((GAS float*)(F.ws + WS_GATE) + (size_t)m * 2) = (f32x2){glo, ghi};
            }
        }
    }
}

DI void moe_setup(Frame& F, int layer) {
    int tid = F.tid; asm volatile("" : "+v"(tid));
    __syncthreads();
    if (tid < NCLS) F.MISC[48 + tid] = __hip_atomic_load(F.ctl + CW_CNT + layer * 64 + tid, __ATOMIC_RELAXED, __HIP_MEMORY_SCOPE_AGENT);
    __syncthreads();
    if (tid == 0) { unsigned run = 0; for (int c = 0; c < NCLS; ++c) { F.MISC[16 + c] = run; run += (F.MISC[48 + c] + 255u) >> 8; } F.MISC[16 + NCLS] = run; }
    __syncthreads();
}
DI void cls_experts(int cls, int& elo, int& ehi) { const int g = cls / 6, pr = cls % 6; const int lo = pr < 3 ? 0 : (pr < 5 ? 1 : 2), hi = pr < 3 ? pr + 1 : (pr < 5 ? pr - 1 : 3); elo = g * 4 + lo; ehi = g * 4 + hi; }
DI bool moe_next(const volatile LAS unsigned* MISC, int G, int c, int i, int& cp, int& pn, int& cls) {
    const int npan = __builtin_amdgcn_readfirstlane((int)MISC[16 + NCLS]); const long L = (long)i * G + c; if (L >= 4L * npan) return false;
    cp = (int)(L >> 2); pn = (int)(L & 3); cls = 0;
    for (int k = 1; k < NCLS; ++k) if (__builtin_amdgcn_readfirstlane((int)MISC[16 + k]) <= cp) cls = k;
    return true;
}
struct MoeUp {
    static constexpr bool GATHER = true, SPLITB = false; static constexpr int KSPLIT = 0, K = 1024, lda = 1024, ldb = 1024;
    const GAS bf16* A; int G, c, layer; GAS unsigned char* ws; const volatile LAS unsigned* MISC;
    DI bool next(int i, pg8::Unit& u) const { int cp, pn, cls; if (!moe_next(MISC, G, c, i, cp, pn, cls)) return false;
        int elo, ehi; cls_experts(cls, elo, ehi); const int e = pn < 2 ? elo : ehi;
        u.pm = cp; u.pn = pn; u.aux = cls; u.B0 = (const GAS char*)((const GAS bf16*)(ws + WS_WGU) + ((size_t)(layer * 16 + e) * 512 + (pn & 1) * 256) * 1024); u.B1 = u.B0; return true; }
    DI unsigned a_row(const pg8::Unit& u, int r) const { const int cls = u.aux, cnt = __builtin_amdgcn_readfirstlane((int)MISC[48 + cls]); int slot = (u.pm - __builtin_amdgcn_readfirstlane((int)MISC[16 + cls])) * 256 + r; slot = slot < cnt ? slot : cnt - 1;
        const int tok = ((const GAS int*)(ws + WS_TOK))[(size_t)cls * CLS_CAP + slot]; return (unsigned)tok * 2048u; }
    DI void epi(const AccT& acc, const pg8::Unit& u, int wr, int wc, int fr, int fq) const {
        asm volatile("" : "+v"(fr), "+v"(fq));
        const int cls = u.aux, cnt = __builtin_amdgcn_readfirstlane((int)MISC[48 + cls]), sbase = (u.pm - __builtin_amdgcn_readfirstlane((int)MISC[16 + cls])) * 256;
        GAS bf16* H = (GAS bf16*)(ws + WS_H);
#pragma unroll
        for (int ai = 0; ai < 2; ++ai)
#pragma unroll
            for (int m = 0; m < 4; ++m) { const int r = ai * 128 + wr * 64 + m * 16 + fr; int slot = sbase + r; slot = slot < cnt ? slot : cnt - 1;
                const int tok = ((const GAS int*)(ws + WS_TOK))[(unsigned)cls * CLS_CAP + slot]; const float gate = ((const GAS float*)(ws + WS_GATE))[(unsigned)tok * 2 + (u.pn >> 1)];
#pragma unroll
                for (int n = 0; n < 2; ++n) { const f32x4 gv = acc[ai][0][m][n], uv = acc[ai][1][m][n]; u32x2 o;
                    o.x = pk2(siluf_(gv[0]) * uv[0] * gate, siluf_(gv[1]) * uv[1] * gate); o.y = pk2(siluf_(gv[2]) * uv[2] * gate, siluf_(gv[3]) * uv[3] * gate);
                    *(GAS u32x2*)(H + (unsigned)(u.pm * 256 + r) * 512 + u.pn * 128 + wc * 32 + n * 16 + 4 * fq) = o; } }
    }
};
struct MoeDown {
    static constexpr bool GATHER = false, SPLITB = true; static constexpr int KSPLIT = 4, K = 512, lda = 512, ldb = 256;
    const GAS bf16* A; int G, c, layer; GAS unsigned char* ws; const volatile LAS unsigned* MISC;
    DI bool next(int i, pg8::Unit& u) const { int cp, pn, cls; if (!moe_next(MISC, G, c, i, cp, pn, cls)) return false;
        int elo, ehi; cls_experts(cls, elo, ehi);
        u.pm = cp; u.pn = pn; u.aux = cls; const GAS bf16* WD = (const GAS bf16*)(ws + WS_WD);
        u.B0 = (const GAS char*)(WD + ((size_t)(layer * 16 + elo) * 1024 + pn * 256) * 256); u.B1 = (const GAS char*)(WD + ((size_t)(layer * 16 + ehi) * 1024 + pn * 256) * 256) - 4 * 128; return true; }
    DI void epi(const AccT& acc, const pg8::Unit& u, int wr, int wc, int fr, int fq) const {
        asm volatile("" : "+v"(fr), "+v"(fq));
        const int cls = u.aux, cnt = __builtin_amdgcn_readfirstlane((int)MISC[48 + cls]), sbase = (u.pm - __builtin_amdgcn_readfirstlane((int)MISC[16 + cls])) * 256;
        GAS float* X = (GAS float*)(ws + WS_X);
#pragma unroll
        for (int ai = 0; ai < 2; ++ai)
#pragma unroll
            for (int m = 0; m < 4; ++m) { const int r = ai * 128 + wr * 64 + m * 16 + fr, slot = sbase + r;
                if (slot < cnt) { const int tok = ((const GAS int*)(ws + WS_TOK))[(unsigned)cls * CLS_CAP + slot]; GAS float* rp = X + (unsigned)tok * D + u.pn * 256 + wc * 32 + 4 * fq;
#pragma unroll
                    for (int bj = 0; bj < 2; ++bj)
#pragma unroll
                        for (int n = 0; n < 2; ++n) { GAS f32x4* q = (GAS f32x4*)(rp + bj * 128 + n * 16); *q = *q * DN_ALPHA + acc[ai][bj][m][n]; } }
                asm volatile("" ::: "memory"); }
    }
};

struct OddIn {
    static constexpr bool GATHER = false, SPLITB = false; static constexpr int KSPLIT = 0, K = 1024, lda = 1024, ldb = 1024;
    const GAS bf16* A; const GAS bf16* Bt; int G, c, li; GAS unsigned char* ws; GAS float* out;
    DI bool next(int i, pg8::Unit& u) const { if (!pg8::static_next<M / 256, ODD_IN / 256>(G, c, i, u.pm, u.pn)) return false;
        u.B0 = (const GAS char*)(Bt + (size_t)u.pn * 256 * 1024); u.B1 = u.B0; u.aux = 0; return true; }
    DI void epi(const AccT& acc, const pg8::Unit& u, int wr, int wc, int fr, int fq) const {
        asm volatile("" : "+v"(fr), "+v"(fq));
        const int pn = u.pn;
#pragma unroll
        for (int ai = 0; ai < 2; ++ai)
#pragma unroll
            for (int m = 0; m < 4; ++m) {
                const int row = u.pm * 256 + ai * 128 + wr * 64 + m * 16 + fr;
                int b = 0, t = 0, sidx = 0; const bool pr = row < NPR; if (pr) { b = row / T; t = row % T; } else sidx = row - NPR;
                if (pn < 4) {
                    GAS float* so = nullptr;
                    if (pr) { if (t >= T - 30) so = out + O_CP + ((unsigned)(b * 2 + li) * 30 + (t - (T - 30))) * 512; } else so = out + O_CS + ((unsigned)(sidx * 2 + li) * 30 + 29) * 512;
#pragma unroll
                    for (int n = 0; n < 2; ++n) { const int ch = 128 * pn + wc * 32 + n * 16 + 4 * fq; const f32x4 a = acc[ai][0][m][n], g = acc[ai][1][m][n]; f32x4 uv;
#pragma unroll
                        for (int j = 0; j < 4; ++j) uv[j] = a[j] * sigmoidf_(g[j]);
                        u32x2 o; o.x = pk2(uv[0], uv[1]); o.y = pk2(uv[2], uv[3]); *(GAS u32x2*)((GAS bf16*)(ws + WS_A0) + (unsigned)row * 512 + ch) = o;
                        if (so) *(GAS f32x4*)(so + ch) = uv; }
                } else if (pn < 6) {
                    GAS float* so = nullptr;
                    if (pr) { if (t >= T - 3) so = out + O_DP + ((unsigned)(b * 2 + li) * 3 + (t - (T - 3))) * 512; } else so = out + O_DS + ((unsigned)(sidx * 2 + li) * 3 + 2) * 512;
#pragma unroll
                    for (int bj = 0; bj < 2; ++bj)
#pragma unroll
                        for (int n = 0; n < 2; ++n) { const int ch = (pn - 4) * 256 + bj * 128 + wc * 32 + n * 16 + 4 * fq; const f32x4 v = acc[ai][bj][m][n];
                            u32x2 o; o.x = pk2(v[0], v[1]); o.y = pk2(v[2], v[3]); *(GAS u32x2*)((GAS bf16*)(ws + WS_A1) + (unsigned)row * 512 + ch) = o;
                            if (so) *(GAS f32x4*)(so + ch) = v; }
                } else {
#pragma unroll
                    for (int bj = 0; bj < 2; ++bj)
#pragma unroll
                        for (int n = 0; n < 2; ++n) { const int ch = (pn - 6) * 256 + bj * 128 + wc * 32 + n * 16 + 4 * fq; const f32x4 v = acc[ai][bj][m][n];
                            u32x2 o; o.x = pk2(gelu_tanh(v[0]), gelu_tanh(v[1])); o.y = pk2(gelu_tanh(v[2]), gelu_tanh(v[3])); *(GAS u32x2*)((GAS bf16*)(ws + WS_A2) + (unsigned)row * 512 + ch) = o; }
                }
            }
    }
};

DI float lru_sp8(float lam) { return 8.0f * log1pf(__expf(-lam)); }
DI void lru_chain_item(Frame& F, int li, int b, int n) {
    int tid_ = F.tid; asm volatile("" : "+v"(tid_)); LAUNDER_F(F);
    const int tid = tid_, lane = tid & 63, w = __builtin_amdgcn_readfirstlane(tid >> 6), l15 = lane & 15, l4 = lane >> 4;
    LAS bf16* XC = (LAS bf16*)(F.lds + 0);
    LAS bf16* WB = (LAS bf16*)(F.lds + 9216);
    LAS float* GT = (LAS float*)(F.lds + 27648);
    LAS float* AA = (LAS float*)(F.lds + 61440);
    LAS float* UU = (LAS float*)(F.lds + 77824);
    LAS float* SEGP = (LAS float*)(F.lds + 94208);
    LAS float* SEGH = (LAS float*)(F.lds + 96256);
    LAS float* HC = (LAS float*)(F.lds + 98304);
    const GAS bf16* DX = (const GAS bf16*)(F.ws + WS_A1); const GAS bf16* DG = (const GAS bf16*)(F.ws + WS_A2); GAS bf16* MIX = (GAS bf16*)(F.ws + WS_MIX);
    const GAS float* wa = GIN(23) + ((size_t)(li * 8 + n) * 64) * 64; const GAS float* wx = GIN(25) + ((size_t)(li * 8 + n) * 64) * 64;
    __syncthreads();
    for (int e = tid; e < 4096; e += 512) { const int i = e >> 6, j = e & 63; WB[j * 72 + i] = (bf16)f2bf(wa[e]); WB[(64 + j) * 72 + i] = (bf16)f2bf(wx[e]); }
    if (tid < 64) HC[tid] = 0.f;
    const int t = tid >> 3, c8 = tid & 7, cb = 64 * n + 8 * c8;
    float dw[4][8], dbv[8], bav[8], bxv[8], sp[8];
#pragma unroll
    for (int j = 0; j < 8; ++j) { dbv[j] = GIN(22)[li * 512 + cb + j]; bav[j] = GIN(24)[li * 512 + cb + j]; bxv[j] = GIN(26)[li * 512 + cb + j]; sp[j] = lru_sp8(GIN(27)[li * 512 + cb + j]);
#pragma unroll
        for (int q = 0; q < 4; ++q) dw[q][j] = GIN(21)[(li * 4 + q) * 512 + cb + j]; }
    constexpr int NCH = (T + 63) / 64;
    for (int c = 0; c < NCH; ++c) {
        const int tg = 64 * c + t;
        float xc[8];
#pragma unroll
        for (int j = 0; j < 8; ++j) xc[j] = dbv[j];
#pragma unroll
        for (int q = 0; q < 4; ++q) { const int ts = tg - 3 + q;
            if (ts >= 0 && ts < T) { const u32x4 raw = *(const GAS u32x4*)(DX + (size_t)(b * T + ts) * 512 + cb); const unsigned rw[4] = {raw.x, raw.y, raw.z, raw.w};
#pragma unroll
                for (int j = 0; j < 8; ++j) xc[j] += dw[q][j] * bf2f((rw[j >> 1] >> (16 * (j & 1))) & 0xffffu); } }
        *(LAS bf16x8*)(XC + t * 72 + 8 * c8) = pack8(xc);
        __syncthreads();
        {
            const bf16x8 b0 = *(const LAS bf16x8*)(WB + (16 * w + l15) * 72 + 8 * l4), b1 = *(const LAS bf16x8*)(WB + (16 * w + l15) * 72 + 32 + 8 * l4);
#pragma unroll
            for (int tt = 0; tt < 4; ++tt) { f32x4 a = {0.f, 0.f, 0.f, 0.f};
                a = MFMA16(*(const LAS bf16x8*)(XC + (16 * tt + l15) * 72 + 8 * l4), b0, a); a = MFMA16(*(const LAS bf16x8*)(XC + (16 * tt + l15) * 72 + 32 + 8 * l4), b1, a);
#pragma unroll
                for (int r = 0; r < 4; ++r) GT[(16 * tt + 4 * l4 + r) * 132 + 16 * w + l15] = a[r]; }
        }
        __syncthreads();
#pragma unroll
        for (int j = 0; j < 8; ++j) { const float r = sigmoidf_(GT[t * 132 + 8 * c8 + j] + bav[j]), ig = sigmoidf_(GT[t * 132 + 64 + 8 * c8 + j] + bxv[j]);
            const float la = -r * sp[j]; float a = __expf(la); float dr = sqrtf(fmaxf(-expm1f(2.0f * la), 0.f)) * ig * xc[j];
            if (tg >= T) { a = 1.0f; dr = 0.f; }
            AA[t * 64 + 8 * c8 + j] = a; UU[t * 64 + 8 * c8 + j] = dr; }
        __syncthreads();
        {
            const int ch = tid & 63, sg = tid >> 6;
            float av[8], uv[8]; float P = 1.0f, H = 0.f;
#pragma unroll
            for (int i = 0; i < 8; ++i) { av[i] = AA[(8 * sg + i) * 64 + ch]; uv[i] = UU[(8 * sg + i) * 64 + ch]; H = av[i] * H + uv[i]; P *= av[i]; }
            SEGP[sg * 64 + ch] = P; SEGH[sg * 64 + ch] = H;
            __syncthreads();
            float h = HC[(c & 1) * 64 + ch];
            for (int q = 0; q < sg; ++q) h = SEGP[q * 64 + ch] * h + SEGH[q * 64 + ch];
#pragma unroll
            for (int i = 0; i < 8; ++i) { h = av[i] * h + uv[i]; UU[(8 * sg + i) * 64 + ch] = h; }
            if (sg == 7) HC[((c + 1) & 1) * 64 + ch] = h;
        }
        __syncthreads();
        if (tg < T) { const u32x4 raw = *(const GAS u32x4*)(DG + (size_t)(b * T + tg) * 512 + cb); const unsigned rw[4] = {raw.x, raw.y, raw.z, raw.w}; float y[8];
#pragma unroll
            for (int j = 0; j < 8; ++j) y[j] = UU[t * 64 + 8 * c8 + j] * bf2f((rw[j >> 1] >> (16 * (j & 1))) & 0xffffu);
            *(GAS bf16x8*)(MIX + (size_t)(b * T + tg) * 1024 + 512 + cb) = pack8(y); }
    }
    __syncthreads();
    if (tid < 64) F.out[O_LP + (size_t)(b * 2 + li) * 512 + 64 * n + tid] = HC[(NCH & 1) * 64 + tid];
}

template <int NV> DI void block_sum2(float (&a)[NV], float (&bq)[NV], LAS float* RED, int wv, int lane) {
#pragma unroll
    for (int i = 0; i < NV; ++i) { a[i] = wave_sum(a[i]); bq[i] = wave_sum(bq[i]); }
    __syncthreads();
    if (lane == 0) {
#pragma unroll
        for (int i = 0; i < NV; ++i) { RED[wv * 2 * NV + i] = a[i]; RED[wv * 2 * NV + NV + i] = bq[i]; } }
    __syncthreads();
#pragma unroll
    for (int i = 0; i < NV; ++i) { float x = 0.f, y = 0.f;
#pragma unroll
        for (int q = 0; q < 8; ++q) { x += RED[q * 2 * NV + i]; y += RED[q * 2 * NV + NV + i]; }
        a[i] = x; bq[i] = y; }
}
DI void convc_item(Frame& F, int li, int b, int blk) {
    int tid_ = F.tid; asm volatile("" : "+v"(tid_)); LAUNDER_F(F);
    const int tid = tid_, lane = tid & 63, wv = __builtin_amdgcn_readfirstlane(tid >> 6), c = tid;
    LAS float* RED = (LAS float*)(F.lds + 0);
    const GAS bf16* U = (const GAS bf16*)(F.ws + WS_A0); GAS bf16* MIX = (GAS bf16*)(F.ws + WS_MIX);
    float cw[31];
#pragma unroll
    for (int j = 0; j < 31; ++j) cw[j] = GIN(17)[(size_t)(li * 31 + j) * 512 + c];
    const float cbv = GIN(18)[li * 512 + c], gln = GIN(19)[li * 512 + c], bln = GIN(20)[li * 512 + c];
    for (int g8 = 0; g8 < 8; ++g8) {
        const int t0 = 64 * blk + 8 * g8; if (t0 >= T) break;
        float val[38];
#pragma unroll
        for (int i = 0; i < 38; ++i) { const int ts = t0 - 30 + i; val[i] = (ts >= 0 && ts < T) ? bf2f(U[(size_t)(b * T + ts) * 512 + c]) : 0.f; }
        float y[8], y2[8];
#pragma unroll
        for (int o = 0; o < 8; ++o) { float a = cbv;
#pragma unroll
            for (int j = 0; j < 31; ++j) a += cw[j] * val[o + j];
            y[o] = a; y2[o] = a * a; }
        float s1[8];
#pragma unroll
        for (int o = 0; o < 8; ++o) s1[o] = y[o];
        block_sum2<8>(s1, y2, RED, wv, lane);
#pragma unroll
        for (int o = 0; o < 8; ++o) { const int tg = t0 + o; if (tg < T) { const float mean = s1[o] * (1.0f / 512.0f); const float var = fmaxf(y2[o] * (1.0f / 512.0f) - mean * mean, 0.f);
            const float z = (y[o] - mean) * rsqrtf(var + LN_EPS) * gln + bln; MIX[(size_t)(b * T + tg) * 1024 + c] = (bf16)f2bf(siluf_(z)); } }
    }
}
DI void odd_sample_item(Frame& F, int li, int s) {
    int tid_ = F.tid; asm volatile("" : "+v"(tid_)); LAUNDER_F(F);
    const int tid = tid_, lane = tid & 63, wv = __builtin_amdgcn_readfirstlane(tid >> 6), c = tid, row = NPR + s;
    LAS float* RED = (LAS float*)(F.lds + 0); LAS float* XS = (LAS float*)(F.lds + 1024);
    GAS bf16* MIX = (GAS bf16*)(F.ws + WS_MIX);
    const GAS float* st = GIN(6) + ((size_t)(s * 2 + li) * 30) * 512 + c; GAS float* so = F.out + O_CS + ((size_t)(s * 2 + li) * 30) * 512 + c;
    float a = GIN(18)[li * 512 + c];
#pragma unroll
    for (int j = 0; j < 30; ++j) { const float v = st[(size_t)j * 512]; a += GIN(17)[(size_t)(li * 31 + j) * 512 + c] * v; if (j >= 1) so[(size_t)(j - 1) * 512] = v; }
    a += GIN(17)[(size_t)(li * 31 + 30) * 512 + c] * so[(size_t)29 * 512];
    float s1[1] = {a}, s2[1] = {a * a};
    block_sum2<1>(s1, s2, RED, wv, lane);
    { const float mean = s1[0] * (1.0f / 512.0f), var = fmaxf(s2[0] * (1.0f / 512.0f) - mean * mean, 0.f);
      const float z = (a - mean) * rsqrtf(var + LN_EPS) * GIN(19)[li * 512 + c] + GIN(20)[li * 512 + c]; MIX[(size_t)row * 1024 + c] = (bf16)f2bf(siluf_(z)); }
    const GAS float* sd = GIN(7) + ((size_t)(s * 2 + li) * 3) * 512 + c; GAS float* sdo = F.out + O_DS + ((size_t)(s * 2 + li) * 3) * 512 + c;
    const float d0 = sd[0], d1 = sd[512], d2 = sd[1024], d3 = sdo[1024];
    sdo[0] = d1; sdo[512] = d2;
    const float xc = GIN(22)[li * 512 + c] + GIN(21)[(li * 4 + 0) * 512 + c] * d0 + GIN(21)[(li * 4 + 1) * 512 + c] * d1 + GIN(21)[(li * 4 + 2) * 512 + c] * d2 + GIN(21)[(li * 4 + 3) * 512 + c] * d3;
    __syncthreads();
    XS[c] = xc;
    __syncthreads();
    const int n = c >> 6, j = c & 63; const GAS float* wa = GIN(23) + ((size_t)(li * 8 + n) * 64) * 64 + j; const GAS float* wx = GIN(25) + ((size_t)(li * 8 + n) * 64) * 64 + j;
    float ra = GIN(24)[li * 512 + c], ia = GIN(26)[li * 512 + c];
#pragma unroll 8
    for (int i = 0; i < 64; ++i) { const float xv = XS[64 * n + i]; ra += xv * wa[(size_t)i * 64]; ia += xv * wx[(size_t)i * 64]; }
    const float r = sigmoidf_(ra), ig = sigmoidf_(ia), la = -r * lru_sp8(GIN(27)[li * 512 + c]);
    const float h = __expf(la) * GIN(8)[(size_t)(s * 2 + li) * 512 + c] + sqrtf(fmaxf(-expm1f(2.0f * la), 0.f)) * ig * xc;
    F.out[O_LS + (size_t)(s * 2 + li) * 512 + c] = h;
    MIX[(size_t)row * 1024 + 512 + c] = (bf16)f2bf(h * bf2f(((const GAS bf16*)(F.ws + WS_A2))[(size_t)row * 512 + c]));
}
NOINL void ph_prologue(Frame F) { frame_fix(F); p_prologue(F); }
DI void ph_evenin(Frame F, int li) { LAUNDER_F(F);
    { EvenIn<false> P; P.A = (const GAS bf16*)(F.ws + WS_XB); P.Bt = (const GAS bf16*)(F.ws + WS_WINE) + (size_t)li * EVEN_PAD * 1024; P.G = F.G; P.c = F.vcu; P.li = li; P.ws = F.ws; P.out = F.out;
      pg8::gemm_phase(F.lds, P); }
    LAUNDER_F(F);
    { EvenIn<true> P; P.A = (const GAS bf16*)(F.ws + WS_XB); P.Bt = (const GAS bf16*)(F.ws + WS_WINE) + (size_t)li * EVEN_PAD * 1024; P.G = F.G; P.c = F.vcu; P.li = li; P.ws = F.ws; P.out = F.out;
      pg8::gemm_phase(F.lds, P); } }
DI void ph_oddin(Frame F, int li) { LAUNDER_F(F);
    OddIn P; P.A = (const GAS bf16*)(F.ws + WS_XB); P.Bt = (const GAS bf16*)(F.ws + WS_WINO) + (size_t)li * ODD_IN * 1024; P.G = F.G; P.c = F.vcu; P.li = li; P.ws = F.ws; P.out = F.out;
    pg8::gemm_phase(F.lds, P); }
DI void ph_outproj(Frame F, int layer) { LAUNDER_F(F);
    OutProj P; P.A = (const GAS bf16*)(F.ws + WS_MIX); P.Bt = (const GAS bf16*)(F.ws + ((layer & 1) ? WS_WOUTO : WS_WOUTE)) + (size_t)(layer >> 1) * 1024 * 1024; P.G = F.G; P.c = F.vcu; P.X = (GAS float*)(F.ws + WS_X);
    pg8::gemm_phase(F.lds, P); }
DI void ph_moeup(Frame F, int layer) { LAUNDER_F(F); moe_setup(F, layer);
    MoeUp P; P.A = (const GAS bf16*)(F.ws + WS_XB); P.G = F.G; P.c = F.vcu; P.layer = layer; P.ws = F.ws; P.MISC = F.MISC;
    pg8::gemm_phase(F.lds, P); }
DI void ph_moedown(Frame F, int layer) { LAUNDER_F(F); moe_setup(F, layer);
    MoeDown P; P.A = (const GAS bf16*)(F.ws + WS_H); P.G = F.G; P.c = F.vcu; P.layer = layer; P.ws = F.ws; P.MISC = F.MISC;
    pg8::gemm_phase(F.lds, P); }
NOINL void ph_ln1(Frame F, int layer) { frame_fix(F); p_ln(F, rfl(layer), false, false); }
NOINL void ph_ln2(Frame F, int layer, int fin) { frame_fix(F); p_ln(F, rfl(layer), true, rfl(fin) != 0); }
NOINL void it_hgrn_prompt(Frame F, int li, int b, int h) { frame_fix(F); hgrn_prompt_item(F, rfl(li), rfl(b), rfl(h)); }
NOINL void it_hgrn_sample(Frame F, int li, int sq) { frame_fix(F); hgrn_sample_item(F, rfl(li), rfl(sq)); }
DI void it_dsa_prompt(Frame F, int b, int qblk) { dsa_prompt_item(F, b, qblk); }
DI void it_dsa_sample(Frame F, int li, int sq) { dsa_sample_item(F, li, sq); }
DI void it_lru_chain(Frame F, int li, int b, int n) { lru_chain_item(F, li, b, n); }
DI void it_convc(Frame F, int li, int b, int blk) { convc_item(F, li, b, blk); }
NOINL void it_odd_sample(Frame F, int li, int sq) { frame_fix(F); odd_sample_item(F, rfl(li), rfl(sq)); }
DI void p_even_mixer(Frame& F, int li, int qidx) {
    constexpr int E0 = 32, E1 = E0 + 8 * 33, E2 = E1 + NSM, E3 = E2 + NSM;
    int it = q_pop(F, qidx);
    while (it < E0) { it_hgrn_prompt(F, li, it >> 2, it & 3); it = q_pop(F, qidx); }
    while (it < E1) { const int j = it - E0; it_dsa_prompt(F, j & 7, 32 - (j >> 3)); it = q_pop(F, qidx); }
    while (it < E2) { it_dsa_sample(F, li, it - E1); it = q_pop(F, qidx); }
    while (it < E3) { it_hgrn_sample(F, li, it - E2); it = q_pop(F, qidx); }
}
DI void p_odd_mixer(Frame& F, int li, int qidx) {
    constexpr int E0 = 64, E1 = E0 + 8 * 33, E2 = E1 + NSM;
    int it = q_pop(F, qidx);
    while (it < E0) { it_lru_chain(F, li, it >> 3, it & 7); it = q_pop(F, qidx); }
    while (it < E1) { const int j = it - E0; it_convc(F, li, j & 7, j >> 3); it = q_pop(F, qidx); }
    while (it < E2) { it_odd_sample(F, li, it - E1); it = q_pop(F, qidx); }
}

constexpr int NPHASE = 29;
__global__ void __launch_bounds__(512, 2) mega(Args args) {
    Frame F;
    F.lds = (LAS unsigned char*)lds_raw; F.MISC = (volatile LAS unsigned*)(F.lds + MISC_OFF);
    F.tid = threadIdx.x; F.lane = F.tid & 63; F.wave = __builtin_amdgcn_readfirstlane(F.tid >> 6);
    F.G = gridDim.x; F.wg = blockIdx.x; F.vcu = (F.G % 8 == 0) ? (F.wg % 8) * (F.G / 8) + F.wg / 8 : F.wg;
    F.in = ((const Args*)__builtin_amdgcn_kernarg_segment_ptr())->in; F.out = (GAS float*)args.out; F.ws = (GAS unsigned char*)args.ws; F.ctl = (unsigned*)(args.ws + WS_CTL);
    for (int u = F.tid; u < (LDS_BYTES - MISC_OFF) / 4; u += 512) ((LAS unsigned*)(F.lds + MISC_OFF))[u] = 0u;
    __syncthreads();
    const int lo = args.ph_lo, hi = args.ph_hi;
    const bool multi = (hi - lo) > 1;
    XcdBarrier bar; bar.bar = F.ctl + CW_BAR; bar.x = 0; bar.st = nullptr;
    if (multi) bar = xcd_barrier_post(F.ctl + CW_BAR, F.MISC + 8);
#define IN(k) (lo <= (k) && (k) < hi)
#define SEAM(k) do { if (IN(k) && IN((k) + 1)) xcd_barrier_call(bar.bar, bar.x, bar.st); } while (0)
    if (IN(0)) ph_prologue(F);
    SEAM(0);
    for (int layer = 0; layer < 4; ++layer) {
        const int pb = 1 + layer * 7, li = layer >> 1;
        if (IN(pb + 0)) { if (!(layer & 1)) ph_evenin(F, li); else ph_oddin(F, li); }
        SEAM(pb + 0);
        if (IN(pb + 1)) { if (!(layer & 1)) p_even_mixer(F, li, layer); else p_odd_mixer(F, li, layer); }
        SEAM(pb + 1);
        if (IN(pb + 2)) ph_outproj(F, layer);
        SEAM(pb + 2);
        if (IN(pb + 3)) ph_ln1(F, layer);
        SEAM(pb + 3);
        if (IN(pb + 4)) ph_moeup(F, layer);
        SEAM(pb + 4);
        if (IN(pb + 5)) ph_moedown(F, layer);
        SEAM(pb + 5);
        if (IN(pb + 6)) ph_ln2(F, layer, layer == 3 ? 1 : 0);
        SEAM(pb + 6);
    }
}

extern "C" void kernel_launch(void* const* d_in, const int* in_sizes, int n_in, void* d_out, int out_size, void* d_ws, size_t ws_size, hipStream_t stream) {
    static int grid = 0;
    if (!grid) {
        int dev = 0, cus = 0, per_cu = 0;
        (void)hipGetDevice(&dev); (void)hipDeviceGetAttribute(&cus, hipDeviceAttributeMultiprocessorCount, dev);
        (void)hipFuncSetAttribute((const void*)mega, hipFuncAttributeMaxDynamicSharedMemorySize, LDS_BYTES);
        (void)hipOccupancyMaxActiveBlocksPerMultiprocessor(&per_cu, (const void*)mega, 512, LDS_BYTES);
        if (per_cu < 1) fprintf(stderr, "occupancy query says %d\n", per_cu);
        grid = cus > 0 ? cus : 256;
        if (n_in != 39 || (size_t)out_size != O_END || ws_size < WS_END) fprintf(stderr, "kernel_launch: unexpected sizes n_in %d out %d ws %zu (need %zu)\n", n_in, out_size, ws_size, (size_t)WS_END);
    }
    (void)hipMemsetAsync((char*)d_ws + WS_CTL, 0, CTL_BYTES, stream);
    Args a; memset(&a, 0, sizeof(a));
    for (int i = 0; i < 39; ++i) a.in[i] = (const float*)d_in[i];
    a.out = (float*)d_out; a.ws = (unsigned char*)d_ws;
    a.ph_lo = 0; a.ph_hi = NPHASE;
    hipLaunchKernelGGL(mega, dim3(grid), dim3(512), LDS_BYTES, stream, a);
}
```

```cpp
#include <hip/hip_runtime.h>
#include <cstdio>
#include <cstdint>
#include <cstring>
#ifndef PROBE_TS
#define PROBE_TS 0
#endif
#ifndef PROBE_BASE
#define PROBE_BASE 0
#endif

#define GAS __attribute__((address_space(1)))
#define LAS __attribute__((address_space(3)))
typedef unsigned short bf16;
typedef short bf16x8 __attribute__((ext_vector_type(8)));
typedef float f32x4 __attribute__((ext_vector_type(4)));
typedef float f32x2 __attribute__((ext_vector_type(2)));
typedef float f32x16 __attribute__((ext_vector_type(16)));
typedef unsigned u32x4 __attribute__((ext_vector_type(4)));
typedef unsigned u32x2 __attribute__((ext_vector_type(2)));
typedef unsigned long long u64;
#define DI __device__ __forceinline__

constexpr int D = 1024, NB = 8, SEQ = 2048, NMETA = 16, T = NMETA + SEQ  , NPR = NB * T  , NSM = 128, M = NPR + NSM  ;
constexpr int PAST = 2048, PAGE = 128, NPAGES = 16, NPHYS = 2560;
constexpr int EVEN_IN = 3400, EVEN_PAD = 3584, ODD_IN = 2048;
constexpr int NCLS = 24, CLS_CAP = M, MAXPAN = 96;
constexpr float DN_ALPHA = 1.681792830507429f;
constexpr float LN_EPS = 1e-5f, RMS_EPS = 1e-6f;

constexpr size_t O_YP = 0, O_YS = O_YP + (size_t)NB * SEQ * D, O_KP = O_YS + (size_t)NSM * D, O_VP = O_KP + (size_t)NPR * 256, O_IP = O_VP + (size_t)NPR * 256,
    O_HP = O_IP + (size_t)NPR * 128, O_CP = O_HP + (size_t)NB * 2 * 4 * 128 * 128, O_DP = O_CP + (size_t)NB * 2 * 30 * 512, O_LP = O_DP + (size_t)NB * 2 * 3 * 512,
    O_KS = O_LP + (size_t)NB * 2 * 512, O_VS = O_KS + (size_t)NSM * 256, O_IS = O_VS + (size_t)NSM * 256, O_HS = O_IS + (size_t)NSM * 128,
    O_CS = O_HS + (size_t)NSM * 2 * 4 * 128 * 128, O_DS = O_CS + (size_t)NSM * 2 * 30 * 512, O_LS = O_DS + (size_t)NSM * 2 * 3 * 512, O_END = O_LS + (size_t)NSM * 2 * 512;

constexpr size_t MiB = 1u << 20;
constexpr size_t WS_CTL = 0, CTL_BYTES = 1 * MiB;
constexpr size_t WS_WINE = 2 * MiB;
constexpr size_t WS_WOUTE = WS_WINE + 2ull * EVEN_PAD * 1024 * 2;
constexpr size_t WS_WINO = WS_WOUTE + 2ull * 1024 * 1024 * 2;
constexpr size_t WS_WOUTO = WS_WINO + 2ull * 2048 * 1024 * 2;
constexpr size_t WS_WGU = WS_WOUTO + 2ull * 1024 * 1024 * 2;
constexpr size_t WS_WD = WS_WGU + 64ull * 512 * 1024 * 2;
constexpr size_t WS_X = WS_WD + 64ull * 1024 * 256 * 2;
constexpr size_t WS_XB = WS_X + (size_t)M * D * 4;
constexpr size_t WS_MIX = WS_XB + (size_t)M * D * 2;
constexpr size_t WS_A0 = WS_MIX + (size_t)M * D * 2;
constexpr size_t WS_A1 = WS_A0 + (size_t)M * 512 * 2;
constexpr size_t WS_A2 = WS_A1 + (size_t)M * 512 * 2;
constexpr size_t WS_A3 = WS_A2 + (size_t)M * 512 * 2;
constexpr size_t WS_LF = WS_A3 + (size_t)M * 512 * 2;
constexpr size_t WS_QB = WS_LF + (size_t)M * 512 * 4;
constexpr size_t WS_QI = WS_QB + (size_t)M * 512 * 2;
constexpr size_t WS_KBB = WS_QI + (size_t)M * 512 * 2;
constexpr size_t WS_KIB = WS_KBB + (size_t)M * 128 * 2;
constexpr size_t WS_WI = WS_KIB + (size_t)M * 64 * 2;
constexpr int TP = 2112;
constexpr size_t WS_VT = WS_WI + (size_t)M * 8 * 4;
constexpr size_t WS_ROPE = WS_VT + 8ull * 2 * 64 * TP * 2;
constexpr size_t WS_LB = WS_ROPE + 2ull * T * 32 * 4;
constexpr size_t WS_H = WS_LB + 2ull * 3 * 512 * 4;
constexpr size_t WS_TOK = WS_H + (size_t)MAXPAN * 256 * 512 * 2;
constexpr size_t WS_GATE = WS_TOK + (size_t)NCLS * CLS_CAP * 4;
constexpr size_t WS_SC = (WS_GATE + (size_t)M * 2 * 4 + 4095) / 4096 * 4096;
constexpr size_t WS_END = WS_SC + 256ull * 64 * TP * 4;

constexpr int CW_BAR = 4096;
constexpr int CW_Q = 8192;
constexpr int CW_CNT = 12288;

constexpr int RING_BYTES = 131072, MISC_OFF = RING_BYTES, LDS_BYTES = 147456;

typedef __bf16 bf16v2 __attribute__((ext_vector_type(2)));
DI unsigned pk2(float lo, float hi) { const f32x2 v = {lo, hi}; return __builtin_bit_cast(unsigned, __builtin_convertvector(v, bf16v2)); }
DI unsigned f2bf(float f) { return pk2(f, 0.f) & 0xffffu; }
DI float bf2f(unsigned b) { return __builtin_bit_cast(float, b << 16); }
DI float sigmoidf_(float x) { return 1.0f / (1.0f + __expf(-x)); }
DI float siluf_(float x) { return x / (1.0f + __expf(-x)); }
DI float gelu_tanh(float x) { const float u = 0.7978845608028654f * (x + 0.044715f * x * x * x); const float e = __expf(2.0f * u); const float th = 1.0f - 2.0f / (e + 1.0f); return 0.5f * x * (1.0f + th); }
DI float dppf(float v, int ctrl_sel) {
    const int x = __builtin_bit_cast(int, v);
    const int r = ctrl_sel == 0 ? __builtin_amdgcn_update_dpp(0, x, 0xB1, 0xf, 0xf, false) : ctrl_sel == 1 ? __builtin_amdgcn_update_dpp(0, x, 0x4E, 0xf, 0xf, false)
                : ctrl_sel == 2 ? __builtin_amdgcn_update_dpp(0, x, 0x141, 0xf, 0xf, false) : __builtin_amdgcn_update_dpp(0, x, 0x140, 0xf, 0xf, false);
    return __builtin_bit_cast(float, r);
}
DI float row_sum16(float v) { v += dppf(v, 0); v += dppf(v, 1); v += dppf(v, 2); v += dppf(v, 3); return v; }
DI float rlf(float v, int l) { return __builtin_bit_cast(float, __builtin_amdgcn_readlane(__builtin_bit_cast(int, v), l)); }
DI float wave_sum(float v) { v = row_sum16(v); return (rlf(v, 0) + rlf(v, 16)) + (rlf(v, 32) + rlf(v, 48)); }

#define XB_TMO      128
#define XB_XCNT(j)  (256  + 64 * (j))
#define XB_XSUB(j)  (1280 + 64 * (j))
#define XB_XGEN(j)  (2304 + 64 * (j))
#define XB_TOP      3328
#define XB_TOPGEN   3392
#define XCD_BAR_WORDS 3456
#define XB_SPIN_CAP (1u << 18)
__device__ __forceinline__ unsigned xb_ld(unsigned* p)              { return __hip_atomic_load(p, __ATOMIC_RELAXED, __HIP_MEMORY_SCOPE_AGENT); }
__device__ __forceinline__ unsigned xb_add(unsigned* p, unsigned v) { return __hip_atomic_fetch_add(p, v, __ATOMIC_RELAXED, __HIP_MEMORY_SCOPE_AGENT); }
__device__ __forceinline__ unsigned xb_xcc_id() { return (unsigned)__builtin_amdgcn_s_getreg((3 << 11) | 20) & 0xFu; }
#define XB_SPIN(cond, bar) do { unsigned _sp = 0; while (cond) { __builtin_amdgcn_s_sleep(1); \
    if ((++_sp & 255u) == 0u) { if (xb_ld(&(bar)[XB_TMO])) break; if (_sp > XB_SPIN_CAP) { atomicAdd(&(bar)[XB_TMO], 1u); break; } } } } while (0)
struct XcdBarrier { unsigned* bar; unsigned x; volatile LAS unsigned* st; };
__device__ __forceinline__ XcdBarrier xcd_barrier_post(unsigned* bar, volatile LAS unsigned* st) {
    XcdBarrier b; b.bar = bar; b.x = xb_xcc_id(); b.st = st;
    if (threadIdx.x == 0) (void)xb_add(&bar[XB_XCNT(b.x)], 1u);
    return b;
}
__device__ __forceinline__ void xcd_barrier_complete(unsigned* bar, unsigned x, unsigned& nloc, unsigned& nx) {
    const unsigned G = gridDim.x * gridDim.y * gridDim.z;
    unsigned sum, cnt, mine, sp = 0u;
    for (;;) {
        sum = 0u; cnt = 0u; mine = 0u;
#pragma unroll
        for (unsigned j = 0; j < 16; ++j) { const unsigned c = xb_ld(&bar[XB_XCNT(j)]); sum += c; cnt += (c > 0u) ? 1u : 0u; mine = (j == x) ? c : mine; }
        if (sum == G) break;
        __builtin_amdgcn_s_sleep(1);
        if ((++sp & 255u) == 0u) { if (xb_ld(&bar[XB_TMO])) break; if (sp > XB_SPIN_CAP) { atomicAdd(&bar[XB_TMO], 1u); break; } }
    }
    nloc = mine > 0u ? mine : 1u; nx = cnt > 0u ? cnt : 1u;
}
__device__ __forceinline__ void xcd_barrier(const XcdBarrier& b) {
    asm volatile("s_waitcnt vmcnt(0)" ::: "memory");
    __syncthreads();
    if (threadIdx.x == 0) {
        unsigned* bar = b.bar;
        __builtin_amdgcn_s_waitcnt(0);
        unsigned nloc = b.st[0], nx = b.st[1];
        if (nloc == 0u) { xcd_barrier_complete(bar, b.x, nloc, nx); b.st[0] = nloc; b.st[1] = nx; }
        const unsigned old = xb_add(&bar[XB_XSUB(b.x)], 1u);
        const unsigned gen = old / nloc;
        if (old + 1u == (gen + 1u) * nloc) {
            __builtin_amdgcn_fence(__ATOMIC_RELEASE, "agent");
            asm volatile("s_waitcnt vmcnt(0)" ::: "memory");
            const unsigned og = xb_add(&bar[XB_TOP], 1u);
            const unsigned tg = og / nx;
            if (og + 1u == (tg + 1u) * nx) xb_add(&bar[XB_TOPGEN], 1u);
            else XB_SPIN(xb_ld(&bar[XB_TOPGEN]) == tg, bar);
            __builtin_amdgcn_fence(__ATOMIC_ACQUIRE, "agent");
            xb_add(&bar[XB_XGEN(b.x)], 1u);
            asm volatile("s_waitcnt vmcnt(0)" ::: "memory");
        } else {
            XB_SPIN(xb_ld(&bar[XB_XGEN(b.x)]) == gen, bar);
            __builtin_amdgcn_fence(__ATOMIC_ACQUIRE, "agent");
            asm volatile("s_waitcnt vmcnt(0)" ::: "memory");
        }
    }
    __syncthreads();
}

__device__ __attribute__((noinline)) void xcd_barrier_call(unsigned* bar, unsigned x, volatile LAS unsigned* st) { XcdBarrier b; b.bar = bar; b.x = x; b.st = st; xcd_barrier(b); }
struct Args { const float* in[39]; float* out; unsigned char* ws; int ph_lo, ph_hi; };
#define GIN(k) ((const GAS float*)F.in[(k)])
#define LAUNDER_F(F) asm volatile("" : "+s"((F).in), "+s"((F).ws), "+s"((F).out), "+s"((F).ctl), "+s"((F).vcu), "+s"((F).G), "+s"((F).wg))
struct Frame {
    LAS unsigned char* lds; volatile LAS unsigned* MISC; unsigned* ctl;
    int tid, lane, wave, G, wg, vcu;
    const float* const* in; GAS float* out; GAS unsigned char* ws;
};
extern __shared__ __attribute__((aligned(16))) unsigned char lds_raw[];
#define NOINL __device__ __attribute__((noinline))
DI int rfl(int v) { return __builtin_amdgcn_readfirstlane(v); }
template <class Pt> DI Pt rfl_ptr(Pt p) { const u64 v = (u64)p; const unsigned lo = (unsigned)rfl((int)(unsigned)v), hi = (unsigned)rfl((int)(unsigned)(v >> 32)); return (Pt)(((u64)hi << 32) | lo); }
DI void frame_fix(Frame& F) {
    F.lds = (LAS unsigned char*)lds_raw; F.MISC = (volatile LAS unsigned*)(F.lds + MISC_OFF);
    F.tid = threadIdx.x; F.lane = F.tid & 63; F.wave = rfl(F.tid >> 6);
    F.G = rfl(F.G); F.wg = rfl(F.wg); F.vcu = rfl(F.vcu);
    F.ctl = rfl_ptr(F.ctl); F.in = rfl_ptr(F.in); F.out = rfl_ptr(F.out); F.ws = rfl_ptr(F.ws);
}

namespace pg8 {
constexpr int BM = 256, BK = 64, HALF = 128, HTB = HALF * BK * 2, STAGE_BYTES = 8 * HTB, NXCD = 8, WGM = 8;
__host__ __device__ __forceinline__ int lds_byte(int r, int c) { const int st = (r >> 4) * 2 + (c >> 5), rr = r & 15, cc = c & 31, ob = rr * 64 + cc * 2; return st * 1024 + (ob ^ (((ob >> 9) & 1) << 5)); }
__host__ __device__ __forceinline__ void stage_rc(int b, int& R, int& C) { const int st = b / 1024, sb = b % 1024, swz = sb ^ (((sb >> 9) & 1) << 5); R = (st >> 1) * 16 + swz / 64; C = (st & 1) * 32 + (swz % 64) / 2; }
struct Unit { int pm, pn; const GAS char* B0; const GAS char* B1; int aux; };
template <int nM, int nN> DI bool static_next(int G, int c, int i, int& pm, int& pn) {
    const int L = i * G + c; if (L >= nM * nN) return false;
    pm = L / nN; pn = L % nN; return true;
}
template <class P>
__device__ __forceinline__ void gemm_phase(LAS unsigned char* lds, const P& pb) {
    int tid_ = threadIdx.x; asm volatile("" : "+v"(tid_));
    const int tid = tid_, wid = __builtin_amdgcn_readfirstlane(tid >> 6), lane = tid & 63, wr = wid >> 2, wc = wid & 3, fr = lane & 15, fq = lane >> 4;
    constexpr int K = P::K, nt = K / BK;
    int sR[2], sC[2]; unsigned voffA[2], voffB[2];
#pragma unroll
    for (int i = 0; i < 2; ++i) { stage_rc(tid * 16 + i * 8192, sR[i], sC[i]); voffB[i] = (unsigned)(sR[i] * P::ldb + sC[i]) * 2u; voffA[i] = (unsigned)(sR[i] * P::lda + sC[i]) * 2u; }
    constexpr size_t kstep = (size_t)(BK * 2);
    constexpr size_t hstepB = (size_t)HALF * P::ldb * 2, hstepA = (size_t)HALF * P::lda * 2, tstepA = 2 * hstepA;
    const unsigned ldsw = (unsigned)wid * 1024u;
    const int aoff = lds_byte(wr * 64 + fr, fq * 8), boff = lds_byte(wc * 32 + fr, fq * 8);
#define PG8_SA(b, h) (((b) * 2 + (h)) * HTB)
#define PG8_SB(b, h) ((4 + (b) * 2 + (h)) * HTB)
#define PG8_STAGE(bufoff, gbase, voff) do { _Pragma("unroll") for (int _i = 0; _i < 2; ++_i) \
        __builtin_amdgcn_global_load_lds((const GAS unsigned*)((const GAS char*)(gbase) + (voff)[_i]), (LAS unsigned*)(lds + (bufoff) + ldsw + _i * 8192), 16, 0, 0); } while (0)
#define PG8_STAGE_A(bufoff, gbase, h, G_) do { if constexpr (P::GATHER) { PG8_STAGE(bufoff, gbase, (G_)[h]); } else { PG8_STAGE(bufoff, (gbase) + (h) * hstepA, voffA); } } while (0)
#define PG8_LDA(dst, b, h) do { _Pragma("unroll") for (int m = 0; m < 4; ++m) _Pragma("unroll") for (int k = 0; k < 2; ++k) dst[m][k] = *(const LAS bf16x8*)(lds + PG8_SA(b, h) + aoff + m * 2048 + k * 1024); } while (0)
#define PG8_LDB(dst, b, h) do { _Pragma("unroll") for (int n = 0; n < 2; ++n) _Pragma("unroll") for (int k = 0; k < 2; ++k) dst[n][k] = *(const LAS bf16x8*)(lds + PG8_SB(b, h) + boff + n * 2048 + k * 1024); } while (0)
#define PG8_MMA(ai, bj, At, Bt) do { __builtin_amdgcn_s_setprio(1); _Pragma("unroll") for (int m = 0; m < 4; ++m) _Pragma("unroll") for (int n = 0; n < 2; ++n) _Pragma("unroll") for (int k = 0; k < 2; ++k) \
        acc[ai][bj][m][n] = __builtin_amdgcn_mfma_f32_16x16x32_bf16(Bt[n][k], At[m][k], acc[ai][bj][m][n], 0, 0, 0); __builtin_amdgcn_s_setprio(0); } while (0)
#define PG8_WAIT_V(n) asm volatile("s_waitcnt vmcnt(" #n ")" ::: "memory")
#define PG8_WAIT_L(n) asm volatile("s_waitcnt lgkmcnt(" #n ")" ::: "memory")
#define PG8_BAR __builtin_amdgcn_s_barrier()
#define PG8_SCHED __builtin_amdgcn_sched_barrier(0)
    Unit cur, nxt; int ui = 0;
    if (!pb.next(0, cur)) return;
    f32x4 acc[2][2][4][2];
#pragma unroll
    for (int a = 0; a < 2; ++a)
#pragma unroll
        for (int b = 0; b < 2; ++b)
#pragma unroll
            for (int m = 0; m < 4; ++m)
#pragma unroll
                for (int n = 0; n < 2; ++n) acc[a][b][m][n] = (f32x4){0.f, 0.f, 0.f, 0.f};
    bf16x8 At[4][2], B0[2][2], B1[2][2];
    unsigned gA[2][2] = {{0u, 0u}, {0u, 0u}};
    if constexpr (P::GATHER) {
#pragma unroll
        for (int h = 0; h < 2; ++h)
#pragma unroll
            for (int i = 0; i < 2; ++i) gA[h][i] = pb.a_row(cur, 128 * h + sR[i]) + (unsigned)sC[i] * 2u;
    }
    const GAS char* cA = (const GAS char*)pb.A + (P::GATHER ? (size_t)0 : (size_t)cur.pm * tstepA);
    PG8_STAGE(PG8_SB(0, 0), cur.B0, voffB); PG8_STAGE_A(PG8_SA(0, 0), cA, 0, gA); PG8_STAGE(PG8_SB(0, 1), cur.B0 + hstepB, voffB); PG8_STAGE_A(PG8_SA(0, 1), cA, 1, gA);
    if (wr == 1) PG8_BAR;
    PG8_WAIT_V(4); PG8_BAR;
    PG8_STAGE(PG8_SB(1, 0), cur.B0 + kstep, voffB); PG8_STAGE_A(PG8_SA(1, 0), cA + kstep, 0, gA); PG8_STAGE(PG8_SB(1, 1), cur.B0 + hstepB + kstep, voffB);
    PG8_WAIT_V(6); PG8_BAR;
    for (;;) {
        const bool has_next = pb.next(ui + 1, nxt);
        if (!has_next) nxt = cur;
        const GAS char* nA = (const GAS char*)pb.A + (P::GATHER ? (size_t)0 : (size_t)nxt.pm * tstepA);
#pragma unroll 1
        for (int t = 0; t < nt; t += 2) {
            const bool last = (t == nt - 2);
            const GAS char* a1 = cA + (size_t)(t + 1) * kstep;
            const GAS char* a2 = last ? nA : cA + (size_t)(t + 2) * kstep;
            const GAS char* a3 = a2 + kstep;
            const GAS char* b2;
            if constexpr (P::SPLITB) b2 = last ? nxt.B0 : ((t + 2 < pb.KSPLIT) ? cur.B0 : cur.B1) + (size_t)(t + 2) * kstep;
            else b2 = last ? nxt.B0 : cur.B0 + (size_t)(t + 2) * kstep;
            const GAS char* b3 = b2 + kstep;
            PG8_LDB(B0, 0, 0); PG8_SCHED; PG8_LDA(At, 0, 0); PG8_STAGE_A(PG8_SA(1, 1), a1, 1, gA);
            PG8_WAIT_L(8); PG8_BAR; PG8_WAIT_L(0); PG8_MMA(0, 0, At, B0); PG8_BAR; PG8_SCHED;
            if constexpr (P::GATHER) { if (last) {
#pragma unroll
                for (int h = 0; h < 2; ++h)
#pragma unroll
                    for (int i = 0; i < 2; ++i) gA[h][i] = pb.a_row(nxt, 128 * h + sR[i]) + (unsigned)sC[i] * 2u; } }
            PG8_LDB(B1, 0, 1); PG8_STAGE(PG8_SB(0, 0), b2, voffB);
            PG8_BAR; PG8_WAIT_L(0); PG8_MMA(0, 1, At, B1); PG8_BAR;
            PG8_LDA(At, 0, 1); PG8_STAGE_A(PG8_SA(0, 0), a2, 0, gA);
            PG8_BAR; PG8_WAIT_L(0); PG8_MMA(1, 0, At, B0); PG8_BAR; PG8_SCHED;
            PG8_STAGE(PG8_SB(0, 1), b2 + hstepB, voffB);
            PG8_WAIT_V(6); PG8_BAR; PG8_MMA(1, 1, At, B1); PG8_BAR;
            PG8_LDB(B0, 1, 0); PG8_SCHED; PG8_LDA(At, 1, 0); PG8_STAGE_A(PG8_SA(0, 1), a2, 1, gA);
            PG8_WAIT_L(8); PG8_BAR; PG8_WAIT_L(0); PG8_MMA(0, 0, At, B0); PG8_BAR; PG8_SCHED;
            PG8_LDB(B1, 1, 1); PG8_STAGE(PG8_SB(1, 0), b3, voffB);
            PG8_BAR; PG8_WAIT_L(0); PG8_MMA(0, 1, At, B1); PG8_BAR;
            PG8_LDA(At, 1, 1); PG8_STAGE_A(PG8_SA(1, 0), a3, 0, gA);
            PG8_BAR; PG8_WAIT_L(0); PG8_MMA(1, 0, At, B0); PG8_BAR; PG8_SCHED;
            PG8_STAGE(PG8_SB(1, 1), b3 + hstepB, voffB);
            PG8_WAIT_V(6); PG8_BAR; PG8_MMA(1, 1, At, B1); PG8_BAR;
        }
        pb.epi(acc, cur, wr, wc, fr, fq);
        if (!has_next) break;
#pragma unroll
        for (int a = 0; a < 2; ++a)
#pragma unroll
            for (int b = 0; b < 2; ++b)
#pragma unroll
                for (int m = 0; m < 4; ++m)
#pragma unroll
                    for (int n = 0; n < 2; ++n) acc[a][b][m][n] = (f32x4){0.f, 0.f, 0.f, 0.f};
        cur = nxt; cA = nA; ++ui;
    }
    PG8_WAIT_V(0);
    if (wr == 0) PG8_BAR;
    PG8_BAR;
#undef PG8_SA
#undef PG8_SB
#undef PG8_STAGE
#undef PG8_STAGE_A
#undef PG8_LDA
#undef PG8_LDB
#undef PG8_MMA
#undef PG8_WAIT_V
#undef PG8_WAIT_L
#undef PG8_BAR
#undef PG8_SCHED
}
}
typedef f32x4 AccT[2][2][4][2];

DI int swap45(int s) { return (s & ~48) | ((s & 16) << 1) | ((s & 32) >> 1); }
DI int map_even(int s) {
    if (s < 2048) return s;
    if (s < 2688) { const int r = s - 2048; return 2048 + (r & ~63) + swap45(r & 63); }
    if (s < 2816) return s;
    if (s < 3392) { const int r = s - 2816; return 2816 + (r & ~63) + swap45(r & 63); }
    if (s < EVEN_IN) return s;
    return -1;
}
DI int map_odd(int s) {
    if (s >= 1024) return s;
    const int u = s >> 8, r = s & 255; return r < 128 ? 128 * u + r : 512 + 128 * u + (r - 128);
}
DI void transpose_item(const GAS float* W, int ldn, int K, GAS bf16* WT, int k0, int n0, int mode, int coloff, LAS float* scr, int lane) {
    int col = n0 + (lane & 31);
    if (mode == 1) col = map_even(col); else if (mode == 2) col = map_odd(col); else col += coloff;
#pragma unroll 8
    for (int i = 0; i < 32; ++i) { const int kk = 2 * i + (lane >> 5); scr[kk * 33 + (lane & 31)] = col >= 0 ? W[(size_t)(k0 + kk) * ldn + col] : 0.f; }
    asm volatile("s_waitcnt lgkmcnt(0)" ::: "memory");
    const int c = lane & 7;
#pragma unroll
    for (int j = 0; j < 4; ++j) { const int n = (lane >> 3) + 8 * j; const LAS float* s = scr + (8 * c) * 33 + n;
        u32x4 o; o.x = pk2(s[0 * 33], s[1 * 33]); o.y = pk2(s[2 * 33], s[3 * 33]); o.z = pk2(s[4 * 33], s[5 * 33]); o.w = pk2(s[6 * 33], s[7 * 33]);
        *(GAS u32x4*)(WT + (size_t)(n0 + n) * K + k0 + 8 * c) = o; }
    asm volatile("s_waitcnt lgkmcnt(0)" ::: "memory");
}
DI void p_prologue(Frame& F) {
    LAUNDER_F(F);
    LAS float* scr = (LAS float*)(F.lds + F.wave * 16384);
    const int gw = F.wg * 8 + F.wave, NGW = F.G * 8, lane = F.lane;
    constexpr int I_WINE = 2 * 16 * (EVEN_PAD / 32), I_WOUT = 2 * 16 * 32, I_WINO = 2 * 16 * 64, I_WGU = 64 * 16 * 16, I_WD = 64 * 4 * 32;
    constexpr int NIT = I_WINE + I_WOUT + I_WINO + I_WOUT + I_WGU + I_WD;
    for (int it = gw; it < NIT; it += NGW) {
        asm volatile("" ::: "memory");
        int r = it; asm volatile("" : "+v"(r));
        const GAS float* W; GAS bf16* WT; int ldn, K, k0, n0, mode = 0, coloff = 0;
        if (r < I_WINE) { const int li = r / (I_WINE / 2); r %= (I_WINE / 2); const int kb = r / (EVEN_PAD / 32), nb = r % (EVEN_PAD / 32);
            W = GIN(11) + (size_t)li * 1024 * EVEN_IN; ldn = EVEN_IN; K = 1024; WT = (GAS bf16*)(F.ws + WS_WINE) + (size_t)li * EVEN_PAD * 1024; k0 = 64 * kb; n0 = 32 * nb; mode = 1; }
        else if ((r -= I_WINE) < I_WOUT) { const int li = r / (I_WOUT / 2); r %= (I_WOUT / 2); const int kb = r / 32, nb = r % 32;
            W = GIN(12) + (size_t)li * 1024 * 1024; ldn = 1024; K = 1024; WT = (GAS bf16*)(F.ws + WS_WOUTE) + (size_t)li * 1024 * 1024; k0 = 64 * kb; n0 = 32 * nb; }
        else if ((r -= I_WOUT) < I_WINO) { const int li = r / (I_WINO / 2); r %= (I_WINO / 2); const int kb = r / 64, nb = r % 64;
            W = GIN(15) + (size_t)li * 1024 * 2048; ldn = 2048; K = 1024; WT = (GAS bf16*)(F.ws + WS_WINO) + (size_t)li * 2048 * 1024; k0 = 64 * kb; n0 = 32 * nb; mode = 2; }
        else if ((r -= I_WINO) < I_WOUT) { const int li = r / (I_WOUT / 2); r %= (I_WOUT / 2); const int kb = r / 32, nb = r % 32;
            W = GIN(16) + (size_t)li * 1024 * 1024; ldn = 1024; K = 1024; WT = (GAS bf16*)(F.ws + WS_WOUTO) + (size_t)li * 1024 * 1024; k0 = 64 * kb; n0 = 32 * nb; }
        else if ((r -= I_WOUT) < I_WGU) { const int le = r / 256; r %= 256; const int kb = r / 16, nb = r % 16;
            const int s0 = 32 * nb, jj = s0 >> 8, rr = s0 & 255; const bool up = rr >= 128; const int c0 = 128 * jj + (up ? rr - 128 : rr);
            W = (up ? GIN(37) : GIN(36)) + (size_t)le * 1024 * 256; ldn = 256; K = 1024; WT = (GAS bf16*)(F.ws + WS_WGU) + (size_t)le * 512 * 1024; k0 = 64 * kb; n0 = s0; coloff = c0 - s0; }
        else { r -= I_WGU; const int le = r / 128; r %= 128; const int kb = r / 32, nb = r % 32;
            W = GIN(38) + (size_t)le * 256 * 1024; ldn = 1024; K = 256; WT = (GAS bf16*)(F.ws + WS_WD) + (size_t)le * 1024 * 256; k0 = 64 * kb; n0 = 32 * nb; }
        transpose_item(W, ldn, K, WT, k0, n0, mode, coloff, scr, lane);
    }
    GAS float* X = (GAS float*)(F.ws + WS_X); GAS bf16* XB = (GAS bf16*)(F.ws + WS_XB);
    for (int m = gw; m < M; m += NGW) {
        const GAS float* src;
        if (m < NPR) { const int b = m / T, t = m % T; src = t < NMETA ? GIN(10) + (size_t)t * D : GIN(0) + ((size_t)b * SEQ + (t - NMETA)) * D; }
        else src = GIN(1) + (size_t)(m - NPR) * D;
#pragma unroll
        for (int j = 0; j < 4; ++j) { const f32x4 v = *((const GAS f32x4*)src + lane + 64 * j); *((GAS f32x4*)(X + (size_t)m * D) + lane + 64 * j) = v;
            u32x2 o; o.x = pk2(v.x, v.y); o.y = pk2(v.z, v.w); *((GAS u32x2*)(XB + (size_t)m * D) + lane + 64 * j) = o; }
    }
    GAS float* RC = (GAS float*)(F.ws + WS_ROPE); GAS float* RS = RC + T * 32;
    for (int e = F.wg * 512 + F.tid; e < T * 32; e += F.G * 512) {
        const int pos = e >> 5, i = e & 31;
        const float inv = exp2f(-(float)i * (13.287712379549449f / 32.0f));
        const double ang = (double)((float)pos * inv);
        const double kq = rint(ang * 0.15915494309189535);
        const double rr = fma(-kq, 6.283185307179586, ang) - kq * 2.4492935982947064e-16;
        const float rf = (float)rr;
        RC[e] = cosf(rf); RS[e] = sinf(rf);
    }
    GAS float* LB = (GAS float*)(F.ws + WS_LB);
    for (int e = F.wg * 512 + F.tid; e < 2 * 512; e += F.G * 512) {
        const int li = e >> 9, c = e & 511;
        const float l0 = GIN(13)[c], l1 = GIN(13)[512 + c];
        const float lb = li == 0 ? 0.f : 1.0f / (1.0f + expf(l0 - l1));
        LB[(li * 3 + 0) * 512 + c] = logf(fmaxf(lb, 1e-30f)); LB[(li * 3 + 1) * 512 + c] = log1pf(-lb); LB[(li * 3 + 2) * 512 + c] = 1.0f - lb;
    }
}

template <bool ROPE> struct EvenIn {
    static constexpr bool GATHER = false, SPLITB = false; static constexpr int KSPLIT = 0, K = 1024, lda = 1024, ldb = 1024;
    const GAS bf16* A; const GAS bf16* Bt; int G, c, li; GAS unsigned char* ws; GAS float* out;
    DI bool next(int i, pg8::Unit& u) const { if (!pg8::static_next<M / 256, (ROPE ? 6 : 8)>(G, c, i, u.pm, u.pn)) return false;
        if (ROPE) u.pn += 8;
        u.B0 = (const GAS char*)(Bt + (size_t)u.pn * 256 * 1024); u.B1 = u.B0; u.aux = 0; return true; }
    DI void epi(const AccT& acc, const pg8::Unit& u, int wr, int wc, int fr, int fq) const {
        asm volatile("" : "+v"(fr), "+v"(fq));
        const int pn = u.pn;
        const int rbase = u.pm * 256 + wr * 64 + fr;
        if constexpr (!ROPE) {
            GAS bf16* dst = (GAS bf16*)(ws + (pn < 2 ? WS_A0 : pn < 4 ? WS_A1 : pn < 6 ? WS_A2 : WS_A3));
            GAS float* LF = (GAS float*)(ws + WS_LF); const GAS float* LB = (const GAS float*)(ws + WS_LB) + li * 3 * 512;
#pragma unroll
            for (int bj = 0; bj < 2; ++bj)
#pragma unroll
                for (int n = 0; n < 2; ++n) {
                    const int col = (pn & 1) * 256 + bj * 128 + wc * 32 + n * 16 + 4 * fq;
                    f32x4 la = {0, 0, 0, 0}, lb1 = {0, 0, 0, 0}, lc = {0, 0, 0, 0};
                    if (pn == 2 || pn == 3) { la = *(const GAS f32x4*)(LB + col); lb1 = *(const GAS f32x4*)(LB + 512 + col); lc = *(const GAS f32x4*)(LB + 1024 + col); }
#pragma unroll
                    for (int ai = 0; ai < 2; ++ai)
#pragma unroll
                        for (int m = 0; m < 4; ++m) {
                            const int row = rbase + ai * 128 + m * 16; const f32x4 v = acc[ai][bj][m][n]; float o[4];
                            if (pn < 2 || pn >= 6) {
#pragma unroll
                                for (int j = 0; j < 4; ++j) o[j] = siluf_(v[j]);
                            } else if (pn < 4) {
                                f32x4 lf;
#pragma unroll
                                for (int j = 0; j < 4; ++j) { const float z = v[j]; const float e = __expf(-fabsf(z)); const float l1p = __logf(1.0f + e);
                                    const float ls = fminf(z, 0.f) - l1p;
                                    const float bb = lb1[j] + ls, aa = la[j]; const float mx = fmaxf(aa, bb);
                                    lf[j] = mx + __logf(1.0f + __expf(-fabsf(aa - bb)));
                                    const float sg = (z >= 0.f ? e : 1.0f) / (1.0f + e);
                                    o[j] = lc[j] * sg; }
                                *(GAS f32x4*)(LF + (unsigned)row * 512 + col) = lf;
                            } else {
#pragma unroll
                                for (int j = 0; j < 4; ++j) o[j] = v[j];
                            }
                            u32x2 w; w.x = pk2(o[0], o[1]); w.y = pk2(o[2], o[3]); *(GAS u32x2*)(dst + (unsigned)row * 512 + col) = w;
                        }
                    asm volatile("" ::: "memory");
                }
        } else {
        const GAS float* RC = (const GAS float*)(ws + WS_ROPE); const GAS float* RS = RC + T * 32;
        const int i0 = 16 * (wc & 1) + 4 * fq;
#pragma unroll
        for (int ai = 0; ai < 2; ++ai)
#pragma unroll
            for (int m = 0; m < 4; ++m) {
                const int row = rbase + ai * 128 + m * 16;
                const int pos = row < NPR ? row % T : PAST;
                const f32x4 cs = *(const GAS f32x4*)(RC + pos * 32 + i0), sn = *(const GAS f32x4*)(RS + pos * 32 + i0);
#pragma unroll
                for (int bj = 0; bj < 2; ++bj) {
                    const f32x4 x1 = acc[ai][bj][m][0], x2 = acc[ai][bj][m][1];
                    const f32x4 r1 = x1 * cs - x2 * sn, r2 = x2 * cs + x1 * sn;
                    const int hd = bj * 2 + (wc >> 1);
                    if (pn == 8 || pn == 9) {
                        GAS bf16* Q = (GAS bf16*)(ws + WS_QB) + (unsigned)row * 512 + (pn - 8) * 256 + hd * 64 + i0;
                        u32x2 w; w.x = pk2(r1[0] * 0.125f, r1[1] * 0.125f); w.y = pk2(r1[2] * 0.125f, r1[3] * 0.125f); *(GAS u32x2*)Q = w;
                        w.x = pk2(r2[0] * 0.125f, r2[1] * 0.125f); w.y = pk2(r2[2] * 0.125f, r2[3] * 0.125f); *(GAS u32x2*)(Q + 32) = w;
                    } else if (pn == 11 || pn == 12) {
                        GAS bf16* Q = (GAS bf16*)(ws + WS_QI) + (unsigned)row * 512 + (pn - 11) * 256 + hd * 64 + i0;
                        u32x2 w; w.x = pk2(r1[0], r1[1]); w.y = pk2(r1[2], r1[3]); *(GAS u32x2*)Q = w;
                        w.x = pk2(r2[0], r2[1]); w.y = pk2(r2[2], r2[3]); *(GAS u32x2*)(Q + 32) = w;
                    } else if (pn == 10) {
                        if (bj == 0) {
                            const int g = wc >> 1;
                            GAS float* KO = row < NPR ? out + O_KP + ((unsigned)row * 2 + li) * 128 + g * 64 + i0 : out + O_KS + ((unsigned)(row - NPR) * 2 + li) * 128 + g * 64 + i0;
                            *(GAS f32x4*)KO = r1; *(GAS f32x4*)(KO + 32) = r2;
                            GAS bf16* KB = (GAS bf16*)(ws + WS_KBB) + (unsigned)row * 128 + g * 64 + i0;
                            u32x2 w; w.x = pk2(r1[0], r1[1]); w.y = pk2(r1[2], r1[3]); *(GAS u32x2*)KB = w;
                            w.x = pk2(r2[0], r2[1]); w.y = pk2(r2[2], r2[3]); *(GAS u32x2*)(KB + 32) = w;
                        } else {
#pragma unroll
                            for (int n = 0; n < 2; ++n) {
                                const int sl = wc * 32 + n * 16 + 4 * fq; const f32x4 v = n ? x2 : x1;
                                GAS float* VO = row < NPR ? out + O_VP + ((unsigned)row * 2 + li) * 128 + sl : out + O_VS + ((unsigned)(row - NPR) * 2 + li) * 128 + sl;
                                *(GAS f32x4*)VO = v;
                                if (row < NPR) { const int b = row / T, t = row % T; GAS bf16* VT = (GAS bf16*)(ws + WS_VT) + ((unsigned)(b * 2 + (sl >> 6)) * 64 + (sl & 63)) * TP + t;
#pragma unroll
                                    for (int j = 0; j < 4; ++j) VT[(unsigned)j * TP] = (bf16)f2bf(v[j]); }
                            }
                        }
                    } else {
                        if (bj == 0 && wc < 2) {
                            GAS float* KO = row < NPR ? out + O_IP + ((unsigned)row * 2 + li) * 64 + i0 : out + O_IS + ((unsigned)(row - NPR) * 2 + li) * 64 + i0;
                            *(GAS f32x4*)KO = r1; *(GAS f32x4*)(KO + 32) = r2;
                            GAS bf16* KB = (GAS bf16*)(ws + WS_KIB) + (unsigned)row * 64 + i0;
                            u32x2 w; w.x = pk2(r1[0], r1[1]); w.y = pk2(r1[2], r1[3]); *(GAS u32x2*)KB = w;
                            w.x = pk2(r2[0], r2[1]); w.y = pk2(r2[2], r2[3]); *(GAS u32x2*)(KB + 32) = w;
                        } else if (bj == 0 && wc == 2 && fq < 2) {
                            const float sc = 0.125f * 0.35355339059327373f;
                            *(GAS f32x4*)((GAS float*)(ws + WS_WI) + (unsigned)row * 8 + 4 * fq) = x1 * sc;
                        }
                    }
                }
                asm volatile("" ::: "memory");
            }
        }
    }
};

DI int q_pop(Frame& F, int qidx) {
    __syncthreads();
    if (F.tid == 0) F.MISC[0] = __hip_atomic_fetch_add(F.ctl + CW_Q + 64 * qidx, 1u, __ATOMIC_RELAXED, __HIP_MEMORY_SCOPE_AGENT);
    __syncthreads();
    return (int)F.MISC[0];
}
#define MFMA16(a, b, c) __builtin_amdgcn_mfma_f32_16x16x32_bf16((a), (b), (c), 0, 0, 0)
#define MFMA32(a, b, c) __builtin_amdgcn_mfma_f32_32x32x16_bf16((a), (b), (c), 0, 0, 0)
DI bf16x8 pack8(const float (&v)[8]) { u32x4 p; p.x = pk2(v[0], v[1]); p.y = pk2(v[2], v[3]); p.z = pk2(v[4], v[5]); p.w = pk2(v[6], v[7]); return __builtin_bit_cast(bf16x8, p); }

#define LDS_BAR() do { asm volatile("s_waitcnt lgkmcnt(0)" ::: "memory"); __builtin_amdgcn_s_barrier(); asm volatile("" ::: "memory"); } while (0)
DI void hgrn_prompt_item(Frame& F, int li, int b, int h) {
    constexpr int P1 = 136, P2 = 40;
    LAS bf16* QS = (LAS bf16*)(F.lds + 0);
    LAS bf16* KH = (LAS bf16*)(F.lds + 8704);
    LAS bf16* KDT = (LAS bf16*)(F.lds + 17408);
    LAS bf16* VTL = (LAS bf16*)(F.lds + 27648);
    LAS bf16* PM = (LAS bf16*)(F.lds + 37888);
    LAS bf16* ST = (LAS bf16*)(F.lds + 40448);
    LAS float* OF = (LAS float*)(F.lds + 75264);
    LAS float* BSEG = (LAS float*)(F.lds + 92160);
    LAS float* DF = (LAS float*)(F.lds + 94208);
    int tid_ = F.tid; asm volatile("" : "+v"(tid_)); LAUNDER_F(F);
    const int tid = tid_, lane = tid & 63, w = __builtin_amdgcn_readfirstlane(tid >> 6), k = tid & 127, seg = tid >> 7, l15 = lane & 15, l4 = lane >> 4;
    const GAS bf16* QA = (const GAS bf16*)(F.ws + WS_A0); const GAS bf16* KA = (const GAS bf16*)(F.ws + WS_A1); const GAS bf16* VA = (const GAS bf16*)(F.ws + WS_A2); const GAS bf16* GA = (const GAS bf16*)(F.ws + WS_A3);
    const GAS float* LF = (const GAS float*)(F.ws + WS_LF); GAS bf16* MIX = (GAS bf16*)(F.ws + WS_MIX);
    const int t4 = tid >> 4, part = tid & 15;
    float ng[8];
#pragma unroll
    for (int j = 0; j < 8; ++j) ng[j] = GIN(14)[li * 128 + 8 * part + j];
    f32x4 S[8];
#pragma unroll
    for (int i = 0; i < 8; ++i) S[i] = (f32x4){0.f, 0.f, 0.f, 0.f};
    float clf[8], cq[8], ck[8], cv[8], nlf[8]; unsigned nq[8], nk[8], nv[8]; u32x4 gcur, gnext;
    const unsigned colb = (unsigned)(h * 128 + k);
    const unsigned gcol = (unsigned)(h * 128 + 8 * part);
#define HG_LOAD(c) do { _Pragma("unroll") for (int i = 0; i < 8; ++i) { const int t = 32 * (c) + 8 * seg + i; const unsigned o = (unsigned)(b * T + (t < T ? t : T - 1)) * 512u + colb; \
        nlf[i] = LF[o]; nq[i] = QA[o]; nk[i] = KA[o]; nv[i] = VA[o]; } \
        { const int t = 32 * (c) + t4; gnext = *(const GAS u32x4*)(GA + (unsigned)(b * T + (t < T ? t : T - 1)) * 512u + gcol); } } while (0)
#define HG_TAKE(c) do { _Pragma("unroll") for (int i = 0; i < 8; ++i) { const bool ok = 32 * (c) + 8 * seg + i < T; clf[i] = ok ? nlf[i] : 0.f; cq[i] = ok ? bf2f(nq[i]) : 0.f; ck[i] = ok ? bf2f(nk[i]) : 0.f; cv[i] = ok ? bf2f(nv[i]) : 0.f; } gcur = gnext; } while (0)
    __syncthreads();
    HG_LOAD(0);
    constexpr int NCH = (T + 31) / 32;
    for (int c = 0; c < NCH; ++c) {
        HG_TAKE(c);
        if (c + 1 < NCH) HG_LOAD(c + 1);
        float cs[8]; float run = 0.f;
#pragma unroll
        for (int i = 0; i < 8; ++i) { run += clf[i]; cs[i] = run; }
        BSEG[seg * 128 + k] = run;
        LDS_BAR();
        float pre = 0.f, tot = 0.f;
#pragma unroll
        for (int sgi = 0; sgi < 4; ++sgi) { const float v = BSEG[sgi * 128 + k]; tot += v; if (sgi < seg) pre += v; }
        float kd[8];
#pragma unroll
        for (int i = 0; i < 8; ++i) { const float bb = pre + cs[i]; const int t = 8 * seg + i;
            QS[t * P1 + k] = (bf16)f2bf(cq[i] * __expf(bb)); KH[t * P1 + k] = (bf16)f2bf(ck[i] * __expf(-bb)); kd[i] = ck[i] * __expf(tot - bb); }
        *(LAS bf16x8*)(KDT + k * P2 + 8 * seg) = pack8(kd);
        *(LAS bf16x8*)(VTL + k * P2 + 8 * seg) = pack8(cv);
        if (seg == 0) DF[k] = __expf(tot);
#pragma unroll
        for (int i = 0; i < 8; ++i) { u32x2 o; o.x = pk2(S[i][0], S[i][1]); o.y = pk2(S[i][2], S[i][3]); *(LAS u32x2*)(ST + (16 * w + l15) * P1 + 16 * i + 4 * l4) = o; }
        LDS_BAR();
        if (w < 4) {
            const int ti = w >> 1, tj = w & 1; f32x4 pacc = {0.f, 0.f, 0.f, 0.f};
            if (tj <= ti) {
#pragma unroll
                for (int ks = 0; ks < 4; ++ks) { const bf16x8 a = *(const LAS bf16x8*)(QS + (16 * ti + l15) * P1 + 32 * ks + 8 * l4); const bf16x8 bb = *(const LAS bf16x8*)(KH + (16 * tj + l15) * P1 + 32 * ks + 8 * l4); pacc = MFMA16(a, bb, pacc); }
            }
#pragma unroll
            for (int r = 0; r < 4; ++r) { const int t = 16 * ti + 4 * l4 + r, sidx = 16 * tj + l15; PM[t * P2 + sidx] = (bf16)f2bf(sidx <= t ? pacc[r] : 0.f); }
        }
        LDS_BAR();
        {
            const bf16x8 bv = *(const LAS bf16x8*)(VTL + (16 * w + l15) * P2 + 8 * l4);
#pragma unroll
            for (int ti = 0; ti < 2; ++ti) {
                f32x4 o = {0.f, 0.f, 0.f, 0.f};
                o = MFMA16(*(const LAS bf16x8*)(PM + (16 * ti + l15) * P2 + 8 * l4), bv, o);
#pragma unroll
                for (int ks = 0; ks < 4; ++ks) o = MFMA16(*(const LAS bf16x8*)(QS + (16 * ti + l15) * P1 + 32 * ks + 8 * l4), *(const LAS bf16x8*)(ST + (16 * w + l15) * P1 + 32 * ks + 8 * l4), o);
#pragma unroll
                for (int r = 0; r < 4; ++r) OF[(16 * ti + 4 * l4 + r) * 132 + 16 * w + l15] = o[r];
            }
#pragma unroll
            for (int i = 0; i < 8; ++i) { const f32x4 d = *(const LAS f32x4*)(DF + 16 * i + 4 * l4); f32x4 sc = S[i] * d;
                S[i] = MFMA16(*(const LAS bf16x8*)(KDT + (16 * i + l15) * P2 + 8 * l4), bv, sc); }
        }
        LDS_BAR();
        {
            const int tg = 32 * c + t4;
            float o[8]; float ss = 0.f;
            { const f32x4 o0 = *(const LAS f32x4*)(OF + t4 * 132 + 8 * part), o1 = *(const LAS f32x4*)(OF + t4 * 132 + 8 * part + 4); o[0] = o0[0]; o[1] = o0[1]; o[2] = o0[2]; o[3] = o0[3]; o[4] = o1[0]; o[5] = o1[1]; o[6] = o1[2]; o[7] = o1[3]; }
#pragma unroll
            for (int j = 0; j < 8; ++j) ss += o[j] * o[j];
            ss += __shfl_xor(ss, 1); ss += __shfl_xor(ss, 2); ss += __shfl_xor(ss, 4); ss += __shfl_xor(ss, 8);
            if (tg < T) { const float rs = rsqrtf(ss * (1.0f / 128.0f) + RMS_EPS);
                const unsigned gw[4] = {gcur.x, gcur.y, gcur.z, gcur.w}; float r8[8];
#pragma unroll
                for (int j = 0; j < 8; ++j) { const float gv = bf2f((gw[j >> 1] >> (16 * (j & 1))) & 0xffffu); r8[j] = o[j] * rs * ng[j] * gv; }
                *(GAS bf16x8*)(MIX + (unsigned)(b * T + tg) * 1024u + gcol) = pack8(r8); }
        }
    }
#undef HG_LOAD
#undef HG_TAKE
    GAS float* HO = F.out + O_HP + ((size_t)((b * 2 + li) * 4 + h) * 128) * 128;
#pragma unroll
    for (int i = 0; i < 8; ++i)
#pragma unroll
        for (int r = 0; r < 4; ++r) HO[(size_t)(16 * i + 4 * l4 + r) * 128 + 16 * w + l15] = S[i][r];
}

DI void hgrn_sample_item(Frame& F, int li, int s) {
    LAS float* RED = (LAS float*)(F.lds + 0);
    int tid_ = F.tid; asm volatile("" : "+v"(tid_)); LAUNDER_F(F);
    const int tid = tid_, lane = tid & 63, kg = tid >> 5, v4 = tid & 31, row = NPR + s;
    const GAS bf16* QA = (const GAS bf16*)(F.ws + WS_A0); const GAS bf16* KA = (const GAS bf16*)(F.ws + WS_A1); const GAS bf16* VA = (const GAS bf16*)(F.ws + WS_A2); const GAS bf16* GA = (const GAS bf16*)(F.ws + WS_A3);
    const GAS float* LF = (const GAS float*)(F.ws + WS_LF); GAS bf16* MIX = (GAS bf16*)(F.ws + WS_MIX); const GAS float* NG = GIN(14) + li * 128;
    for (int h = 0; h < 4; ++h) {
        const GAS float* S0 = GIN(5) + ((size_t)((s * 2 + li) * 4 + h) * 128) * 128; GAS float* S1 = F.out + O_HS + ((size_t)((s * 2 + li) * 4 + h) * 128) * 128;
        const size_t ro = (size_t)row * 512 + h * 128;
        f32x4 vv; { const u32x2 vr = *(const GAS u32x2*)(VA + ro + 4 * v4); vv = (f32x4){bf2f(vr.x & 0xffffu), bf2f(vr.x >> 16), bf2f(vr.y & 0xffffu), bf2f(vr.y >> 16)}; }
        f32x4 o4 = {0.f, 0.f, 0.f, 0.f};
#pragma unroll
        for (int kk = 0; kk < 8; ++kk) { const int k = 8 * kg + kk; const float dec = __expf(LF[ro + k]), ka = bf2f(KA[ro + k]), q = bf2f(QA[ro + k]);
            const f32x4 sv = *(const GAS f32x4*)(S0 + (size_t)k * 128 + 4 * v4); const f32x4 nv = sv * dec + vv * ka; *(GAS f32x4*)(S1 + (size_t)k * 128 + 4 * v4) = nv; o4 += nv * q; }
        __syncthreads();
        *(LAS f32x4*)(RED + kg * 128 + 4 * v4) = o4;
        __syncthreads();
        if (tid < 64) {
            float oa = 0.f, ob = 0.f;
#pragma unroll
            for (int g = 0; g < 16; ++g) { oa += RED[g * 128 + lane]; ob += RED[g * 128 + 64 + lane]; }
            const float ss = wave_sum(oa * oa + ob * ob); const float rs = rsqrtf(ss * (1.0f / 128.0f) + RMS_EPS);
            MIX[(size_t)row * 1024 + h * 128 + lane] = (bf16)f2bf(oa * rs * NG[lane] * bf2f(GA[ro + lane]));
            MIX[(size_t)row * 1024 + h * 128 + 64 + lane] = (bf16)f2bf(ob * rs * NG[64 + lane] * bf2f(GA[ro + 64 + lane]));
        }
    }
}

DI unsigned ord_key(float v) { const unsigned bits = __builtin_bit_cast(unsigned, v); return (bits & 0x80000000u) ? ~bits : (bits | 0x80000000u); }
DI int dpp_row_sum(int v) {
    v += __builtin_amdgcn_update_dpp(0, v, 0xB1, 0xf, 0xf, false);
    v += __builtin_amdgcn_update_dpp(0, v, 0x4E, 0xf, 0xf, false);
    v += __builtin_amdgcn_update_dpp(0, v, 0x141, 0xf, 0xf, false);
    v += __builtin_amdgcn_update_dpp(0, v, 0x140, 0xf, 0xf, false);
    return v;
}
DI int wave_sum_i(int v) { v = dpp_row_sum(v); return __builtin_amdgcn_readlane(v, 0) + __builtin_amdgcn_readlane(v, 16) + __builtin_amdgcn_readlane(v, 32) + __builtin_amdgcn_readlane(v, 48); }
template <int NJ> DI u64 select256(const unsigned (&u)[NJ], int lane, LAS unsigned* scr) {
    unsigned Tv = 0u; int c_lo = NJ * 64, c_hi = 0, bit = 31;
    for (; bit >= 0; --bit) {
        if (c_lo - c_hi <= 64) break;
        const unsigned cand = Tv | (1u << bit); int cl = 0;
#pragma unroll
        for (int j = 0; j < NJ; ++j) cl += (u[j] >= cand) ? 1 : 0;
        const int c = wave_sum_i(cl);
        if (c >= 256) { Tv = cand; c_lo = c; } else c_hi = c;
    }
    if (bit >= 0) {
        const unsigned width = 2u << bit; int base = 0;
#pragma unroll
        for (int j = 0; j < NJ; ++j) { const bool in = (u[j] - Tv) < width; const u64 m = __ballot(in);
            if (in) scr[base + __builtin_popcountll(m & ((1ull << lane) - 1ull))] = u[j];
            base += __builtin_popcountll(m); }
        asm volatile("s_waitcnt lgkmcnt(0)" ::: "memory");
        const unsigned cv = lane < (c_lo - c_hi) ? scr[lane] : 0u;
        for (; bit >= 0; --bit) { const unsigned cand = Tv | (1u << bit); if (c_hi + __builtin_popcountll(__ballot(cv >= cand)) >= 256) Tv = cand; }
    }
    int ngt = 0;
#pragma unroll
    for (int j = 0; j < NJ; ++j) ngt += (u[j] > Tv) ? 1 : 0;
    int need = 256 - wave_sum_i(ngt); u64 my = 0ull;
#pragma unroll
    for (int j = 0; j < NJ; ++j) {
        const u64 gt = __ballot(u[j] > Tv), eq = __ballot(u[j] == Tv); const int c = __builtin_popcountll(eq); u64 take;
        if (c <= need) { take = eq; need -= c; }
        else { take = 0ull; u64 e = eq; for (int z = 0; z < need; ++z) { const u64 low = e & (~e + 1ull); take |= low; e ^= low; } need = 0; }
        const u64 wd = gt | take; my = (lane == j) ? wd : my;
    }
    return my;
}
template <int NJ> DI void dsa_select_rows(const GAS float* SC, LAS u64* MASK, LAS unsigned* scr, int w, int lane, int q0) {
    for (int i = 0; i < 8; ++i) {
        const int q = w * 8 + i, t = q0 + q; LAS u64* mrow = MASK + q * 34;
        if (t >= T) { if (lane < 34) mrow[lane] = 0ull; continue; }
        const int jfull = t >> 6, rem = t & 63;
        if (t + 1 <= 256) { if (lane < 34) mrow[lane] = lane < jfull ? ~0ull : (lane == jfull ? ((2ull << rem) - 1ull) : 0ull); continue; }
        unsigned u[NJ];
#pragma unroll
        for (int j = 0; j < NJ; ++j) { const int sidx = 64 * j + lane; const float v = SC[(size_t)q * TP + (sidx < TP ? sidx : 0)]; u[j] = sidx <= t ? ord_key(v) : 0u; }
        const u64 my = select256<NJ>(u, lane, scr);
        if (lane < 34) mrow[lane] = lane < NJ ? my : 0ull;
    }
}

DI void dsa_prompt_item(Frame& F, int b, int qblk) {
    constexpr int QP = 520;
    LAS bf16* QIL = (LAS bf16*)(F.lds + 0);
    LAS u64* MASK = (LAS u64*)(F.lds + 66560);
    int tid_ = F.tid; asm volatile("" : "+v"(tid_)); LAUNDER_F(F);
    const int tid = tid_, lane = tid & 63, w = __builtin_amdgcn_readfirstlane(tid >> 6), l31 = lane & 31, hh = lane >> 5;
    const int q0 = 64 * qblk, nq = (T - q0) < 64 ? (T - q0) : 64, tmax = q0 + nq - 1, nkt = tmax / 32 + 1;
    const GAS bf16* QI = (const GAS bf16*)(F.ws + WS_QI); const GAS bf16* KIB = (const GAS bf16*)(F.ws + WS_KIB); const GAS float* WI = (const GAS float*)(F.ws + WS_WI);
    const GAS bf16* QB = (const GAS bf16*)(F.ws + WS_QB); const GAS bf16* KBB = (const GAS bf16*)(F.ws + WS_KBB); const GAS bf16* VT = (const GAS bf16*)(F.ws + WS_VT); GAS bf16* MIX = (GAS bf16*)(F.ws + WS_MIX);
    GAS float* SC = (GAS float*)(F.ws + WS_SC) + (size_t)F.wg * 64 * TP;
    const size_t rb = (size_t)b * T;
#pragma unroll
    for (int i = 0; i < 8; ++i) { const int e = tid + 512 * i, r = e >> 6, c8 = e & 63; const int t = q0 + r < T ? q0 + r : T - 1;
        *(LAS u32x4*)(QIL + r * QP + 8 * c8) = *(const GAS u32x4*)(QI + (rb + t) * 512 + 8 * c8); }
    __syncthreads();
#if PROBE_TS == 3
    const unsigned long long _ta = __builtin_amdgcn_s_memrealtime();
#endif
    {
        const int qh = w & 1, tq = q0 + 32 * qh + l31, tqc = tq < T ? tq : T - 1;
        float wq[8]; { const f32x4 a = *(const GAS f32x4*)(WI + (rb + tqc) * 8), c = *(const GAS f32x4*)(WI + (rb + tqc) * 8 + 4); wq[0] = a[0]; wq[1] = a[1]; wq[2] = a[2]; wq[3] = a[3]; wq[4] = c[0]; wq[5] = c[1]; wq[6] = c[2]; wq[7] = c[3]; }
        const int tlast = (q0 + 32 * qh + 31) < tmax ? (q0 + 32 * qh + 31) : tmax;
        if (q0 + 32 * qh <= tmax) {
        bf16x8 kan[4];
        { const int key = 32 * (w >> 1) + l31, keyc = key < T ? key : T - 1;
#pragma unroll
          for (int ks = 0; ks < 4; ++ks) kan[ks] = *(const GAS bf16x8*)(KIB + (rb + keyc) * 64 + 16 * ks + 8 * hh); }
        for (int kt = (w >> 1); 32 * kt <= tlast; kt += 4) {
            bf16x8 ka[4];
#pragma unroll
            for (int ks = 0; ks < 4; ++ks) ka[ks] = kan[ks];
            { const int key = 32 * (kt + 4) + l31, keyc = key < T ? key : T - 1;
#pragma unroll
              for (int ks = 0; ks < 4; ++ks) kan[ks] = *(const GAS bf16x8*)(KIB + (rb + keyc) * 64 + 16 * ks + 8 * hh); }
            f32x16 tot;
#pragma unroll
            for (int r = 0; r < 16; ++r) tot[r] = 0.f;
#pragma unroll
            for (int hd = 0; hd < 8; ++hd) {
                asm volatile("" ::: "memory");
                f32x16 a;
#pragma unroll
                for (int r = 0; r < 16; ++r) a[r] = 0.f;
#pragma unroll
                for (int ks = 0; ks < 4; ++ks) a = MFMA32(ka[ks], *(const LAS bf16x8*)(QIL + (32 * qh + l31) * QP + hd * 64 + 16 * ks + 8 * hh), a);
#pragma unroll
                for (int r = 0; r < 16; ++r) tot[r] += wq[hd] * fmaxf(a[r], 0.f);
            }
            if (tq < T) {
#pragma unroll
                for (int g = 0; g < 4; ++g) *(GAS f32x4*)(SC + (size_t)(32 * qh + l31) * TP + 32 * kt + 8 * g + 4 * hh) = (f32x4){tot[4 * g], tot[4 * g + 1], tot[4 * g + 2], tot[4 * g + 3]};
            }
        }
        }
    }
    __syncthreads();
#if PROBE_TS == 3
    const unsigned long long _tb = __builtin_amdgcn_s_memrealtime();
#endif
    {
        LAS unsigned* scr = (LAS unsigned*)(F.lds + 84992) + w * 64;
        const int njn = (tmax >> 6) + 1;
        if (njn <= 9) dsa_select_rows<9>(SC, MASK, scr, w, lane, q0);
        else if (njn <= 17) dsa_select_rows<17>(SC, MASK, scr, w, lane, q0);
        else if (njn <= 25) dsa_select_rows<25>(SC, MASK, scr, w, lane, q0);
        else dsa_select_rows<33>(SC, MASK, scr, w, lane, q0);
    }
    __syncthreads();
#if PROBE_TS == 3
    const unsigned long long _tc = __builtin_amdgcn_s_memrealtime();
#endif
    {
        const int hd = w, g = hd >> 2;
        const LAS unsigned* M32 = (const LAS unsigned*)MASK;
        for (int qh = 0; qh < 2; ++qh) {
            if (q0 + 32 * qh > tmax) break;
            const int tq = q0 + 32 * qh + l31, tqc = tq < T ? tq : T - 1;
            bf16x8 qf[4];
#pragma unroll
            for (int ks = 0; ks < 4; ++ks) qf[ks] = *(const GAS bf16x8*)(QB + (rb + tqc) * 512 + hd * 64 + 16 * ks + 8 * hh);
            f32x16 O[2]; float mrun = -INFINITY, lrun = 0.f;
#pragma unroll
            for (int dt = 0; dt < 2; ++dt)
#pragma unroll
                for (int r = 0; r < 16; ++r) O[dt][r] = 0.f;
            const int tlast = (q0 + 32 * qh + 31) < tmax ? (q0 + 32 * qh + 31) : tmax;
#define DP_LOADKV(kt_) do { const int key_ = 32 * (kt_) + l31, keyc_ = key_ < T ? key_ : T - 1; \
                _Pragma("unroll") for (int ks = 0; ks < 4; ++ks) nkf[ks] = *(const GAS bf16x8*)(KBB + (rb + keyc_) * 128 + g * 64 + 16 * ks + 8 * hh); \
                _Pragma("unroll") for (int dt = 0; dt < 2; ++dt) _Pragma("unroll") for (int s2 = 0; s2 < 2; ++s2) { const GAS bf16* vp = VT + ((size_t)(b * 2 + g) * 64 + 32 * dt + l31) * TP + 32 * (kt_) + 16 * s2 + 4 * hh; \
                    const u32x2 lo = *(const GAS u32x2*)vp, hi = *(const GAS u32x2*)(vp + 8); u32x4 pk; pk.x = lo.x; pk.y = lo.y; pk.z = hi.x; pk.w = hi.y; nvf[dt][s2] = __builtin_bit_cast(bf16x8, pk); } } while (0)
            bf16x8 nkf[4], nvf[2][2];
            DP_LOADKV(0);
            for (int kt = 0; 32 * kt <= tlast; ++kt) {
                bf16x8 kf[4], vf[2][2];
#pragma unroll
                for (int ks = 0; ks < 4; ++ks) kf[ks] = nkf[ks];
#pragma unroll
                for (int dt = 0; dt < 2; ++dt)
#pragma unroll
                    for (int s2 = 0; s2 < 2; ++s2) vf[dt][s2] = nvf[dt][s2];
                if (32 * (kt + 1) <= tlast) DP_LOADKV(kt + 1);
                f32x16 sa;
#pragma unroll
                for (int r = 0; r < 16; ++r) sa[r] = 0.f;
#pragma unroll
                for (int ks = 0; ks < 4; ++ks) sa = MFMA32(kf[ks], qf[ks], sa);
                const unsigned mw = M32[(32 * qh + l31) * 68 + kt] >> (4 * hh);
                float mx = -INFINITY;
#pragma unroll
                for (int r = 0; r < 16; ++r) { const bool on = (mw >> ((r & 3) + 8 * (r >> 2))) & 1u; sa[r] = on ? sa[r] : -INFINITY; mx = fmaxf(mx, sa[r]); }
                mx = fmaxf(mx, __shfl_xor(mx, 32));
                const float mnew = fmaxf(mrun, mx);
                const float msafe = mnew == -INFINITY ? 0.f : mnew;
                const float alpha = __expf(mrun - msafe);
                float pr[16]; float rs = 0.f;
#pragma unroll
                for (int r = 0; r < 16; ++r) { pr[r] = __expf(sa[r] - msafe); rs += pr[r]; }
                rs += __shfl_xor(rs, 32);
                lrun = lrun * alpha + rs; mrun = mnew;
#pragma unroll
                for (int dt = 0; dt < 2; ++dt)
#pragma unroll
                    for (int r = 0; r < 16; ++r) O[dt][r] *= alpha;
#pragma unroll
                for (int s2 = 0; s2 < 2; ++s2) {
                    const float pv[8] = {pr[8 * s2], pr[8 * s2 + 1], pr[8 * s2 + 2], pr[8 * s2 + 3], pr[8 * s2 + 4], pr[8 * s2 + 5], pr[8 * s2 + 6], pr[8 * s2 + 7]};
                    const bf16x8 pf = pack8(pv);
#pragma unroll
                    for (int dt = 0; dt < 2; ++dt) O[dt] = MFMA32(vf[dt][s2], pf, O[dt]);
                }
            }
            if (tq < T) { const float inv = 1.0f / lrun;
#pragma unroll
                for (int dt = 0; dt < 2; ++dt)
#pragma unroll
                    for (int g4 = 0; g4 < 4; ++g4) { u32x2 o; o.x = pk2(O[dt][4 * g4] * inv, O[dt][4 * g4 + 1] * inv); o.y = pk2(O[dt][4 * g4 + 2] * inv, O[dt][4 * g4 + 3] * inv);
                        *(GAS u32x2*)(MIX + (rb + tq) * 1024 + 512 + hd * 64 + 32 * dt + 8 * g4 + 4 * hh) = o; } }
        }
    }
#if PROBE_TS == 3
    __syncthreads();
    if (tid == 0) { const unsigned long long _td = __builtin_amdgcn_s_memrealtime(); atomicAdd(F.ctl + 20000, (unsigned)(_tb - _ta)); atomicAdd(F.ctl + 20001, (unsigned)(_tc - _tb)); atomicAdd(F.ctl + 20002, (unsigned)(_td - _tc)); }
#endif
}

DI void dsa_sample_item(Frame& F, int li, int s) {
    LAS float* QIF = (LAS float*)(F.lds + 0);
    LAS float* QBF = (LAS float*)(F.lds + 2048);
    LAS float* WIF = (LAS float*)(F.lds + 4096);
    LAS float* SCL = (LAS float*)(F.lds + 4352);
    LAS int* SEL = (LAS int*)(F.lds + 12800);
    LAS float* LG = (LAS float*)(F.lds + 13824);
    int tid_ = F.tid; asm volatile("" : "+v"(tid_)); LAUNDER_F(F);
    const int tid = tid_, lane = tid & 63, wv = __builtin_amdgcn_readfirstlane(tid >> 6), row = NPR + s;
    const GAS int* PT = (const GAS int*)GIN(9) + s * NPAGES;
    QIF[tid] = bf2f(((const GAS bf16*)(F.ws + WS_QI))[(size_t)row * 512 + tid]);
    QBF[tid] = bf2f(((const GAS bf16*)(F.ws + WS_QB))[(size_t)row * 512 + tid]);
    if (tid < 8) WIF[tid] = ((const GAS float*)(F.ws + WS_WI))[(size_t)row * 8 + tid];
    __syncthreads();
    {
        const GAS float* kp[4];
#pragma unroll
        for (int i = 0; i < 4; ++i) { const int n = tid + 512 * i; const int pg = PT[n >> 7]; kp[i] = GIN(4) + ((size_t)(pg * PAGE + (n & 127)) * 2 + li) * 64; }
        float acc[4][8];
#pragma unroll
        for (int i = 0; i < 4; ++i)
#pragma unroll
            for (int hd = 0; hd < 8; ++hd) acc[i][hd] = 0.f;
#pragma unroll 2
        for (int dq = 0; dq < 16; ++dq) {
            f32x4 kv[4];
#pragma unroll
            for (int i = 0; i < 4; ++i) kv[i] = *(const GAS f32x4*)(kp[i] + 4 * dq);
#pragma unroll
            for (int hd = 0; hd < 8; ++hd) { const f32x4 qv = *(const LAS f32x4*)(QIF + hd * 64 + 4 * dq);
#pragma unroll
                for (int i = 0; i < 4; ++i) acc[i][hd] += kv[i][0] * qv[0] + kv[i][1] * qv[1] + kv[i][2] * qv[2] + kv[i][3] * qv[3]; }
        }
#pragma unroll
        for (int i = 0; i < 4; ++i) { float sc = 0.f;
#pragma unroll
            for (int hd = 0; hd < 8; ++hd) sc += WIF[hd] * fmaxf(acc[i][hd], 0.f);
            SCL[tid + 512 * i] = sc; }
        if (tid < 64) {
            const float kvn = F.out[O_IS + ((size_t)s * 2 + li) * 64 + lane]; float sc = 0.f;
#pragma unroll
            for (int hd = 0; hd < 8; ++hd) { const float d = wave_sum(kvn * QIF[hd * 64 + lane]); sc += WIF[hd] * fmaxf(d, 0.f); }
            if (lane == 0) SCL[2048] = sc;
        }
    }
    __syncthreads();
    if (wv == 0) {
        unsigned u[33];
#pragma unroll
        for (int j = 0; j < 33; ++j) { const int sidx = 64 * j + lane; u[j] = sidx <= PAST ? ord_key(SCL[sidx]) : 0u; }
        const u64 my = select256<33>(u, lane, (LAS unsigned*)(F.lds + 24576));
        int base = 0;
#pragma unroll
        for (int j = 0; j < 33; ++j) { const u64 wd = __shfl(my, j); const bool on = (wd >> lane) & 1ull; const int pos = base + __builtin_popcountll(wd & ((1ull << lane) - 1ull));
            if (on && pos < 256) SEL[pos] = 64 * j + lane; base += __builtin_popcountll(wd); }
    }
    __syncthreads();
    {
        const int n = tid >> 1, g = tid & 1, idx = SEL[n];
        const GAS float* kp = idx < PAST ? GIN(2) + ((size_t)(PT[idx >> 7] * PAGE + (idx & 127)) * 2 + li) * 128 + g * 64 : F.out + O_KS + ((size_t)s * 2 + li) * 128 + g * 64;
        float a4[4] = {0.f, 0.f, 0.f, 0.f};
#pragma unroll 4
        for (int dq = 0; dq < 16; ++dq) { const f32x4 kv = *(const GAS f32x4*)(kp + 4 * dq);
#pragma unroll
            for (int i = 0; i < 4; ++i) { const f32x4 qv = *(const LAS f32x4*)(QBF + (4 * g + i) * 64 + 4 * dq); a4[i] += kv[0] * qv[0] + kv[1] * qv[1] + kv[2] * qv[2] + kv[3] * qv[3]; } }
#pragma unroll
        for (int i = 0; i < 4; ++i) LG[(4 * g + i) * 256 + n] = a4[i];
    }
    __syncthreads();
    {
        const int hd = wv; float v[4]; float mx = -INFINITY;
#pragma unroll
        for (int i = 0; i < 4; ++i) { v[i] = LG[hd * 256 + lane + 64 * i]; mx = fmaxf(mx, v[i]); }
#pragma unroll
        for (int o = 1; o < 64; o <<= 1) mx = fmaxf(mx, __shfl_xor(mx, o));
        float sm = 0.f;
#pragma unroll
        for (int i = 0; i < 4; ++i) { v[i] = __expf(v[i] - mx); sm += v[i]; }
        sm = wave_sum(sm); const float inv = 1.0f / sm;
#pragma unroll
        for (int i = 0; i < 4; ++i) LG[hd * 256 + lane + 64 * i] = v[i] * inv;
    }
    __syncthreads();
    {
        const int hd = tid >> 6, g = hd >> 2; float o = 0.f;
        for (int n = 0; n < 256; ++n) { const int idx = SEL[n];
            const GAS float* vp = idx < PAST ? GIN(3) + ((size_t)(PT[idx >> 7] * PAGE + (idx & 127)) * 2 + li) * 128 + g * 64 : F.out + O_VS + ((size_t)s * 2 + li) * 128 + g * 64;
            o += LG[hd * 256 + n] * vp[lane]; }
        ((GAS bf16*)(F.ws + WS_MIX))[(size_t)row * 1024 + 512 + hd * 64 + lane] = (bf16)f2bf(o);
    }
}

struct OutProj {
    static constexpr bool GATHER = false, SPLITB = false; static constexpr int KSPLIT = 0, K = 1024, lda = 1024, ldb = 1024;
    const GAS bf16* A; const GAS bf16* Bt; int G, c; GAS float* X;
    DI bool next(int i, pg8::Unit& u) const { if (!pg8::static_next<M / 256, 4>(G, c, i, u.pm, u.pn)) return false;
        u.B0 = (const GAS char*)(Bt + (size_t)u.pn * 256 * 1024); u.B1 = u.B0; u.aux = 0; return true; }
    DI void epi(const AccT& acc, const pg8::Unit& u, int wr, int wc, int fr, int fq) const {
        asm volatile("" : "+v"(fr), "+v"(fq));
#pragma unroll
        for (int ai = 0; ai < 2; ++ai)
#pragma unroll
            for (int m = 0; m < 4; ++m) { GAS float* rp = X + (unsigned)(u.pm * 256 + ai * 128 + wr * 64 + m * 16 + fr) * D + u.pn * 256 + wc * 32 + 4 * fq;
#pragma unroll
                for (int bj = 0; bj < 2; ++bj)
#pragma unroll
                    for (int n = 0; n < 2; ++n) { GAS f32x4* q = (GAS f32x4*)(rp + bj * 128 + n * 16); *q = *q * DN_ALPHA + acc[ai][bj][m][n]; }
                asm volatile("" ::: "memory"); }
    }
};

DI void p_ln(Frame& F, int layer, bool second, bool final_) {
    int tid_ = F.tid; asm volatile("" : "+v"(tid_)); LAUNDER_F(F);
    const int tid = tid_, lane = tid & 63, wv = __builtin_amdgcn_readfirstlane(tid >> 6);
    const bool route = !second;
    LAS float* RW = (LAS float*)(F.lds + 0);
    volatile LAS unsigned* LCNT = (volatile LAS unsigned*)(F.lds + 81920);
    volatile LAS unsigned* ROWC = (volatile LAS unsigned*)(F.lds + 82432);
    int nrow = 0;
    if (route) {
        if (tid < 64) LCNT[tid] = 0u;
        const GAS float* gw = GIN(32) + (size_t)layer * 1024 * 4; const GAS float* ew = GIN(34) + (size_t)layer * 1024 * 16;
#pragma unroll 1
        for (int i = 0; i < 2; ++i) { const int k = tid + 512 * i; f32x4 st[5]; st[0] = *(const GAS f32x4*)(gw + k * 4);
#pragma unroll
            for (int q = 0; q < 4; ++q) st[1 + q] = *(const GAS f32x4*)(ew + k * 16 + 4 * q);
#pragma unroll
            for (int q = 0; q < 5; ++q) *(LAS f32x4*)(RW + k * 20 + 4 * q) = st[q]; }
        __syncthreads();
        asm volatile("" ::: "memory");
    }
    const GAS float* lg = GIN(second ? 30 : 28) + layer * D; const GAS float* lb = GIN(second ? 31 : 29) + layer * D;
    f32x4 g4[4], b4[4];
#pragma unroll
    for (int j = 0; j < 4; ++j) { g4[j] = *((const GAS f32x4*)lg + lane + 64 * j); b4[j] = *((const GAS f32x4*)lb + lane + 64 * j); }
    GAS float* X = (GAS float*)(F.ws + WS_X); GAS bf16* XB = (GAS bf16*)(F.ws + WS_XB);
    f32x4 nv[4];
    { const int m0 = F.wg * 8 + wv;
#pragma unroll
      for (int j = 0; j < 4; ++j) nv[j] = *((const GAS f32x4*)(X + (size_t)(m0 < M ? m0 : 0) * D) + lane + 64 * j); }
    for (int m = F.wg * 8 + wv; m < M; m += F.G * 8) {
        asm volatile("" ::: "memory");
        f32x4 v[4]; float sm = 0.f;
#pragma unroll
        for (int j = 0; j < 4; ++j) { v[j] = nv[j]; sm += (v[j][0] + v[j][1]) + (v[j][2] + v[j][3]); }
        { const int mn = m + F.G * 8 < M ? m + F.G * 8 : m;
#pragma unroll
          for (int j = 0; j < 4; ++j) nv[j] = *((const GAS f32x4*)(X + (size_t)mn * D) + lane + 64 * j); }
        const float mean = wave_sum(sm) * (1.0f / D); float s2 = 0.f;
#pragma unroll
        for (int j = 0; j < 4; ++j) { v[j] = v[j] - mean; s2 += (v[j][0] * v[j][0] + v[j][1] * v[j][1]) + (v[j][2] * v[j][2] + v[j][3] * v[j][3]); }
        const float rstd = rsqrtf(wave_sum(s2) * (1.0f / D) + LN_EPS);
#pragma unroll
        for (int j = 0; j < 4; ++j) v[j] = v[j] * rstd * g4[j] + b4[j];
        if (final_) {
            GAS float* dst = nullptr;
            if (m < NPR) { const int b = m / T, t = m % T; if (t >= NMETA) dst = F.out + O_YP + ((size_t)b * SEQ + (t - NMETA)) * D; }
            else dst = F.out + O_YS + (size_t)(m - NPR) * D;
            if (dst) {
#pragma unroll
                for (int j = 0; j < 4; ++j) *((GAS f32x4*)dst + lane + 64 * j) = v[j]; }
        } else {
#pragma unroll
            for (int j = 0; j < 4; ++j) { *((GAS f32x4*)(X + (size_t)m * D) + lane + 64 * j) = v[j]; u32x2 o; o.x = pk2(v[j][0], v[j][1]); o.y = pk2(v[j][2], v[j][3]); *((GAS u32x2*)(XB + (size_t)m * D) + lane + 64 * j) = o; }
        }
        if (route) {
            float pl[20];
#pragma unroll
            for (int e = 0; e < 20; ++e) pl[e] = 0.f;
#pragma unroll
            for (int j = 0; j < 4; ++j)
#pragma unroll
                for (int i = 0; i < 4; ++i) { const LAS float* wp = RW + (4 * lane + 256 * j + i) * 20; const float xv = v[j][i];
#pragma unroll
                    for (int q = 0; q < 5; ++q) { const f32x4 wq = *(const LAS f32x4*)(wp + 4 * q); pl[4 * q] += xv * wq[0]; pl[4 * q + 1] += xv * wq[1]; pl[4 * q + 2] += xv * wq[2]; pl[4 * q + 3] += xv * wq[3]; } }
#pragma unroll
            for (int e = 0; e < 20; ++e) pl[e] = wave_sum(pl[e]);
            const GAS float* gb = GIN(33) + layer * 4; const GAS float* eb = GIN(35) + layer * 16;
            float l0 = pl[0] + gb[0], l1 = pl[1] + gb[1], l2 = pl[2] + gb[2], l3 = pl[3] + gb[3];
            int g = 0; float lm = l0; if (l1 > lm) { lm = l1; g = 1; } if (l2 > lm) { lm = l2; g = 2; } if (l3 > lm) { lm = l3; g = 3; }
            const float gval = 1.0f / (__expf(l0 - lm) + __expf(l1 - lm) + __expf(l2 - lm) + __expf(l3 - lm));
            float le[4];
#pragma unroll
            for (int i = 0; i < 4; ++i) le[i] = (g == 0 ? pl[4 + i] : g == 1 ? pl[8 + i] : g == 2 ? pl[12 + i] : pl[16 + i]) + eb[4 * g + i];
            int ea = 0; float la = le[0];
#pragma unroll
            for (int i = 1; i < 4; ++i) if (le[i] > la) { la = le[i]; ea = i; }
            int e2 = -1; float l2b = -INFINITY;
#pragma unroll
            for (int i = 0; i < 4; ++i) if (i != ea && le[i] > l2b) { l2b = le[i]; e2 = i; }
            const float p1 = 1.0f / (1.0f + __expf(l2b - la)), p2 = 1.0f - p1;
            const int lo = ea < e2 ? ea : e2, hi = ea < e2 ? e2 : ea;
            const float glo = gval * (ea < e2 ? p1 : p2), ghi = gval * (ea < e2 ? p2 : p1);
            const int pr = lo == 0 ? hi - 1 : (lo == 1 ? hi + 1 : 5), cls = g * 6 + pr;
            if (lane == 0) {
                const unsigned lp = __hip_atomic_fetch_add((LAS unsigned*)LCNT + cls, 1u, __ATOMIC_RELAXED, __HIP_MEMORY_SCOPE_WORKGROUP);
                ROWC[wv * 12 + nrow] = (unsigned)cls | (lp << 8);
                *(GAS f32x2*)((GAS float*)(F.ws + WS_GATE) + (size_t)m * 2) = (f32x2){glo, ghi};
            }
            ++nrow;
        }
    }
    if (route) {
        __syncthreads();
        if (tid < NCLS) { const unsigned n = LCNT[tid]; LCNT[32 + tid] = n ? __hip_atomic_fetch_add(F.ctl + CW_CNT + (layer * NCLS + tid) * 64, n, __ATOMIC_RELAXED, __HIP_MEMORY_SCOPE_AGENT) : 0u; }
        __syncthreads();
        if (lane == 0) { int r = 0;
            for (int m = F.wg * 8 + wv; m < M; m += F.G * 8, ++r) { const unsigned e = ROWC[wv * 12 + r]; const unsigned cls = e & 255u, lp = e >> 8;
                ((GAS int*)(F.ws + WS_TOK))[(size_t)cls * CLS_CAP + LCNT[32 + cls] + lp] = m; } }
    }
}

DI void moe_setup(Frame& F, int layer) {
    int tid = F.tid; asm volatile("" : "+v"(tid));
    __syncthreads();
    if (tid < NCLS) F.MISC[48 + tid] = __hip_atomic_load(F.ctl + CW_CNT + (layer * NCLS + tid) * 64, __ATOMIC_RELAXED, __HIP_MEMORY_SCOPE_AGENT);
    __syncthreads();
    if (tid == 0) { unsigned run = 0; for (int c = 0; c < NCLS; ++c) { F.MISC[16 + c] = run; run += (F.MISC[48 + c] + 255u) >> 8; } F.MISC[16 + NCLS] = run; }
    __syncthreads();
}
DI void cls_experts(int cls, int& elo, int& ehi) { const int g = cls / 6, pr = cls % 6; const int lo = pr < 3 ? 0 : (pr < 5 ? 1 : 2), hi = pr < 3 ? pr + 1 : (pr < 5 ? pr - 1 : 3); elo = g * 4 + lo; ehi = g * 4 + hi; }
DI bool moe_next(const volatile LAS unsigned* MISC, int G, int c, int i, int& cp, int& pn, int& cls) {
    const int npan = __builtin_amdgcn_readfirstlane((int)MISC[16 + NCLS]); const long L = (long)i * G + c; if (L >= 4L * npan) return false;
    cp = (int)(L >> 2); pn = (int)(L & 3); cls = 0;
    for (int k = 1; k < NCLS; ++k) if (__builtin_amdgcn_readfirstlane((int)MISC[16 + k]) <= cp) cls = k;
    return true;
}
struct MoeUp {
    static constexpr bool GATHER = true, SPLITB = false; static constexpr int KSPLIT = 0, K = 1024, lda = 1024, ldb = 1024;
    const GAS bf16* A; int G, c, layer; GAS unsigned char* ws; const volatile LAS unsigned* MISC;
    DI bool next(int i, pg8::Unit& u) const { int cp, pn, cls; if (!moe_next(MISC, G, c, i, cp, pn, cls)) return false;
        int elo, ehi; cls_experts(cls, elo, ehi); const int e = pn < 2 ? elo : ehi;
        u.pm = cp; u.pn = pn; u.aux = cls; u.B0 = (const GAS char*)((const GAS bf16*)(ws + WS_WGU) + ((size_t)(layer * 16 + e) * 512 + (pn & 1) * 256) * 1024); u.B1 = u.B0; return true; }
    DI unsigned a_row(const pg8::Unit& u, int r) const { const int cls = u.aux, cnt = __builtin_amdgcn_readfirstlane((int)MISC[48 + cls]); int slot = (u.pm - __builtin_amdgcn_readfirstlane((int)MISC[16 + cls])) * 256 + r; slot = slot < cnt ? slot : cnt - 1;
        const int tok = ((const GAS int*)(ws + WS_TOK))[(size_t)cls * CLS_CAP + slot]; return (unsigned)tok * 2048u; }
    DI void epi(const AccT& acc, const pg8::Unit& u, int wr, int wc, int fr, int fq) const {
        asm volatile("" : "+v"(fr), "+v"(fq));
        const int cls = u.aux, cnt = __builtin_amdgcn_readfirstlane((int)MISC[48 + cls]), sbase = (u.pm - __builtin_amdgcn_readfirstlane((int)MISC[16 + cls])) * 256;
        GAS bf16* H = (GAS bf16*)(ws + WS_H);
#pragma unroll
        for (int ai = 0; ai < 2; ++ai)
#pragma unroll
            for (int m = 0; m < 4; ++m) { const int r = ai * 128 + wr * 64 + m * 16 + fr; int slot = sbase + r; slot = slot < cnt ? slot : cnt - 1;
                const int tok = ((const GAS int*)(ws + WS_TOK))[(unsigned)cls * CLS_CAP + slot]; const float gate = ((const GAS float*)(ws + WS_GATE))[(unsigned)tok * 2 + (u.pn >> 1)];
#pragma unroll
                for (int n = 0; n < 2; ++n) { const f32x4 gv = acc[ai][0][m][n], uv = acc[ai][1][m][n]; u32x2 o;
                    o.x = pk2(siluf_(gv[0]) * uv[0] * gate, siluf_(gv[1]) * uv[1] * gate); o.y = pk2(siluf_(gv[2]) * uv[2] * gate, siluf_(gv[3]) * uv[3] * gate);
                    *(GAS u32x2*)(H + (unsigned)(u.pm * 256 + r) * 512 + u.pn * 128 + wc * 32 + n * 16 + 4 * fq) = o; } }
    }
};
struct MoeDown {
    static constexpr bool GATHER = false, SPLITB = true; static constexpr int KSPLIT = 4, K = 512, lda = 512, ldb = 256;
    const GAS bf16* A; int G, c, layer; GAS unsigned char* ws; const volatile LAS unsigned* MISC;
    DI bool next(int i, pg8::Unit& u) const { int cp, pn, cls; if (!moe_next(MISC, G, c, i, cp, pn, cls)) return false;
        int elo, ehi; cls_experts(cls, elo, ehi);
        u.pm = cp; u.pn = pn; u.aux = cls; const GAS bf16* WD = (const GAS bf16*)(ws + WS_WD);
        u.B0 = (const GAS char*)(WD + ((size_t)(layer * 16 + elo) * 1024 + pn * 256) * 256); u.B1 = (const GAS char*)(WD + ((size_t)(layer * 16 + ehi) * 1024 + pn * 256) * 256) - 4 * 128; return true; }
    DI void epi(const AccT& acc, const pg8::Unit& u, int wr, int wc, int fr, int fq) const {
        asm volatile("" : "+v"(fr), "+v"(fq));
        const int cls = u.aux, cnt = __builtin_amdgcn_readfirstlane((int)MISC[48 + cls]), sbase = (u.pm - __builtin_amdgcn_readfirstlane((int)MISC[16 + cls])) * 256;
        GAS float* X = (GAS float*)(ws + WS_X);
#pragma unroll
        for (int ai = 0; ai < 2; ++ai)
#pragma unroll
            for (int m = 0; m < 4; ++m) { const int r = ai * 128 + wr * 64 + m * 16 + fr, slot = sbase + r;
                if (slot < cnt) { const int tok = ((const GAS int*)(ws + WS_TOK))[(unsigned)cls * CLS_CAP + slot]; GAS float* rp = X + (unsigned)tok * D + u.pn * 256 + wc * 32 + 4 * fq;
#pragma unroll
                    for (int bj = 0; bj < 2; ++bj)
#pragma unroll
                        for (int n = 0; n < 2; ++n) { GAS f32x4* q = (GAS f32x4*)(rp + bj * 128 + n * 16); *q = *q * DN_ALPHA + acc[ai][bj][m][n]; } }
                asm volatile("" ::: "memory"); }
    }
};

struct OddIn {
    static constexpr bool GATHER = false, SPLITB = false; static constexpr int KSPLIT = 0, K = 1024, lda = 1024, ldb = 1024;
    const GAS bf16* A; const GAS bf16* Bt; int G, c, li; GAS unsigned char* ws; GAS float* out;
    DI bool next(int i, pg8::Unit& u) const { if (!pg8::static_next<M / 256, ODD_IN / 256>(G, c, i, u.pm, u.pn)) return false;
        u.B0 = (const GAS char*)(Bt + (size_t)u.pn * 256 * 1024); u.B1 = u.B0; u.aux = 0; return true; }
    DI void epi(const AccT& acc, const pg8::Unit& u, int wr, int wc, int fr, int fq) const {
        asm volatile("" : "+v"(fr), "+v"(fq));
        const int pn = u.pn;
#pragma unroll
        for (int ai = 0; ai < 2; ++ai)
#pragma unroll
            for (int m = 0; m < 4; ++m) {
                const int row = u.pm * 256 + ai * 128 + wr * 64 + m * 16 + fr;
                int b = 0, t = 0, sidx = 0; const bool pr = row < NPR; if (pr) { b = row / T; t = row % T; } else sidx = row - NPR;
                if (pn < 4) {
                    GAS float* so = nullptr;
                    if (pr) { if (t >= T - 30) so = out + O_CP + ((unsigned)(b * 2 + li) * 30 + (t - (T - 30))) * 512; } else so = out + O_CS + ((unsigned)(sidx * 2 + li) * 30 + 29) * 512;
#pragma unroll
                    for (int n = 0; n < 2; ++n) { const int ch = 128 * pn + wc * 32 + n * 16 + 4 * fq; const f32x4 a = acc[ai][0][m][n], g = acc[ai][1][m][n]; f32x4 uv;
#pragma unroll
                        for (int j = 0; j < 4; ++j) uv[j] = a[j] * sigmoidf_(g[j]);
                        u32x2 o; o.x = pk2(uv[0], uv[1]); o.y = pk2(uv[2], uv[3]); *(GAS u32x2*)((GAS bf16*)(ws + WS_A0) + (unsigned)row * 512 + ch) = o;
                        if (so) *(GAS f32x4*)(so + ch) = uv; }
                } else if (pn < 6) {
                    GAS float* so = nullptr;
                    if (pr) { if (t >= T - 3) so = out + O_DP + ((unsigned)(b * 2 + li) * 3 + (t - (T - 3))) * 512; } else so = out + O_DS + ((unsigned)(sidx * 2 + li) * 3 + 2) * 512;
#pragma unroll
                    for (int bj = 0; bj < 2; ++bj)
#pragma unroll
                        for (int n = 0; n < 2; ++n) { const int ch = (pn - 4) * 256 + bj * 128 + wc * 32 + n * 16 + 4 * fq; const f32x4 v = acc[ai][bj][m][n];
                            u32x2 o; o.x = pk2(v[0], v[1]); o.y = pk2(v[2], v[3]); *(GAS u32x2*)((GAS bf16*)(ws + WS_A1) + (unsigned)row * 512 + ch) = o;
                            if (so) *(GAS f32x4*)(so + ch) = v; }
                } else {
#pragma unroll
                    for (int bj = 0; bj < 2; ++bj)
#pragma unroll
                        for (int n = 0; n < 2; ++n) { const int ch = (pn - 6) * 256 + bj * 128 + wc * 32 + n * 16 + 4 * fq; const f32x4 v = acc[ai][bj][m][n];
                            u32x2 o; o.x = pk2(gelu_tanh(v[0]), gelu_tanh(v[1])); o.y = pk2(gelu_tanh(v[2]), gelu_tanh(v[3])); *(GAS u32x2*)((GAS bf16*)(ws + WS_A2) + (unsigned)row * 512 + ch) = o; }
                }
            }
    }
};

DI float lru_sp8(float lam) { return 8.0f * log1pf(__expf(-lam)); }
DI void lru_chain_item(Frame& F, int li, int b, int n) {
    int tid_ = F.tid; asm volatile("" : "+v"(tid_)); LAUNDER_F(F);
    const int tid = tid_, lane = tid & 63, w = __builtin_amdgcn_readfirstlane(tid >> 6), l15 = lane & 15, l4 = lane >> 4;
    LAS bf16* XC = (LAS bf16*)(F.lds + 0);
    LAS bf16* WB = (LAS bf16*)(F.lds + 9216);
    LAS float* GT = (LAS float*)(F.lds + 27648);
    LAS float* AA = (LAS float*)(F.lds + 61440);
    LAS float* UU = (LAS float*)(F.lds + 77824);
    LAS float* SEGP = (LAS float*)(F.lds + 94208);
    LAS float* SEGH = (LAS float*)(F.lds + 96256);
    LAS float* HC = (LAS float*)(F.lds + 98304);
    const GAS bf16* DX = (const GAS bf16*)(F.ws + WS_A1); const GAS bf16* DG = (const GAS bf16*)(F.ws + WS_A2); GAS bf16* MIX = (GAS bf16*)(F.ws + WS_MIX);
    const GAS float* wa = GIN(23) + ((size_t)(li * 8 + n) * 64) * 64; const GAS float* wx = GIN(25) + ((size_t)(li * 8 + n) * 64) * 64;
    __syncthreads();
    for (int e = tid; e < 4096; e += 512) { const int i = e >> 6, j = e & 63; WB[j * 72 + i] = (bf16)f2bf(wa[e]); WB[(64 + j) * 72 + i] = (bf16)f2bf(wx[e]); }
    if (tid < 64) HC[tid] = 0.f;
    const int t = tid >> 3, c8 = tid & 7, cb = 64 * n + 8 * c8;
    float dw[4][8], dbv[8], bav[8], bxv[8], sp[8];
#pragma unroll
    for (int j = 0; j < 8; ++j) { dbv[j] = GIN(22)[li * 512 + cb + j]; bav[j] = GIN(24)[li * 512 + cb + j]; bxv[j] = GIN(26)[li * 512 + cb + j]; sp[j] = lru_sp8(GIN(27)[li * 512 + cb + j]);
#pragma unroll
        for (int q = 0; q < 4; ++q) dw[q][j] = GIN(21)[(li * 4 + q) * 512 + cb + j]; }
    constexpr int NCH = (T + 63) / 64;
    u32x4 ndx[4], ndg;
#define LC_LOAD(c) do { const int tgl = 64 * (c) + t; _Pragma("unroll") for (int q = 0; q < 4; ++q) { const int ts = tgl - 3 + q; const int tsc = ts < 0 ? 0 : (ts < T ? ts : T - 1); \
        ndx[q] = *(const GAS u32x4*)(DX + (unsigned)(b * T + tsc) * 512u + (unsigned)cb); } \
        ndg = *(const GAS u32x4*)(DG + (unsigned)(b * T + (tgl < T ? tgl : T - 1)) * 512u + (unsigned)cb); } while (0)
    __syncthreads();
    LC_LOAD(0);
    for (int c = 0; c < NCH; ++c) {
        const int tg = 64 * c + t;
        float xc[8];
#pragma unroll
        for (int j = 0; j < 8; ++j) xc[j] = dbv[j];
#pragma unroll
        for (int q = 0; q < 4; ++q) { const int ts = tg - 3 + q; const bool ok = ts >= 0 && ts < T; const unsigned rw[4] = {ndx[q].x, ndx[q].y, ndx[q].z, ndx[q].w};
#pragma unroll
            for (int j = 0; j < 8; ++j) xc[j] += ok ? dw[q][j] * bf2f((rw[j >> 1] >> (16 * (j & 1))) & 0xffffu) : 0.f; }
        const u32x4 dgc = ndg;
        if (c + 1 < NCH) LC_LOAD(c + 1);
        *(LAS bf16x8*)(XC + t * 72 + 8 * c8) = pack8(xc);
        LDS_BAR();
        {
            const bf16x8 b0 = *(const LAS bf16x8*)(WB + (16 * w + l15) * 72 + 8 * l4), b1 = *(const LAS bf16x8*)(WB + (16 * w + l15) * 72 + 32 + 8 * l4);
#pragma unroll
            for (int tt = 0; tt < 4; ++tt) { f32x4 a = {0.f, 0.f, 0.f, 0.f};
                a = MFMA16(*(const LAS bf16x8*)(XC + (16 * tt + l15) * 72 + 8 * l4), b0, a); a = MFMA16(*(const LAS bf16x8*)(XC + (16 * tt + l15) * 72 + 32 + 8 * l4), b1, a);
#pragma unroll
                for (int r = 0; r < 4; ++r) GT[(16 * tt + 4 * l4 + r) * 132 + 16 * w + l15] = a[r]; }
        }
        LDS_BAR();
#pragma unroll
        for (int j = 0; j < 8; ++j) { const float r = sigmoidf_(GT[t * 132 + 8 * c8 + j] + bav[j]), ig = sigmoidf_(GT[t * 132 + 64 + 8 * c8 + j] + bxv[j]);
            const float la = -r * sp[j]; float a = __expf(la); float dr = sqrtf(fmaxf(-expm1f(2.0f * la), 0.f)) * ig * xc[j];
            if (tg >= T) { a = 1.0f; dr = 0.f; }
            AA[t * 64 + 8 * c8 + j] = a; UU[t * 64 + 8 * c8 + j] = dr; }
        LDS_BAR();
        {
            const int ch = tid & 63, sg = tid >> 6;
            float av[8], uv[8]; float P = 1.0f, H = 0.f;
#pragma unroll
            for (int i = 0; i < 8; ++i) { av[i] = AA[(8 * sg + i) * 64 + ch]; uv[i] = UU[(8 * sg + i) * 64 + ch]; H = av[i] * H + uv[i]; P *= av[i]; }
            SEGP[sg * 64 + ch] = P; SEGH[sg * 64 + ch] = H;
            LDS_BAR();
            float h = HC[(c & 1) * 64 + ch];
            for (int q = 0; q < sg; ++q) h = SEGP[q * 64 + ch] * h + SEGH[q * 64 + ch];
#pragma unroll
            for (int i = 0; i < 8; ++i) { h = av[i] * h + uv[i]; UU[(8 * sg + i) * 64 + ch] = h; }
            if (sg == 7) HC[((c + 1) & 1) * 64 + ch] = h;
        }
        LDS_BAR();
        if (tg < T) { const unsigned rw[4] = {dgc.x, dgc.y, dgc.z, dgc.w}; float y[8];
#pragma unroll
            for (int j = 0; j < 8; ++j) y[j] = UU[t * 64 + 8 * c8 + j] * bf2f((rw[j >> 1] >> (16 * (j & 1))) & 0xffffu);
            *(GAS bf16x8*)(MIX + (unsigned)(b * T + tg) * 1024u + 512u + (unsigned)cb) = pack8(y); }
    }
#undef LC_LOAD
    __syncthreads();
    if (tid < 64) F.out[O_LP + (size_t)(b * 2 + li) * 512 + 64 * n + tid] = HC[(NCH & 1) * 64 + tid];
}

template <int NV> DI void block_sum2(float (&a)[NV], float (&bq)[NV], LAS float* RED, int wv, int lane) {
#pragma unroll
    for (int i = 0; i < NV; ++i) { a[i] = wave_sum(a[i]); bq[i] = wave_sum(bq[i]); }
    __syncthreads();
    if (lane == 0) {
#pragma unroll
        for (int i = 0; i < NV; ++i) { RED[wv * 2 * NV + i] = a[i]; RED[wv * 2 * NV + NV + i] = bq[i]; } }
    __syncthreads();
#pragma unroll
    for (int i = 0; i < NV; ++i) { float x = 0.f, y = 0.f;
#pragma unroll
        for (int q = 0; q < 8; ++q) { x += RED[q * 2 * NV + i]; y += RED[q * 2 * NV + NV + i]; }
        a[i] = x; bq[i] = y; }
}
DI void convc_item(Frame& F, int li, int b, int blk) {
    int tid_ = F.tid; asm volatile("" : "+v"(tid_)); LAUNDER_F(F);
    const int tid = tid_, lane = tid & 63, wv = __builtin_amdgcn_readfirstlane(tid >> 6), c = tid;
    LAS float* RED = (LAS float*)(F.lds + 0);
    const GAS bf16* U = (const GAS bf16*)(F.ws + WS_A0); GAS bf16* MIX = (GAS bf16*)(F.ws + WS_MIX);
    float cw[31];
#pragma unroll
    for (int j = 0; j < 31; ++j) cw[j] = GIN(17)[(size_t)(li * 31 + j) * 512 + c];
    const float cbv = GIN(18)[li * 512 + c], gln = GIN(19)[li * 512 + c], bln = GIN(20)[li * 512 + c];
    for (int g8 = 0; g8 < 8; ++g8) {
        const int t0 = 64 * blk + 8 * g8; if (t0 >= T) break;
        float val[38];
#pragma unroll
        for (int i = 0; i < 38; ++i) { const int ts = t0 - 30 + i; const bool ok = ts >= 0 && ts < T; const unsigned raw = U[(unsigned)(b * T + (ts < 0 ? 0 : (ts < T ? ts : T - 1))) * 512u + (unsigned)c]; val[i] = ok ? bf2f(raw) : 0.f; }
        float y[8], y2[8];
#pragma unroll
        for (int o = 0; o < 8; ++o) { float a = cbv;
#pragma unroll
            for (int j = 0; j < 31; ++j) a += cw[j] * val[o + j];
            y[o] = a; y2[o] = a * a; }
        float s1[8];
#pragma unroll
        for (int o = 0; o < 8; ++o) s1[o] = y[o];
        block_sum2<8>(s1, y2, RED, wv, lane);
#pragma unroll
        for (int o = 0; o < 8; ++o) { const int tg = t0 + o; if (tg < T) { const float mean = s1[o] * (1.0f / 512.0f); const float var = fmaxf(y2[o] * (1.0f / 512.0f) - mean * mean, 0.f);
            const float z = (y[o] - mean) * rsqrtf(var + LN_EPS) * gln + bln; MIX[(size_t)(b * T + tg) * 1024 + c] = (bf16)f2bf(siluf_(z)); } }
    }
}
DI void odd_sample_item(Frame& F, int li, int s) {
    int tid_ = F.tid; asm volatile("" : "+v"(tid_)); LAUNDER_F(F);
    const int tid = tid_, lane = tid & 63, wv = __builtin_amdgcn_readfirstlane(tid >> 6), c = tid, row = NPR + s;
    LAS float* RED = (LAS float*)(F.lds + 0); LAS float* XS = (LAS float*)(F.lds + 1024);
    GAS bf16* MIX = (GAS bf16*)(F.ws + WS_MIX);
    const GAS float* st = GIN(6) + ((size_t)(s * 2 + li) * 30) * 512 + c; GAS float* so = F.out + O_CS + ((size_t)(s * 2 + li) * 30) * 512 + c;
    float a = GIN(18)[li * 512 + c];
#pragma unroll
    for (int j = 0; j < 30; ++j) { const float v = st[(size_t)j * 512]; a += GIN(17)[(size_t)(li * 31 + j) * 512 + c] * v; if (j >= 1) so[(size_t)(j - 1) * 512] = v; }
    a += GIN(17)[(size_t)(li * 31 + 30) * 512 + c] * so[(size_t)29 * 512];
    float s1[1] = {a}, s2[1] = {a * a};
    block_sum2<1>(s1, s2, RED, wv, lane);
    { const float mean = s1[0] * (1.0f / 512.0f), var = fmaxf(s2[0] * (1.0f / 512.0f) - mean * mean, 0.f);
      const float z = (a - mean) * rsqrtf(var + LN_EPS) * GIN(19)[li * 512 + c] + GIN(20)[li * 512 + c]; MIX[(size_t)row * 1024 + c] = (bf16)f2bf(siluf_(z)); }
    const GAS float* sd = GIN(7) + ((size_t)(s * 2 + li) * 3) * 512 + c; GAS float* sdo = F.out + O_DS + ((size_t)(s * 2 + li) * 3) * 512 + c;
    const float d0 = sd[0], d1 = sd[512], d2 = sd[1024], d3 = sdo[1024];
    sdo[0] = d1; sdo[512] = d2;
    const float xc = GIN(22)[li * 512 + c] + GIN(21)[(li * 4 + 0) * 512 + c] * d0 + GIN(21)[(li * 4 + 1) * 512 + c] * d1 + GIN(21)[(li * 4 + 2) * 512 + c] * d2 + GIN(21)[(li * 4 + 3) * 512 + c] * d3;
    __syncthreads();
    XS[c] = xc;
    __syncthreads();
    const int n = c >> 6, j = c & 63; const GAS float* wa = GIN(23) + ((size_t)(li * 8 + n) * 64) * 64 + j; const GAS float* wx = GIN(25) + ((size_t)(li * 8 + n) * 64) * 64 + j;
    float ra = GIN(24)[li * 512 + c], ia = GIN(26)[li * 512 + c];
#pragma unroll 8
    for (int i = 0; i < 64; ++i) { const float xv = XS[64 * n + i]; ra += xv * wa[(size_t)i * 64]; ia += xv * wx[(size_t)i * 64]; }
    const float r = sigmoidf_(ra), ig = sigmoidf_(ia), la = -r * lru_sp8(GIN(27)[li * 512 + c]);
    const float h = __expf(la) * GIN(8)[(size_t)(s * 2 + li) * 512 + c] + sqrtf(fmaxf(-expm1f(2.0f * la), 0.f)) * ig * xc;
    F.out[O_LS + (size_t)(s * 2 + li) * 512 + c] = h;
    MIX[(size_t)row * 1024 + 512 + c] = (bf16)f2bf(h * bf2f(((const GAS bf16*)(F.ws + WS_A2))[(size_t)row * 512 + c]));
}
NOINL void ph_prologue(Frame F) { frame_fix(F); p_prologue(F); }
DI void ph_evenin(Frame F, int li) { LAUNDER_F(F);
    { EvenIn<false> P; P.A = (const GAS bf16*)(F.ws + WS_XB); P.Bt = (const GAS bf16*)(F.ws + WS_WINE) + (size_t)li * EVEN_PAD * 1024; P.G = F.G; P.c = F.vcu; P.li = li; P.ws = F.ws; P.out = F.out;
      pg8::gemm_phase(F.lds, P); }
    LAUNDER_F(F);
    { EvenIn<true> P; P.A = (const GAS bf16*)(F.ws + WS_XB); P.Bt = (const GAS bf16*)(F.ws + WS_WINE) + (size_t)li * EVEN_PAD * 1024; P.G = F.G; P.c = F.vcu; P.li = li; P.ws = F.ws; P.out = F.out;
      pg8::gemm_phase(F.lds, P); } }
DI void ph_oddin(Frame F, int li) { LAUNDER_F(F);
    OddIn P; P.A = (const GAS bf16*)(F.ws + WS_XB); P.Bt = (const GAS bf16*)(F.ws + WS_WINO) + (size_t)li * ODD_IN * 1024; P.G = F.G; P.c = F.vcu; P.li = li; P.ws = F.ws; P.out = F.out;
    pg8::gemm_phase(F.lds, P); }
DI void ph_outproj(Frame F, int layer) { LAUNDER_F(F);
    OutProj P; P.A = (const GAS bf16*)(F.ws + WS_MIX); P.Bt = (const GAS bf16*)(F.ws + ((layer & 1) ? WS_WOUTO : WS_WOUTE)) + (size_t)(layer >> 1) * 1024 * 1024; P.G = F.G; P.c = F.vcu; P.X = (GAS float*)(F.ws + WS_X);
    pg8::gemm_phase(F.lds, P); }
DI void ph_moeup(Frame F, int layer) { LAUNDER_F(F); moe_setup(F, layer);
    MoeUp P; P.A = (const GAS bf16*)(F.ws + WS_XB); P.G = F.G; P.c = F.vcu; P.layer = layer; P.ws = F.ws; P.MISC = F.MISC;
    pg8::gemm_phase(F.lds, P); }
DI void ph_moedown(Frame F, int layer) { LAUNDER_F(F); moe_setup(F, layer);
    MoeDown P; P.A = (const GAS bf16*)(F.ws + WS_H); P.G = F.G; P.c = F.vcu; P.layer = layer; P.ws = F.ws; P.MISC = F.MISC;
    pg8::gemm_phase(F.lds, P); }
DI void ph_ln1(Frame F, int layer) { LAUNDER_F(F); p_ln(F, layer, false, false); }
NOINL void ph_ln2(Frame F, int layer, int fin) { frame_fix(F); p_ln(F, rfl(layer), true, rfl(fin) != 0); }
DI void it_hgrn_prompt(Frame F, int li, int b, int h) { hgrn_prompt_item(F, li, b, h); }
NOINL void it_hgrn_sample(Frame F, int li, int sq) { frame_fix(F); hgrn_sample_item(F, rfl(li), rfl(sq)); }
DI void it_dsa_prompt(Frame F, int b, int qblk) { dsa_prompt_item(F, b, qblk); }
DI void it_dsa_sample(Frame F, int li, int sq) { dsa_sample_item(F, li, sq); }
DI void it_lru_chain(Frame F, int li, int b, int n) { lru_chain_item(F, li, b, n); }
DI void it_convc(Frame F, int li, int b, int blk) { convc_item(F, li, b, blk); }
NOINL void it_odd_sample(Frame F, int li, int sq) { frame_fix(F); odd_sample_item(F, rfl(li), rfl(sq)); }
#if PROBE_TS
#define PT_MARK(slot) do { const unsigned long long _t = __builtin_amdgcn_s_memrealtime(); if (F.tid == 0 && qidx == 0) atomicMax(F.ctl + 20000 + (slot), (unsigned)(_t - _t0)); } while (0)
#else
#define PT_MARK(slot) do { } while (0)
#endif
DI void p_even_mixer(Frame& F, int li, int qidx) {
    constexpr int E0 = 32, E1 = E0 + 8 * 33, E2 = E1 + NSM, E3 = E2 + NSM;
#if PROBE_TS
    const unsigned long long _t0 = __builtin_amdgcn_s_memrealtime();
#endif
    int it = q_pop(F, qidx);
    while (it < E0) { it_hgrn_prompt(F, li, it >> 2, it & 3); it = q_pop(F, qidx); PT_MARK(0); }
    while (it < E1) { const int j = it - E0; it_dsa_prompt(F, j & 7, 32 - (j >> 3)); it = q_pop(F, qidx); PT_MARK(1); }
    while (it < E2) { it_dsa_sample(F, li, it - E1); it = q_pop(F, qidx); PT_MARK(2); }
    while (it < E3) { it_hgrn_sample(F, li, it - E2); it = q_pop(F, qidx); PT_MARK(3); }
}
DI void p_odd_mixer(Frame& F, int li, int qidx) {
    constexpr int E0 = 64, E1 = E0 + 8 * 33, E2 = E1 + NSM;
#if PROBE_TS
    const unsigned long long _t0 = __builtin_amdgcn_s_memrealtime();
#endif
    int it = q_pop(F, qidx);
#if PROBE_TS
    if (F.tid == 0 && qidx == 1) atomicMax(F.ctl + 20000 + 4, 0u);
#define PT_MARK2(slot) do { const unsigned long long _t = __builtin_amdgcn_s_memrealtime(); if (F.tid == 0 && qidx == 1) atomicMax(F.ctl + 20000 + (slot), (unsigned)(_t - _t0)); } while (0)
#else
#define PT_MARK2(slot) do { } while (0)
#endif
    while (it < E0) { it_lru_chain(F, li, it >> 3, it & 7); it = q_pop(F, qidx); PT_MARK2(4); }
    while (it < E1) { const int j = it - E0; it_convc(F, li, j & 7, j >> 3); it = q_pop(F, qidx); PT_MARK2(5); }
    while (it < E2) { it_odd_sample(F, li, it - E1); it = q_pop(F, qidx); PT_MARK2(6); }
}

constexpr int NPHASE = 29;
__global__ void __launch_bounds__(512, 2) mega(Args args) {
    Frame F;
    F.lds = (LAS unsigned char*)lds_raw; F.MISC = (volatile LAS unsigned*)(F.lds + MISC_OFF);
    F.tid = threadIdx.x; F.lane = F.tid & 63; F.wave = __builtin_amdgcn_readfirstlane(F.tid >> 6);
    F.G = gridDim.x; F.wg = blockIdx.x; F.vcu = (F.G % 8 == 0) ? (F.wg % 8) * (F.G / 8) + F.wg / 8 : F.wg;
    F.in = ((const Args*)__builtin_amdgcn_kernarg_segment_ptr())->in; F.out = (GAS float*)args.out; F.ws = (GAS unsigned char*)args.ws; F.ctl = (unsigned*)(args.ws + WS_CTL);
    for (int u = F.tid; u < (LDS_BYTES - MISC_OFF) / 4; u += 512) ((LAS unsigned*)(F.lds + MISC_OFF))[u] = 0u;
    __syncthreads();
    const int lo = args.ph_lo, hi = args.ph_hi;
    const bool multi = (hi - lo) > 1;
    XcdBarrier bar; bar.bar = F.ctl + CW_BAR; bar.x = 0; bar.st = nullptr;
    if (multi) bar = xcd_barrier_post(F.ctl + CW_BAR, F.MISC + 8);
#define IN(k) (lo <= (k) && (k) < hi)
#if PROBE_TS
    const unsigned fillv = __builtin_bit_cast(unsigned, args.out[O_END - 1]);
    const unsigned long long t00 = __builtin_amdgcn_s_memrealtime();
#define SEAM(k) do { if (IN(k) && IN((k) + 1)) xcd_barrier_call(bar.bar, bar.x, bar.st); if (F.tid == 0) F.MISC[128 + (k)] = (unsigned)(__builtin_amdgcn_s_memrealtime() - t00); } while (0)
#else
#define SEAM(k) do { if (IN(k) && IN((k) + 1)) xcd_barrier_call(bar.bar, bar.x, bar.st); } while (0)
#endif
    if (IN(0)) ph_prologue(F);
    SEAM(0);
    for (int layer = 0; layer < 4; ++layer) {
        const int pb = 1 + layer * 7, li = layer >> 1;
        if (IN(pb + 0)) { if (!(layer & 1)) ph_evenin(F, li); else ph_oddin(F, li); }
        SEAM(pb + 0);
        if (IN(pb + 1)) { if (!(layer & 1)) p_even_mixer(F, li, layer); else p_odd_mixer(F, li, layer); }
        SEAM(pb + 1);
        if (IN(pb + 2)) ph_outproj(F, layer);
        SEAM(pb + 2);
        if (IN(pb + 3)) ph_ln1(F, layer);
        SEAM(pb + 3);
        if (IN(pb + 4)) ph_moeup(F, layer);
        SEAM(pb + 4);
        if (IN(pb + 5)) ph_moedown(F, layer);
        SEAM(pb + 5);
        if (IN(pb + 6)) ph_ln2(F, layer, layer == 3 ? 1 : 0);
        SEAM(pb + 6);
    }
#if PROBE_TS
    xcd_barrier_call(bar.bar, bar.x, bar.st);
    if (F.wg == 0) {
        __syncthreads();
        const size_t offs[7] = {O_YP, O_KP, O_VP, O_IP, O_HP, O_HS, O_CS};
        for (int i = 0; i < 7; ++i) {
            const int k = PROBE_BASE + i; if (k >= NPHASE) break;
            unsigned t1 = F.MISC[128 + k], t0 = k > 0 ? F.MISC[128 + k - 1] : 0u;
            if (PROBE_TS == 2) { t0 = 0u; t1 = __hip_atomic_load(F.ctl + 20000 + i, __ATOMIC_RELAXED, __HIP_MEMORY_SCOPE_AGENT); }
            unsigned n = (t1 - t0) / 1600u;
            if (PROBE_TS == 3) n = __hip_atomic_load(F.ctl + 20000 + i, __ATOMIC_RELAXED, __HIP_MEMORY_SCOPE_AGENT) / (256u * 400u); if (n > 60000u) n = 60000u; if (n < 1u) n = 1u;
            for (unsigned j = F.tid; j < n; j += 512) ((unsigned*)args.out)[offs[i] + j] = fillv;
        }
        for (unsigned j = F.tid; j < (unsigned)(NSM * 2 * 512); j += 512) ((unsigned*)args.out)[O_LS + j] = fillv;
    }
#endif
}

extern "C" void kernel_launch(void* const* d_in, const int* in_sizes, int n_in, void* d_out, int out_size, void* d_ws, size_t ws_size, hipStream_t stream) {
    static int grid = 0;
    if (!grid) {
        int dev = 0, cus = 0, per_cu = 0;
        (void)hipGetDevice(&dev); (void)hipDeviceGetAttribute(&cus, hipDeviceAttributeMultiprocessorCount, dev);
        (void)hipFuncSetAttribute((const void*)mega, hipFuncAttributeMaxDynamicSharedMemorySize, LDS_BYTES);
        (void)hipOccupancyMaxActiveBlocksPerMultiprocessor(&per_cu, (const void*)mega, 512, LDS_BYTES);
        if (per_cu < 1) fprintf(stderr, "occupancy query says %d\n", per_cu);
        grid = cus > 0 ? cus : 256;
        if (n_in != 39 || (size_t)out_size != O_END || ws_size < WS_END) fprintf(stderr, "kernel_launch: unexpected sizes n_in %d out %d ws %zu (need %zu)\n", n_in, out_size, ws_size, (size_t)WS_END);
    }
    (void)hipMemsetAsync((char*)d_ws + WS_CTL, 0, CTL_BYTES, stream);
    Args a; memset(&a, 0, sizeof(a));
    for (int i = 0; i < 39; ++i) a.in[i] = (const float*)d_in[i];
    a.out = (float*)d_out; a.ws = (unsigned char*)d_ws;
    a.ph_lo = 0; a.ph_hi = NPHASE;
    hipLaunchKernelGGL(mega, dim3(grid), dim3(512), LDS_BYTES, stream, a);
}
```

```cpp
#include <hip/hip_runtime.h>
#include <cstdio>
#include <cstdint>
#include <cstring>
#ifndef PROBE_TS
#define PROBE_TS 0
#endif
#ifndef PROBE_BASE
#define PROBE_BASE 0
#endif

#define GAS __attribute__((address_space(1)))
#define LAS __attribute__((address_space(3)))
typedef unsigned short bf16;
typedef short bf16x8 __attribute__((ext_vector_type(8)));
typedef float f32x4 __attribute__((ext_vector_type(4)));
typedef float f32x2 __attribute__((ext_vector_type(2)));
typedef float f32x16 __attribute__((ext_vector_type(16)));
typedef unsigned u32x4 __attribute__((ext_vector_type(4)));
typedef unsigned u32x2 __attribute__((ext_vector_type(2)));
typedef unsigned long long u64;
#define DI __device__ __forceinline__

constexpr int D = 1024, NB = 8, SEQ = 2048, NMETA = 16, T = NMETA + SEQ  , NPR = NB * T  , NSM = 128, M = NPR + NSM  ;
constexpr int PAST = 2048, PAGE = 128, NPAGES = 16, NPHYS = 2560;
constexpr int EVEN_IN = 3400, EVEN_PAD = 3584, ODD_IN = 2048;
constexpr int NCLS = 24, CLS_CAP = M, MAXPAN = 96;
constexpr float DN_ALPHA = 1.681792830507429f;
constexpr float LN_EPS = 1e-5f, RMS_EPS = 1e-6f;

constexpr size_t O_YP = 0, O_YS = O_YP + (size_t)NB * SEQ * D, O_KP = O_YS + (size_t)NSM * D, O_VP = O_KP + (size_t)NPR * 256, O_IP = O_VP + (size_t)NPR * 256,
    O_HP = O_IP + (size_t)NPR * 128, O_CP = O_HP + (size_t)NB * 2 * 4 * 128 * 128, O_DP = O_CP + (size_t)NB * 2 * 30 * 512, O_LP = O_DP + (size_t)NB * 2 * 3 * 512,
    O_KS = O_LP + (size_t)NB * 2 * 512, O_VS = O_KS + (size_t)NSM * 256, O_IS = O_VS + (size_t)NSM * 256, O_HS = O_IS + (size_t)NSM * 128,
    O_CS = O_HS + (size_t)NSM * 2 * 4 * 128 * 128, O_DS = O_CS + (size_t)NSM * 2 * 30 * 512, O_LS = O_DS + (size_t)NSM * 2 * 3 * 512, O_END = O_LS + (size_t)NSM * 2 * 512;

constexpr size_t MiB = 1u << 20;
constexpr size_t WS_CTL = 0, CTL_BYTES = 1 * MiB;
constexpr size_t WS_WINE = 2 * MiB;
constexpr size_t WS_WOUTE = WS_WINE + 2ull * EVEN_PAD * 1024 * 2;
constexpr size_t WS_WINO = WS_WOUTE + 2ull * 1024 * 1024 * 2;
constexpr size_t WS_WOUTO = WS_WINO + 2ull * 2048 * 1024 * 2;
constexpr size_t WS_WGU = WS_WOUTO + 2ull * 1024 * 1024 * 2;
constexpr size_t WS_WD = WS_WGU + 64ull * 512 * 1024 * 2;
constexpr size_t WS_X = WS_WD + 64ull * 1024 * 256 * 2;
constexpr size_t WS_XB = WS_X + (size_t)M * D * 4;
constexpr size_t WS_MIX = WS_XB + (size_t)M * D * 2;
constexpr size_t WS_A0 = WS_MIX + (size_t)M * D * 2;
constexpr size_t WS_A1 = WS_A0 + (size_t)M * 512 * 2;
constexpr size_t WS_A2 = WS_A1 + (size_t)M * 512 * 2;
constexpr size_t WS_A3 = WS_A2 + (size_t)M * 512 * 2;
constexpr size_t WS_LF = WS_A3 + (size_t)M * 512 * 2;
constexpr size_t WS_QB = WS_LF + (size_t)M * 512 * 4;
constexpr size_t WS_QI = WS_QB + (size_t)M * 512 * 2;
constexpr size_t WS_KBB = WS_QI + (size_t)M * 512 * 2;
constexpr size_t WS_KIB = WS_KBB + (size_t)M * 128 * 2;
constexpr size_t WS_WI = WS_KIB + (size_t)M * 64 * 2;
constexpr int TP = 2112;
constexpr size_t WS_VT = WS_WI + (size_t)M * 8 * 4;
constexpr size_t WS_ROPE = WS_VT + 8ull * 2 * 64 * TP * 2;
constexpr size_t WS_LB = WS_ROPE + 2ull * T * 32 * 4;
constexpr size_t WS_H = WS_LB + 2ull * 3 * 512 * 4;
constexpr size_t WS_TOK = WS_H + (size_t)MAXPAN * 256 * 512 * 2;
constexpr size_t WS_GATE = WS_TOK + (size_t)NCLS * CLS_CAP * 4;
constexpr size_t WS_SC = (WS_GATE + (size_t)M * 2 * 4 + 4095) / 4096 * 4096;
constexpr size_t WS_END = WS_SC + 256ull * 64 * TP * 4;

constexpr int CW_BAR = 4096;
constexpr int CW_Q = 8192;
constexpr int CW_CNT = 12288;

constexpr int RING_BYTES = 131072, MISC_OFF = RING_BYTES, LDS_BYTES = 147456;

typedef __bf16 bf16v2 __attribute__((ext_vector_type(2)));
DI unsigned pk2(float lo, float hi) { const f32x2 v = {lo, hi}; return __builtin_bit_cast(unsigned, __builtin_convertvector(v, bf16v2)); }
DI unsigned f2bf(float f) { return pk2(f, 0.f) & 0xffffu; }
DI float bf2f(unsigned b) { return __builtin_bit_cast(float, b << 16); }
DI float frcp(float x) { return __builtin_amdgcn_rcpf(x); }
DI float sigmoidf_(float x) { return frcp(1.0f + __expf(-x)); }
DI float siluf_(float x) { return x * frcp(1.0f + __expf(-x)); }
DI float gelu_tanh(float x) { const float u = 0.7978845608028654f * (x + 0.044715f * x * x * x); const float e = __expf(2.0f * u); const float th = 1.0f - 2.0f * frcp(e + 1.0f); return 0.5f * x * (1.0f + th); }
DI float neg_expm1_small(float x) { const float p = 1.0f + x * (0.5f + x * (0.16666667f + x * (0.041666668f + x * (0.0083333338f + x * 0.0013888889f)))); return -x * p; }
DI float dppf(float v, int ctrl_sel) {
    const int x = __builtin_bit_cast(int, v);
    const int r = ctrl_sel == 0 ? __builtin_amdgcn_update_dpp(0, x, 0xB1, 0xf, 0xf, false) : ctrl_sel == 1 ? __builtin_amdgcn_update_dpp(0, x, 0x4E, 0xf, 0xf, false)
                : ctrl_sel == 2 ? __builtin_amdgcn_update_dpp(0, x, 0x141, 0xf, 0xf, false) : __builtin_amdgcn_update_dpp(0, x, 0x140, 0xf, 0xf, false);
    return __builtin_bit_cast(float, r);
}
DI float row_sum16(float v) { v += dppf(v, 0); v += dppf(v, 1); v += dppf(v, 2); v += dppf(v, 3); return v; }
DI float rlf(float v, int l) { return __builtin_bit_cast(float, __builtin_amdgcn_readlane(__builtin_bit_cast(int, v), l)); }
DI float wave_sum(float v) { v = row_sum16(v); return (rlf(v, 0) + rlf(v, 16)) + (rlf(v, 32) + rlf(v, 48)); }

#define XB_TMO      128
#define XB_XCNT(j)  (256  + 64 * (j))
#define XB_XSUB(j)  (1280 + 64 * (j))
#define XB_XGEN(j)  (2304 + 64 * (j))
#define XB_TOP      3328
#define XB_TOPGEN   3392
#define XCD_BAR_WORDS 3456
#define XB_SPIN_CAP (1u << 18)
__device__ __forceinline__ unsigned xb_ld(unsigned* p)              { return __hip_atomic_load(p, __ATOMIC_RELAXED, __HIP_MEMORY_SCOPE_AGENT); }
__device__ __forceinline__ unsigned xb_add(unsigned* p, unsigned v) { return __hip_atomic_fetch_add(p, v, __ATOMIC_RELAXED, __HIP_MEMORY_SCOPE_AGENT); }
__device__ __forceinline__ unsigned xb_xcc_id() { return (unsigned)__builtin_amdgcn_s_getreg((3 << 11) | 20) & 0xFu; }
#define XB_SPIN(cond, bar) do { unsigned _sp = 0; while (cond) { __builtin_amdgcn_s_sleep(1); \
    if ((++_sp & 255u) == 0u) { if (xb_ld(&(bar)[XB_TMO])) break; if (_sp > XB_SPIN_CAP) { atomicAdd(&(bar)[XB_TMO], 1u); break; } } } } while (0)
struct XcdBarrier { unsigned* bar; unsigned x; volatile LAS unsigned* st; };
__device__ __forceinline__ XcdBarrier xcd_barrier_post(unsigned* bar, volatile LAS unsigned* st) {
    XcdBarrier b; b.bar = bar; b.x = xb_xcc_id(); b.st = st;
    if (threadIdx.x == 0) (void)xb_add(&bar[XB_XCNT(b.x)], 1u);
    return b;
}
__device__ __forceinline__ void xcd_barrier_complete(unsigned* bar, unsigned x, unsigned& nloc, unsigned& nx) {
    const unsigned G = gridDim.x * gridDim.y * gridDim.z;
    unsigned sum, cnt, mine, sp = 0u;
    for (;;) {
        sum = 0u; cnt = 0u; mine = 0u;
#pragma unroll
        for (unsigned j = 0; j < 16; ++j) { const unsigned c = xb_ld(&bar[XB_XCNT(j)]); sum += c; cnt += (c > 0u) ? 1u : 0u; mine = (j == x) ? c : mine; }
        if (sum == G) break;
        __builtin_amdgcn_s_sleep(1);
        if ((++sp & 255u) == 0u) { if (xb_ld(&bar[XB_TMO])) break; if (sp > XB_SPIN_CAP) { atomicAdd(&bar[XB_TMO], 1u); break; } }
    }
    nloc = mine > 0u ? mine : 1u; nx = cnt > 0u ? cnt : 1u;
}
__device__ __forceinline__ void xcd_barrier(const XcdBarrier& b) {
    asm volatile("s_waitcnt vmcnt(0)" ::: "memory");
    __syncthreads();
    if (threadIdx.x == 0) {
        unsigned* bar = b.bar;
        __builtin_amdgcn_s_waitcnt(0);
        unsigned nloc = b.st[0], nx = b.st[1];
        if (nloc == 0u) { xcd_barrier_complete(bar, b.x, nloc, nx); b.st[0] = nloc; b.st[1] = nx; }
        const unsigned old = xb_add(&bar[XB_XSUB(b.x)], 1u);
        const unsigned gen = old / nloc;
        if (old + 1u == (gen + 1u) * nloc) {
            __builtin_amdgcn_fence(__ATOMIC_RELEASE, "agent");
            asm volatile("s_waitcnt vmcnt(0)" ::: "memory");
            const unsigned og = xb_add(&bar[XB_TOP], 1u);
            const unsigned tg = og / nx;
            if (og + 1u == (tg + 1u) * nx) xb_add(&bar[XB_TOPGEN], 1u);
            else XB_SPIN(xb_ld(&bar[XB_TOPGEN]) == tg, bar);
            __builtin_amdgcn_fence(__ATOMIC_ACQUIRE, "agent");
            xb_add(&bar[XB_XGEN(b.x)], 1u);
            asm volatile("s_waitcnt vmcnt(0)" ::: "memory");
        } else {
            XB_SPIN(xb_ld(&bar[XB_XGEN(b.x)]) == gen, bar);
            __builtin_amdgcn_fence(__ATOMIC_ACQUIRE, "agent");
            asm volatile("s_waitcnt vmcnt(0)" ::: "memory");
        }
    }
    __syncthreads();
}

__device__ __attribute__((noinline)) void xcd_barrier_call(unsigned* bar, unsigned x, volatile LAS unsigned* st) { XcdBarrier b; b.bar = bar; b.x = x; b.st = st; xcd_barrier(b); }
struct Args { const float* in[39]; float* out; unsigned char* ws; int ph_lo, ph_hi; };
#define GIN(k) ((const GAS float*)F.in[(k)])
#define LAUNDER_F(F) asm volatile("" : "+s"((F).in), "+s"((F).ws), "+s"((F).out), "+s"((F).ctl), "+s"((F).vcu), "+s"((F).G), "+s"((F).wg))
struct Frame {
    LAS unsigned char* lds; volatile LAS unsigned* MISC; unsigned* ctl;
    int tid, lane, wave, G, wg, vcu;
    const float* const* in; GAS float* out; GAS unsigned char* ws;
};
extern __shared__ __attribute__((aligned(16))) unsigned char lds_raw[];
#define NOINL __device__ __attribute__((noinline))
DI int rfl(int v) { return __builtin_amdgcn_readfirstlane(v); }
template <class Pt> DI Pt rfl_ptr(Pt p) { const u64 v = (u64)p; const unsigned lo = (unsigned)rfl((int)(unsigned)v), hi = (unsigned)rfl((int)(unsigned)(v >> 32)); return (Pt)(((u64)hi << 32) | lo); }
DI void frame_fix(Frame& F) {
    F.lds = (LAS unsigned char*)lds_raw; F.MISC = (volatile LAS unsigned*)(F.lds + MISC_OFF);
    F.tid = threadIdx.x; F.lane = F.tid & 63; F.wave = rfl(F.tid >> 6);
    F.G = rfl(F.G); F.wg = rfl(F.wg); F.vcu = rfl(F.vcu);
    F.ctl = rfl_ptr(F.ctl); F.in = rfl_ptr(F.in); F.out = rfl_ptr(F.out); F.ws = rfl_ptr(F.ws);
}

namespace pg8 {
constexpr int BM = 256, BK = 64, HALF = 128, HTB = HALF * BK * 2, STAGE_BYTES = 8 * HTB, NXCD = 8, WGM = 8;
__host__ __device__ __forceinline__ int lds_byte(int r, int c) { const int st = (r >> 4) * 2 + (c >> 5), rr = r & 15, cc = c & 31, ob = rr * 64 + cc * 2; return st * 1024 + (ob ^ (((ob >> 9) & 1) << 5)); }
__host__ __device__ __forceinline__ void stage_rc(int b, int& R, int& C) { const int st = b / 1024, sb = b % 1024, swz = sb ^ (((sb >> 9) & 1) << 5); R = (st >> 1) * 16 + swz / 64; C = (st & 1) * 32 + (swz % 64) / 2; }
struct Unit { int pm, pn; const GAS char* B0; const GAS char* B1; int aux; };
template <int nM, int nN> DI bool static_next(int G, int c, int i, int& pm, int& pn) {
    const int L = i * G + c; if (L >= nM * nN) return false;
    pm = L / nN; pn = L % nN; return true;
}
template <class P>
__device__ __forceinline__ void gemm_phase(LAS unsigned char* lds, const P& pb) {
    int tid_ = threadIdx.x; asm volatile("" : "+v"(tid_));
    const int tid = tid_, wid = __builtin_amdgcn_readfirstlane(tid >> 6), lane = tid & 63, wr = wid >> 2, wc = wid & 3, fr = lane & 15, fq = lane >> 4;
    constexpr int K = P::K, nt = K / BK;
    int sR[2], sC[2]; unsigned voffA[2], voffB[2];
#pragma unroll
    for (int i = 0; i < 2; ++i) { stage_rc(tid * 16 + i * 8192, sR[i], sC[i]); voffB[i] = (unsigned)(sR[i] * P::ldb + sC[i]) * 2u; voffA[i] = (unsigned)(sR[i] * P::lda + sC[i]) * 2u; }
    constexpr size_t kstep = (size_t)(BK * 2);
    constexpr size_t hstepB = (size_t)HALF * P::ldb * 2, hstepA = (size_t)HALF * P::lda * 2, tstepA = 2 * hstepA;
    const unsigned ldsw = (unsigned)wid * 1024u;
    const int aoff = lds_byte(wr * 64 + fr, fq * 8), boff = lds_byte(wc * 32 + fr, fq * 8);
#define PG8_SA(b, h) (((b) * 2 + (h)) * HTB)
#define PG8_SB(b, h) ((4 + (b) * 2 + (h)) * HTB)
#define PG8_STAGE(bufoff, gbase, voff) do { _Pragma("unroll") for (int _i = 0; _i < 2; ++_i) \
        __builtin_amdgcn_global_load_lds((const GAS unsigned*)((const GAS char*)(gbase) + (voff)[_i]), (LAS unsigned*)(lds + (bufoff) + ldsw + _i * 8192), 16, 0, 0); } while (0)
#define PG8_STAGE_A(bufoff, gbase, h, G_) do { if constexpr (P::GATHER) { PG8_STAGE(bufoff, gbase, (G_)[h]); } else { PG8_STAGE(bufoff, (gbase) + (h) * hstepA, voffA); } } while (0)
#define PG8_LDA(dst, b, h) do { _Pragma("unroll") for (int m = 0; m < 4; ++m) _Pragma("unroll") for (int k = 0; k < 2; ++k) dst[m][k] = *(const LAS bf16x8*)(lds + PG8_SA(b, h) + aoff + m * 2048 + k * 1024); } while (0)
#define PG8_LDB(dst, b, h) do { _Pragma("unroll") for (int n = 0; n < 2; ++n) _Pragma("unroll") for (int k = 0; k < 2; ++k) dst[n][k] = *(const LAS bf16x8*)(lds + PG8_SB(b, h) + boff + n * 2048 + k * 1024); } while (0)
#define PG8_MMA(ai, bj, At, Bt) do { __builtin_amdgcn_s_setprio(1); _Pragma("unroll") for (int m = 0; m < 4; ++m) _Pragma("unroll") for (int n = 0; n < 2; ++n) _Pragma("unroll") for (int k = 0; k < 2; ++k) \
        acc[ai][bj][m][n] = __builtin_amdgcn_mfma_f32_16x16x32_bf16(Bt[n][k], At[m][k], acc[ai][bj][m][n], 0, 0, 0); __builtin_amdgcn_s_setprio(0); } while (0)
#define PG8_WAIT_V(n) asm volatile("s_waitcnt vmcnt(" #n ")" ::: "memory")
#define PG8_WAIT_L(n) asm volatile("s_waitcnt lgkmcnt(" #n ")" ::: "memory")
#define PG8_BAR __builtin_amdgcn_s_barrier()
#define PG8_SCHED __builtin_amdgcn_sched_barrier(0)
    Unit cur, nxt; int ui = 0;
    if (!pb.next(0, cur)) return;
    f32x4 acc[2][2][4][2];
#pragma unroll
    for (int a = 0; a < 2; ++a)
#pragma unroll
        for (int b = 0; b < 2; ++b)
#pragma unroll
            for (int m = 0; m < 4; ++m)
#pragma unroll
                for (int n = 0; n < 2; ++n) acc[a][b][m][n] = (f32x4){0.f, 0.f, 0.f, 0.f};
    bf16x8 At[4][2], B0[2][2], B1[2][2];
    unsigned gA[2][2] = {{0u, 0u}, {0u, 0u}};
    if constexpr (P::GATHER) {
#pragma unroll
        for (int h = 0; h < 2; ++h)
#pragma unroll
            for (int i = 0; i < 2; ++i) gA[h][i] = pb.a_row(cur, 128 * h + sR[i]) + (unsigned)sC[i] * 2u;
    }
    const GAS char* cA = (const GAS char*)pb.A + (P::GATHER ? (size_t)0 : (size_t)cur.pm * tstepA);
    PG8_STAGE(PG8_SB(0, 0), cur.B0, voffB); PG8_STAGE_A(PG8_SA(0, 0), cA, 0, gA); PG8_STAGE(PG8_SB(0, 1), cur.B0 + hstepB, voffB); PG8_STAGE_A(PG8_SA(0, 1), cA, 1, gA);
    if (wr == 1) PG8_BAR;
    PG8_WAIT_V(4); PG8_BAR;
    PG8_STAGE(PG8_SB(1, 0), cur.B0 + kstep, voffB); PG8_STAGE_A(PG8_SA(1, 0), cA + kstep, 0, gA); PG8_STAGE(PG8_SB(1, 1), cur.B0 + hstepB + kstep, voffB);
    PG8_WAIT_V(6); PG8_BAR;
    for (;;) {
        const bool has_next = pb.next(ui + 1, nxt);
        if (!has_next) nxt = cur;
        const GAS char* nA = (const GAS char*)pb.A + (P::GATHER ? (size_t)0 : (size_t)nxt.pm * tstepA);
#pragma unroll 1
        for (int t = 0; t < nt; t += 2) {
            const bool last = (t == nt - 2);
            const GAS char* a1 = cA + (size_t)(t + 1) * kstep;
            const GAS char* a2 = last ? nA : cA + (size_t)(t + 2) * kstep;
            const GAS char* a3 = a2 + kstep;
            const GAS char* b2;
            if constexpr (P::SPLITB) b2 = last ? nxt.B0 : ((t + 2 < pb.KSPLIT) ? cur.B0 : cur.B1) + (size_t)(t + 2) * kstep;
            else b2 = last ? nxt.B0 : cur.B0 + (size_t)(t + 2) * kstep;
            const GAS char* b3 = b2 + kstep;
            PG8_LDB(B0, 0, 0); PG8_SCHED; PG8_LDA(At, 0, 0); PG8_STAGE_A(PG8_SA(1, 1), a1, 1, gA);
            PG8_WAIT_L(8); PG8_BAR; PG8_WAIT_L(0); PG8_MMA(0, 0, At, B0); PG8_BAR; PG8_SCHED;
            if constexpr (P::GATHER) { if (last) {
#pragma unroll
                for (int h = 0; h < 2; ++h)
#pragma unroll
                    for (int i = 0; i < 2; ++i) gA[h][i] = pb.a_row(nxt, 128 * h + sR[i]) + (unsigned)sC[i] * 2u; } }
            PG8_LDB(B1, 0, 1); PG8_STAGE(PG8_SB(0, 0), b2, voffB);
            PG8_BAR; PG8_WAIT_L(0); PG8_MMA(0, 1, At, B1); PG8_BAR;
            PG8_LDA(At, 0, 1); PG8_STAGE_A(PG8_SA(0, 0), a2, 0, gA);
            PG8_BAR; PG8_WAIT_L(0); PG8_MMA(1, 0, At, B0); PG8_BAR; PG8_SCHED;
            PG8_STAGE(PG8_SB(0, 1), b2 + hstepB, voffB);
            PG8_WAIT_V(6); PG8_BAR; PG8_MMA(1, 1, At, B1); PG8_BAR;
            PG8_LDB(B0, 1, 0); PG8_SCHED; PG8_LDA(At, 1, 0); PG8_STAGE_A(PG8_SA(0, 1), a2, 1, gA);
            PG8_WAIT_L(8); PG8_BAR; PG8_WAIT_L(0); PG8_MMA(0, 0, At, B0); PG8_BAR; PG8_SCHED;
            PG8_LDB(B1, 1, 1); PG8_STAGE(PG8_SB(1, 0), b3, voffB);
            PG8_BAR; PG8_WAIT_L(0); PG8_MMA(0, 1, At, B1); PG8_BAR;
            PG8_LDA(At, 1, 1); PG8_STAGE_A(PG8_SA(1, 0), a3, 0, gA);
            PG8_BAR; PG8_WAIT_L(0); PG8_MMA(1, 0, At, B0); PG8_BAR; PG8_SCHED;
            PG8_STAGE(PG8_SB(1, 1), b3 + hstepB, voffB);
            PG8_WAIT_V(6); PG8_BAR; PG8_MMA(1, 1, At, B1); PG8_BAR;
        }
        pb.epi(acc, cur, wr, wc, fr, fq);
        if (!has_next) break;
#pragma unroll
        for (int a = 0; a < 2; ++a)
#pragma unroll
            for (int b = 0; b < 2; ++b)
#pragma unroll
                for (int m = 0; m < 4; ++m)
#pragma unroll
                    for (int n = 0; n < 2; ++n) acc[a][b][m][n] = (f32x4){0.f, 0.f, 0.f, 0.f};
        cur = nxt; cA = nA; ++ui;
    }
    PG8_WAIT_V(0);
    if (wr == 0) PG8_BAR;
    PG8_BAR;
#undef PG8_SA
#undef PG8_SB
#undef PG8_STAGE
#undef PG8_STAGE_A
#undef PG8_LDA
#undef PG8_LDB
#undef PG8_MMA
#undef PG8_WAIT_V
#undef PG8_WAIT_L
#undef PG8_BAR
#undef PG8_SCHED
}
}
typedef f32x4 AccT[2][2][4][2];

DI int swap45(int s) { return (s & ~48) | ((s & 16) << 1) | ((s & 32) >> 1); }
DI int map_even(int s) {
    if (s < 2048) return s;
    if (s < 2688) { const int r = s - 2048; return 2048 + (r & ~63) + swap45(r & 63); }
    if (s < 2816) return s;
    if (s < 3392) { const int r = s - 2816; return 2816 + (r & ~63) + swap45(r & 63); }
    if (s < EVEN_IN) return s;
    return -1;
}
DI int map_odd(int s) {
    if (s >= 1024) return s;
    const int u = s >> 8, r = s & 255; return r < 128 ? 128 * u + r : 512 + 128 * u + (r - 128);
}
DI void transpose_item(const GAS float* W, int ldn, int K, GAS bf16* WT, int k0, int n0, int mode, int coloff, LAS float* scr, int lane) {
    int col = n0 + (lane & 31);
    if (mode == 1) col = map_even(col); else if (mode == 2) col = map_odd(col); else col += coloff;
    const bool okc = col >= 0; const GAS float* wp = W + (size_t)(k0 + (lane >> 5)) * ldn + (okc ? col : 0);
    float tv[32];
#pragma unroll
    for (int i = 0; i < 32; ++i) tv[i] = wp[(size_t)(2 * i) * ldn];
#pragma unroll
    for (int i = 0; i < 32; ++i) { const int kk = 2 * i + (lane >> 5); scr[kk * 33 + (lane & 31)] = okc ? tv[i] : 0.f; }
    asm volatile("s_waitcnt lgkmcnt(0)" ::: "memory");
    const int c = lane & 7;
#pragma unroll
    for (int j = 0; j < 4; ++j) { const int n = (lane >> 3) + 8 * j; const LAS float* s = scr + (8 * c) * 33 + n;
        u32x4 o; o.x = pk2(s[0 * 33], s[1 * 33]); o.y = pk2(s[2 * 33], s[3 * 33]); o.z = pk2(s[4 * 33], s[5 * 33]); o.w = pk2(s[6 * 33], s[7 * 33]);
        *(GAS u32x4*)(WT + (size_t)(n0 + n) * K + k0 + 8 * c) = o; }
    asm volatile("s_waitcnt lgkmcnt(0)" ::: "memory");
}
DI void p_prologue(Frame& F) {
    LAUNDER_F(F);
#if PROBE_TS == 4
    const unsigned long long _tp0 = __builtin_amdgcn_s_memrealtime();
#endif
    LAS float* scr = (LAS float*)(F.lds + F.wave * 16384);
    const int gw = F.wg * 8 + F.wave, NGW = F.G * 8, lane = F.lane;
    constexpr int I_WINE = 2 * 16 * (EVEN_PAD / 32), I_WOUT = 2 * 16 * 32, I_WINO = 2 * 16 * 64, I_WGU = 64 * 16 * 16, I_WD = 64 * 4 * 32;
    constexpr int NIT = I_WINE + I_WOUT + I_WINO + I_WOUT + I_WGU + I_WD;
    for (int it = gw; it < NIT; it += NGW) {
        asm volatile("" ::: "memory");
        int r = it; asm volatile("" : "+v"(r));
        const GAS float* W; GAS bf16* WT; int ldn, K, k0, n0, mode = 0, coloff = 0;
        if (r < I_WINE) { const int li = r / (I_WINE / 2); r %= (I_WINE / 2); const int kb = r / (EVEN_PAD / 32), nb = r % (EVEN_PAD / 32);
            W = GIN(11) + (size_t)li * 1024 * EVEN_IN; ldn = EVEN_IN; K = 1024; WT = (GAS bf16*)(F.ws + WS_WINE) + (size_t)li * EVEN_PAD * 1024; k0 = 64 * kb; n0 = 32 * nb; mode = 1; }
        else if ((r -= I_WINE) < I_WOUT) { const int li = r / (I_WOUT / 2); r %= (I_WOUT / 2); const int kb = r / 32, nb = r % 32;
            W = GIN(12) + (size_t)li * 1024 * 1024; ldn = 1024; K = 1024; WT = (GAS bf16*)(F.ws + WS_WOUTE) + (size_t)li * 1024 * 1024; k0 = 64 * kb; n0 = 32 * nb; }
        else if ((r -= I_WOUT) < I_WINO) { const int li = r / (I_WINO / 2); r %= (I_WINO / 2); const int kb = r / 64, nb = r % 64;
            W = GIN(15) + (size_t)li * 1024 * 2048; ldn = 2048; K = 1024; WT = (GAS bf16*)(F.ws + WS_WINO) + (size_t)li * 2048 * 1024; k0 = 64 * kb; n0 = 32 * nb; mode = 2; }
        else if ((r -= I_WINO) < I_WOUT) { const int li = r / (I_WOUT / 2); r %= (I_WOUT / 2); const int kb = r / 32, nb = r % 32;
            W = GIN(16) + (size_t)li * 1024 * 1024; ldn = 1024; K = 1024; WT = (GAS bf16*)(F.ws + WS_WOUTO) + (size_t)li * 1024 * 1024; k0 = 64 * kb; n0 = 32 * nb; }
        else if ((r -= I_WOUT) < I_WGU) { const int le = r / 256; r %= 256; const int kb = r / 16, nb = r % 16;
            const int s0 = 32 * nb, jj = s0 >> 8, rr = s0 & 255; const bool up = rr >= 128; const int c0 = 128 * jj + (up ? rr - 128 : rr);
            W = (up ? GIN(37) : GIN(36)) + (size_t)le * 1024 * 256; ldn = 256; K = 1024; WT = (GAS bf16*)(F.ws + WS_WGU) + (size_t)le * 512 * 1024; k0 = 64 * kb; n0 = s0; coloff = c0 - s0; }
        else { r -= I_WGU; const int le = r / 128; r %= 128; const int kb = r / 32, nb = r % 32;
            W = GIN(38) + (size_t)le * 256 * 1024; ldn = 1024; K = 256; WT = (GAS bf16*)(F.ws + WS_WD) + (size_t)le * 1024 * 256; k0 = 64 * kb; n0 = 32 * nb; }
        transpose_item(W, ldn, K, WT, k0, n0, mode, coloff, scr, lane);
    }
#if PROBE_TS == 4
    if (F.tid == 0) atomicMax(F.ctl + 20000, (unsigned)(__builtin_amdgcn_s_memrealtime() - _tp0));
#endif
    GAS float* X = (GAS float*)(F.ws + WS_X); GAS bf16* XB = (GAS bf16*)(F.ws + WS_XB);
    for (int m = gw; m < M; m += NGW) {
        const GAS float* src;
        if (m < NPR) { const int b = m / T, t = m % T; src = t < NMETA ? GIN(10) + (size_t)t * D : GIN(0) + ((size_t)b * SEQ + (t - NMETA)) * D; }
        else src = GIN(1) + (size_t)(m - NPR) * D;
#pragma unroll
        for (int j = 0; j < 4; ++j) { const f32x4 v = *((const GAS f32x4*)src + lane + 64 * j); *((GAS f32x4*)(X + (size_t)m * D) + lane + 64 * j) = v;
            u32x2 o; o.x = pk2(v.x, v.y); o.y = pk2(v.z, v.w); *((GAS u32x2*)(XB + (size_t)m * D) + lane + 64 * j) = o; }
    }
#if PROBE_TS == 4
    if (F.tid == 0) atomicMax(F.ctl + 20001, (unsigned)(__builtin_amdgcn_s_memrealtime() - _tp0));
#endif
    GAS float* RC = (GAS float*)(F.ws + WS_ROPE); GAS float* RS = RC + T * 32;
    for (int e = F.wg * 512 + F.tid; e < T * 32; e += F.G * 512) {
        const int pos = e >> 5, i = e & 31;
        const float inv = exp2f(-(float)i * (13.287712379549449f / 32.0f));
        const double ang = (double)((float)pos * inv);
        const double kq = rint(ang * 0.15915494309189535);
        const double rr = fma(-kq, 6.283185307179586, ang) - kq * 2.4492935982947064e-16;
        const float rf = (float)rr;
        RC[e] = cosf(rf); RS[e] = sinf(rf);
    }
#if PROBE_TS == 4
    if (F.tid == 0) atomicMax(F.ctl + 20002, (unsigned)(__builtin_amdgcn_s_memrealtime() - _tp0));
#endif
    GAS float* LB = (GAS float*)(F.ws + WS_LB);
    for (int e = F.wg * 512 + F.tid; e < 2 * 512; e += F.G * 512) {
        const int li = e >> 9, c = e & 511;
        const float l0 = GIN(13)[c], l1 = GIN(13)[512 + c];
        const float lb = li == 0 ? 0.f : 1.0f / (1.0f + expf(l0 - l1));
        LB[(li * 3 + 0) * 512 + c] = logf(fmaxf(lb, 1e-30f)); LB[(li * 3 + 1) * 512 + c] = log1pf(-lb); LB[(li * 3 + 2) * 512 + c] = 1.0f - lb;
    }
}

template <bool ROPE> struct EvenIn {
    static constexpr bool GATHER = false, SPLITB = false; static constexpr int KSPLIT = 0, K = 1024, lda = 1024, ldb = 1024;
    const GAS bf16* A; const GAS bf16* Bt; int G, c, li; GAS unsigned char* ws; GAS float* out;
    DI bool next(int i, pg8::Unit& u) const { if (!pg8::static_next<M / 256, 7>(G, c, i, u.pm, u.pn)) return false;
        if (ROPE) u.pn += 7;
        u.B0 = (const GAS char*)(Bt + (size_t)u.pn * 256 * 1024); u.B1 = u.B0; u.aux = 0; return true; }
    DI void epi(const AccT& acc, const pg8::Unit& u, int wr, int wc, int fr, int fq) const {
        asm volatile("" : "+v"(fr), "+v"(fq));
        const int pn = u.pn;
        const int rbase = u.pm * 256 + wr * 64 + fr;
        if constexpr (!ROPE) {
            GAS bf16* dst = (GAS bf16*)(ws + (pn < 2 ? WS_A0 : pn < 4 ? WS_A1 : pn < 6 ? WS_A2 : WS_A3));
            GAS float* LF = (GAS float*)(ws + WS_LF); const GAS float* LB = (const GAS float*)(ws + WS_LB) + li * 3 * 512;
#pragma unroll
            for (int bj = 0; bj < 2; ++bj)
#pragma unroll
                for (int n = 0; n < 2; ++n) {
                    const int col = (pn & 1) * 256 + bj * 128 + wc * 32 + n * 16 + 4 * fq;
                    f32x4 la = {0, 0, 0, 0}, lb1 = {0, 0, 0, 0}, lc = {0, 0, 0, 0};
                    if (pn == 2 || pn == 3) { la = *(const GAS f32x4*)(LB + col); lb1 = *(const GAS f32x4*)(LB + 512 + col); lc = *(const GAS f32x4*)(LB + 1024 + col); }
#pragma unroll
                    for (int ai = 0; ai < 2; ++ai)
#pragma unroll
                        for (int m = 0; m < 4; ++m) {
                            const int row = rbase + ai * 128 + m * 16; const f32x4 v = acc[ai][bj][m][n]; float o[4];
                            if (pn < 2 || pn >= 6) {
#pragma unroll
                                for (int j = 0; j < 4; ++j) o[j] = siluf_(v[j]);
                            } else if (pn < 4) {
                                f32x4 lf;
#pragma unroll
                                for (int j = 0; j < 4; ++j) { const float z = v[j]; const float e = __expf(-fabsf(z)); const float l1p = __logf(1.0f + e);
                                    const float ls = fminf(z, 0.f) - l1p;
                                    const float bb = lb1[j] + ls, aa = la[j]; const float mx = fmaxf(aa, bb);
                                    lf[j] = mx + __logf(1.0f + __expf(-fabsf(aa - bb)));
                                    const float sg = (z >= 0.f ? e : 1.0f) * frcp(1.0f + e);
                                    o[j] = lc[j] * sg; }
                                *(GAS f32x4*)(LF + (unsigned)row * 512 + col) = lf;
                            } else {
#pragma unroll
                                for (int j = 0; j < 4; ++j) o[j] = v[j];
                            }
                            u32x2 w; w.x = pk2(o[0], o[1]); w.y = pk2(o[2], o[3]); *(GAS u32x2*)(dst + (unsigned)row * 512 + col) = w;
                        }
                    asm volatile("" ::: "memory");
                }
        } else if (pn == 7) {
            GAS bf16* dst = (GAS bf16*)(ws + WS_A3);
#pragma unroll
            for (int bj = 0; bj < 2; ++bj)
#pragma unroll
                for (int n = 0; n < 2; ++n) { const int col = 256 + bj * 128 + wc * 32 + n * 16 + 4 * fq;
#pragma unroll
                    for (int ai = 0; ai < 2; ++ai)
#pragma unroll
                        for (int m = 0; m < 4; ++m) { const int row = rbase + ai * 128 + m * 16; const f32x4 v = acc[ai][bj][m][n];
                            u32x2 w; w.x = pk2(siluf_(v[0]), siluf_(v[1])); w.y = pk2(siluf_(v[2]), siluf_(v[3])); *(GAS u32x2*)(dst + (unsigned)row * 512 + col) = w; } }
        } else {
        const GAS float* RC = (const GAS float*)(ws + WS_ROPE); const GAS float* RS = RC + T * 32;
        const int i0 = 16 * (wc & 1) + 4 * fq;
#pragma unroll
        for (int ai = 0; ai < 2; ++ai)
#pragma unroll
            for (int m = 0; m < 4; ++m) {
                const int row = rbase + ai * 128 + m * 16;
                const int pos = row < NPR ? row % T : PAST;
                const f32x4 cs = *(const GAS f32x4*)(RC + pos * 32 + i0), sn = *(const GAS f32x4*)(RS + pos * 32 + i0);
#pragma unroll
                for (int bj = 0; bj < 2; ++bj) {
                    const f32x4 x1 = acc[ai][bj][m][0], x2 = acc[ai][bj][m][1];
                    const f32x4 r1 = x1 * cs - x2 * sn, r2 = x2 * cs + x1 * sn;
                    const int hd = bj * 2 + (wc >> 1);
                    if (pn == 8 || pn == 9) {
                        GAS bf16* Q = (GAS bf16*)(ws + WS_QB) + (unsigned)row * 512 + (pn - 8) * 256 + hd * 64 + i0;
                        u32x2 w; w.x = pk2(r1[0] * 0.125f, r1[1] * 0.125f); w.y = pk2(r1[2] * 0.125f, r1[3] * 0.125f); *(GAS u32x2*)Q = w;
                        w.x = pk2(r2[0] * 0.125f, r2[1] * 0.125f); w.y = pk2(r2[2] * 0.125f, r2[3] * 0.125f); *(GAS u32x2*)(Q + 32) = w;
                    } else if (pn == 11 || pn == 12) {
                        GAS bf16* Q = (GAS bf16*)(ws + WS_QI) + (unsigned)row * 512 + (pn - 11) * 256 + hd * 64 + i0;
                        u32x2 w; w.x = pk2(r1[0], r1[1]); w.y = pk2(r1[2], r1[3]); *(GAS u32x2*)Q = w;
                        w.x = pk2(r2[0], r2[1]); w.y = pk2(r2[2], r2[3]); *(GAS u32x2*)(Q + 32) = w;
                    } else if (pn == 10) {
                        if (bj == 0) {
                            const int g = wc >> 1;
                            GAS float* KO = row < NPR ? out + O_KP + ((unsigned)row * 2 + li) * 128 + g * 64 + i0 : out + O_KS + ((unsigned)(row - NPR) * 2 + li) * 128 + g * 64 + i0;
                            *(GAS f32x4*)KO = r1; *(GAS f32x4*)(KO + 32) = r2;
                            GAS bf16* KB = (GAS bf16*)(ws + WS_KBB) + (unsigned)row * 128 + g * 64 + i0;
                            u32x2 w; w.x = pk2(r1[0], r1[1]); w.y = pk2(r1[2], r1[3]); *(GAS u32x2*)KB = w;
                            w.x = pk2(r2[0], r2[1]); w.y = pk2(r2[2], r2[3]); *(GAS u32x2*)(KB + 32) = w;
                        } else {
#pragma unroll
                            for (int n = 0; n < 2; ++n) {
                                const int sl = wc * 32 + n * 16 + 4 * fq; const f32x4 v = n ? x2 : x1;
                                GAS float* VO = row < NPR ? out + O_VP + ((unsigned)row * 2 + li) * 128 + sl : out + O_VS + ((unsigned)(row - NPR) * 2 + li) * 128 + sl;
                                *(GAS f32x4*)VO = v;
                                if (row < NPR) { const int b = row / T, t = row % T; GAS bf16* VT = (GAS bf16*)(ws + WS_VT) + ((unsigned)(b * 2 + (sl >> 6)) * 64 + (sl & 63)) * TP + t;
#pragma unroll
                                    for (int j = 0; j < 4; ++j) VT[(unsigned)j * TP] = (bf16)f2bf(v[j]); }
                            }
                        }
                    } else {
                        if (bj == 0 && wc < 2) {
                            GAS float* KO = row < NPR ? out + O_IP + ((unsigned)row * 2 + li) * 64 + i0 : out + O_IS + ((unsigned)(row - NPR) * 2 + li) * 64 + i0;
                            *(GAS f32x4*)KO = r1; *(GAS f32x4*)(KO + 32) = r2;
                            GAS bf16* KB = (GAS bf16*)(ws + WS_KIB) + (unsigned)row * 64 + i0;
                            u32x2 w; w.x = pk2(r1[0], r1[1]); w.y = pk2(r1[2], r1[3]); *(GAS u32x2*)KB = w;
                            w.x = pk2(r2[0], r2[1]); w.y = pk2(r2[2], r2[3]); *(GAS u32x2*)(KB + 32) = w;
                        } else if (bj == 0 && wc == 2 && fq < 2) {
                            const float sc = 0.125f * 0.35355339059327373f;
                            *(GAS f32x4*)((GAS float*)(ws + WS_WI) + (unsigned)row * 8 + 4 * fq) = x1 * sc;
                        }
                    }
                }
                if (m & 1) asm volatile("" ::: "memory");
            }
        }
    }
};

DI int q_pop(Frame& F, int qidx) {
    __syncthreads();
    if (F.tid == 0) F.MISC[0] = __hip_atomic_fetch_add(F.ctl + CW_Q + 64 * qidx, 1u, __ATOMIC_RELAXED, __HIP_MEMORY_SCOPE_AGENT);
    __syncthreads();
    return (int)F.MISC[0];
}
#define MFMA16(a, b, c) __builtin_amdgcn_mfma_f32_16x16x32_bf16((a), (b), (c), 0, 0, 0)
#define MFMA32(a, b, c) __builtin_amdgcn_mfma_f32_32x32x16_bf16((a), (b), (c), 0, 0, 0)
DI bf16x8 pack8(const float (&v)[8]) { u32x4 p; p.x = pk2(v[0], v[1]); p.y = pk2(v[2], v[3]); p.z = pk2(v[4], v[5]); p.w = pk2(v[6], v[7]); return __builtin_bit_cast(bf16x8, p); }

#define LDS_BAR() do { asm volatile("s_waitcnt lgkmcnt(0)" ::: "memory"); __builtin_amdgcn_s_barrier(); asm volatile("" ::: "memory"); } while (0)
DI void hgrn_prompt_item(Frame& F, int li, int b, int h) {
    constexpr int P1 = 136, P2 = 40;
    LAS bf16* QS = (LAS bf16*)(F.lds + 0);
    LAS bf16* KH = (LAS bf16*)(F.lds + 8704);
    LAS bf16* KDT = (LAS bf16*)(F.lds + 17408);
    LAS bf16* VTL = (LAS bf16*)(F.lds + 27648);
    LAS bf16* PM = (LAS bf16*)(F.lds + 37888);
    LAS bf16* ST = (LAS bf16*)(F.lds + 40448);
    LAS float* OF = (LAS float*)(F.lds + 75264);
    LAS float* BSEG = (LAS float*)(F.lds + 92160);
    LAS float* DF = (LAS float*)(F.lds + 94208);
    int tid_ = F.tid; asm volatile("" : "+v"(tid_)); LAUNDER_F(F);
    const int tid = tid_, lane = tid & 63, w = __builtin_amdgcn_readfirstlane(tid >> 6), k = (w & 1) * 64 + lane, seg = w >> 1  , l15 = lane & 15, l4 = lane >> 4;
    const GAS bf16* QA = (const GAS bf16*)(F.ws + WS_A0); const GAS bf16* KA = (const GAS bf16*)(F.ws + WS_A1); const GAS bf16* VA = (const GAS bf16*)(F.ws + WS_A2); const GAS bf16* GA = (const GAS bf16*)(F.ws + WS_A3);
    const GAS float* LF = (const GAS float*)(F.ws + WS_LF); GAS bf16* MIX = (GAS bf16*)(F.ws + WS_MIX);
    const int t4 = tid >> 4, part = tid & 15;
    float ng[8];
#pragma unroll
    for (int j = 0; j < 8; ++j) ng[j] = GIN(14)[li * 128 + 8 * part + j];
    f32x4 S[8];
#pragma unroll
    for (int i = 0; i < 8; ++i) S[i] = (f32x4){0.f, 0.f, 0.f, 0.f};
    float clf[8], cq[8], ck[8], cv[8], nlf[8]; unsigned nq[8], nk[8], nv[8]; u32x4 gcur, gnext;
    const unsigned colb = (unsigned)(h * 128 + k);
    const unsigned gcol = (unsigned)(h * 128 + 8 * part);
#define HG_LOAD(c) do { _Pragma("unroll") for (int i = 0; i < 8; ++i) { const int t = 32 * (c) + 8 * seg + i; const unsigned o = (unsigned)(b * T + (t < T ? t : T - 1)) * 512u + colb; \
        nlf[i] = LF[o]; nq[i] = QA[o]; nk[i] = KA[o]; nv[i] = VA[o]; } \
        { const int t = 32 * (c) + t4; gnext = *(const GAS u32x4*)(GA + (unsigned)(b * T + (t < T ? t : T - 1)) * 512u + gcol); } } while (0)
#define HG_TAKE(c) do { _Pragma("unroll") for (int i = 0; i < 8; ++i) { const bool ok = 32 * (c) + 8 * seg + i < T; clf[i] = ok ? nlf[i] : 0.f; cq[i] = ok ? bf2f(nq[i]) : 0.f; ck[i] = ok ? bf2f(nk[i]) : 0.f; cv[i] = ok ? bf2f(nv[i]) : 0.f; } gcur = gnext; } while (0)
    __syncthreads();
    HG_LOAD(0);
    constexpr int NCH = (T + 31) / 32;
    for (int c = 0; c < NCH; ++c) {
        HG_TAKE(c);
        if (c + 1 < NCH) HG_LOAD(c + 1);
        float cs[8]; float run = 0.f;
#pragma unroll
        for (int i = 0; i < 8; ++i) { run += clf[i]; cs[i] = run; }
        BSEG[seg * 128 + k] = run;
        LDS_BAR();
        float pre = 0.f, tot = 0.f;
#pragma unroll
        for (int sgi = 0; sgi < 4; ++sgi) { const float v = BSEG[sgi * 128 + k]; tot += v; if (sgi < seg) pre += v; }
        float kd[8];
#pragma unroll
        for (int i = 0; i < 8; ++i) { const float bb = pre + cs[i]; const int t = 8 * seg + i;
            QS[t * P1 + k] = (bf16)f2bf(cq[i] * __expf(bb)); KH[t * P1 + k] = (bf16)f2bf(ck[i] * __expf(-bb)); kd[i] = ck[i] * __expf(tot - bb); }
        *(LAS bf16x8*)(KDT + k * P2 + 8 * seg) = pack8(kd);
        *(LAS bf16x8*)(VTL + k * P2 + 8 * seg) = pack8(cv);
        if (seg == 0) DF[k] = __expf(tot);
#pragma unroll
        for (int i = 0; i < 8; ++i) { u32x2 o; o.x = pk2(S[i][0], S[i][1]); o.y = pk2(S[i][2], S[i][3]); *(LAS u32x2*)(ST + (16 * w + l15) * P1 + 16 * i + 4 * l4) = o; }
        LDS_BAR();
        if (w < 4) {
            const int ti = w >> 1, tj = w & 1; f32x4 pacc = {0.f, 0.f, 0.f, 0.f};
            if (tj <= ti) {
#pragma unroll
                for (int ks = 0; ks < 4; ++ks) { const bf16x8 a = *(const LAS bf16x8*)(QS + (16 * ti + l15) * P1 + 32 * ks + 8 * l4); const bf16x8 bb = *(const LAS bf16x8*)(KH + (16 * tj + l15) * P1 + 32 * ks + 8 * l4); pacc = MFMA16(a, bb, pacc); }
            }
#pragma unroll
            for (int r = 0; r < 4; ++r) { const int t = 16 * ti + 4 * l4 + r, sidx = 16 * tj + l15; PM[t * P2 + sidx] = (bf16)f2bf(sidx <= t ? pacc[r] : 0.f); }
        }
        LDS_BAR();
        {
            const bf16x8 bv = *(const LAS bf16x8*)(VTL + (16 * w + l15) * P2 + 8 * l4);
#pragma unroll
            for (int ti = 0; ti < 2; ++ti) {
                f32x4 o = {0.f, 0.f, 0.f, 0.f};
                o = MFMA16(*(const LAS bf16x8*)(PM + (16 * ti + l15) * P2 + 8 * l4), bv, o);
#pragma unroll
                for (int ks = 0; ks < 4; ++ks) o = MFMA16(*(const LAS bf16x8*)(QS + (16 * ti + l15) * P1 + 32 * ks + 8 * l4), *(const LAS bf16x8*)(ST + (16 * w + l15) * P1 + 32 * ks + 8 * l4), o);
#pragma unroll
                for (int r = 0; r < 4; ++r) OF[(16 * ti + 4 * l4 + r) * 132 + 16 * w + l15] = o[r];
            }
#pragma unroll
            for (int i = 0; i < 8; ++i) { const f32x4 d = *(const LAS f32x4*)(DF + 16 * i + 4 * l4); f32x4 sc = S[i] * d;
                S[i] = MFMA16(*(const LAS bf16x8*)(KDT + (16 * i + l15) * P2 + 8 * l4), bv, sc); }
        }
        LDS_BAR();
        {
            const int tg = 32 * c + t4;
            float o[8]; float ss = 0.f;
            { const f32x4 o0 = *(const LAS f32x4*)(OF + t4 * 132 + 8 * part), o1 = *(const LAS f32x4*)(OF + t4 * 132 + 8 * part + 4); o[0] = o0[0]; o[1] = o0[1]; o[2] = o0[2]; o[3] = o0[3]; o[4] = o1[0]; o[5] = o1[1]; o[6] = o1[2]; o[7] = o1[3]; }
#pragma unroll
            for (int j = 0; j < 8; ++j) ss += o[j] * o[j];
            ss += __shfl_xor(ss, 1); ss += __shfl_xor(ss, 2); ss += __shfl_xor(ss, 4); ss += __shfl_xor(ss, 8);
            if (tg < T) { const float rs = rsqrtf(ss * (1.0f / 128.0f) + RMS_EPS);
                const unsigned gw[4] = {gcur.x, gcur.y, gcur.z, gcur.w}; float r8[8];
#pragma unroll
                for (int j = 0; j < 8; ++j) { const float gv = bf2f((gw[j >> 1] >> (16 * (j & 1))) & 0xffffu); r8[j] = o[j] * rs * ng[j] * gv; }
                *(GAS bf16x8*)(MIX + (unsigned)(b * T + tg) * 1024u + gcol) = pack8(r8); }
        }
    }
#undef HG_LOAD
#undef HG_TAKE
    GAS float* HO = F.out + O_HP + ((size_t)((b * 2 + li) * 4 + h) * 128) * 128;
#pragma unroll
    for (int i = 0; i < 8; ++i)
#pragma unroll
        for (int r = 0; r < 4; ++r) HO[(size_t)(16 * i + 4 * l4 + r) * 128 + 16 * w + l15] = S[i][r];
}

DI void hgrn_sample_item(Frame& F, int li, int s) {
    LAS float* RED = (LAS float*)(F.lds + 0);
    int tid_ = F.tid; asm volatile("" : "+v"(tid_)); LAUNDER_F(F);
    const int tid = tid_, lane = tid & 63, kg = tid >> 5, v4 = tid & 31, row = NPR + s;
    const GAS bf16* QA = (const GAS bf16*)(F.ws + WS_A0); const GAS bf16* KA = (const GAS bf16*)(F.ws + WS_A1); const GAS bf16* VA = (const GAS bf16*)(F.ws + WS_A2); const GAS bf16* GA = (const GAS bf16*)(F.ws + WS_A3);
    const GAS float* LF = (const GAS float*)(F.ws + WS_LF); GAS bf16* MIX = (GAS bf16*)(F.ws + WS_MIX); const GAS float* NG = GIN(14) + li * 128;
    for (int h = 0; h < 4; ++h) {
        const GAS float* S0 = GIN(5) + ((size_t)((s * 2 + li) * 4 + h) * 128) * 128; GAS float* S1 = F.out + O_HS + ((size_t)((s * 2 + li) * 4 + h) * 128) * 128;
        const size_t ro = (size_t)row * 512 + h * 128;
        f32x4 vv; { const u32x2 vr = *(const GAS u32x2*)(VA + ro + 4 * v4); vv = (f32x4){bf2f(vr.x & 0xffffu), bf2f(vr.x >> 16), bf2f(vr.y & 0xffffu), bf2f(vr.y >> 16)}; }
        f32x4 o4 = {0.f, 0.f, 0.f, 0.f};
#pragma unroll
        for (int kk = 0; kk < 8; ++kk) { const int k = 8 * kg + kk; const float dec = __expf(LF[ro + k]), ka = bf2f(KA[ro + k]), q = bf2f(QA[ro + k]);
            const f32x4 sv = *(const GAS f32x4*)(S0 + (size_t)k * 128 + 4 * v4); const f32x4 nv = sv * dec + vv * ka; *(GAS f32x4*)(S1 + (size_t)k * 128 + 4 * v4) = nv; o4 += nv * q; }
        __syncthreads();
        *(LAS f32x4*)(RED + kg * 128 + 4 * v4) = o4;
        __syncthreads();
        if (tid < 64) {
            float oa = 0.f, ob = 0.f;
#pragma unroll
            for (int g = 0; g < 16; ++g) { oa += RED[g * 128 + lane]; ob += RED[g * 128 + 64 + lane]; }
            const float ss = wave_sum(oa * oa + ob * ob); const float rs = rsqrtf(ss * (1.0f / 128.0f) + RMS_EPS);
            MIX[(size_t)row * 1024 + h * 128 + lane] = (bf16)f2bf(oa * rs * NG[lane] * bf2f(GA[ro + lane]));
            MIX[(size_t)row * 1024 + h * 128 + 64 + lane] = (bf16)f2bf(ob * rs * NG[64 + lane] * bf2f(GA[ro + 64 + lane]));
        }
    }
}

DI unsigned ord_key(float v) { const unsigned bits = __builtin_bit_cast(unsigned, v); return (bits & 0x80000000u) ? ~bits : (bits | 0x80000000u); }
DI int dpp_row_sum(int v) {
    v += __builtin_amdgcn_update_dpp(0, v, 0xB1, 0xf, 0xf, false);
    v += __builtin_amdgcn_update_dpp(0, v, 0x4E, 0xf, 0xf, false);
    v += __builtin_amdgcn_update_dpp(0, v, 0x141, 0xf, 0xf, false);
    v += __builtin_amdgcn_update_dpp(0, v, 0x140, 0xf, 0xf, false);
    return v;
}
DI int wave_sum_i(int v) { v = dpp_row_sum(v); return __builtin_amdgcn_readlane(v, 0) + __builtin_amdgcn_readlane(v, 16) + __builtin_amdgcn_readlane(v, 32) + __builtin_amdgcn_readlane(v, 48); }
#define PROBE_CTL ((unsigned*)(((const Args*)__builtin_amdgcn_kernarg_segment_ptr())->ws))
template <int NJ> DI int count_ge(const unsigned (&u)[NJ], unsigned cand) {
    int c0 = 0, c1 = 0, c2 = 0, c3 = 0;
#pragma unroll
    for (int j = 0; j + 3 < NJ; j += 4) { c0 += (u[j] >= cand) ? 1 : 0; c1 += (u[j + 1] >= cand) ? 1 : 0; c2 += (u[j + 2] >= cand) ? 1 : 0; c3 += (u[j + 3] >= cand) ? 1 : 0; }
#pragma unroll
    for (int j = NJ & ~3; j < NJ; ++j) c0 += (u[j] >= cand) ? 1 : 0;
    return wave_sum_i((c0 + c1) + (c2 + c3));
}
template <int NJ> DI u64 select256(const unsigned (&u)[NJ], int lane, LAS unsigned* scr) {
    unsigned Tv = 0u; int c_lo = NJ * 64, c_hi = 0, bit = 31;
    for (; bit >= 0; --bit) {
        if (c_lo - c_hi <= 64) break;
        const unsigned cand = Tv | (1u << bit);
        const int c = count_ge<NJ>(u, cand);
        if (c >= 256) { Tv = cand; c_lo = c; } else c_hi = c;
    }
    int cT = c_lo;
    if (bit >= 0) {
        const unsigned width = 2u << bit; int base = 0;
        const u64 ltmask = (1ull << lane) - 1ull;
#pragma unroll
        for (int j = 0; j < NJ; ++j) { const bool in = (u[j] - Tv) < width; const u64 m = __ballot(in);
            const int pos = in ? base + __builtin_popcountll(m & ltmask) : 65;
            scr[pos] = u[j];
            base += __builtin_popcountll(m); }
        asm volatile("s_waitcnt lgkmcnt(0)" ::: "memory");
        const unsigned cv = lane < (c_lo - c_hi) ? scr[lane] : 0u;
        for (; bit >= 0; --bit) { const unsigned cand = Tv | (1u << bit); if (c_hi + __builtin_popcountll(__ballot(cv >= cand)) >= 256) Tv = cand; }
        cT = c_hi + __builtin_popcountll(__ballot(cv >= Tv));
    }
    u64 my = 0ull;
    if (cT == 256) {
#pragma unroll
        for (int j = 0; j < NJ; ++j) { const u64 wd = __ballot(u[j] >= Tv); my = (lane == j) ? wd : my; }
        return my;
    }
    int need = 256 - count_ge<NJ>(u, Tv + 1u);
#pragma unroll
    for (int j = 0; j < NJ; ++j) {
        const u64 gt = __ballot(u[j] > Tv), eq = __ballot(u[j] == Tv); const int c = __builtin_popcountll(eq); u64 take;
        if (c <= need) { take = eq; need -= c; }
        else { take = 0ull; u64 e = eq; for (int z = 0; z < need; ++z) { const u64 low = e & (~e + 1ull); take |= low; e ^= low; } need = 0; }
        const u64 wd = gt | take; my = (lane == j) ? wd : my;
    }
    return my;
}
template <int NJ> DI void dsa_select_rows(const GAS float* SC, LAS u64* MASK, LAS unsigned* scr, int w, int lane, int q0, int rpw) {
    for (int i = 0; i < rpw; ++i) {
        const int q = w * rpw + i, t = q0 + q; LAS u64* mrow = MASK + q * 34;
        if (t >= T) { if (lane < 34) mrow[lane] = 0ull; continue; }
        const int jfull = t >> 6, rem = t & 63;
        if (t + 1 <= 256) { if (lane < 34) mrow[lane] = lane < jfull ? ~0ull : (lane == jfull ? ((2ull << rem) - 1ull) : 0ull); continue; }
        unsigned u[NJ];
#pragma unroll
        for (int j = 0; j < NJ; ++j) { const int sidx = 64 * j + lane; const float v = SC[(size_t)q * TP + (sidx < TP ? sidx : 0)]; u[j] = sidx <= t ? ord_key(v) : 0u; }
        const u64 my = select256<NJ>(u, lane, scr);
        if (lane < 34) mrow[lane] = lane < NJ ? my : 0ull;
    }
}

DI float xhalf_max(float x) { const auto r = __builtin_amdgcn_permlane32_swap(__builtin_bit_cast(unsigned, x), __builtin_bit_cast(unsigned, x), false, false); return fmaxf(__builtin_bit_cast(float, r[0]), __builtin_bit_cast(float, r[1])); }
DI float xhalf_sum(float x) { const auto r = __builtin_amdgcn_permlane32_swap(__builtin_bit_cast(unsigned, x), __builtin_bit_cast(unsigned, x), false, false); return __builtin_bit_cast(float, r[0]) + __builtin_bit_cast(float, r[1]); }
DI void dsa_prompt_item(Frame& F, int b, int q0, int nqh) {
    constexpr int QP = 520;
    LAS bf16* QIL = (LAS bf16*)(F.lds + 0);
    LAS u64* MASK = (LAS u64*)(F.lds + 66560);
    int tid_ = F.tid; asm volatile("" : "+v"(tid_)); LAUNDER_F(F);
    const int tid = tid_, lane = tid & 63, w = __builtin_amdgcn_readfirstlane(tid >> 6), l31 = lane & 31, hh = lane >> 5;
    const int nq = (T - q0) < 32 * nqh ? (T - q0) : 32 * nqh, tmax = q0 + nq - 1, nkt = tmax / 32 + 1;
    const GAS bf16* QI = (const GAS bf16*)(F.ws + WS_QI); const GAS bf16* KIB = (const GAS bf16*)(F.ws + WS_KIB); const GAS float* WI = (const GAS float*)(F.ws + WS_WI);
    const GAS bf16* QB = (const GAS bf16*)(F.ws + WS_QB); const GAS bf16* KBB = (const GAS bf16*)(F.ws + WS_KBB); const GAS bf16* VT = (const GAS bf16*)(F.ws + WS_VT); GAS bf16* MIX = (GAS bf16*)(F.ws + WS_MIX);
    GAS float* SC = (GAS float*)(F.ws + WS_SC) + (size_t)F.wg * 64 * TP;
    const size_t rb = (size_t)b * T;
#pragma unroll
    for (int i = 0; i < 8; ++i) { const int e = tid + 512 * i, r = e >> 6, c8 = e & 63; const int t = q0 + r < T ? q0 + r : T - 1;
        *(LAS u32x4*)(QIL + r * QP + 8 * c8) = *(const GAS u32x4*)(QI + (rb + t) * 512 + 8 * c8); }
    __syncthreads();
#if PROBE_TS == 3
    const unsigned long long _ta = __builtin_amdgcn_s_memrealtime();
#endif
    {
        const int qh = nqh == 2 ? (w & 1) : 0, kt0 = nqh == 2 ? (w >> 1) : w, kts = nqh == 2 ? 4 : 8, tq = q0 + 32 * qh + l31, tqc = tq < T ? tq : T - 1;
        float wq[8]; { const f32x4 a = *(const GAS f32x4*)(WI + (rb + tqc) * 8), c = *(const GAS f32x4*)(WI + (rb + tqc) * 8 + 4); wq[0] = a[0]; wq[1] = a[1]; wq[2] = a[2]; wq[3] = a[3]; wq[4] = c[0]; wq[5] = c[1]; wq[6] = c[2]; wq[7] = c[3]; }
        const int tlast = (q0 + 32 * qh + 31) < tmax ? (q0 + 32 * qh + 31) : tmax;
        if (q0 + 32 * qh <= tmax) {
        bf16x8 kan[4];
        { const int key = 32 * kt0 + l31, keyc = key < T ? key : T - 1;
#pragma unroll
          for (int ks = 0; ks < 4; ++ks) kan[ks] = *(const GAS bf16x8*)(KIB + (rb + keyc) * 64 + 16 * ks + 8 * hh); }
        for (int kt = kt0; 32 * kt <= tlast; kt += kts) {
            bf16x8 ka[4];
#pragma unroll
            for (int ks = 0; ks < 4; ++ks) ka[ks] = kan[ks];
            { const int key = 32 * (kt + kts) + l31, keyc = key < T ? key : T - 1;
#pragma unroll
              for (int ks = 0; ks < 4; ++ks) kan[ks] = *(const GAS bf16x8*)(KIB + (rb + keyc) * 64 + 16 * ks + 8 * hh); }
            f32x16 tot;
#pragma unroll
            for (int r = 0; r < 16; ++r) tot[r] = 0.f;
#pragma unroll
            for (int hd = 0; hd < 8; ++hd) {
                asm volatile("" ::: "memory");
                f32x16 a;
#pragma unroll
                for (int r = 0; r < 16; ++r) a[r] = 0.f;
#pragma unroll
                for (int ks = 0; ks < 4; ++ks) a = MFMA32(ka[ks], *(const LAS bf16x8*)(QIL + (32 * qh + l31) * QP + hd * 64 + 16 * ks + 8 * hh), a);
#pragma unroll
                for (int r = 0; r < 16; ++r) tot[r] += wq[hd] * fmaxf(a[r], 0.f);
            }
            if (tq < T) {
#pragma unroll
                for (int g = 0; g < 4; ++g) *(GAS f32x4*)(SC + (size_t)(32 * qh + l31) * TP + 32 * kt + 8 * g + 4 * hh) = (f32x4){tot[4 * g], tot[4 * g + 1], tot[4 * g + 2], tot[4 * g + 3]};
            }
        }
        }
    }
    __syncthreads();
#if PROBE_TS == 3
    const unsigned long long _tb = __builtin_amdgcn_s_memrealtime();
#endif
    {
        LAS unsigned* scr = (LAS unsigned*)(F.lds + 84480) + w * 80;
        const int njn = (tmax >> 6) + 1;
        const int rpw = 4 * nqh;
        if (njn <= 9) dsa_select_rows<9>(SC, MASK, scr, w, lane, q0, rpw);
        else if (njn <= 17) dsa_select_rows<17>(SC, MASK, scr, w, lane, q0, rpw);
        else if (njn <= 25) dsa_select_rows<25>(SC, MASK, scr, w, lane, q0, rpw);
        else dsa_select_rows<33>(SC, MASK, scr, w, lane, q0, rpw);
    }
    __syncthreads();
#if PROBE_TS == 3
    const unsigned long long _tc = __builtin_amdgcn_s_memrealtime();
#endif
    {
        const int hd = w, g = hd >> 2;
        constexpr int KP = 136, VP = 40;
        LAS bf16* KL = (LAS bf16*)(F.lds + 87040);
        LAS bf16* VL = (LAS bf16*)(F.lds + 104448);
        const LAS unsigned* M32 = (const LAS unsigned*)MASK;
        bf16x8 qf[2][4];
#pragma unroll
        for (int qh = 0; qh < 2; ++qh) { const int tq = q0 + 32 * qh + l31, tqc = tq < T ? tq : T - 1;
#pragma unroll
            for (int ks = 0; ks < 4; ++ks) qf[qh][ks] = *(const GAS bf16x8*)(QB + (rb + tqc) * 512 + hd * 64 + 16 * ks + 8 * hh); }
        f32x16 O[2][2]; float mrun[2], lrun[2];
#pragma unroll
        for (int qh = 0; qh < 2; ++qh) { mrun[qh] = -INFINITY; lrun[qh] = 0.f;
#pragma unroll
            for (int dt = 0; dt < 2; ++dt)
#pragma unroll
                for (int r = 0; r < 16; ++r) O[qh][dt][r] = 0.f; }
        const int krow = tid >> 4, kch = tid & 15, vrow = tid >> 2, vch = tid & 3;
        u32x4 sk, sv;
#define DC_LOAD(kt_) do { const int key_ = 32 * (kt_) + krow, keyc_ = key_ < T ? key_ : T - 1; sk = *(const GAS u32x4*)(KBB + (rb + keyc_) * 128 + 8 * kch); \
            sv = *(const GAS u32x4*)(VT + ((size_t)(b * 128 + vrow)) * TP + 32 * (kt_) + 8 * vch); } while (0)
#define DC_STORE(buf_) do { *(LAS u32x4*)(KL + ((buf_) * 32 + krow) * KP + 8 * kch) = sk; *(LAS u32x4*)(VL + ((buf_) * 128 + vrow) * VP + 8 * vch) = sv; } while (0)
        DC_LOAD(0); DC_STORE(0);
        __syncthreads();
        for (int kt = 0; kt < nkt; ++kt) {
            const int buf = kt & 1;
            if (kt + 1 < nkt) DC_LOAD(kt + 1);
#pragma unroll
            for (int qh = 0; qh < 2; ++qh) {
                if (qh >= nqh || 32 * kt > q0 + 32 * qh + 31 || q0 + 32 * qh > tmax) continue;
                f32x16 sa;
#pragma unroll
                for (int r = 0; r < 16; ++r) sa[r] = 0.f;
#pragma unroll
                for (int ks = 0; ks < 4; ++ks) sa = MFMA32(*(const LAS bf16x8*)(KL + (buf * 32 + l31) * KP + g * 64 + 16 * ks + 8 * hh), qf[qh][ks], sa);
                const unsigned mw = M32[(32 * qh + l31) * 68 + kt] >> (4 * hh);
                float mx = -INFINITY;
#pragma unroll
                for (int r = 0; r < 16; ++r) { const bool on = (mw >> ((r & 3) + 8 * (r >> 2))) & 1u; sa[r] = on ? sa[r] : -INFINITY; mx = fmaxf(mx, sa[r]); }
                mx = xhalf_max(mx);
                const float mnew = fmaxf(mrun[qh], mx);
                const float msafe = mnew == -INFINITY ? 0.f : mnew;
                const float alpha = __expf(mrun[qh] - msafe);
                float pr[16]; float rs = 0.f;
#pragma unroll
                for (int r = 0; r < 16; ++r) { pr[r] = __expf(sa[r] - msafe); rs += pr[r]; }
                rs = xhalf_sum(rs);
                lrun[qh] = lrun[qh] * alpha + rs; mrun[qh] = mnew;
                if (!__all(alpha == 1.0f)) {
#pragma unroll
                    for (int dt = 0; dt < 2; ++dt)
#pragma unroll
                        for (int r = 0; r < 16; ++r) O[qh][dt][r] *= alpha;
                }
#pragma unroll
                for (int s2 = 0; s2 < 2; ++s2) {
                    const float pv[8] = {pr[8 * s2], pr[8 * s2 + 1], pr[8 * s2 + 2], pr[8 * s2 + 3], pr[8 * s2 + 4], pr[8 * s2 + 5], pr[8 * s2 + 6], pr[8 * s2 + 7]};
                    const bf16x8 pf = pack8(pv);
#pragma unroll
                    for (int dt = 0; dt < 2; ++dt) { const LAS bf16* vp = VL + (buf * 128 + g * 64 + 32 * dt + l31) * VP + 16 * s2 + 4 * hh;
                        const u32x2 lo = *(const LAS u32x2*)vp, hi = *(const LAS u32x2*)(vp + 8); u32x4 pk; pk.x = lo.x; pk.y = lo.y; pk.z = hi.x; pk.w = hi.y;
                        O[qh][dt] = MFMA32(__builtin_bit_cast(bf16x8, pk), pf, O[qh][dt]); }
                }
            }
            if (kt + 1 < nkt) DC_STORE(buf ^ 1);
            LDS_BAR();
        }
#undef DC_LOAD
#undef DC_STORE
#pragma unroll
        for (int qh = 0; qh < 2; ++qh) { const int tq = q0 + 32 * qh + l31;
            if (qh < nqh && tq < T) { const float inv = frcp(lrun[qh]);
#pragma unroll
                for (int dt = 0; dt < 2; ++dt)
#pragma unroll
                    for (int g4 = 0; g4 < 4; ++g4) { u32x2 o; o.x = pk2(O[qh][dt][4 * g4] * inv, O[qh][dt][4 * g4 + 1] * inv); o.y = pk2(O[qh][dt][4 * g4 + 2] * inv, O[qh][dt][4 * g4 + 3] * inv);
                        *(GAS u32x2*)(MIX + (rb + tq) * 1024 + 512 + hd * 64 + 32 * dt + 8 * g4 + 4 * hh) = o; } } }
    }
#if PROBE_TS == 3
    __syncthreads();
    if (tid == 0) { const unsigned long long _td = __builtin_amdgcn_s_memrealtime(); atomicAdd(F.ctl + 20000, (unsigned)(_tb - _ta)); atomicAdd(F.ctl + 20001, (unsigned)(_tc - _tb)); atomicAdd(F.ctl + 20002, (unsigned)(_td - _tc)); }
#endif
}

DI void dsa_sample_item(Frame& F, int li, int s) {
    LAS float* QIF = (LAS float*)(F.lds + 0);
    LAS float* QBF = (LAS float*)(F.lds + 2048);
    LAS float* WIF = (LAS float*)(F.lds + 4096);
    LAS float* SCL = (LAS float*)(F.lds + 4352);
    LAS int* SEL = (LAS int*)(F.lds + 12800);
    LAS float* LG = (LAS float*)(F.lds + 13824);
    int tid_ = F.tid; asm volatile("" : "+v"(tid_)); LAUNDER_F(F);
    const int tid = tid_, lane = tid & 63, wv = __builtin_amdgcn_readfirstlane(tid >> 6), row = NPR + s;
    const GAS int* PT = (const GAS int*)GIN(9) + s * NPAGES;
    QIF[tid] = bf2f(((const GAS bf16*)(F.ws + WS_QI))[(size_t)row * 512 + tid]);
    QBF[tid] = bf2f(((const GAS bf16*)(F.ws + WS_QB))[(size_t)row * 512 + tid]);
    if (tid < 8) WIF[tid] = ((const GAS float*)(F.ws + WS_WI))[(size_t)row * 8 + tid];
    __syncthreads();
    {
        const GAS float* kp[4];
#pragma unroll
        for (int i = 0; i < 4; ++i) { const int n = tid + 512 * i; const int pg = PT[n >> 7]; kp[i] = GIN(4) + ((size_t)(pg * PAGE + (n & 127)) * 2 + li) * 64; }
        float acc[4][8];
#pragma unroll
        for (int i = 0; i < 4; ++i)
#pragma unroll
            for (int hd = 0; hd < 8; ++hd) acc[i][hd] = 0.f;
#pragma unroll 2
        for (int dq = 0; dq < 16; ++dq) {
            f32x4 kv[4];
#pragma unroll
            for (int i = 0; i < 4; ++i) kv[i] = *(const GAS f32x4*)(kp[i] + 4 * dq);
#pragma unroll
            for (int hd = 0; hd < 8; ++hd) { const f32x4 qv = *(const LAS f32x4*)(QIF + hd * 64 + 4 * dq);
#pragma unroll
                for (int i = 0; i < 4; ++i) acc[i][hd] += kv[i][0] * qv[0] + kv[i][1] * qv[1] + kv[i][2] * qv[2] + kv[i][3] * qv[3]; }
        }
#pragma unroll
        for (int i = 0; i < 4; ++i) { float sc = 0.f;
#pragma unroll
            for (int hd = 0; hd < 8; ++hd) sc += WIF[hd] * fmaxf(acc[i][hd], 0.f);
            SCL[tid + 512 * i] = sc; }
        if (tid < 64) {
            const float kvn = F.out[O_IS + ((size_t)s * 2 + li) * 64 + lane]; float sc = 0.f;
#pragma unroll
            for (int hd = 0; hd < 8; ++hd) { const float d = wave_sum(kvn * QIF[hd * 64 + lane]); sc += WIF[hd] * fmaxf(d, 0.f); }
            if (lane == 0) SCL[2048] = sc;
        }
    }
    __syncthreads();
    if (wv == 0) {
        unsigned u[33];
#pragma unroll
        for (int j = 0; j < 33; ++j) { const int sidx = 64 * j + lane; u[j] = sidx <= PAST ? ord_key(SCL[sidx]) : 0u; }
        const u64 my = select256<33>(u, lane, (LAS unsigned*)(F.lds + 24576));
        int base = 0;
#pragma unroll
        for (int j = 0; j < 33; ++j) { const u64 wd = __shfl(my, j); const bool on = (wd >> lane) & 1ull; const int pos = base + __builtin_popcountll(wd & ((1ull << lane) - 1ull));
            if (on && pos < 256) SEL[pos] = 64 * j + lane; base += __builtin_popcountll(wd); }
    }
    __syncthreads();
    LAS int* ROWID = (LAS int*)(F.lds + 22016);
    if (tid < 256) { const int idx = SEL[tid]; ROWID[tid] = idx < PAST ? PT[idx >> 7] * PAGE + (idx & 127) : -1; }
    __syncthreads();
    {
        const int n = tid >> 1, g = tid & 1, rid = ROWID[n];
        const GAS float* kp = rid >= 0 ? GIN(2) + ((size_t)rid * 2 + li) * 128 + g * 64 : F.out + O_KS + ((size_t)s * 2 + li) * 128 + g * 64;
        f32x4 kv[16];
#pragma unroll
        for (int dq = 0; dq < 16; ++dq) kv[dq] = *(const GAS f32x4*)(kp + 4 * dq);
        float a4[4] = {0.f, 0.f, 0.f, 0.f};
#pragma unroll
        for (int dq = 0; dq < 16; ++dq) {
#pragma unroll
            for (int i = 0; i < 4; ++i) { const f32x4 qv = *(const LAS f32x4*)(QBF + (4 * g + i) * 64 + 4 * dq); a4[i] += kv[dq][0] * qv[0] + kv[dq][1] * qv[1] + kv[dq][2] * qv[2] + kv[dq][3] * qv[3]; } }
#pragma unroll
        for (int i = 0; i < 4; ++i) LG[(4 * g + i) * 256 + n] = a4[i];
    }
    __syncthreads();
    {
        const int hd = wv; float v[4]; float mx = -INFINITY;
#pragma unroll
        for (int i = 0; i < 4; ++i) { v[i] = LG[hd * 256 + lane + 64 * i]; mx = fmaxf(mx, v[i]); }
#pragma unroll
        for (int o = 1; o < 64; o <<= 1) mx = fmaxf(mx, __shfl_xor(mx, o));
        float sm = 0.f;
#pragma unroll
        for (int i = 0; i < 4; ++i) { v[i] = __expf(v[i] - mx); sm += v[i]; }
        sm = wave_sum(sm); const float inv = frcp(sm);
#pragma unroll
        for (int i = 0; i < 4; ++i) LG[hd * 256 + lane + 64 * i] = v[i] * inv;
    }
    __syncthreads();
    {
        const int hd = tid >> 6, g = hd >> 2; float o = 0.f;
        const GAS float* vnew = F.out + O_VS + ((size_t)s * 2 + li) * 128 + g * 64 + lane;
        const GAS float* vbase = GIN(3) + (size_t)li * 128 + g * 64 + lane;
        for (int n0 = 0; n0 < 256; n0 += 8) {
            float vv[8];
#pragma unroll
            for (int i = 0; i < 8; ++i) { const int rid = ROWID[n0 + i]; const GAS float* vp = rid >= 0 ? vbase + (size_t)rid * 256 : vnew; vv[i] = *vp; }
#pragma unroll
            for (int i = 0; i < 8; ++i) o += LG[hd * 256 + n0 + i] * vv[i];
        }
        ((GAS bf16*)(F.ws + WS_MIX))[(size_t)row * 1024 + 512 + hd * 64 + lane] = (bf16)f2bf(o);
    }
}

struct OutProj {
    static constexpr bool GATHER = false, SPLITB = false; static constexpr int KSPLIT = 0, K = 1024, lda = 1024, ldb = 1024;
    const GAS bf16* A; const GAS bf16* Bt; int G, c; GAS float* X;
    DI bool next(int i, pg8::Unit& u) const { if (!pg8::static_next<M / 256, 4>(G, c, i, u.pm, u.pn)) return false;
        u.B0 = (const GAS char*)(Bt + (size_t)u.pn * 256 * 1024); u.B1 = u.B0; u.aux = 0; return true; }
    DI void epi(const AccT& acc, const pg8::Unit& u, int wr, int wc, int fr, int fq) const {
        asm volatile("" : "+v"(fr), "+v"(fq));
#pragma unroll
        for (int ai = 0; ai < 2; ++ai)
#pragma unroll
            for (int m = 0; m < 4; ++m) { GAS float* rp = X + (unsigned)(u.pm * 256 + ai * 128 + wr * 64 + m * 16 + fr) * D + u.pn * 256 + wc * 32 + 4 * fq;
#pragma unroll
                for (int bj = 0; bj < 2; ++bj)
#pragma unroll
                    for (int n = 0; n < 2; ++n) { GAS f32x4* q = (GAS f32x4*)(rp + bj * 128 + n * 16); *q = *q * DN_ALPHA + acc[ai][bj][m][n]; }
                if (m & 1) asm volatile("" ::: "memory"); }
    }
};

DI void p_ln(Frame& F, int layer, bool second, bool final_) {
    int tid_ = F.tid; asm volatile("" : "+v"(tid_)); LAUNDER_F(F);
    const int tid = tid_, lane = tid & 63, wv = __builtin_amdgcn_readfirstlane(tid >> 6);
    const bool route = !second;
    LAS float* RW = (LAS float*)(F.lds + 0);
    volatile LAS unsigned* LCNT = (volatile LAS unsigned*)(F.lds + 81920);
    volatile LAS unsigned* ROWC = (volatile LAS unsigned*)(F.lds + 82432);
    int nrow = 0;
    if (route) {
        if (tid < 64) LCNT[tid] = 0u;
        const GAS float* gw = GIN(32) + (size_t)layer * 1024 * 4; const GAS float* ew = GIN(34) + (size_t)layer * 1024 * 16;
#pragma unroll 1
        for (int i = 0; i < 2; ++i) { const int k = tid + 512 * i; f32x4 st[5]; st[0] = *(const GAS f32x4*)(gw + k * 4);
#pragma unroll
            for (int q = 0; q < 4; ++q) st[1 + q] = *(const GAS f32x4*)(ew + k * 16 + 4 * q);
#pragma unroll
            for (int q = 0; q < 5; ++q) *(LAS f32x4*)(RW + k * 20 + 4 * q) = st[q]; }
        __syncthreads();
        asm volatile("" ::: "memory");
    }
    const GAS float* lg = GIN(second ? 30 : 28) + layer * D; const GAS float* lb = GIN(second ? 31 : 29) + layer * D;
    f32x4 g4[4], b4[4];
#pragma unroll
    for (int j = 0; j < 4; ++j) { g4[j] = *((const GAS f32x4*)lg + lane + 64 * j); b4[j] = *((const GAS f32x4*)lb + lane + 64 * j); }
    GAS float* X = (GAS float*)(F.ws + WS_X); GAS bf16* XB = (GAS bf16*)(F.ws + WS_XB);
    f32x4 nv[4];
    { const int m0 = F.wg * 8 + wv;
#pragma unroll
      for (int j = 0; j < 4; ++j) nv[j] = *((const GAS f32x4*)(X + (size_t)(m0 < M ? m0 : 0) * D) + lane + 64 * j); }
    for (int m = F.wg * 8 + wv; m < M; m += F.G * 8) {
        asm volatile("" ::: "memory");
        f32x4 v[4]; float sm = 0.f;
#pragma unroll
        for (int j = 0; j < 4; ++j) { v[j] = nv[j]; sm += (v[j][0] + v[j][1]) + (v[j][2] + v[j][3]); }
        { const int mn = m + F.G * 8 < M ? m + F.G * 8 : m;
#pragma unroll
          for (int j = 0; j < 4; ++j) nv[j] = *((const GAS f32x4*)(X + (size_t)mn * D) + lane + 64 * j); }
        const float mean = wave_sum(sm) * (1.0f / D); float s2 = 0.f;
#pragma unroll
        for (int j = 0; j < 4; ++j) { v[j] = v[j] - mean; s2 += (v[j][0] * v[j][0] + v[j][1] * v[j][1]) + (v[j][2] * v[j][2] + v[j][3] * v[j][3]); }
        const float rstd = rsqrtf(wave_sum(s2) * (1.0f / D) + LN_EPS);
#pragma unroll
        for (int j = 0; j < 4; ++j) v[j] = v[j] * rstd * g4[j] + b4[j];
        if (final_) {
            GAS float* dst = nullptr;
            if (m < NPR) { const int b = m / T, t = m % T; if (t >= NMETA) dst = F.out + O_YP + ((size_t)b * SEQ + (t - NMETA)) * D; }
            else dst = F.out + O_YS + (size_t)(m - NPR) * D;
            if (dst) {
#pragma unroll
                for (int j = 0; j < 4; ++j) *((GAS f32x4*)dst + lane + 64 * j) = v[j]; }
        } else {
#pragma unroll
            for (int j = 0; j < 4; ++j) { *((GAS f32x4*)(X + (size_t)m * D) + lane + 64 * j) = v[j]; u32x2 o; o.x = pk2(v[j][0], v[j][1]); o.y = pk2(v[j][2], v[j][3]); *((GAS u32x2*)(XB + (size_t)m * D) + lane + 64 * j) = o; }
        }
        if (route) {
            float pl[20];
#pragma unroll
            for (int e = 0; e < 20; ++e) pl[e] = 0.f;
#pragma unroll
            for (int j = 0; j < 4; ++j)
#pragma unroll
                for (int i = 0; i < 4; ++i) { const LAS float* wp = RW + (4 * lane + 256 * j + i) * 20; const float xv = v[j][i];
#pragma unroll
                    for (int q = 0; q < 5; ++q) { const f32x4 wq = *(const LAS f32x4*)(wp + 4 * q); pl[4 * q] += xv * wq[0]; pl[4 * q + 1] += xv * wq[1]; pl[4 * q + 2] += xv * wq[2]; pl[4 * q + 3] += xv * wq[3]; } }
#pragma unroll
            for (int e = 0; e < 20; ++e) pl[e] = wave_sum(pl[e]);
            const GAS float* gb = GIN(33) + layer * 4; const GAS float* eb = GIN(35) + layer * 16;
            float l0 = pl[0] + gb[0], l1 = pl[1] + gb[1], l2 = pl[2] + gb[2], l3 = pl[3] + gb[3];
            int g = 0; float lm = l0; if (l1 > lm) { lm = l1; g = 1; } if (l2 > lm) { lm = l2; g = 2; } if (l3 > lm) { lm = l3; g = 3; }
            const float gval = frcp(__expf(l0 - lm) + __expf(l1 - lm) + __expf(l2 - lm) + __expf(l3 - lm));
            float le[4];
#pragma unroll
            for (int i = 0; i < 4; ++i) le[i] = (g == 0 ? pl[4 + i] : g == 1 ? pl[8 + i] : g == 2 ? pl[12 + i] : pl[16 + i]) + eb[4 * g + i];
            int ea = 0; float la = le[0];
#pragma unroll
            for (int i = 1; i < 4; ++i) if (le[i] > la) { la = le[i]; ea = i; }
            int e2 = -1; float l2b = -INFINITY;
#pragma unroll
            for (int i = 0; i < 4; ++i) if (i != ea && le[i] > l2b) { l2b = le[i]; e2 = i; }
            const float p1 = frcp(1.0f + __expf(l2b - la)), p2 = 1.0f - p1;
            const int lo = ea < e2 ? ea : e2, hi = ea < e2 ? e2 : ea;
            const float glo = gval * (ea < e2 ? p1 : p2), ghi = gval * (ea < e2 ? p2 : p1);
            const int pr = lo == 0 ? hi - 1 : (lo == 1 ? hi + 1 : 5), cls = g * 6 + pr;
            if (lane == 0) {
                const unsigned lp = __hip_atomic_fetch_add((LAS unsigned*)LCNT + cls, 1u, __ATOMIC_RELAXED, __HIP_MEMORY_SCOPE_WORKGROUP);
                ROWC[wv * 12 + nrow] = (unsigned)cls | (lp << 8);
                *(GAS f32x2*)((GAS float*)(F.ws + WS_GATE) + (size_t)m * 2) = (f32x2){glo, ghi};
            }
            ++nrow;
        }
    }
    if (route) {
        __syncthreads();
        if (tid < NCLS) { const unsigned n = LCNT[tid]; LCNT[32 + tid] = n ? __hip_atomic_fetch_add(F.ctl + CW_CNT + (layer * NCLS + tid) * 64, n, __ATOMIC_RELAXED, __HIP_MEMORY_SCOPE_AGENT) : 0u; }
        __syncthreads();
        if (lane == 0) { int r = 0;
            for (int m = F.wg * 8 + wv; m < M; m += F.G * 8, ++r) { const unsigned e = ROWC[wv * 12 + r]; const unsigned cls = e & 255u, lp = e >> 8;
                ((GAS int*)(F.ws + WS_TOK))[(size_t)cls * CLS_CAP + LCNT[32 + cls] + lp] = m; } }
    }
}

DI void moe_setup(Frame& F, int layer) {
    int tid = F.tid; asm volatile("" : "+v"(tid));
    __syncthreads();
    if (tid < NCLS) F.MISC[48 + tid] = __hip_atomic_load(F.ctl + CW_CNT + (layer * NCLS + tid) * 64, __ATOMIC_RELAXED, __HIP_MEMORY_SCOPE_AGENT);
    __syncthreads();
    if (tid == 0) { unsigned run = 0; for (int c = 0; c < NCLS; ++c) { F.MISC[16 + c] = run; run += (F.MISC[48 + c] + 255u) >> 8; } F.MISC[16 + NCLS] = run; }
    __syncthreads();
}
DI void cls_experts(int cls, int& elo, int& ehi) { const int g = cls / 6, pr = cls % 6; const int lo = pr < 3 ? 0 : (pr < 5 ? 1 : 2), hi = pr < 3 ? pr + 1 : (pr < 5 ? pr - 1 : 3); elo = g * 4 + lo; ehi = g * 4 + hi; }
DI bool moe_next(const volatile LAS unsigned* MISC, int G, int c, int i, int& cp, int& pn, int& cls) {
    const int npan = __builtin_amdgcn_readfirstlane((int)MISC[16 + NCLS]); const long L = (long)i * G + c; if (L >= 4L * npan) return false;
    cp = (int)(L >> 2); pn = (int)(L & 3); cls = 0;
    for (int k = 1; k < NCLS; ++k) if (__builtin_amdgcn_readfirstlane((int)MISC[16 + k]) <= cp) cls = k;
    return true;
}
struct MoeUp {
    static constexpr bool GATHER = true, SPLITB = false; static constexpr int KSPLIT = 0, K = 1024, lda = 1024, ldb = 1024;
    const GAS bf16* A; int G, c, layer; GAS unsigned char* ws; const volatile LAS unsigned* MISC;
    DI bool next(int i, pg8::Unit& u) const { int cp, pn, cls; if (!moe_next(MISC, G, c, i, cp, pn, cls)) return false;
        int elo, ehi; cls_experts(cls, elo, ehi); const int e = pn < 2 ? elo : ehi;
        u.pm = cp; u.pn = pn; u.aux = cls; u.B0 = (const GAS char*)((const GAS bf16*)(ws + WS_WGU) + ((size_t)(layer * 16 + e) * 512 + (pn & 1) * 256) * 1024); u.B1 = u.B0; return true; }
    DI unsigned a_row(const pg8::Unit& u, int r) const { const int cls = u.aux, cnt = __builtin_amdgcn_readfirstlane((int)MISC[48 + cls]); int slot = (u.pm - __builtin_amdgcn_readfirstlane((int)MISC[16 + cls])) * 256 + r; slot = slot < cnt ? slot : cnt - 1;
        const int tok = ((const GAS int*)(ws + WS_TOK))[(size_t)cls * CLS_CAP + slot]; return (unsigned)tok * 2048u; }
    DI void epi(const AccT& acc, const pg8::Unit& u, int wr, int wc, int fr, int fq) const {
        asm volatile("" : "+v"(fr), "+v"(fq));
        const int cls = u.aux, cnt = __builtin_amdgcn_readfirstlane((int)MISC[48 + cls]), sbase = (u.pm - __builtin_amdgcn_readfirstlane((int)MISC[16 + cls])) * 256;
        GAS bf16* H = (GAS bf16*)(ws + WS_H);
        int tok8[8]; float gate8[8];
#pragma unroll
        for (int i = 0; i < 8; ++i) { const int r = (i >> 2) * 128 + wr * 64 + (i & 3) * 16 + fr; int slot = sbase + r; slot = slot < cnt ? slot : cnt - 1; tok8[i] = ((const GAS int*)(ws + WS_TOK))[(unsigned)cls * CLS_CAP + slot]; }
#pragma unroll
        for (int i = 0; i < 8; ++i) gate8[i] = ((const GAS float*)(ws + WS_GATE))[(unsigned)tok8[i] * 2 + (u.pn >> 1)];
#pragma unroll
        for (int ai = 0; ai < 2; ++ai)
#pragma unroll
            for (int m = 0; m < 4; ++m) { const int r = ai * 128 + wr * 64 + m * 16 + fr; const float gate = gate8[ai * 4 + m];
#pragma unroll
                for (int n = 0; n < 2; ++n) { const f32x4 gv = acc[ai][0][m][n], uv = acc[ai][1][m][n]; u32x2 o;
                    o.x = pk2(siluf_(gv[0]) * uv[0] * gate, siluf_(gv[1]) * uv[1] * gate); o.y = pk2(siluf_(gv[2]) * uv[2] * gate, siluf_(gv[3]) * uv[3] * gate);
                    *(GAS u32x2*)(H + (unsigned)(u.pm * 256 + r) * 512 + u.pn * 128 + wc * 32 + n * 16 + 4 * fq) = o; } }
    }
};
struct MoeDown {
    static constexpr bool GATHER = false, SPLITB = true; static constexpr int KSPLIT = 4, K = 512, lda = 512, ldb = 256;
    const GAS bf16* A; int G, c, layer; GAS unsigned char* ws; const volatile LAS unsigned* MISC;
    DI bool next(int i, pg8::Unit& u) const { int cp, pn, cls; if (!moe_next(MISC, G, c, i, cp, pn, cls)) return false;
        int elo, ehi; cls_experts(cls, elo, ehi);
        u.pm = cp; u.pn = pn; u.aux = cls; const GAS bf16* WD = (const GAS bf16*)(ws + WS_WD);
        u.B0 = (const GAS char*)(WD + ((size_t)(layer * 16 + elo) * 1024 + pn * 256) * 256); u.B1 = (const GAS char*)(WD + ((size_t)(layer * 16 + ehi) * 1024 + pn * 256) * 256) - 4 * 128; return true; }
    DI void epi(const AccT& acc, const pg8::Unit& u, int wr, int wc, int fr, int fq) const {
        asm volatile("" : "+v"(fr), "+v"(fq));
        const int cls = u.aux, cnt = __builtin_amdgcn_readfirstlane((int)MISC[48 + cls]), sbase = (u.pm - __builtin_amdgcn_readfirstlane((int)MISC[16 + cls])) * 256;
        GAS float* X = (GAS float*)(ws + WS_X);
        int tok8[8];
#pragma unroll
        for (int i = 0; i < 8; ++i) { const int r = (i >> 2) * 128 + wr * 64 + (i & 3) * 16 + fr; int slot = sbase + r; slot = slot < cnt ? slot : cnt - 1; tok8[i] = ((const GAS int*)(ws + WS_TOK))[(unsigned)cls * CLS_CAP + slot]; }
#pragma unroll
        for (int ai = 0; ai < 2; ++ai)
#pragma unroll
            for (int m = 0; m < 4; ++m) { const int r = ai * 128 + wr * 64 + m * 16 + fr, slot = sbase + r;
                if (slot < cnt) { const int tok = tok8[ai * 4 + m]; GAS float* rp = X + (unsigned)tok * D + u.pn * 256 + wc * 32 + 4 * fq;
#pragma unroll
                    for (int bj = 0; bj < 2; ++bj)
#pragma unroll
                        for (int n = 0; n < 2; ++n) { GAS f32x4* q = (GAS f32x4*)(rp + bj * 128 + n * 16); *q = *q * DN_ALPHA + acc[ai][bj][m][n]; } }
                if (m & 1) asm volatile("" ::: "memory"); }
    }
};

struct OddIn {
    static constexpr bool GATHER = false, SPLITB = false; static constexpr int KSPLIT = 0, K = 1024, lda = 1024, ldb = 1024;
    const GAS bf16* A; const GAS bf16* Bt; int G, c, li; GAS unsigned char* ws; GAS float* out;
    DI bool next(int i, pg8::Unit& u) const { if (!pg8::static_next<M / 256, ODD_IN / 256>(G, c, i, u.pm, u.pn)) return false;
        u.B0 = (const GAS char*)(Bt + (size_t)u.pn * 256 * 1024); u.B1 = u.B0; u.aux = 0; return true; }
    DI void epi(const AccT& acc, const pg8::Unit& u, int wr, int wc, int fr, int fq) const {
        asm volatile("" : "+v"(fr), "+v"(fq));
        const int pn = u.pn;
#pragma unroll
        for (int ai = 0; ai < 2; ++ai)
#pragma unroll
            for (int m = 0; m < 4; ++m) {
                const int row = u.pm * 256 + ai * 128 + wr * 64 + m * 16 + fr;
                int b = 0, t = 0, sidx = 0; const bool pr = row < NPR; if (pr) { b = row / T; t = row % T; } else sidx = row - NPR;
                if (pn < 4) {
                    GAS float* so = nullptr;
                    if (pr) { if (t >= T - 30) so = out + O_CP + ((unsigned)(b * 2 + li) * 30 + (t - (T - 30))) * 512; } else so = out + O_CS + ((unsigned)(sidx * 2 + li) * 30 + 29) * 512;
#pragma unroll
                    for (int n = 0; n < 2; ++n) { const int ch = 128 * pn + wc * 32 + n * 16 + 4 * fq; const f32x4 a = acc[ai][0][m][n], g = acc[ai][1][m][n]; f32x4 uv;
#pragma unroll
                        for (int j = 0; j < 4; ++j) uv[j] = a[j] * sigmoidf_(g[j]);
                        u32x2 o; o.x = pk2(uv[0], uv[1]); o.y = pk2(uv[2], uv[3]); *(GAS u32x2*)((GAS bf16*)(ws + WS_A0) + (unsigned)row * 512 + ch) = o;
                        if (so) *(GAS f32x4*)(so + ch) = uv; }
                } else if (pn < 6) {
                    GAS float* so = nullptr;
                    if (pr) { if (t >= T - 3) so = out + O_DP + ((unsigned)(b * 2 + li) * 3 + (t - (T - 3))) * 512; } else so = out + O_DS + ((unsigned)(sidx * 2 + li) * 3 + 2) * 512;
#pragma unroll
                    for (int bj = 0; bj < 2; ++bj)
#pragma unroll
                        for (int n = 0; n < 2; ++n) { const int ch = (pn - 4) * 256 + bj * 128 + wc * 32 + n * 16 + 4 * fq; const f32x4 v = acc[ai][bj][m][n];
                            u32x2 o; o.x = pk2(v[0], v[1]); o.y = pk2(v[2], v[3]); *(GAS u32x2*)((GAS bf16*)(ws + WS_A1) + (unsigned)row * 512 + ch) = o;
                            if (so) *(GAS f32x4*)(so + ch) = v; }
                } else {
#pragma unroll
                    for (int bj = 0; bj < 2; ++bj)
#pragma unroll
                        for (int n = 0; n < 2; ++n) { const int ch = (pn - 6) * 256 + bj * 128 + wc * 32 + n * 16 + 4 * fq; const f32x4 v = acc[ai][bj][m][n];
                            u32x2 o; o.x = pk2(gelu_tanh(v[0]), gelu_tanh(v[1])); o.y = pk2(gelu_tanh(v[2]), gelu_tanh(v[3])); *(GAS u32x2*)((GAS bf16*)(ws + WS_A2) + (unsigned)row * 512 + ch) = o; }
                }
            }
    }
};

DI float lru_sp8(float lam) { return 8.0f * log1pf(__expf(-lam)); }
DI void lru_chain_item(Frame& F, int li, int b, int n) {
    int tid_ = F.tid; asm volatile("" : "+v"(tid_)); LAUNDER_F(F);
    const int tid = tid_, lane = tid & 63, w = __builtin_amdgcn_readfirstlane(tid >> 6), l15 = lane & 15, l4 = lane >> 4;
    LAS bf16* XC = (LAS bf16*)(F.lds + 0);
    LAS bf16* WB = (LAS bf16*)(F.lds + 9216);
    LAS float* GT = (LAS float*)(F.lds + 27648);
    LAS float* AA = (LAS float*)(F.lds + 61440);
    LAS float* UU = (LAS float*)(F.lds + 77824);
    LAS float* SEGP = (LAS float*)(F.lds + 94208);
    LAS float* SEGH = (LAS float*)(F.lds + 96256);
    LAS float* HC = (LAS float*)(F.lds + 98304);
    const GAS bf16* DX = (const GAS bf16*)(F.ws + WS_A1); const GAS bf16* DG = (const GAS bf16*)(F.ws + WS_A2); GAS bf16* MIX = (GAS bf16*)(F.ws + WS_MIX);
    const GAS float* wa = GIN(23) + ((size_t)(li * 8 + n) * 64) * 64; const GAS float* wx = GIN(25) + ((size_t)(li * 8 + n) * 64) * 64;
    __syncthreads();
    for (int e = tid; e < 4096; e += 512) { const int i = e >> 6, j = e & 63; WB[j * 72 + i] = (bf16)f2bf(wa[e]); WB[(64 + j) * 72 + i] = (bf16)f2bf(wx[e]); }
    if (tid < 64) HC[tid] = 0.f;
    const int t = tid >> 3, c8 = tid & 7, cb = 64 * n + 8 * c8;
    float dw[4][8], dbv[8], bav[8], bxv[8], sp[8];
#pragma unroll
    for (int j = 0; j < 8; ++j) { dbv[j] = GIN(22)[li * 512 + cb + j]; bav[j] = GIN(24)[li * 512 + cb + j]; bxv[j] = GIN(26)[li * 512 + cb + j]; sp[j] = lru_sp8(GIN(27)[li * 512 + cb + j]);
#pragma unroll
        for (int q = 0; q < 4; ++q) dw[q][j] = GIN(21)[(li * 4 + q) * 512 + cb + j]; }
    constexpr int NCH = (T + 63) / 64;
    u32x4 ndx[4], ndg;
#define LC_LOAD(c) do { const int tgl = 64 * (c) + t; _Pragma("unroll") for (int q = 0; q < 4; ++q) { const int ts = tgl - 3 + q; const int tsc = ts < 0 ? 0 : (ts < T ? ts : T - 1); \
        ndx[q] = *(const GAS u32x4*)(DX + (unsigned)(b * T + tsc) * 512u + (unsigned)cb); } \
        ndg = *(const GAS u32x4*)(DG + (unsigned)(b * T + (tgl < T ? tgl : T - 1)) * 512u + (unsigned)cb); } while (0)
    __syncthreads();
    LC_LOAD(0);
    for (int c = 0; c < NCH; ++c) {
        const int tg = 64 * c + t;
        float xc[8];
#pragma unroll
        for (int j = 0; j < 8; ++j) xc[j] = dbv[j];
#pragma unroll
        for (int q = 0; q < 4; ++q) { const int ts = tg - 3 + q; const bool ok = ts >= 0 && ts < T; const unsigned rw[4] = {ndx[q].x, ndx[q].y, ndx[q].z, ndx[q].w};
#pragma unroll
            for (int j = 0; j < 8; ++j) xc[j] += ok ? dw[q][j] * bf2f((rw[j >> 1] >> (16 * (j & 1))) & 0xffffu) : 0.f; }
        const u32x4 dgc = ndg;
        if (c + 1 < NCH) LC_LOAD(c + 1);
        *(LAS bf16x8*)(XC + t * 72 + 8 * c8) = pack8(xc);
        LDS_BAR();
        {
            const bf16x8 b0 = *(const LAS bf16x8*)(WB + (16 * w + l15) * 72 + 8 * l4), b1 = *(const LAS bf16x8*)(WB + (16 * w + l15) * 72 + 32 + 8 * l4);
#pragma unroll
            for (int tt = 0; tt < 4; ++tt) { f32x4 a = {0.f, 0.f, 0.f, 0.f};
                a = MFMA16(*(const LAS bf16x8*)(XC + (16 * tt + l15) * 72 + 8 * l4), b0, a); a = MFMA16(*(const LAS bf16x8*)(XC + (16 * tt + l15) * 72 + 32 + 8 * l4), b1, a);
#pragma unroll
                for (int r = 0; r < 4; ++r) GT[(16 * tt + 4 * l4 + r) * 132 + 16 * w + l15] = a[r]; }
        }
        LDS_BAR();
#pragma unroll
        for (int j = 0; j < 8; ++j) { const float r = sigmoidf_(GT[t * 132 + 8 * c8 + j] + bav[j]), ig = sigmoidf_(GT[t * 132 + 64 + 8 * c8 + j] + bxv[j]);
            const float la = -r * sp[j]; float a = __expf(la); const float x2 = 2.0f * la; const float om = x2 > -0.25f ? neg_expm1_small(x2) : 1.0f - a * a; float dr = sqrtf(fmaxf(om, 0.f)) * ig * xc[j];
            if (tg >= T) { a = 1.0f; dr = 0.f; }
            AA[t * 64 + 8 * c8 + j] = a; UU[t * 64 + 8 * c8 + j] = dr; }
        LDS_BAR();
        {
            const int ch = tid & 63, sg = tid >> 6;
            float av[8], uv[8]; float P = 1.0f, H = 0.f;
#pragma unroll
            for (int i = 0; i < 8; ++i) { av[i] = AA[(8 * sg + i) * 64 + ch]; uv[i] = UU[(8 * sg + i) * 64 + ch]; H = av[i] * H + uv[i]; P *= av[i]; }
            SEGP[sg * 64 + ch] = P; SEGH[sg * 64 + ch] = H;
            LDS_BAR();
            float h = HC[(c & 1) * 64 + ch];
            for (int q = 0; q < sg; ++q) h = SEGP[q * 64 + ch] * h + SEGH[q * 64 + ch];
#pragma unroll
            for (int i = 0; i < 8; ++i) { h = av[i] * h + uv[i]; UU[(8 * sg + i) * 64 + ch] = h; }
            if (sg == 7) HC[((c + 1) & 1) * 64 + ch] = h;
        }
        LDS_BAR();
        if (tg < T) { const unsigned rw[4] = {dgc.x, dgc.y, dgc.z, dgc.w}; float y[8];
#pragma unroll
            for (int j = 0; j < 8; ++j) y[j] = UU[t * 64 + 8 * c8 + j] * bf2f((rw[j >> 1] >> (16 * (j & 1))) & 0xffffu);
            *(GAS bf16x8*)(MIX + (unsigned)(b * T + tg) * 1024u + 512u + (unsigned)cb) = pack8(y); }
    }
#undef LC_LOAD
    __syncthreads();
    if (tid < 64) F.out[O_LP + (size_t)(b * 2 + li) * 512 + 64 * n + tid] = HC[(NCH & 1) * 64 + tid];
}

template <int NV> DI void block_sum2(float (&a)[NV], float (&bq)[NV], LAS float* RED, int wv, int lane) {
#pragma unroll
    for (int i = 0; i < NV; ++i) { a[i] = wave_sum(a[i]); bq[i] = wave_sum(bq[i]); }
    __syncthreads();
    if (lane == 0) {
#pragma unroll
        for (int i = 0; i < NV; ++i) { RED[wv * 2 * NV + i] = a[i]; RED[wv * 2 * NV + NV + i] = bq[i]; } }
    __syncthreads();
#pragma unroll
    for (int i = 0; i < NV; ++i) { float x = 0.f, y = 0.f;
#pragma unroll
        for (int q = 0; q < 8; ++q) { x += RED[q * 2 * NV + i]; y += RED[q * 2 * NV + NV + i]; }
        a[i] = x; bq[i] = y; }
}
DI void convc_item(Frame& F, int li, int b, int blk) {
    int tid_ = F.tid; asm volatile("" : "+v"(tid_)); LAUNDER_F(F);
    const int tid = tid_, lane = tid & 63, wv = __builtin_amdgcn_readfirstlane(tid >> 6), c = tid;
    LAS float* RED = (LAS float*)(F.lds + 0);
    const GAS bf16* U = (const GAS bf16*)(F.ws + WS_A0); GAS bf16* MIX = (GAS bf16*)(F.ws + WS_MIX);
    float cw[31];
#pragma unroll
    for (int j = 0; j < 31; ++j) cw[j] = GIN(17)[(size_t)(li * 31 + j) * 512 + c];
    const float cbv = GIN(18)[li * 512 + c], gln = GIN(19)[li * 512 + c], bln = GIN(20)[li * 512 + c];
    for (int g8 = 0; g8 < 8; ++g8) {
        const int t0 = 64 * blk + 8 * g8; if (t0 >= T) break;
        float val[38];
#pragma unroll
        for (int i = 0; i < 38; ++i) { const int ts = t0 - 30 + i; const bool ok = ts >= 0 && ts < T; const unsigned raw = U[(unsigned)(b * T + (ts < 0 ? 0 : (ts < T ? ts : T - 1))) * 512u + (unsigned)c]; val[i] = ok ? bf2f(raw) : 0.f; }
        float y[8], y2[8];
#pragma unroll
        for (int o = 0; o < 8; ++o) { float a = cbv;
#pragma unroll
            for (int j = 0; j < 31; ++j) a += cw[j] * val[o + j];
            y[o] = a; y2[o] = a * a; }
        float s1[8];
#pragma unroll
        for (int o = 0; o < 8; ++o) s1[o] = y[o];
        block_sum2<8>(s1, y2, RED, wv, lane);
#pragma unroll
        for (int o = 0; o < 8; ++o) { const int tg = t0 + o; if (tg < T) { const float mean = s1[o] * (1.0f / 512.0f); const float var = fmaxf(y2[o] * (1.0f / 512.0f) - mean * mean, 0.f);
            const float z = (y[o] - mean) * rsqrtf(var + LN_EPS) * gln + bln; MIX[(size_t)(b * T + tg) * 1024 + c] = (bf16)f2bf(siluf_(z)); } }
    }
}
DI void odd_sample_item(Frame& F, int li, int s) {
    int tid_ = F.tid; asm volatile("" : "+v"(tid_)); LAUNDER_F(F);
    const int tid = tid_, lane = tid & 63, wv = __builtin_amdgcn_readfirstlane(tid >> 6), c = tid, row = NPR + s;
    LAS float* RED = (LAS float*)(F.lds + 0); LAS float* XS = (LAS float*)(F.lds + 1024);
    GAS bf16* MIX = (GAS bf16*)(F.ws + WS_MIX);
    const GAS float* st = GIN(6) + ((size_t)(s * 2 + li) * 30) * 512 + c; GAS float* so = F.out + O_CS + ((size_t)(s * 2 + li) * 30) * 512 + c;
    float a = GIN(18)[li * 512 + c];
#pragma unroll
    for (int j = 0; j < 30; ++j) { const float v = st[(size_t)j * 512]; a += GIN(17)[(size_t)(li * 31 + j) * 512 + c] * v; if (j >= 1) so[(size_t)(j - 1) * 512] = v; }
    a += GIN(17)[(size_t)(li * 31 + 30) * 512 + c] * so[(size_t)29 * 512];
    float s1[1] = {a}, s2[1] = {a * a};
    block_sum2<1>(s1, s2, RED, wv, lane);
    { const float mean = s1[0] * (1.0f / 512.0f), var = fmaxf(s2[0] * (1.0f / 512.0f) - mean * mean, 0.f);
      const float z = (a - mean) * rsqrtf(var + LN_EPS) * GIN(19)[li * 512 + c] + GIN(20)[li * 512 + c]; MIX[(size_t)row * 1024 + c] = (bf16)f2bf(siluf_(z)); }
    const GAS float* sd = GIN(7) + ((size_t)(s * 2 + li) * 3) * 512 + c; GAS float* sdo = F.out + O_DS + ((size_t)(s * 2 + li) * 3) * 512 + c;
    const float d0 = sd[0], d1 = sd[512], d2 = sd[1024], d3 = sdo[1024];
    sdo[0] = d1; sdo[512] = d2;
    const float xc = GIN(22)[li * 512 + c] + GIN(21)[(li * 4 + 0) * 512 + c] * d0 + GIN(21)[(li * 4 + 1) * 512 + c] * d1 + GIN(21)[(li * 4 + 2) * 512 + c] * d2 + GIN(21)[(li * 4 + 3) * 512 + c] * d3;
    __syncthreads();
    XS[c] = xc;
    __syncthreads();
    const int n = c >> 6, j = c & 63; const GAS float* wa = GIN(23) + ((size_t)(li * 8 + n) * 64) * 64 + j; const GAS float* wx = GIN(25) + ((size_t)(li * 8 + n) * 64) * 64 + j;
    float ra = GIN(24)[li * 512 + c], ia = GIN(26)[li * 512 + c];
#pragma unroll 8
    for (int i = 0; i < 64; ++i) { const float xv = XS[64 * n + i]; ra += xv * wa[(size_t)i * 64]; ia += xv * wx[(size_t)i * 64]; }
    const float r = sigmoidf_(ra), ig = sigmoidf_(ia), la = -r * lru_sp8(GIN(27)[li * 512 + c]);
    const float h = __expf(la) * GIN(8)[(size_t)(s * 2 + li) * 512 + c] + sqrtf(fmaxf(-expm1f(2.0f * la), 0.f)) * ig * xc;
    F.out[O_LS + (size_t)(s * 2 + li) * 512 + c] = h;
    MIX[(size_t)row * 1024 + 512 + c] = (bf16)f2bf(h * bf2f(((const GAS bf16*)(F.ws + WS_A2))[(size_t)row * 512 + c]));
}
NOINL void ph_prologue(Frame F) { frame_fix(F); p_prologue(F); }
DI void ph_evenin(Frame F, int li) { LAUNDER_F(F);
    { EvenIn<false> P; P.A = (const GAS bf16*)(F.ws + WS_XB); P.Bt = (const GAS bf16*)(F.ws + WS_WINE) + (size_t)li * EVEN_PAD * 1024; P.G = F.G; P.c = F.vcu; P.li = li; P.ws = F.ws; P.out = F.out;
      pg8::gemm_phase(F.lds, P); }
    LAUNDER_F(F);
    { EvenIn<true> P; P.A = (const GAS bf16*)(F.ws + WS_XB); P.Bt = (const GAS bf16*)(F.ws + WS_WINE) + (size_t)li * EVEN_PAD * 1024; P.G = F.G; P.c = F.vcu; P.li = li; P.ws = F.ws; P.out = F.out;
      pg8::gemm_phase(F.lds, P); } }
DI void ph_oddin(Frame F, int li) { LAUNDER_F(F);
    OddIn P; P.A = (const GAS bf16*)(F.ws + WS_XB); P.Bt = (const GAS bf16*)(F.ws + WS_WINO) + (size_t)li * ODD_IN * 1024; P.G = F.G; P.c = F.vcu; P.li = li; P.ws = F.ws; P.out = F.out;
    pg8::gemm_phase(F.lds, P); }
DI void ph_outproj(Frame F, int layer) { LAUNDER_F(F);
    OutProj P; P.A = (const GAS bf16*)(F.ws + WS_MIX); P.Bt = (const GAS bf16*)(F.ws + ((layer & 1) ? WS_WOUTO : WS_WOUTE)) + (size_t)(layer >> 1) * 1024 * 1024; P.G = F.G; P.c = F.vcu; P.X = (GAS float*)(F.ws + WS_X);
    pg8::gemm_phase(F.lds, P); }
DI void ph_moeup(Frame F, int layer) { LAUNDER_F(F); moe_setup(F, layer);
    MoeUp P; P.A = (const GAS bf16*)(F.ws + WS_XB); P.G = F.G; P.c = F.vcu; P.layer = layer; P.ws = F.ws; P.MISC = F.MISC;
    pg8::gemm_phase(F.lds, P); }
DI void ph_moedown(Frame F, int layer) { LAUNDER_F(F); moe_setup(F, layer);
    MoeDown P; P.A = (const GAS bf16*)(F.ws + WS_H); P.G = F.G; P.c = F.vcu; P.layer = layer; P.ws = F.ws; P.MISC = F.MISC;
    pg8::gemm_phase(F.lds, P); }
DI void ph_ln1(Frame F, int layer) { LAUNDER_F(F); p_ln(F, layer, false, false); }
NOINL void ph_ln2(Frame F, int layer, int fin) { frame_fix(F); p_ln(F, rfl(layer), true, rfl(fin) != 0); }
DI void it_hgrn_prompt(Frame F, int li, int b, int h) { hgrn_prompt_item(F, li, b, h); }
NOINL void it_hgrn_sample(Frame F, int li, int sq) { frame_fix(F); hgrn_sample_item(F, rfl(li), rfl(sq)); }
DI void it_dsa_prompt(Frame F, int b, int q0, int nqh) { dsa_prompt_item(F, b, q0, nqh); }
DI void it_dsa_sample(Frame F, int li, int sq) { dsa_sample_item(F, li, sq); }
DI void it_lru_chain(Frame F, int li, int b, int n) { lru_chain_item(F, li, b, n); }
DI void it_convc(Frame F, int li, int b, int blk) { convc_item(F, li, b, blk); }
NOINL void it_odd_sample(Frame F, int li, int sq) { frame_fix(F); odd_sample_item(F, rfl(li), rfl(sq)); }
#if PROBE_TS
#define PT_MARK(slot) do { const unsigned long long _t = __builtin_amdgcn_s_memrealtime(); if (F.tid == 0 && qidx == 0) atomicMax(F.ctl + 20000 + (slot), (unsigned)(_t - _t0)); } while (0)
#else
#define PT_MARK(slot) do { } while (0)
#endif
DI void p_even_mixer(Frame& F, int li, int qidx) {
    constexpr int E0 = 32, E1 = E0 + 8 * 33, E2 = E1 + NSM, E3 = E2 + 8 * 16, E4 = E3 + NSM;
#if PROBE_TS
    const unsigned long long _t0 = __builtin_amdgcn_s_memrealtime();
#endif
    int it = q_pop(F, qidx);
    while (it < E0) { it_hgrn_prompt(F, li, it >> 2, it & 3); it = q_pop(F, qidx); PT_MARK(0); }
    while (it < E3) {
        if (it >= E1 && it < E2) { it_dsa_sample(F, li, it - E1); PT_MARK(2); }
        else if (it < E1) { const int j = it - E0; it_dsa_prompt(F, j & 7, 1024 + 32 * (32 - (j >> 3)), 1); PT_MARK(1); }
        else { const int j = it - E2; it_dsa_prompt(F, j & 7, 64 * (15 - (j >> 3)), 2); PT_MARK(1); }
        it = q_pop(F, qidx);
    }
    while (it < E4) { it_hgrn_sample(F, li, it - E3); it = q_pop(F, qidx); PT_MARK(3); }
}
DI void p_odd_mixer(Frame& F, int li, int qidx) {
    constexpr int E0 = 64, E1 = E0 + 8 * 33, E2 = E1 + NSM;
#if PROBE_TS
    const unsigned long long _t0 = __builtin_amdgcn_s_memrealtime();
#endif
    int it = q_pop(F, qidx);
#if PROBE_TS
    if (F.tid == 0 && qidx == 1) atomicMax(F.ctl + 20000 + 4, 0u);
#define PT_MARK2(slot) do { const unsigned long long _t = __builtin_amdgcn_s_memrealtime(); if (F.tid == 0 && qidx == 1) atomicMax(F.ctl + 20000 + (slot), (unsigned)(_t - _t0)); } while (0)
#else
#define PT_MARK2(slot) do { } while (0)
#endif
    while (it < E0) { it_lru_chain(F, li, it >> 3, it & 7); it = q_pop(F, qidx); PT_MARK2(4); }
    while (it < E1) { const int j = it - E0; it_convc(F, li, j & 7, j >> 3); it = q_pop(F, qidx); PT_MARK2(5); }
    while (it < E2) { it_odd_sample(F, li, it - E1); it = q_pop(F, qidx); PT_MARK2(6); }
}

constexpr int NPHASE = 29;
__global__ void __launch_bounds__(512, 2) mega(Args args) {
    Frame F;
    F.lds = (LAS unsigned char*)lds_raw; F.MISC = (volatile LAS unsigned*)(F.lds + MISC_OFF);
    F.tid = threadIdx.x; F.lane = F.tid & 63; F.wave = __builtin_amdgcn_readfirstlane(F.tid >> 6);
    F.G = gridDim.x; F.wg = blockIdx.x; F.vcu = (F.G % 8 == 0) ? (F.wg % 8) * (F.G / 8) + F.wg / 8 : F.wg;
    F.in = ((const Args*)__builtin_amdgcn_kernarg_segment_ptr())->in; F.out = (GAS float*)args.out; F.ws = (GAS unsigned char*)args.ws; F.ctl = (unsigned*)(args.ws + WS_CTL);
    for (int u = F.tid; u < (LDS_BYTES - MISC_OFF) / 4; u += 512) ((LAS unsigned*)(F.lds + MISC_OFF))[u] = 0u;
    __syncthreads();
    const int lo = args.ph_lo, hi = args.ph_hi;
    const bool multi = (hi - lo) > 1;
    XcdBarrier bar; bar.bar = F.ctl + CW_BAR; bar.x = 0; bar.st = nullptr;
    if (multi) bar = xcd_barrier_post(F.ctl + CW_BAR, F.MISC + 8);
#define IN(k) (lo <= (k) && (k) < hi)
#if PROBE_TS
    const unsigned fillv = __builtin_bit_cast(unsigned, args.out[O_END - 1]);
    const unsigned long long t00 = __builtin_amdgcn_s_memrealtime();
#define SEAM(k) do { if (IN(k) && IN((k) + 1)) xcd_barrier_call(bar.bar, bar.x, bar.st); if (F.tid == 0) F.MISC[128 + (k)] = (unsigned)(__builtin_amdgcn_s_memrealtime() - t00); } while (0)
#else
#define SEAM(k) do { if (IN(k) && IN((k) + 1)) xcd_barrier_call(bar.bar, bar.x, bar.st); } while (0)
#endif
    if (IN(0)) ph_prologue(F);
    SEAM(0);
    for (int layer = 0; layer < 4; ++layer) {
        const int pb = 1 + layer * 7, li = layer >> 1;
        if (IN(pb + 0)) { if (!(layer & 1)) ph_evenin(F, li); else ph_oddin(F, li); }
        SEAM(pb + 0);
        if (IN(pb + 1)) { if (!(layer & 1)) p_even_mixer(F, li, layer); else p_odd_mixer(F, li, layer); }
        SEAM(pb + 1);
        if (IN(pb + 2)) ph_outproj(F, layer);
        SEAM(pb + 2);
        if (IN(pb + 3)) ph_ln1(F, layer);
        SEAM(pb + 3);
        if (IN(pb + 4)) ph_moeup(F, layer);
        SEAM(pb + 4);
        if (IN(pb + 5)) ph_moedown(F, layer);
        SEAM(pb + 5);
        if (IN(pb + 6)) ph_ln2(F, layer, layer == 3 ? 1 : 0);
        SEAM(pb + 6);
    }
#if PROBE_TS
    xcd_barrier_call(bar.bar, bar.x, bar.st);
    if (F.wg == 0) {
        __syncthreads();
        const size_t offs[7] = {O_YP, O_KP, O_VP, O_IP, O_HP, O_HS, O_CS};
        for (int i = 0; i < 7; ++i) {
            const int k = PROBE_BASE + i; if (k >= NPHASE) break;
            unsigned t1 = F.MISC[128 + k], t0 = k > 0 ? F.MISC[128 + k - 1] : 0u;
            if (PROBE_TS == 2 || PROBE_TS == 4) { t0 = 0u; t1 = __hip_atomic_load(F.ctl + 20000 + i, __ATOMIC_RELAXED, __HIP_MEMORY_SCOPE_AGENT); }
            unsigned n = (t1 - t0) / 1600u;
            if (PROBE_TS == 3) n = __hip_atomic_load(F.ctl + 20000 + i, __ATOMIC_RELAXED, __HIP_MEMORY_SCOPE_AGENT) / (256u * 400u); if (n > 60000u) n = 60000u; if (n < 1u) n = 1u;
            for (unsigned j = F.tid; j < n; j += 512) ((unsigned*)args.out)[offs[i] + j] = fillv;
        }
        for (unsigned j = F.tid; j < (unsigned)(NSM * 2 * 512); j += 512) ((unsigned*)args.out)[O_LS + j] = fillv;
    }
#endif
}

extern "C" void kernel_launch(void* const* d_in, const int* in_sizes, int n_in, void* d_out, int out_size, void* d_ws, size_t ws_size, hipStream_t stream) {
    static int grid = 0;
    if (!grid) {
        int dev = 0, cus = 0, per_cu = 0;
        (void)hipGetDevice(&dev); (void)hipDeviceGetAttribute(&cus, hipDeviceAttributeMultiprocessorCount, dev);
        (void)hipFuncSetAttribute((const void*)mega, hipFuncAttributeMaxDynamicSharedMemorySize, LDS_BYTES);
        (void)hipOccupancyMaxActiveBlocksPerMultiprocessor(&per_cu, (const void*)mega, 512, LDS_BYTES);
        if (per_cu < 1) fprintf(stderr, "occupancy query says %d\n", per_cu);
        grid = cus > 0 ? cus : 256;
        if (n_in != 39 || (size_t)out_size != O_END || ws_size < WS_END) fprintf(stderr, "kernel_launch: unexpected sizes n_in %d out %d ws %zu (need %zu)\n", n_in, out_size, ws_size, (size_t)WS_END);
    }
    (void)hipMemsetAsync((char*)d_ws + WS_CTL, 0, CTL_BYTES, stream);
    Args a; memset(&a, 0, sizeof(a));
    for (int i = 0; i < 39; ++i) a.in[i] = (const float*)d_in[i];
    a.out = (float*)d_out; a.ws = (unsigned char*)d_ws;
    a.ph_lo = 0; a.ph_hi = NPHASE;
    hipLaunchKernelGGL(mega, dim3(grid), dim3(512), LDS_BYTES, stream, a);
}
```

```cpp
#include <hip/hip_runtime.h>
#include <cstdio>
#include <cstdint>
#include <cstring>
#ifndef PROBE_TS
#define PROBE_TS 0
#endif
#ifndef PROBE_BASE
#define PROBE_BASE 0
#endif

#define GAS __attribute__((address_space(1)))
#define LAS __attribute__((address_space(3)))
typedef unsigned short bf16;
typedef short bf16x8 __attribute__((ext_vector_type(8)));
typedef float f32x4 __attribute__((ext_vector_type(4)));
typedef float f32x2 __attribute__((ext_vector_type(2)));
typedef float f32x16 __attribute__((ext_vector_type(16)));
typedef unsigned u32x4 __attribute__((ext_vector_type(4)));
typedef unsigned u32x2 __attribute__((ext_vector_type(2)));
typedef unsigned long long u64;
#define DI __device__ __forceinline__

constexpr int D = 1024, NB = 8, SEQ = 2048, NMETA = 16, T = NMETA + SEQ  , NPR = NB * T  , NSM = 128, M = NPR + NSM  ;
constexpr int PAST = 2048, PAGE = 128, NPAGES = 16, NPHYS = 2560;
constexpr int EVEN_IN = 3400, EVEN_PAD = 3584, ODD_IN = 2048;
constexpr int NCLS = 24, CLS_CAP = M, MAXPAN = 96;
constexpr float DN_ALPHA = 1.681792830507429f;
constexpr float LN_EPS = 1e-5f, RMS_EPS = 1e-6f;

constexpr size_t O_YP = 0, O_YS = O_YP + (size_t)NB * SEQ * D, O_KP = O_YS + (size_t)NSM * D, O_VP = O_KP + (size_t)NPR * 256, O_IP = O_VP + (size_t)NPR * 256,
    O_HP = O_IP + (size_t)NPR * 128, O_CP = O_HP + (size_t)NB * 2 * 4 * 128 * 128, O_DP = O_CP + (size_t)NB * 2 * 30 * 512, O_LP = O_DP + (size_t)NB * 2 * 3 * 512,
    O_KS = O_LP + (size_t)NB * 2 * 512, O_VS = O_KS + (size_t)NSM * 256, O_IS = O_VS + (size_t)NSM * 256, O_HS = O_IS + (size_t)NSM * 128,
    O_CS = O_HS + (size_t)NSM * 2 * 4 * 128 * 128, O_DS = O_CS + (size_t)NSM * 2 * 30 * 512, O_LS = O_DS + (size_t)NSM * 2 * 3 * 512, O_END = O_LS + (size_t)NSM * 2 * 512;

constexpr size_t MiB = 1u << 20;
constexpr size_t WS_CTL = 0, CTL_BYTES = 1 * MiB;
constexpr size_t WS_WINE = 2 * MiB;
constexpr size_t WS_WOUTE = WS_WINE + 2ull * EVEN_PAD * 1024 * 2;
constexpr size_t WS_WINO = WS_WOUTE + 2ull * 1024 * 1024 * 2;
constexpr size_t WS_WOUTO = WS_WINO + 2ull * 2048 * 1024 * 2;
constexpr size_t WS_WGU = WS_WOUTO + 2ull * 1024 * 1024 * 2;
constexpr size_t WS_WD = WS_WGU + 64ull * 512 * 1024 * 2;
constexpr size_t WS_X = WS_WD + 64ull * 1024 * 256 * 2;
constexpr size_t WS_XB = WS_X + (size_t)M * D * 4;
constexpr size_t WS_MIX = WS_XB + (size_t)M * D * 2;
constexpr size_t WS_A0 = WS_MIX + (size_t)M * D * 2;
constexpr size_t WS_A1 = WS_A0 + (size_t)M * 512 * 2;
constexpr size_t WS_A2 = WS_A1 + (size_t)M * 512 * 2;
constexpr size_t WS_A3 = WS_A2 + (size_t)M * 512 * 2;
constexpr size_t WS_LF = WS_A3 + (size_t)M * 512 * 2;
constexpr size_t WS_QB = WS_LF + (size_t)M * 512 * 4;
constexpr size_t WS_QI = WS_QB + (size_t)M * 512 * 2;
constexpr size_t WS_KBB = WS_QI + (size_t)M * 512 * 2;
constexpr size_t WS_KIB = WS_KBB + (size_t)M * 128 * 2;
constexpr size_t WS_WI = WS_KIB + (size_t)M * 64 * 2;
constexpr int TP = 2112;
constexpr size_t WS_VT = WS_WI + (size_t)M * 8 * 4;
constexpr size_t WS_ROPE = WS_VT + 8ull * 2 * 64 * TP * 2;
constexpr size_t WS_LB = WS_ROPE + 2ull * T * 32 * 4;
constexpr size_t WS_H = WS_LB + 2ull * 3 * 512 * 4;
constexpr size_t WS_TOK = WS_H + (size_t)MAXPAN * 256 * 512 * 2;
constexpr size_t WS_GATE = WS_TOK + (size_t)NCLS * CLS_CAP * 4;
constexpr size_t WS_D = (WS_GATE + (size_t)M * 2 * 4 + 4095) / 4096 * 4096;
constexpr size_t WS_SC = WS_D + (size_t)M * D * 2;
constexpr size_t WS_END = WS_SC + 256ull * 64 * TP * 4;

constexpr int CW_BAR = 4096;
constexpr int CW_Q = 8192;
constexpr int CW_CNT = 12288;

constexpr int RING_BYTES = 131072, MISC_OFF = RING_BYTES, LDS_BYTES = 147456;

typedef __bf16 bf16v2 __attribute__((ext_vector_type(2)));
DI unsigned pk2(float lo, float hi) { const f32x2 v = {lo, hi}; return __builtin_bit_cast(unsigned, __builtin_convertvector(v, bf16v2)); }
DI unsigned f2bf(float f) { return pk2(f, 0.f) & 0xffffu; }
DI float bf2f(unsigned b) { return __builtin_bit_cast(float, b << 16); }
DI float frcp(float x) { return __builtin_amdgcn_rcpf(x); }
DI float sigmoidf_(float x) { return frcp(1.0f + __expf(-x)); }
DI float siluf_(float x) { return x * frcp(1.0f + __expf(-x)); }
DI float gelu_tanh(float x) { const float u = 0.7978845608028654f * (x + 0.044715f * x * x * x); const float e = __expf(2.0f * u); const float th = 1.0f - 2.0f * frcp(e + 1.0f); return 0.5f * x * (1.0f + th); }
DI float neg_expm1_small(float x) { const float p = 1.0f + x * (0.5f + x * (0.16666667f + x * (0.041666668f + x * (0.0083333338f + x * 0.0013888889f)))); return -x * p; }
DI float dppf(float v, int ctrl_sel) {
    const int x = __builtin_bit_cast(int, v);
    const int r = ctrl_sel == 0 ? __builtin_amdgcn_update_dpp(0, x, 0xB1, 0xf, 0xf, false) : ctrl_sel == 1 ? __builtin_amdgcn_update_dpp(0, x, 0x4E, 0xf, 0xf, false)
                : ctrl_sel == 2 ? __builtin_amdgcn_update_dpp(0, x, 0x141, 0xf, 0xf, false) : __builtin_amdgcn_update_dpp(0, x, 0x140, 0xf, 0xf, false);
    return __builtin_bit_cast(float, r);
}
DI float row_sum16(float v) { v += dppf(v, 0); v += dppf(v, 1); v += dppf(v, 2); v += dppf(v, 3); return v; }
DI float rlf(float v, int l) { return __builtin_bit_cast(float, __builtin_amdgcn_readlane(__builtin_bit_cast(int, v), l)); }
DI float wave_sum(float v) { v = row_sum16(v); return (rlf(v, 0) + rlf(v, 16)) + (rlf(v, 32) + rlf(v, 48)); }

#define XB_TMO      128
#define XB_XCNT(j)  (256  + 64 * (j))
#define XB_XSUB(j)  (1280 + 64 * (j))
#define XB_XGEN(j)  (2304 + 64 * (j))
#define XB_TOP      3328
#define XB_TOPGEN   3392
#define XCD_BAR_WORDS 3456
#define XB_SPIN_CAP (1u << 18)
__device__ __forceinline__ unsigned xb_ld(unsigned* p)              { return __hip_atomic_load(p, __ATOMIC_RELAXED, __HIP_MEMORY_SCOPE_AGENT); }
__device__ __forceinline__ unsigned xb_add(unsigned* p, unsigned v) { return __hip_atomic_fetch_add(p, v, __ATOMIC_RELAXED, __HIP_MEMORY_SCOPE_AGENT); }
__device__ __forceinline__ unsigned xb_xcc_id() { return (unsigned)__builtin_amdgcn_s_getreg((3 << 11) | 20) & 0xFu; }
#define XB_SPIN(cond, bar) do { unsigned _sp = 0; while (cond) { __builtin_amdgcn_s_sleep(1); \
    if ((++_sp & 255u) == 0u) { if (xb_ld(&(bar)[XB_TMO])) break; if (_sp > XB_SPIN_CAP) { atomicAdd(&(bar)[XB_TMO], 1u); break; } } } } while (0)
struct XcdBarrier { unsigned* bar; unsigned x; volatile LAS unsigned* st; };
__device__ __forceinline__ XcdBarrier xcd_barrier_post(unsigned* bar, volatile LAS unsigned* st) {
    XcdBarrier b; b.bar = bar; b.x = xb_xcc_id(); b.st = st;
    if (threadIdx.x == 0) (void)xb_add(&bar[XB_XCNT(b.x)], 1u);
    return b;
}
__device__ __forceinline__ void xcd_barrier_complete(unsigned* bar, unsigned x, unsigned& nloc, unsigned& nx) {
    const unsigned G = gridDim.x * gridDim.y * gridDim.z;
    unsigned sum, cnt, mine, sp = 0u;
    for (;;) {
        sum = 0u; cnt = 0u; mine = 0u;
#pragma unroll
        for (unsigned j = 0; j < 16; ++j) { const unsigned c = xb_ld(&bar[XB_XCNT(j)]); sum += c; cnt += (c > 0u) ? 1u : 0u; mine = (j == x) ? c : mine; }
        if (sum == G) break;
        __builtin_amdgcn_s_sleep(1);
        if ((++sp & 255u) == 0u) { if (xb_ld(&bar[XB_TMO])) break; if (sp > XB_SPIN_CAP) { atomicAdd(&bar[XB_TMO], 1u); break; } }
    }
    nloc = mine > 0u ? mine : 1u; nx = cnt > 0u ? cnt : 1u;
}
__device__ __forceinline__ void xcd_barrier(const XcdBarrier& b) {
    asm volatile("s_waitcnt vmcnt(0)" ::: "memory");
    __syncthreads();
    if (threadIdx.x == 0) {
        unsigned* bar = b.bar;
        __builtin_amdgcn_s_waitcnt(0);
        unsigned nloc = b.st[0], nx = b.st[1];
        if (nloc == 0u) { xcd_barrier_complete(bar, b.x, nloc, nx); b.st[0] = nloc; b.st[1] = nx; }
        const unsigned old = xb_add(&bar[XB_XSUB(b.x)], 1u);
        const unsigned gen = old / nloc;
        if (old + 1u == (gen + 1u) * nloc) {
            __builtin_amdgcn_fence(__ATOMIC_RELEASE, "agent");
            asm volatile("s_waitcnt vmcnt(0)" ::: "memory");
            const unsigned og = xb_add(&bar[XB_TOP], 1u);
            const unsigned tg = og / nx;
            if (og + 1u == (tg + 1u) * nx) xb_add(&bar[XB_TOPGEN], 1u);
            else XB_SPIN(xb_ld(&bar[XB_TOPGEN]) == tg, bar);
            __builtin_amdgcn_fence(__ATOMIC_ACQUIRE, "agent");
            xb_add(&bar[XB_XGEN(b.x)], 1u);
            asm volatile("s_waitcnt vmcnt(0)" ::: "memory");
        } else {
            XB_SPIN(xb_ld(&bar[XB_XGEN(b.x)]) == gen, bar);
            __builtin_amdgcn_fence(__ATOMIC_ACQUIRE, "agent");
            asm volatile("s_waitcnt vmcnt(0)" ::: "memory");
        }
    }
    __syncthreads();
}

__device__ __attribute__((noinline)) void xcd_barrier_call(unsigned* bar, unsigned x, volatile LAS unsigned* st) { XcdBarrier b; b.bar = bar; b.x = x; b.st = st; xcd_barrier(b); }
struct Args { const float* in[39]; float* out; unsigned char* ws; int ph_lo, ph_hi; };
#define GIN(k) ((const GAS float*)F.in[(k)])
#define LAUNDER_F(F) asm volatile("" : "+s"((F).in), "+s"((F).ws), "+s"((F).out), "+s"((F).ctl), "+s"((F).vcu), "+s"((F).G), "+s"((F).wg))
struct Frame {
    LAS unsigned char* lds; volatile LAS unsigned* MISC; unsigned* ctl;
    int tid, lane, wave, G, wg, vcu;
    const float* const* in; GAS float* out; GAS unsigned char* ws;
};
extern __shared__ __attribute__((aligned(16))) unsigned char lds_raw[];
#define NOINL __device__ __attribute__((noinline))
DI int rfl(int v) { return __builtin_amdgcn_readfirstlane(v); }
template <class Pt> DI Pt rfl_ptr(Pt p) { const u64 v = (u64)p; const unsigned lo = (unsigned)rfl((int)(unsigned)v), hi = (unsigned)rfl((int)(unsigned)(v >> 32)); return (Pt)(((u64)hi << 32) | lo); }
DI void frame_fix(Frame& F) {
    F.lds = (LAS unsigned char*)lds_raw; F.MISC = (volatile LAS unsigned*)(F.lds + MISC_OFF);
    F.tid = threadIdx.x; F.lane = F.tid & 63; F.wave = rfl(F.tid >> 6);
    F.G = rfl(F.G); F.wg = rfl(F.wg); F.vcu = rfl(F.vcu);
    F.ctl = rfl_ptr(F.ctl); F.in = rfl_ptr(F.in); F.out = rfl_ptr(F.out); F.ws = rfl_ptr(F.ws);
}

namespace pg8 {
constexpr int BM = 256, BK = 64, HALF = 128, HTB = HALF * BK * 2, STAGE_BYTES = 8 * HTB, NXCD = 8, WGM = 8;
__host__ __device__ __forceinline__ int lds_byte(int r, int c) { const int st = (r >> 4) * 2 + (c >> 5), rr = r & 15, cc = c & 31, ob = rr * 64 + cc * 2; return st * 1024 + (ob ^ (((ob >> 9) & 1) << 5)); }
__host__ __device__ __forceinline__ void stage_rc(int b, int& R, int& C) { const int st = b / 1024, sb = b % 1024, swz = sb ^ (((sb >> 9) & 1) << 5); R = (st >> 1) * 16 + swz / 64; C = (st & 1) * 32 + (swz % 64) / 2; }
struct Unit { int pm, pn; const GAS char* B0; const GAS char* B1; int aux; };
template <int nM, int nN> DI bool static_next(int G, int c, int i, int& pm, int& pn) {
    const int L = i * G + c; if (L >= nM * nN) return false;
    pm = L / nN; pn = L % nN; return true;
}
template <class P>
__device__ __forceinline__ void gemm_phase(LAS unsigned char* lds, const P& pb) {
    int tid_ = threadIdx.x; asm volatile("" : "+v"(tid_));
    const int tid = tid_, wid = __builtin_amdgcn_readfirstlane(tid >> 6), lane = tid & 63, wr = wid >> 2, wc = wid & 3, fr = lane & 15, fq = lane >> 4;
    constexpr int K = P::K, nt = K / BK;
    int sR[2], sC[2]; unsigned voffA[2], voffB[2];
#pragma unroll
    for (int i = 0; i < 2; ++i) { stage_rc(tid * 16 + i * 8192, sR[i], sC[i]); voffB[i] = (unsigned)(sR[i] * P::ldb + sC[i]) * 2u; voffA[i] = (unsigned)(sR[i] * P::lda + sC[i]) * 2u; }
    constexpr size_t kstep = (size_t)(BK * 2);
    constexpr size_t hstepB = (size_t)HALF * P::ldb * 2, hstepA = (size_t)HALF * P::lda * 2, tstepA = 2 * hstepA;
    const unsigned ldsw = (unsigned)wid * 1024u;
    const int aoff = lds_byte(wr * 64 + fr, fq * 8), boff = lds_byte(wc * 32 + fr, fq * 8);
#define PG8_SA(b, h) (((b) * 2 + (h)) * HTB)
#define PG8_SB(b, h) ((4 + (b) * 2 + (h)) * HTB)
#define PG8_STAGE(bufoff, gbase, voff) do { _Pragma("unroll") for (int _i = 0; _i < 2; ++_i) \
        __builtin_amdgcn_global_load_lds((const GAS unsigned*)((const GAS char*)(gbase) + (voff)[_i]), (LAS unsigned*)(lds + (bufoff) + ldsw + _i * 8192), 16, 0, 0); } while (0)
#define PG8_STAGE_A(bufoff, gbase, h, G_) do { if constexpr (P::GATHER) { PG8_STAGE(bufoff, gbase, (G_)[h]); } else { PG8_STAGE(bufoff, (gbase) + (h) * hstepA, voffA); } } while (0)
#define PG8_LDA(dst, b, h) do { _Pragma("unroll") for (int m = 0; m < 4; ++m) _Pragma("unroll") for (int k = 0; k < 2; ++k) dst[m][k] = *(const LAS bf16x8*)(lds + PG8_SA(b, h) + aoff + m * 2048 + k * 1024); } while (0)
#define PG8_LDB(dst, b, h) do { _Pragma("unroll") for (int n = 0; n < 2; ++n) _Pragma("unroll") for (int k = 0; k < 2; ++k) dst[n][k] = *(const LAS bf16x8*)(lds + PG8_SB(b, h) + boff + n * 2048 + k * 1024); } while (0)
#define PG8_MMA(ai, bj, At, Bt) do { __builtin_amdgcn_s_setprio(1); _Pragma("unroll") for (int m = 0; m < 4; ++m) _Pragma("unroll") for (int n = 0; n < 2; ++n) _Pragma("unroll") for (int k = 0; k < 2; ++k) \
        acc[ai][bj][m][n] = __builtin_amdgcn_mfma_f32_16x16x32_bf16(Bt[n][k], At[m][k], acc[ai][bj][m][n], 0, 0, 0); __builtin_amdgcn_s_setprio(0); } while (0)
#define PG8_WAIT_V(n) asm volatile("s_waitcnt vmcnt(" #n ")" ::: "memory")
#define PG8_WAIT_L(n) asm volatile("s_waitcnt lgkmcnt(" #n ")" ::: "memory")
#define PG8_BAR __builtin_amdgcn_s_barrier()
#define PG8_SCHED __builtin_amdgcn_sched_barrier(0)
    Unit cur, nxt; int ui = 0;
    if (!pb.next(0, cur)) return;
    f32x4 acc[2][2][4][2];
#pragma unroll
    for (int a = 0; a < 2; ++a)
#pragma unroll
        for (int b = 0; b < 2; ++b)
#pragma unroll
            for (int m = 0; m < 4; ++m)
#pragma unroll
                for (int n = 0; n < 2; ++n) acc[a][b][m][n] = (f32x4){0.f, 0.f, 0.f, 0.f};
    bf16x8 At[4][2], B0[2][2], B1[2][2];
    unsigned gA[2][2] = {{0u, 0u}, {0u, 0u}};
    if constexpr (P::GATHER) {
#pragma unroll
        for (int h = 0; h < 2; ++h)
#pragma unroll
            for (int i = 0; i < 2; ++i) gA[h][i] = pb.a_row(cur, 128 * h + sR[i]) + (unsigned)sC[i] * 2u;
    }
    const GAS char* cA = (const GAS char*)pb.A + (P::GATHER ? (size_t)0 : (size_t)cur.pm * tstepA);
    PG8_STAGE(PG8_SB(0, 0), cur.B0, voffB); PG8_STAGE_A(PG8_SA(0, 0), cA, 0, gA); PG8_STAGE(PG8_SB(0, 1), cur.B0 + hstepB, voffB); PG8_STAGE_A(PG8_SA(0, 1), cA, 1, gA);
    if (wr == 1) PG8_BAR;
    PG8_WAIT_V(4); PG8_BAR;
    PG8_STAGE(PG8_SB(1, 0), cur.B0 + kstep, voffB); PG8_STAGE_A(PG8_SA(1, 0), cA + kstep, 0, gA); PG8_STAGE(PG8_SB(1, 1), cur.B0 + hstepB + kstep, voffB);
    PG8_WAIT_V(6); PG8_BAR;
    for (;;) {
        const bool has_next = pb.next(ui + 1, nxt);
        if (!has_next) nxt = cur;
        const GAS char* nA = (const GAS char*)pb.A + (P::GATHER ? (size_t)0 : (size_t)nxt.pm * tstepA);
#pragma unroll 1
        for (int t = 0; t < nt; t += 2) {
            const bool last = (t == nt - 2);
            const GAS char* a1 = cA + (size_t)(t + 1) * kstep;
            const GAS char* a2 = last ? nA : cA + (size_t)(t + 2) * kstep;
            const GAS char* a3 = a2 + kstep;
            const GAS char* b2;
            if constexpr (P::SPLITB) b2 = last ? nxt.B0 : ((t + 2 < pb.KSPLIT) ? cur.B0 : cur.B1) + (size_t)(t + 2) * kstep;
            else b2 = last ? nxt.B0 : cur.B0 + (size_t)(t + 2) * kstep;
            const GAS char* b3 = b2 + kstep;
            PG8_LDB(B0, 0, 0); PG8_SCHED; PG8_LDA(At, 0, 0); PG8_STAGE_A(PG8_SA(1, 1), a1, 1, gA);
            PG8_WAIT_L(8); PG8_BAR; PG8_WAIT_L(0); PG8_MMA(0, 0, At, B0); PG8_BAR; PG8_SCHED;
            if constexpr (P::GATHER) { if (last) {
#pragma unroll
                for (int h = 0; h < 2; ++h)
#pragma unroll
                    for (int i = 0; i < 2; ++i) gA[h][i] = pb.a_row(nxt, 128 * h + sR[i]) + (unsigned)sC[i] * 2u; } }
            PG8_LDB(B1, 0, 1); PG8_STAGE(PG8_SB(0, 0), b2, voffB);
            PG8_BAR; PG8_WAIT_L(0); PG8_MMA(0, 1, At, B1); PG8_BAR;
            PG8_LDA(At, 0, 1); PG8_STAGE_A(PG8_SA(0, 0), a2, 0, gA);
            PG8_BAR; PG8_WAIT_L(0); PG8_MMA(1, 0, At, B0); PG8_BAR; PG8_SCHED;
            PG8_STAGE(PG8_SB(0, 1), b2 + hstepB, voffB);
            PG8_WAIT_V(6); PG8_BAR; PG8_MMA(1, 1, At, B1); PG8_BAR;
            PG8_LDB(B0, 1, 0); PG8_SCHED; PG8_LDA(At, 1, 0); PG8_STAGE_A(PG8_SA(0, 1), a2, 1, gA);
            PG8_WAIT_L(8); PG8_BAR; PG8_WAIT_L(0); PG8_MMA(0, 0, At, B0); PG8_BAR; PG8_SCHED;
            PG8_LDB(B1, 1, 1); PG8_STAGE(PG8_SB(1, 0), b3, voffB);
            PG8_BAR; PG8_WAIT_L(0); PG8_MMA(0, 1, At, B1); PG8_BAR;
            PG8_LDA(At, 1, 1); PG8_STAGE_A(PG8_SA(1, 0), a3, 0, gA);
            PG8_BAR; PG8_WAIT_L(0); PG8_MMA(1, 0, At, B0); PG8_BAR; PG8_SCHED;
            PG8_STAGE(PG8_SB(1, 1), b3 + hstepB, voffB);
            PG8_WAIT_V(6); PG8_BAR; PG8_MMA(1, 1, At, B1); PG8_BAR;
        }
        pb.epi(acc, cur, wr, wc, fr, fq);
        if (!has_next) break;
#pragma unroll
        for (int a = 0; a < 2; ++a)
#pragma unroll
            for (int b = 0; b < 2; ++b)
#pragma unroll
                for (int m = 0; m < 4; ++m)
#pragma unroll
                    for (int n = 0; n < 2; ++n) acc[a][b][m][n] = (f32x4){0.f, 0.f, 0.f, 0.f};
        cur = nxt; cA = nA; ++ui;
    }
    PG8_WAIT_V(0);
    if (wr == 0) PG8_BAR;
    PG8_BAR;
#undef PG8_SA
#undef PG8_SB
#undef PG8_STAGE
#undef PG8_STAGE_A
#undef PG8_LDA
#undef PG8_LDB
#undef PG8_MMA
#undef PG8_WAIT_V
#undef PG8_WAIT_L
#undef PG8_BAR
#undef PG8_SCHED
}
}
typedef f32x4 AccT[2][2][4][2];

DI int swap45(int s) { return (s & ~48) | ((s & 16) << 1) | ((s & 32) >> 1); }
DI int map_even(int s) {
    if (s < 2048) return s;
    if (s < 2688) { const int r = s - 2048; return 2048 + (r & ~63) + swap45(r & 63); }
    if (s < 2816) return s;
    if (s < 3392) { const int r = s - 2816; return 2816 + (r & ~63) + swap45(r & 63); }
    if (s < EVEN_IN) return s;
    return -1;
}
DI int map_odd(int s) {
    if (s >= 1024) return s;
    const int u = s >> 8, r = s & 255; return r < 128 ? 128 * u + r : 512 + 128 * u + (r - 128);
}
DI void transpose_item(const GAS float* W, int ldn, int K, GAS bf16* WT, int k0, int n0, int mode, int coloff, LAS float* scr, int lane) {
    int col = n0 + (lane & 31);
    if (mode == 1) col = map_even(col); else if (mode == 2) col = map_odd(col); else col += coloff;
    const bool okc = col >= 0; const GAS float* wp = W + (size_t)(k0 + (lane >> 5)) * ldn + (okc ? col : 0);
    float tv[32];
#pragma unroll
    for (int i = 0; i < 32; ++i) tv[i] = wp[(size_t)(2 * i) * ldn];
#pragma unroll
    for (int i = 0; i < 32; ++i) { const int kk = 2 * i + (lane >> 5); scr[kk * 33 + (lane & 31)] = okc ? tv[i] : 0.f; }
    asm volatile("s_waitcnt lgkmcnt(0)" ::: "memory");
    const int c = lane & 7;
#pragma unroll
    for (int j = 0; j < 4; ++j) { const int n = (lane >> 3) + 8 * j; const LAS float* s = scr + (8 * c) * 33 + n;
        u32x4 o; o.x = pk2(s[0 * 33], s[1 * 33]); o.y = pk2(s[2 * 33], s[3 * 33]); o.z = pk2(s[4 * 33], s[5 * 33]); o.w = pk2(s[6 * 33], s[7 * 33]);
        *(GAS u32x4*)(WT + (size_t)(n0 + n) * K + k0 + 8 * c) = o; }
    asm volatile("s_waitcnt lgkmcnt(0)" ::: "memory");
}
DI void p_prologue(Frame& F) {
    LAUNDER_F(F);
#if PROBE_TS == 4
    const unsigned long long _tp0 = __builtin_amdgcn_s_memrealtime();
#endif
    LAS float* scr = (LAS float*)(F.lds + F.wave * 16384);
    const int gw = F.wg * 8 + F.wave, NGW = F.G * 8, lane = F.lane;
    constexpr int I_WINE = 2 * 16 * (EVEN_PAD / 32), I_WOUT = 2 * 16 * 32, I_WINO = 2 * 16 * 64, I_WGU = 64 * 16 * 16, I_WD = 64 * 4 * 32;
    constexpr int NIT = I_WINE + I_WOUT + I_WINO + I_WOUT + I_WGU + I_WD;
    for (int it = gw; it < NIT; it += NGW) {
        asm volatile("" ::: "memory");
        int r = it; asm volatile("" : "+v"(r));
        const GAS float* W; GAS bf16* WT; int ldn, K, k0, n0, mode = 0, coloff = 0;
        if (r < I_WINE) { const int li = r / (I_WINE / 2); r %= (I_WINE / 2); const int kb = r / (EVEN_PAD / 32), nb = r % (EVEN_PAD / 32);
            W = GIN(11) + (size_t)li * 1024 * EVEN_IN; ldn = EVEN_IN; K = 1024; WT = (GAS bf16*)(F.ws + WS_WINE) + (size_t)li * EVEN_PAD * 1024; k0 = 64 * kb; n0 = 32 * nb; mode = 1; }
        else if ((r -= I_WINE) < I_WOUT) { const int li = r / (I_WOUT / 2); r %= (I_WOUT / 2); const int kb = r / 32, nb = r % 32;
            W = GIN(12) + (size_t)li * 1024 * 1024; ldn = 1024; K = 1024; WT = (GAS bf16*)(F.ws + WS_WOUTE) + (size_t)li * 1024 * 1024; k0 = 64 * kb; n0 = 32 * nb; }
        else if ((r -= I_WOUT) < I_WINO) { const int li = r / (I_WINO / 2); r %= (I_WINO / 2); const int kb = r / 64, nb = r % 64;
            W = GIN(15) + (size_t)li * 1024 * 2048; ldn = 2048; K = 1024; WT = (GAS bf16*)(F.ws + WS_WINO) + (size_t)li * 2048 * 1024; k0 = 64 * kb; n0 = 32 * nb; mode = 2; }
        else if ((r -= I_WINO) < I_WOUT) { const int li = r / (I_WOUT / 2); r %= (I_WOUT / 2); const int kb = r / 32, nb = r % 32;
            W = GIN(16) + (size_t)li * 1024 * 1024; ldn = 1024; K = 1024; WT = (GAS bf16*)(F.ws + WS_WOUTO) + (size_t)li * 1024 * 1024; k0 = 64 * kb; n0 = 32 * nb; }
        else if ((r -= I_WOUT) < I_WGU) { const int le = r / 256; r %= 256; const int kb = r / 16, nb = r % 16;
            const int s0 = 32 * nb, jj = s0 >> 8, rr = s0 & 255; const bool up = rr >= 128; const int c0 = 128 * jj + (up ? rr - 128 : rr);
            W = (up ? GIN(37) : GIN(36)) + (size_t)le * 1024 * 256; ldn = 256; K = 1024; WT = (GAS bf16*)(F.ws + WS_WGU) + (size_t)le * 512 * 1024; k0 = 64 * kb; n0 = s0; coloff = c0 - s0; }
        else { r -= I_WGU; const int le = r / 128; r %= 128; const int kb = r / 32, nb = r % 32;
            W = GIN(38) + (size_t)le * 256 * 1024; ldn = 1024; K = 256; WT = (GAS bf16*)(F.ws + WS_WD) + (size_t)le * 1024 * 256; k0 = 64 * kb; n0 = 32 * nb; }
        transpose_item(W, ldn, K, WT, k0, n0, mode, coloff, scr, lane);
    }
#if PROBE_TS == 4
    if (F.tid == 0) atomicMax(F.ctl + 20000, (unsigned)(__builtin_amdgcn_s_memrealtime() - _tp0));
#endif
    GAS bf16* XB = (GAS bf16*)(F.ws + WS_XB);
    for (int m = gw; m < M; m += NGW) {
        const GAS float* src;
        if (m < NPR) { const int b = m / T, t = m % T; src = t < NMETA ? GIN(10) + (size_t)t * D : GIN(0) + ((size_t)b * SEQ + (t - NMETA)) * D; }
        else src = GIN(1) + (size_t)(m - NPR) * D;
#pragma unroll
        for (int j = 0; j < 4; ++j) { const f32x4 v = *((const GAS f32x4*)src + lane + 64 * j);
            u32x2 o; o.x = pk2(v.x, v.y); o.y = pk2(v.z, v.w); *((GAS u32x2*)(XB + (size_t)m * D) + lane + 64 * j) = o; }
    }
#if PROBE_TS == 4
    if (F.tid == 0) atomicMax(F.ctl + 20001, (unsigned)(__builtin_amdgcn_s_memrealtime() - _tp0));
#endif
    GAS float* RC = (GAS float*)(F.ws + WS_ROPE); GAS float* RS = RC + T * 32;
    for (int e = F.wg * 512 + F.tid; e < T * 32; e += F.G * 512) {
        const int pos = e >> 5, i = e & 31;
        const float inv = exp2f(-(float)i * (13.287712379549449f / 32.0f));
        const double ang = (double)((float)pos * inv);
        const double kq = rint(ang * 0.15915494309189535);
        const double rr = fma(-kq, 6.283185307179586, ang) - kq * 2.4492935982947064e-16;
        const float rf = (float)rr;
        RC[e] = cosf(rf); RS[e] = sinf(rf);
    }
#if PROBE_TS == 4
    if (F.tid == 0) atomicMax(F.ctl + 20002, (unsigned)(__builtin_amdgcn_s_memrealtime() - _tp0));
#endif
    GAS float* LB = (GAS float*)(F.ws + WS_LB);
    for (int e = F.wg * 512 + F.tid; e < 2 * 512; e += F.G * 512) {
        const int li = e >> 9, c = e & 511;
        const float l0 = GIN(13)[c], l1 = GIN(13)[512 + c];
        const float lb = li == 0 ? 0.f : 1.0f / (1.0f + expf(l0 - l1));
        LB[(li * 3 + 0) * 512 + c] = logf(fmaxf(lb, 1e-30f)); LB[(li * 3 + 1) * 512 + c] = log1pf(-lb); LB[(li * 3 + 2) * 512 + c] = 1.0f - lb;
    }
}

template <bool ROPE> struct EvenIn {
    static constexpr bool GATHER = false, SPLITB = false; static constexpr int KSPLIT = 0, K = 1024, lda = 1024, ldb = 1024;
    const GAS bf16* A; const GAS bf16* Bt; int G, c, li; GAS unsigned char* ws; GAS float* out;
    DI bool next(int i, pg8::Unit& u) const { if (!pg8::static_next<M / 256, 7>(G, c, i, u.pm, u.pn)) return false;
        if (ROPE) u.pn += 7;
        u.B0 = (const GAS char*)(Bt + (size_t)u.pn * 256 * 1024); u.B1 = u.B0; u.aux = 0; return true; }
    DI void epi(const AccT& acc, const pg8::Unit& u, int wr, int wc, int fr, int fq) const {
        asm volatile("" : "+v"(fr), "+v"(fq));
        const int pn = u.pn;
        const int rbase = u.pm * 256 + wr * 64 + fr;
        if constexpr (!ROPE) {
            GAS bf16* dst = (GAS bf16*)(ws + (pn < 2 ? WS_A0 : pn < 4 ? WS_A1 : pn < 6 ? WS_A2 : WS_A3));
            GAS float* LF = (GAS float*)(ws + WS_LF); const GAS float* LB = (const GAS float*)(ws + WS_LB) + li * 3 * 512;
#pragma unroll
            for (int bj = 0; bj < 2; ++bj)
#pragma unroll
                for (int n = 0; n < 2; ++n) {
                    const int col = (pn & 1) * 256 + bj * 128 + wc * 32 + n * 16 + 4 * fq;
                    f32x4 la = {0, 0, 0, 0}, lb1 = {0, 0, 0, 0}, lc = {0, 0, 0, 0};
                    if (pn == 2 || pn == 3) { la = *(const GAS f32x4*)(LB + col); lb1 = *(const GAS f32x4*)(LB + 512 + col); lc = *(const GAS f32x4*)(LB + 1024 + col); }
#pragma unroll
                    for (int ai = 0; ai < 2; ++ai)
#pragma unroll
                        for (int m = 0; m < 4; ++m) {
                            const int row = rbase + ai * 128 + m * 16; const f32x4 v = acc[ai][bj][m][n]; float o[4];
                            if (pn < 2 || pn >= 6) {
#pragma unroll
                                for (int j = 0; j < 4; ++j) o[j] = siluf_(v[j]);
                            } else if (pn < 4) {
                                f32x4 lf;
#pragma unroll
                                for (int j = 0; j < 4; ++j) { const float z = v[j]; const float e = __expf(-fabsf(z)); const float l1p = __logf(1.0f + e);
                                    const float ls = fminf(z, 0.f) - l1p;
                                    const float bb = lb1[j] + ls, aa = la[j]; const float mx = fmaxf(aa, bb);
                                    lf[j] = mx + __logf(1.0f + __expf(-fabsf(aa - bb)));
                                    const float sg = (z >= 0.f ? e : 1.0f) * frcp(1.0f + e);
                                    o[j] = lc[j] * sg; }
                                *(GAS f32x4*)(LF + (unsigned)row * 512 + col) = lf;
                            } else {
#pragma unroll
                                for (int j = 0; j < 4; ++j) o[j] = v[j];
                            }
                            u32x2 w; w.x = pk2(o[0], o[1]); w.y = pk2(o[2], o[3]); *(GAS u32x2*)(dst + (unsigned)row * 512 + col) = w;
                        }
                    asm volatile("" ::: "memory");
                }
        } else if (pn == 7) {
            GAS bf16* dst = (GAS bf16*)(ws + WS_A3);
#pragma unroll
            for (int bj = 0; bj < 2; ++bj)
#pragma unroll
                for (int n = 0; n < 2; ++n) { const int col = 256 + bj * 128 + wc * 32 + n * 16 + 4 * fq;
#pragma unroll
                    for (int ai = 0; ai < 2; ++ai)
#pragma unroll
                        for (int m = 0; m < 4; ++m) { const int row = rbase + ai * 128 + m * 16; const f32x4 v = acc[ai][bj][m][n];
                            u32x2 w; w.x = pk2(siluf_(v[0]), siluf_(v[1])); w.y = pk2(siluf_(v[2]), siluf_(v[3])); *(GAS u32x2*)(dst + (unsigned)row * 512 + col) = w; } }
        } else {
        const GAS float* RC = (const GAS float*)(ws + WS_ROPE); const GAS float* RS = RC + T * 32;
        const int i0 = 16 * (wc & 1) + 4 * fq;
#pragma unroll
        for (int ai = 0; ai < 2; ++ai)
#pragma unroll
            for (int m = 0; m < 4; ++m) {
                const int row = rbase + ai * 128 + m * 16;
                const int pos = row < NPR ? row % T : PAST;
                const f32x4 cs = *(const GAS f32x4*)(RC + pos * 32 + i0), sn = *(const GAS f32x4*)(RS + pos * 32 + i0);
#pragma unroll
                for (int bj = 0; bj < 2; ++bj) {
                    const f32x4 x1 = acc[ai][bj][m][0], x2 = acc[ai][bj][m][1];
                    const f32x4 r1 = x1 * cs - x2 * sn, r2 = x2 * cs + x1 * sn;
                    const int hd = bj * 2 + (wc >> 1);
                    if (pn == 8 || pn == 9) {
                        GAS bf16* Q = (GAS bf16*)(ws + WS_QB) + (unsigned)row * 512 + (pn - 8) * 256 + hd * 64 + i0;
                        u32x2 w; w.x = pk2(r1[0] * 0.125f, r1[1] * 0.125f); w.y = pk2(r1[2] * 0.125f, r1[3] * 0.125f); *(GAS u32x2*)Q = w;
                        w.x = pk2(r2[0] * 0.125f, r2[1] * 0.125f); w.y = pk2(r2[2] * 0.125f, r2[3] * 0.125f); *(GAS u32x2*)(Q + 32) = w;
                    } else if (pn == 11 || pn == 12) {
                        GAS bf16* Q = (GAS bf16*)(ws + WS_QI) + (unsigned)row * 512 + (pn - 11) * 256 + hd * 64 + i0;
                        u32x2 w; w.x = pk2(r1[0], r1[1]); w.y = pk2(r1[2], r1[3]); *(GAS u32x2*)Q = w;
                        w.x = pk2(r2[0], r2[1]); w.y = pk2(r2[2], r2[3]); *(GAS u32x2*)(Q + 32) = w;
                    } else if (pn == 10) {
                        if (bj == 0) {
                            const int g = wc >> 1;
                            GAS float* KO = row < NPR ? out + O_KP + ((unsigned)row * 2 + li) * 128 + g * 64 + i0 : out + O_KS + ((unsigned)(row - NPR) * 2 + li) * 128 + g * 64 + i0;
                            *(GAS f32x4*)KO = r1; *(GAS f32x4*)(KO + 32) = r2;
                            GAS bf16* KB = (GAS bf16*)(ws + WS_KBB) + (unsigned)row * 128 + g * 64 + i0;
                            u32x2 w; w.x = pk2(r1[0], r1[1]); w.y = pk2(r1[2], r1[3]); *(GAS u32x2*)KB = w;
                            w.x = pk2(r2[0], r2[1]); w.y = pk2(r2[2], r2[3]); *(GAS u32x2*)(KB + 32) = w;
                        } else {
#pragma unroll
                            for (int n = 0; n < 2; ++n) {
                                const int sl = wc * 32 + n * 16 + 4 * fq; const f32x4 v = n ? x2 : x1;
                                GAS float* VO = row < NPR ? out + O_VP + ((unsigned)row * 2 + li) * 128 + sl : out + O_VS + ((unsigned)(row - NPR) * 2 + li) * 128 + sl;
                                *(GAS f32x4*)VO = v;
                                if (row < NPR) { const int b = row / T, t = row % T; GAS bf16* VT = (GAS bf16*)(ws + WS_VT) + ((unsigned)(b * 2 + (sl >> 6)) * 64 + (sl & 63)) * TP + t;
#pragma unroll
                                    for (int j = 0; j < 4; ++j) VT[(unsigned)j * TP] = (bf16)f2bf(v[j]); }
                            }
                        }
                    } else {
                        if (bj == 0 && wc < 2) {
                            GAS float* KO = row < NPR ? out + O_IP + ((unsigned)row * 2 + li) * 64 + i0 : out + O_IS + ((unsigned)(row - NPR) * 2 + li) * 64 + i0;
                            *(GAS f32x4*)KO = r1; *(GAS f32x4*)(KO + 32) = r2;
                            GAS bf16* KB = (GAS bf16*)(ws + WS_KIB) + (unsigned)row * 64 + i0;
                            u32x2 w; w.x = pk2(r1[0], r1[1]); w.y = pk2(r1[2], r1[3]); *(GAS u32x2*)KB = w;
                            w.x = pk2(r2[0], r2[1]); w.y = pk2(r2[2], r2[3]); *(GAS u32x2*)(KB + 32) = w;
                        } else if (bj == 0 && wc == 2 && fq < 2) {
                            const float sc = 0.125f * 0.35355339059327373f;
                            *(GAS f32x4*)((GAS float*)(ws + WS_WI) + (unsigned)row * 8 + 4 * fq) = x1 * sc;
                        }
                    }
                }
                if (m & 1) asm volatile("" ::: "memory");
            }
        }
    }
};

DI int q_pop(Frame& F, int qidx) {
    __syncthreads();
    if (F.tid == 0) F.MISC[0] = __hip_atomic_fetch_add(F.ctl + CW_Q + 64 * qidx, 1u, __ATOMIC_RELAXED, __HIP_MEMORY_SCOPE_AGENT);
    __syncthreads();
    return (int)F.MISC[0];
}
#define MFMA16(a, b, c) __builtin_amdgcn_mfma_f32_16x16x32_bf16((a), (b), (c), 0, 0, 0)
#define MFMA32(a, b, c) __builtin_amdgcn_mfma_f32_32x32x16_bf16((a), (b), (c), 0, 0, 0)
DI bf16x8 pack8(const float (&v)[8]) { u32x4 p; p.x = pk2(v[0], v[1]); p.y = pk2(v[2], v[3]); p.z = pk2(v[4], v[5]); p.w = pk2(v[6], v[7]); return __builtin_bit_cast(bf16x8, p); }

#define LDS_BAR() do { asm volatile("s_waitcnt lgkmcnt(0)" ::: "memory"); __builtin_amdgcn_s_barrier(); asm volatile("" ::: "memory"); } while (0)
DI void hgrn_prompt_item(Frame& F, int li, int b, int h) {
    constexpr int P1 = 136, P2 = 40;
    LAS bf16* QS = (LAS bf16*)(F.lds + 0);
    LAS bf16* KH = (LAS bf16*)(F.lds + 8704);
    LAS bf16* KDT = (LAS bf16*)(F.lds + 17408);
    LAS bf16* VTL = (LAS bf16*)(F.lds + 27648);
    LAS bf16* PM = (LAS bf16*)(F.lds + 37888);
    LAS bf16* ST = (LAS bf16*)(F.lds + 40448);
    LAS float* OF = (LAS float*)(F.lds + 75264);
    LAS float* BSEG = (LAS float*)(F.lds + 92160);
    LAS float* DF = (LAS float*)(F.lds + 94208);
    int tid_ = F.tid; asm volatile("" : "+v"(tid_)); LAUNDER_F(F);
    const int tid = tid_, lane = tid & 63, w = __builtin_amdgcn_readfirstlane(tid >> 6), k = (w & 1) * 64 + lane, seg = w >> 1  , l15 = lane & 15, l4 = lane >> 4;
    const GAS bf16* QA = (const GAS bf16*)(F.ws + WS_A0); const GAS bf16* KA = (const GAS bf16*)(F.ws + WS_A1); const GAS bf16* VA = (const GAS bf16*)(F.ws + WS_A2); const GAS bf16* GA = (const GAS bf16*)(F.ws + WS_A3);
    const GAS float* LF = (const GAS float*)(F.ws + WS_LF); GAS bf16* MIX = (GAS bf16*)(F.ws + WS_MIX);
    const int t4 = tid >> 4, part = tid & 15;
    float ng[8];
#pragma unroll
    for (int j = 0; j < 8; ++j) ng[j] = GIN(14)[li * 128 + 8 * part + j];
    f32x4 S[8];
#pragma unroll
    for (int i = 0; i < 8; ++i) S[i] = (f32x4){0.f, 0.f, 0.f, 0.f};
    float clf[8], cq[8], ck[8], cv[8], nlf[8]; unsigned nq[8], nk[8], nv[8]; u32x4 gcur, gnext;
    const unsigned colb = (unsigned)(h * 128 + k);
    const unsigned gcol = (unsigned)(h * 128 + 8 * part);
#define HG_LOAD(c) do { _Pragma("unroll") for (int i = 0; i < 8; ++i) { const int t = 32 * (c) + 8 * seg + i; const unsigned o = (unsigned)(b * T + (t < T ? t : T - 1)) * 512u + colb; \
        nlf[i] = LF[o]; nq[i] = QA[o]; nk[i] = KA[o]; nv[i] = VA[o]; } \
        { const int t = 32 * (c) + t4; gnext = *(const GAS u32x4*)(GA + (unsigned)(b * T + (t < T ? t : T - 1)) * 512u + gcol); } } while (0)
#define HG_TAKE(c) do { _Pragma("unroll") for (int i = 0; i < 8; ++i) { const bool ok = 32 * (c) + 8 * seg + i < T; clf[i] = ok ? nlf[i] : 0.f; cq[i] = ok ? bf2f(nq[i]) : 0.f; ck[i] = ok ? bf2f(nk[i]) : 0.f; cv[i] = ok ? bf2f(nv[i]) : 0.f; } gcur = gnext; } while (0)
    __syncthreads();
    HG_LOAD(0);
    constexpr int NCH = (T + 31) / 32;
    for (int c = 0; c < NCH; ++c) {
        HG_TAKE(c);
        if (c + 1 < NCH) HG_LOAD(c + 1);
        float cs[8]; float run = 0.f;
#pragma unroll
        for (int i = 0; i < 8; ++i) { run += clf[i]; cs[i] = run; }
        BSEG[seg * 128 + k] = run;
        LDS_BAR();
        float pre = 0.f, tot = 0.f;
#pragma unroll
        for (int sgi = 0; sgi < 4; ++sgi) { const float v = BSEG[sgi * 128 + k]; tot += v; if (sgi < seg) pre += v; }
        float kd[8];
#pragma unroll
        for (int i = 0; i < 8; ++i) { const float bb = pre + cs[i]; const int t = 8 * seg + i;
            QS[t * P1 + k] = (bf16)f2bf(cq[i] * __expf(bb)); KH[t * P1 + k] = (bf16)f2bf(ck[i] * __expf(-bb)); kd[i] = ck[i] * __expf(tot - bb); }
        *(LAS bf16x8*)(KDT + k * P2 + 8 * seg) = pack8(kd);
        *(LAS bf16x8*)(VTL + k * P2 + 8 * seg) = pack8(cv);
        if (seg == 0) DF[k] = __expf(tot);
#pragma unroll
        for (int i = 0; i < 8; ++i) { u32x2 o; o.x = pk2(S[i][0], S[i][1]); o.y = pk2(S[i][2], S[i][3]); *(LAS u32x2*)(ST + (16 * w + l15) * P1 + 16 * i + 4 * l4) = o; }
        LDS_BAR();
        if (w < 4) {
            const int ti = w >> 1, tj = w & 1; f32x4 pacc = {0.f, 0.f, 0.f, 0.f};
            if (tj <= ti) {
#pragma unroll
                for (int ks = 0; ks < 4; ++ks) { const bf16x8 a = *(const LAS bf16x8*)(QS + (16 * ti + l15) * P1 + 32 * ks + 8 * l4); const bf16x8 bb = *(const LAS bf16x8*)(KH + (16 * tj + l15) * P1 + 32 * ks + 8 * l4); pacc = MFMA16(a, bb, pacc); }
            }
#pragma unroll
            for (int r = 0; r < 4; ++r) { const int t = 16 * ti + 4 * l4 + r, sidx = 16 * tj + l15; PM[t * P2 + sidx] = (bf16)f2bf(sidx <= t ? pacc[r] : 0.f); }
        }
        LDS_BAR();
        {
            const bf16x8 bv = *(const LAS bf16x8*)(VTL + (16 * w + l15) * P2 + 8 * l4);
#pragma unroll
            for (int ti = 0; ti < 2; ++ti) {
                f32x4 o = {0.f, 0.f, 0.f, 0.f};
                o = MFMA16(*(const LAS bf16x8*)(PM + (16 * ti + l15) * P2 + 8 * l4), bv, o);
#pragma unroll
                for (int ks = 0; ks < 4; ++ks) o = MFMA16(*(const LAS bf16x8*)(QS + (16 * ti + l15) * P1 + 32 * ks + 8 * l4), *(const LAS bf16x8*)(ST + (16 * w + l15) * P1 + 32 * ks + 8 * l4), o);
#pragma unroll
                for (int r = 0; r < 4; ++r) OF[(16 * ti + 4 * l4 + r) * 132 + 16 * w + l15] = o[r];
            }
#pragma unroll
            for (int i = 0; i < 8; ++i) { const f32x4 d = *(const LAS f32x4*)(DF + 16 * i + 4 * l4); f32x4 sc = S[i] * d;
                S[i] = MFMA16(*(const LAS bf16x8*)(KDT + (16 * i + l15) * P2 + 8 * l4), bv, sc); }
        }
        LDS_BAR();
        {
            const int tg = 32 * c + t4;
            float o[8]; float ss = 0.f;
            { const f32x4 o0 = *(const LAS f32x4*)(OF + t4 * 132 + 8 * part), o1 = *(const LAS f32x4*)(OF + t4 * 132 + 8 * part + 4); o[0] = o0[0]; o[1] = o0[1]; o[2] = o0[2]; o[3] = o0[3]; o[4] = o1[0]; o[5] = o1[1]; o[6] = o1[2]; o[7] = o1[3]; }
#pragma unroll
            for (int j = 0; j < 8; ++j) ss += o[j] * o[j];
            ss += __shfl_xor(ss, 1); ss += __shfl_xor(ss, 2); ss += __shfl_xor(ss, 4); ss += __shfl_xor(ss, 8);
            if (tg < T) { const float rs = rsqrtf(ss * (1.0f / 128.0f) + RMS_EPS);
                const unsigned gw[4] = {gcur.x, gcur.y, gcur.z, gcur.w}; float r8[8];
#pragma unroll
                for (int j = 0; j < 8; ++j) { const float gv = bf2f((gw[j >> 1] >> (16 * (j & 1))) & 0xffffu); r8[j] = o[j] * rs * ng[j] * gv; }
                *(GAS bf16x8*)(MIX + (unsigned)(b * T + tg) * 1024u + gcol) = pack8(r8); }
        }
    }
#undef HG_LOAD
#undef HG_TAKE
    GAS float* HO = F.out + O_HP + ((size_t)((b * 2 + li) * 4 + h) * 128) * 128;
#pragma unroll
    for (int i = 0; i < 8; ++i)
#pragma unroll
        for (int r = 0; r < 4; ++r) HO[(size_t)(16 * i + 4 * l4 + r) * 128 + 16 * w + l15] = S[i][r];
}

DI void hgrn_sample_item(Frame& F, int li, int s, int h) {
    LAS float* RED = (LAS float*)(F.lds + 0);
    int tid_ = F.tid; asm volatile("" : "+v"(tid_)); LAUNDER_F(F);
    const int tid = tid_, lane = tid & 63, kg = tid >> 5, v4 = tid & 31, row = NPR + s;
    const GAS bf16* QA = (const GAS bf16*)(F.ws + WS_A0); const GAS bf16* KA = (const GAS bf16*)(F.ws + WS_A1); const GAS bf16* VA = (const GAS bf16*)(F.ws + WS_A2); const GAS bf16* GA = (const GAS bf16*)(F.ws + WS_A3);
    const GAS float* LF = (const GAS float*)(F.ws + WS_LF); GAS bf16* MIX = (GAS bf16*)(F.ws + WS_MIX); const GAS float* NG = GIN(14) + li * 128;
    {
        const GAS float* S0 = GIN(5) + ((size_t)((s * 2 + li) * 4 + h) * 128) * 128; GAS float* S1 = F.out + O_HS + ((size_t)((s * 2 + li) * 4 + h) * 128) * 128;
        const size_t ro = (size_t)row * 512 + h * 128;
        f32x4 vv; { const u32x2 vr = *(const GAS u32x2*)(VA + ro + 4 * v4); vv = (f32x4){bf2f(vr.x & 0xffffu), bf2f(vr.x >> 16), bf2f(vr.y & 0xffffu), bf2f(vr.y >> 16)}; }
        f32x4 o4 = {0.f, 0.f, 0.f, 0.f};
#pragma unroll
        for (int kk = 0; kk < 8; ++kk) { const int k = 8 * kg + kk; const float dec = __expf(LF[ro + k]), ka = bf2f(KA[ro + k]), q = bf2f(QA[ro + k]);
            const f32x4 sv = *(const GAS f32x4*)(S0 + (size_t)k * 128 + 4 * v4); const f32x4 nv = sv * dec + vv * ka; *(GAS f32x4*)(S1 + (size_t)k * 128 + 4 * v4) = nv; o4 += nv * q; }
        __syncthreads();
        *(LAS f32x4*)(RED + kg * 128 + 4 * v4) = o4;
        __syncthreads();
        if (tid < 64) {
            float oa = 0.f, ob = 0.f;
#pragma unroll
            for (int g = 0; g < 16; ++g) { oa += RED[g * 128 + lane]; ob += RED[g * 128 + 64 + lane]; }
            const float ss = wave_sum(oa * oa + ob * ob); const float rs = rsqrtf(ss * (1.0f / 128.0f) + RMS_EPS);
            MIX[(size_t)row * 1024 + h * 128 + lane] = (bf16)f2bf(oa * rs * NG[lane] * bf2f(GA[ro + lane]));
            MIX[(size_t)row * 1024 + h * 128 + 64 + lane] = (bf16)f2bf(ob * rs * NG[64 + lane] * bf2f(GA[ro + 64 + lane]));
        }
    }
}

DI unsigned ord_key(float v) { const unsigned bits = __builtin_bit_cast(unsigned, v); return (bits & 0x80000000u) ? ~bits : (bits | 0x80000000u); }
DI int dpp_row_sum(int v) {
    v += __builtin_amdgcn_update_dpp(0, v, 0xB1, 0xf, 0xf, false);
    v += __builtin_amdgcn_update_dpp(0, v, 0x4E, 0xf, 0xf, false);
    v += __builtin_amdgcn_update_dpp(0, v, 0x141, 0xf, 0xf, false);
    v += __builtin_amdgcn_update_dpp(0, v, 0x140, 0xf, 0xf, false);
    return v;
}
DI int wave_sum_i(int v) { v = dpp_row_sum(v); return __builtin_amdgcn_readlane(v, 0) + __builtin_amdgcn_readlane(v, 16) + __builtin_amdgcn_readlane(v, 32) + __builtin_amdgcn_readlane(v, 48); }
#define PROBE_CTL ((unsigned*)(((const Args*)__builtin_amdgcn_kernarg_segment_ptr())->ws))
template <int NJ> DI int count_ge(const unsigned (&u)[NJ], unsigned cand) {
    int c0 = 0, c1 = 0, c2 = 0, c3 = 0;
#pragma unroll
    for (int j = 0; j + 3 < NJ; j += 4) { c0 += (u[j] >= cand) ? 1 : 0; c1 += (u[j + 1] >= cand) ? 1 : 0; c2 += (u[j + 2] >= cand) ? 1 : 0; c3 += (u[j + 3] >= cand) ? 1 : 0; }
#pragma unroll
    for (int j = NJ & ~3; j < NJ; ++j) c0 += (u[j] >= cand) ? 1 : 0;
    return wave_sum_i((c0 + c1) + (c2 + c3));
}
template <int NJ> DI u64 select256(const unsigned (&u)[NJ], int lane, LAS unsigned* scr) {
    unsigned Tv = 0u; int c_lo = NJ * 64, c_hi = 0, bit = 31;
    for (; bit >= 1; bit -= 2) {
        if (c_lo - c_hi <= 64) break;
        const unsigned s1 = Tv | (1u << (bit - 1)), s2 = Tv | (2u << (bit - 1)), s3 = Tv | (3u << (bit - 1));
        int a1 = 0, a2 = 0, a3 = 0;
#pragma unroll
        for (int j = 0; j < NJ; ++j) { a1 += (u[j] >= s1) ? 1 : 0; a2 += (u[j] >= s2) ? 1 : 0; a3 += (u[j] >= s3) ? 1 : 0; }
        a1 = dpp_row_sum(a1); a2 = dpp_row_sum(a2); a3 = dpp_row_sum(a3);
        const int n1 = (__builtin_amdgcn_readlane(a1, 0) + __builtin_amdgcn_readlane(a1, 16)) + (__builtin_amdgcn_readlane(a1, 32) + __builtin_amdgcn_readlane(a1, 48));
        const int n2 = (__builtin_amdgcn_readlane(a2, 0) + __builtin_amdgcn_readlane(a2, 16)) + (__builtin_amdgcn_readlane(a2, 32) + __builtin_amdgcn_readlane(a2, 48));
        const int n3 = (__builtin_amdgcn_readlane(a3, 0) + __builtin_amdgcn_readlane(a3, 16)) + (__builtin_amdgcn_readlane(a3, 32) + __builtin_amdgcn_readlane(a3, 48));
        if (n3 >= 256) { Tv = s3; c_lo = n3; }
        else if (n2 >= 256) { Tv = s2; c_lo = n2; c_hi = n3; }
        else if (n1 >= 256) { Tv = s1; c_lo = n1; c_hi = n2; }
        else c_hi = n1;
    }
    for (; bit >= 0; --bit) {
        if (c_lo - c_hi <= 64) break;
        const unsigned cand = Tv | (1u << bit);
        const int c = count_ge<NJ>(u, cand);
        if (c >= 256) { Tv = cand; c_lo = c; } else c_hi = c;
    }
    int cT = c_lo;
    if (bit >= 0) {
        const unsigned width = 2u << bit; int base = 0;
        const u64 ltmask = (1ull << lane) - 1ull;
#pragma unroll
        for (int j = 0; j < NJ; ++j) { const bool in = (u[j] - Tv) < width; const u64 m = __ballot(in);
            const int pos = in ? base + __builtin_popcountll(m & ltmask) : 65;
            scr[pos] = u[j];
            base += __builtin_popcountll(m); }
        asm volatile("s_waitcnt lgkmcnt(0)" ::: "memory");
        const unsigned cv = lane < (c_lo - c_hi) ? scr[lane] : 0u;
        for (; bit >= 0; --bit) { const unsigned cand = Tv | (1u << bit); if (c_hi + __builtin_popcountll(__ballot(cv >= cand)) >= 256) Tv = cand; }
        cT = c_hi + __builtin_popcountll(__ballot(cv >= Tv));
    }
    u64 my = 0ull;
    if (cT == 256) {
#pragma unroll
        for (int j = 0; j < NJ; ++j) { const u64 wd = __ballot(u[j] >= Tv); my = (lane == j) ? wd : my; }
        return my;
    }
    int need = 256 - count_ge<NJ>(u, Tv + 1u);
#pragma unroll
    for (int j = 0; j < NJ; ++j) {
        const u64 gt = __ballot(u[j] > Tv), eq = __ballot(u[j] == Tv); const int c = __builtin_popcountll(eq); u64 take;
        if (c <= need) { take = eq; need -= c; }
        else { take = 0ull; u64 e = eq; for (int z = 0; z < need; ++z) { const u64 low = e & (~e + 1ull); take |= low; e ^= low; } need = 0; }
        const u64 wd = gt | take; my = (lane == j) ? wd : my;
    }
    return my;
}
template <int NJ> DI void dsa_select_rows(const GAS float* SC, LAS u64* MASK, LAS unsigned* scr, int w, int lane, int q0, int rpw) {
    float nx[NJ];
#pragma unroll
    for (int j = 0; j < NJ; ++j) nx[j] = SC[(size_t)(w * rpw) * TP + 64 * j + lane];
    for (int i = 0; i < rpw; ++i) {
        const int q = w * rpw + i, t = q0 + q; LAS u64* mrow = MASK + q * 34;
        unsigned u[NJ];
#pragma unroll
        for (int j = 0; j < NJ; ++j) { const int sidx = 64 * j + lane; u[j] = sidx <= t ? ord_key(nx[j]) : 0u; }
        if (i + 1 < rpw) {
#pragma unroll
            for (int j = 0; j < NJ; ++j) nx[j] = SC[(size_t)(q + 1) * TP + 64 * j + lane]; }
        if (t >= T) { if (lane < 34) mrow[lane] = 0ull; continue; }
        const int jfull = t >> 6, rem = t & 63;
        if (t + 1 <= 256) { if (lane < 34) mrow[lane] = lane < jfull ? ~0ull : (lane == jfull ? ((2ull << rem) - 1ull) : 0ull); continue; }
        const u64 my = select256<NJ>(u, lane, scr);
        if (lane < 34) mrow[lane] = lane < NJ ? my : 0ull;
    }
}

DI float xhalf_max(float x) { const auto r = __builtin_amdgcn_permlane32_swap(__builtin_bit_cast(unsigned, x), __builtin_bit_cast(unsigned, x), false, false); return fmaxf(__builtin_bit_cast(float, r[0]), __builtin_bit_cast(float, r[1])); }
DI float xhalf_sum(float x) { const auto r = __builtin_amdgcn_permlane32_swap(__builtin_bit_cast(unsigned, x), __builtin_bit_cast(unsigned, x), false, false); return __builtin_bit_cast(float, r[0]) + __builtin_bit_cast(float, r[1]); }
DI void dsa_prompt_item(Frame& F, int b, int q0, int nqh) {
    constexpr int QP = 520;
    LAS bf16* QIL = (LAS bf16*)(F.lds + 0);
    LAS u64* MASK = (LAS u64*)(F.lds + 66560);
    int tid_ = F.tid; asm volatile("" : "+v"(tid_)); LAUNDER_F(F);
    const int tid = tid_, lane = tid & 63, w = __builtin_amdgcn_readfirstlane(tid >> 6), l31 = lane & 31, hh = lane >> 5;
    const int nq = (T - q0) < 32 * nqh ? (T - q0) : 32 * nqh, tmax = q0 + nq - 1, nkt = tmax / 32 + 1;
    const GAS bf16* QI = (const GAS bf16*)(F.ws + WS_QI); const GAS bf16* KIB = (const GAS bf16*)(F.ws + WS_KIB); const GAS float* WI = (const GAS float*)(F.ws + WS_WI);
    const GAS bf16* QB = (const GAS bf16*)(F.ws + WS_QB); const GAS bf16* KBB = (const GAS bf16*)(F.ws + WS_KBB); const GAS bf16* VT = (const GAS bf16*)(F.ws + WS_VT); GAS bf16* MIX = (GAS bf16*)(F.ws + WS_MIX);
    GAS float* SC = (GAS float*)(F.ws + WS_SC) + (size_t)F.wg * 64 * TP;
    const size_t rb = (size_t)b * T;
#pragma unroll
    for (int i = 0; i < 8; ++i) { const int e = tid + 512 * i, r = e >> 6, c8 = e & 63; const int t = q0 + r < T ? q0 + r : T - 1;
        *(LAS u32x4*)(QIL + r * QP + 8 * c8) = *(const GAS u32x4*)(QI + (rb + t) * 512 + 8 * c8); }
    __syncthreads();
#if PROBE_TS == 3
    const unsigned long long _ta = __builtin_amdgcn_s_memrealtime();
#endif
    {
        const int qh = nqh == 2 ? (w & 1) : 0, kt0 = nqh == 2 ? (w >> 1) : w, kts = nqh == 2 ? 4 : 8, tq = q0 + 32 * qh + l31, tqc = tq < T ? tq : T - 1;
        float wq[8]; { const f32x4 a = *(const GAS f32x4*)(WI + (rb + tqc) * 8), c = *(const GAS f32x4*)(WI + (rb + tqc) * 8 + 4); wq[0] = a[0]; wq[1] = a[1]; wq[2] = a[2]; wq[3] = a[3]; wq[4] = c[0]; wq[5] = c[1]; wq[6] = c[2]; wq[7] = c[3]; }
        const int tlast = (q0 + 32 * qh + 31) < tmax ? (q0 + 32 * qh + 31) : tmax;
        if (q0 + 32 * qh <= tmax) {
        bf16x8 kan[4];
        { const int key = 32 * kt0 + l31, keyc = key < T ? key : T - 1;
#pragma unroll
          for (int ks = 0; ks < 4; ++ks) kan[ks] = *(const GAS bf16x8*)(KIB + (rb + keyc) * 64 + 16 * ks + 8 * hh); }
        for (int kt = kt0; 32 * kt <= tlast; kt += kts) {
            bf16x8 ka[4];
#pragma unroll
            for (int ks = 0; ks < 4; ++ks) ka[ks] = kan[ks];
            { const int key = 32 * (kt + kts) + l31, keyc = key < T ? key : T - 1;
#pragma unroll
              for (int ks = 0; ks < 4; ++ks) kan[ks] = *(const GAS bf16x8*)(KIB + (rb + keyc) * 64 + 16 * ks + 8 * hh); }
            f32x16 tot;
#pragma unroll
            for (int r = 0; r < 16; ++r) tot[r] = 0.f;
#pragma unroll
            for (int hd = 0; hd < 8; ++hd) {
                asm volatile("" ::: "memory");
                f32x16 a;
#pragma unroll
                for (int r = 0; r < 16; ++r) a[r] = 0.f;
#pragma unroll
                for (int ks = 0; ks < 4; ++ks) a = MFMA32(ka[ks], *(const LAS bf16x8*)(QIL + (32 * qh + l31) * QP + hd * 64 + 16 * ks + 8 * hh), a);
#pragma unroll
                for (int r = 0; r < 16; ++r) tot[r] += wq[hd] * fmaxf(a[r], 0.f);
            }
            if (tq < T) {
#pragma unroll
                for (int g = 0; g < 4; ++g) *(GAS f32x4*)(SC + (size_t)(32 * qh + l31) * TP + 32 * kt + 8 * g + 4 * hh) = (f32x4){tot[4 * g], tot[4 * g + 1], tot[4 * g + 2], tot[4 * g + 3]};
            }
        }
        }
    }
    __syncthreads();
#if PROBE_TS == 3
    const unsigned long long _tb = __builtin_amdgcn_s_memrealtime();
#endif
    {
        LAS unsigned* scr = (LAS unsigned*)(F.lds + 84480) + w * 80;
        const int njn = (tmax >> 6) + 1;
        const int rpw = 4 * nqh;
        if (njn <= 9) dsa_select_rows<9>(SC, MASK, scr, w, lane, q0, rpw);
        else if (njn <= 17) dsa_select_rows<17>(SC, MASK, scr, w, lane, q0, rpw);
        else if (njn <= 25) dsa_select_rows<25>(SC, MASK, scr, w, lane, q0, rpw);
        else dsa_select_rows<33>(SC, MASK, scr, w, lane, q0, rpw);
    }
    __syncthreads();
#if PROBE_TS == 3
    const unsigned long long _tc = __builtin_amdgcn_s_memrealtime();
#endif
    {
        const int hd = w, g = hd >> 2;
        constexpr int KP = 136, VP = 40;
        LAS bf16* KL = (LAS bf16*)(F.lds + 87040);
        LAS bf16* VL = (LAS bf16*)(F.lds + 104448);
        const LAS unsigned* M32 = (const LAS unsigned*)MASK;
        bf16x8 qf[2][4];
#pragma unroll
        for (int qh = 0; qh < 2; ++qh) { const int tq = q0 + 32 * qh + l31, tqc = tq < T ? tq : T - 1;
#pragma unroll
            for (int ks = 0; ks < 4; ++ks) qf[qh][ks] = *(const GAS bf16x8*)(QB + (rb + tqc) * 512 + hd * 64 + 16 * ks + 8 * hh); }
        f32x16 O[2][2]; float mrun[2], lrun[2];
#pragma unroll
        for (int qh = 0; qh < 2; ++qh) { mrun[qh] = -INFINITY; lrun[qh] = 0.f;
#pragma unroll
            for (int dt = 0; dt < 2; ++dt)
#pragma unroll
                for (int r = 0; r < 16; ++r) O[qh][dt][r] = 0.f; }
        const int krow = tid >> 4, kch = tid & 15, vrow = tid >> 2, vch = tid & 3;
        u32x4 sk, sv;
#define DC_LOAD(kt_) do { const int key_ = 32 * (kt_) + krow, keyc_ = key_ < T ? key_ : T - 1; sk = *(const GAS u32x4*)(KBB + (rb + keyc_) * 128 + 8 * kch); \
            sv = *(const GAS u32x4*)(VT + ((size_t)(b * 128 + vrow)) * TP + 32 * (kt_) + 8 * vch); } while (0)
#define DC_STORE(buf_) do { *(LAS u32x4*)(KL + ((buf_) * 32 + krow) * KP + 8 * kch) = sk; *(LAS u32x4*)(VL + ((buf_) * 128 + vrow) * VP + 8 * vch) = sv; } while (0)
        DC_LOAD(0); DC_STORE(0);
        __syncthreads();
        for (int kt = 0; kt < nkt; ++kt) {
            const int buf = kt & 1;
            if (kt + 1 < nkt) DC_LOAD(kt + 1);
#pragma unroll
            for (int qh = 0; qh < 2; ++qh) {
                if (qh >= nqh || 32 * kt > q0 + 32 * qh + 31 || q0 + 32 * qh > tmax) continue;
                f32x16 sa;
#pragma unroll
                for (int r = 0; r < 16; ++r) sa[r] = 0.f;
#pragma unroll
                for (int ks = 0; ks < 4; ++ks) sa = MFMA32(*(const LAS bf16x8*)(KL + (buf * 32 + l31) * KP + g * 64 + 16 * ks + 8 * hh), qf[qh][ks], sa);
                const unsigned mw = M32[(32 * qh + l31) * 68 + kt] >> (4 * hh);
                float mx = -INFINITY;
#pragma unroll
                for (int r = 0; r < 16; ++r) { const bool on = (mw >> ((r & 3) + 8 * (r >> 2))) & 1u; sa[r] = on ? sa[r] : -INFINITY; mx = fmaxf(mx, sa[r]); }
                mx = xhalf_max(mx);
                const float mnew = fmaxf(mrun[qh], mx);
                const float msafe = mnew == -INFINITY ? 0.f : mnew;
                const float alpha = __expf(mrun[qh] - msafe);
                float pr[16]; float rs = 0.f;
#pragma unroll
                for (int r = 0; r < 16; ++r) { pr[r] = __expf(sa[r] - msafe); rs += pr[r]; }
                rs = xhalf_sum(rs);
                lrun[qh] = lrun[qh] * alpha + rs; mrun[qh] = mnew;
                if (!__all(alpha == 1.0f)) {
#pragma unroll
                    for (int dt = 0; dt < 2; ++dt)
#pragma unroll
                        for (int r = 0; r < 16; ++r) O[qh][dt][r] *= alpha;
                }
#pragma unroll
                for (int s2 = 0; s2 < 2; ++s2) {
                    const float pv[8] = {pr[8 * s2], pr[8 * s2 + 1], pr[8 * s2 + 2], pr[8 * s2 + 3], pr[8 * s2 + 4], pr[8 * s2 + 5], pr[8 * s2 + 6], pr[8 * s2 + 7]};
                    const bf16x8 pf = pack8(pv);
#pragma unroll
                    for (int dt = 0; dt < 2; ++dt) { const LAS bf16* vp = VL + (buf * 128 + g * 64 + 32 * dt + l31) * VP + 16 * s2 + 4 * hh;
                        const u32x2 lo = *(const LAS u32x2*)vp, hi = *(const LAS u32x2*)(vp + 8); u32x4 pk; pk.x = lo.x; pk.y = lo.y; pk.z = hi.x; pk.w = hi.y;
                        O[qh][dt] = MFMA32(__builtin_bit_cast(bf16x8, pk), pf, O[qh][dt]); }
                }
            }
            if (kt + 1 < nkt) DC_STORE(buf ^ 1);
            LDS_BAR();
        }
#undef DC_LOAD
#undef DC_STORE
#pragma unroll
        for (int qh = 0; qh < 2; ++qh) { const int tq = q0 + 32 * qh + l31;
            if (qh < nqh && tq < T) { const float inv = frcp(lrun[qh]);
#pragma unroll
                for (int dt = 0; dt < 2; ++dt)
#pragma unroll
                    for (int g4 = 0; g4 < 4; ++g4) { u32x2 o; o.x = pk2(O[qh][dt][4 * g4] * inv, O[qh][dt][4 * g4 + 1] * inv); o.y = pk2(O[qh][dt][4 * g4 + 2] * inv, O[qh][dt][4 * g4 + 3] * inv);
                        *(GAS u32x2*)(MIX + (rb + tq) * 1024 + 512 + hd * 64 + 32 * dt + 8 * g4 + 4 * hh) = o; } } }
    }
#if PROBE_TS == 3
    __syncthreads();
    if (tid == 0) { const unsigned long long _td = __builtin_amdgcn_s_memrealtime(); atomicAdd(F.ctl + 20000, (unsigned)(_tb - _ta)); atomicAdd(F.ctl + 20001, (unsigned)(_tc - _tb)); atomicAdd(F.ctl + 20002, (unsigned)(_td - _tc)); }
#endif
}

DI void dsa_sample_item(Frame& F, int li, int s) {
    LAS float* QIF = (LAS float*)(F.lds + 0);
    LAS float* QBF = (LAS float*)(F.lds + 2048);
    LAS float* WIF = (LAS float*)(F.lds + 4096);
    LAS float* SCL = (LAS float*)(F.lds + 4352);
    LAS int* SEL = (LAS int*)(F.lds + 12800);
    LAS float* LG = (LAS float*)(F.lds + 13824);
    int tid_ = F.tid; asm volatile("" : "+v"(tid_)); LAUNDER_F(F);
    const int tid = tid_, lane = tid & 63, wv = __builtin_amdgcn_readfirstlane(tid >> 6), row = NPR + s;
    const GAS int* PT = (const GAS int*)GIN(9) + s * NPAGES;
    QIF[tid] = bf2f(((const GAS bf16*)(F.ws + WS_QI))[(size_t)row * 512 + tid]);
    QBF[tid] = bf2f(((const GAS bf16*)(F.ws + WS_QB))[(size_t)row * 512 + tid]);
    if (tid < 8) WIF[tid] = ((const GAS float*)(F.ws + WS_WI))[(size_t)row * 8 + tid];
    LAS int* PTL = (LAS int*)(F.lds + 23040);
    if (tid >= 64 && tid < 64 + NPAGES) PTL[tid - 64] = PT[tid - 64];
    __syncthreads();
    {
        const int sub = lane & 15, kq = lane >> 4;
        f32x4 qs[8];
#pragma unroll
        for (int hd = 0; hd < 8; ++hd) qs[hd] = *(const LAS f32x4*)(QIF + hd * 64 + 4 * sub);
        float wv8[8];
#pragma unroll
        for (int hd = 0; hd < 8; ++hd) wv8[hd] = WIF[hd];
        const GAS float* kbase = GIN(4) + (size_t)li * 64 + 4 * sub;
        for (int g0 = 0; g0 < 64; g0 += 8) {
            f32x4 kv[8];
#pragma unroll
            for (int i = 0; i < 8; ++i) { const int n = 256 * wv + 4 * (g0 + i) + kq; const int pg = PTL[n >> 7]; kv[i] = *(const GAS f32x4*)(kbase + (size_t)(pg * PAGE + (n & 127)) * 128); }
#pragma unroll
            for (int i = 0; i < 8; ++i) { float sc = 0.f;
#pragma unroll
                for (int hd = 0; hd < 8; ++hd) { float d = kv[i][0] * qs[hd][0] + kv[i][1] * qs[hd][1] + kv[i][2] * qs[hd][2] + kv[i][3] * qs[hd][3]; d = row_sum16(d); sc += wv8[hd] * fmaxf(d, 0.f); }
                if (sub == 0) SCL[256 * wv + 4 * (g0 + i) + kq] = sc; }
        }
        if (tid < 64) {
            const float kvn = F.out[O_IS + ((size_t)s * 2 + li) * 64 + lane]; float sc = 0.f;
#pragma unroll
            for (int hd = 0; hd < 8; ++hd) { const float d = wave_sum(kvn * QIF[hd * 64 + lane]); sc += WIF[hd] * fmaxf(d, 0.f); }
            if (lane == 0) SCL[2048] = sc;
        }
    }
    __syncthreads();
    if (wv == 0) {
        unsigned u[33];
#pragma unroll
        for (int j = 0; j < 33; ++j) { const int sidx = 64 * j + lane; u[j] = sidx <= PAST ? ord_key(SCL[sidx]) : 0u; }
        const u64 my = select256<33>(u, lane, (LAS unsigned*)(F.lds + 24576));
        int base = 0;
#pragma unroll
        for (int j = 0; j < 33; ++j) { const u64 wd = __shfl(my, j); const bool on = (wd >> lane) & 1ull; const int pos = base + __builtin_popcountll(wd & ((1ull << lane) - 1ull));
            if (on && pos < 256) SEL[pos] = 64 * j + lane; base += __builtin_popcountll(wd); }
    }
    __syncthreads();
    LAS int* ROWID = (LAS int*)(F.lds + 22016);
    if (tid < 256) { const int idx = SEL[tid]; ROWID[tid] = idx < PAST ? PTL[idx >> 7] * PAGE + (idx & 127) : -1; }
    __syncthreads();
    {
        const int n = tid >> 1, g = tid & 1, rid = ROWID[n];
        const GAS float* kp = rid >= 0 ? GIN(2) + ((size_t)rid * 2 + li) * 128 + g * 64 : F.out + O_KS + ((size_t)s * 2 + li) * 128 + g * 64;
        f32x4 kv[16];
#pragma unroll
        for (int dq = 0; dq < 16; ++dq) kv[dq] = *(const GAS f32x4*)(kp + 4 * dq);
        float a4[4] = {0.f, 0.f, 0.f, 0.f};
#pragma unroll
        for (int dq = 0; dq < 16; ++dq) {
#pragma unroll
            for (int i = 0; i < 4; ++i) { const f32x4 qv = *(const LAS f32x4*)(QBF + (4 * g + i) * 64 + 4 * dq); a4[i] += kv[dq][0] * qv[0] + kv[dq][1] * qv[1] + kv[dq][2] * qv[2] + kv[dq][3] * qv[3]; } }
#pragma unroll
        for (int i = 0; i < 4; ++i) LG[(4 * g + i) * 256 + n] = a4[i];
    }
    __syncthreads();
    {
        const int hd = wv; float v[4]; float mx = -INFINITY;
#pragma unroll
        for (int i = 0; i < 4; ++i) { v[i] = LG[hd * 256 + lane + 64 * i]; mx = fmaxf(mx, v[i]); }
#pragma unroll
        for (int o = 1; o < 64; o <<= 1) mx = fmaxf(mx, __shfl_xor(mx, o));
        float sm = 0.f;
#pragma unroll
        for (int i = 0; i < 4; ++i) { v[i] = __expf(v[i] - mx); sm += v[i]; }
        sm = wave_sum(sm); const float inv = frcp(sm);
#pragma unroll
        for (int i = 0; i < 4; ++i) LG[hd * 256 + lane + 64 * i] = v[i] * inv;
    }
    __syncthreads();
    {
        LAS float* PO = (LAS float*)(F.lds + 32768);
        const GAS float* vnew = F.out + O_VS + ((size_t)s * 2 + li) * 128 + lane;
        const GAS float* vbase = GIN(3) + (size_t)li * 128 + lane;
        float v0[32], v1[32];
#pragma unroll
        for (int i = 0; i < 32; ++i) { const int rid = ROWID[32 * wv + i]; const GAS float* vp = rid >= 0 ? vbase + (size_t)rid * 256 : vnew; v0[i] = vp[0]; v1[i] = vp[64]; }
        float o[8];
#pragma unroll
        for (int hd = 0; hd < 8; ++hd) o[hd] = 0.f;
#pragma unroll
        for (int i = 0; i < 32; ++i) {
#pragma unroll
            for (int hd = 0; hd < 8; ++hd) o[hd] += LG[hd * 256 + 32 * wv + i] * (hd < 4 ? v0[i] : v1[i]); }
#pragma unroll
        for (int hd = 0; hd < 8; ++hd) PO[(wv * 8 + hd) * 64 + lane] = o[hd];
        __syncthreads();
        { const int hd = tid >> 6; float a = 0.f;
#pragma unroll
          for (int q = 0; q < 8; ++q) a += PO[(q * 8 + hd) * 64 + lane];
          ((GAS bf16*)(F.ws + WS_MIX))[(size_t)row * 1024 + 512 + hd * 64 + lane] = (bf16)f2bf(a); }
    }
}

struct OutProj {
    static constexpr bool GATHER = false, SPLITB = false; static constexpr int KSPLIT = 0, K = 1024, lda = 1024, ldb = 1024;
    const GAS bf16* A; const GAS bf16* Bt; int G, c; GAS bf16* Dd;
    DI bool next(int i, pg8::Unit& u) const { if (!pg8::static_next<M / 256, 4>(G, c, i, u.pm, u.pn)) return false;
        u.B0 = (const GAS char*)(Bt + (size_t)u.pn * 256 * 1024); u.B1 = u.B0; u.aux = 0; return true; }
    DI void epi(const AccT& acc, const pg8::Unit& u, int wr, int wc, int fr, int fq) const {
        asm volatile("" : "+v"(fr), "+v"(fq));
#pragma unroll
        for (int ai = 0; ai < 2; ++ai)
#pragma unroll
            for (int m = 0; m < 4; ++m) { GAS bf16* rp = Dd + (unsigned)(u.pm * 256 + ai * 128 + wr * 64 + m * 16 + fr) * D + u.pn * 256 + wc * 32 + 4 * fq;
#pragma unroll
                for (int bj = 0; bj < 2; ++bj)
#pragma unroll
                    for (int n = 0; n < 2; ++n) { const f32x4 v = acc[ai][bj][m][n]; u32x2 o; o.x = pk2(v[0], v[1]); o.y = pk2(v[2], v[3]); *(GAS u32x2*)(rp + bj * 128 + n * 16) = o; } }
    }
};

DI void p_ln(Frame& F, int layer, bool second, bool final_) {
    int tid_ = F.tid; asm volatile("" : "+v"(tid_)); LAUNDER_F(F);
    const int tid = tid_, lane = tid & 63, wv = __builtin_amdgcn_readfirstlane(tid >> 6);
    const bool route = !second;
    LAS float* RW = (LAS float*)(F.lds + 0);
    volatile LAS unsigned* LCNT = (volatile LAS unsigned*)(F.lds + 81920);
    volatile LAS unsigned* ROWC = (volatile LAS unsigned*)(F.lds + 82432);
    int nrow = 0;
    if (route) {
        if (tid < 64) LCNT[tid] = 0u;
        const GAS float* gw = GIN(32) + (size_t)layer * 1024 * 4; const GAS float* ew = GIN(34) + (size_t)layer * 1024 * 16;
#pragma unroll 1
        for (int i = 0; i < 2; ++i) { const int k = tid + 512 * i; f32x4 st[5]; st[0] = *(const GAS f32x4*)(gw + k * 4);
#pragma unroll
            for (int q = 0; q < 4; ++q) st[1 + q] = *(const GAS f32x4*)(ew + k * 16 + 4 * q);
#pragma unroll
            for (int q = 0; q < 5; ++q) *(LAS f32x4*)(RW + k * 20 + 4 * q) = st[q]; }
        __syncthreads();
        asm volatile("" ::: "memory");
    }
    const GAS float* lg = GIN(second ? 30 : 28) + layer * D; const GAS float* lb = GIN(second ? 31 : 29) + layer * D;
    f32x4 g4[4], b4[4];
#pragma unroll
    for (int j = 0; j < 4; ++j) { g4[j] = *((const GAS f32x4*)lg + lane + 64 * j); b4[j] = *((const GAS f32x4*)lb + lane + 64 * j); }
    GAS bf16* XB = (GAS bf16*)(F.ws + WS_XB);
    const GAS bf16* Dd = (const GAS bf16*)(F.ws + WS_D);
    u32x2 nv[4], nd[4];
    { const int m0 = F.wg * 8 + wv;
#pragma unroll
      for (int j = 0; j < 4; ++j) { nv[j] = *((const GAS u32x2*)(XB + (size_t)(m0 < M ? m0 : 0) * D) + lane + 64 * j); nd[j] = *((const GAS u32x2*)(Dd + (size_t)(m0 < M ? m0 : 0) * D) + lane + 64 * j); } }
    for (int m = F.wg * 8 + wv; m < M; m += F.G * 8) {
        asm volatile("" ::: "memory");
        f32x4 v[4]; float sm = 0.f;
#pragma unroll
        for (int j = 0; j < 4; ++j) { const f32x4 dd = {bf2f(nd[j].x & 0xffffu), bf2f(nd[j].x >> 16), bf2f(nd[j].y & 0xffffu), bf2f(nd[j].y >> 16)};
            const f32x4 xx = {bf2f(nv[j].x & 0xffffu), bf2f(nv[j].x >> 16), bf2f(nv[j].y & 0xffffu), bf2f(nv[j].y >> 16)};
            v[j] = xx * DN_ALPHA + dd; sm += (v[j][0] + v[j][1]) + (v[j][2] + v[j][3]); }
        { const int mn = m + F.G * 8 < M ? m + F.G * 8 : m;
#pragma unroll
          for (int j = 0; j < 4; ++j) { nv[j] = *((const GAS u32x2*)(XB + (size_t)mn * D) + lane + 64 * j); nd[j] = *((const GAS u32x2*)(Dd + (size_t)mn * D) + lane + 64 * j); } }
        const float mean = wave_sum(sm) * (1.0f / D); float s2 = 0.f;
#pragma unroll
        for (int j = 0; j < 4; ++j) { v[j] = v[j] - mean; s2 += (v[j][0] * v[j][0] + v[j][1] * v[j][1]) + (v[j][2] * v[j][2] + v[j][3] * v[j][3]); }
        const float rstd = rsqrtf(wave_sum(s2) * (1.0f / D) + LN_EPS);
#pragma unroll
        for (int j = 0; j < 4; ++j) v[j] = v[j] * rstd * g4[j] + b4[j];
        if (final_) {
            GAS float* dst = nullptr;
            if (m < NPR) { const int b = m / T, t = m % T; if (t >= NMETA) dst = F.out + O_YP + ((size_t)b * SEQ + (t - NMETA)) * D; }
            else dst = F.out + O_YS + (size_t)(m - NPR) * D;
            if (dst) {
#pragma unroll
                for (int j = 0; j < 4; ++j) *((GAS f32x4*)dst + lane + 64 * j) = v[j]; }
        } else {
#pragma unroll
            for (int j = 0; j < 4; ++j) { u32x2 o; o.x = pk2(v[j][0], v[j][1]); o.y = pk2(v[j][2], v[j][3]); *((GAS u32x2*)(XB + (size_t)m * D) + lane + 64 * j) = o; }
        }
        if (route) {
            float pl[20];
#pragma unroll
            for (int e = 0; e < 20; ++e) pl[e] = 0.f;
#pragma unroll
            for (int j = 0; j < 4; ++j)
#pragma unroll
                for (int i = 0; i < 4; ++i) { const LAS float* wp = RW + (4 * lane + 256 * j + i) * 20; const float xv = v[j][i];
#pragma unroll
                    for (int q = 0; q < 5; ++q) { const f32x4 wq = *(const LAS f32x4*)(wp + 4 * q); pl[4 * q] += xv * wq[0]; pl[4 * q + 1] += xv * wq[1]; pl[4 * q + 2] += xv * wq[2]; pl[4 * q + 3] += xv * wq[3]; } }
#pragma unroll
            for (int e = 0; e < 20; ++e) pl[e] = wave_sum(pl[e]);
            const GAS float* gb = GIN(33) + layer * 4; const GAS float* eb = GIN(35) + layer * 16;
            float l0 = pl[0] + gb[0], l1 = pl[1] + gb[1], l2 = pl[2] + gb[2], l3 = pl[3] + gb[3];
            int g = 0; float lm = l0; if (l1 > lm) { lm = l1; g = 1; } if (l2 > lm) { lm = l2; g = 2; } if (l3 > lm) { lm = l3; g = 3; }
            const float gval = frcp(__expf(l0 - lm) + __expf(l1 - lm) + __expf(l2 - lm) + __expf(l3 - lm));
            float le[4];
#pragma unroll
            for (int i = 0; i < 4; ++i) le[i] = (g == 0 ? pl[4 + i] : g == 1 ? pl[8 + i] : g == 2 ? pl[12 + i] : pl[16 + i]) + eb[4 * g + i];
            int ea = 0; float la = le[0];
#pragma unroll
            for (int i = 1; i < 4; ++i) if (le[i] > la) { la = le[i]; ea = i; }
            int e2 = -1; float l2b = -INFINITY;
#pragma unroll
            for (int i = 0; i < 4; ++i) if (i != ea && le[i] > l2b) { l2b = le[i]; e2 = i; }
            const float p1 = frcp(1.0f + __expf(l2b - la)), p2 = 1.0f - p1;
            const int lo = ea < e2 ? ea : e2, hi = ea < e2 ? e2 : ea;
            const float glo = gval * (ea < e2 ? p1 : p2), ghi = gval * (ea < e2 ? p2 : p1);
            const int pr = lo == 0 ? hi - 1 : (lo == 1 ? hi + 1 : 5), cls = g * 6 + pr;
            if (lane == 0) {
                const unsigned lp = __hip_atomic_fetch_add((LAS unsigned*)LCNT + cls, 1u, __ATOMIC_RELAXED, __HIP_MEMORY_SCOPE_WORKGROUP);
                ROWC[wv * 12 + nrow] = (unsigned)cls | (lp << 8);
                *(GAS f32x2*)((GAS float*)(F.ws + WS_GATE) + (size_t)m * 2) = (f32x2){glo, ghi};
            }
            ++nrow;
        }
    }
    if (route) {
        __syncthreads();
        if (tid < NCLS) { const unsigned n = LCNT[tid]; LCNT[32 + tid] = n ? __hip_atomic_fetch_add(F.ctl + CW_CNT + (layer * NCLS + tid) * 64, n, __ATOMIC_RELAXED, __HIP_MEMORY_SCOPE_AGENT) : 0u; }
        __syncthreads();
        if (lane == 0) { int r = 0;
            for (int m = F.wg * 8 + wv; m < M; m += F.G * 8, ++r) { const unsigned e = ROWC[wv * 12 + r]; const unsigned cls = e & 255u, lp = e >> 8;
                ((GAS int*)(F.ws + WS_TOK))[(size_t)cls * CLS_CAP + LCNT[32 + cls] + lp] = m; } }
    }
}

DI void moe_setup(Frame& F, int layer) {
    int tid = F.tid; asm volatile("" : "+v"(tid));
    __syncthreads();
    if (tid < NCLS) F.MISC[48 + tid] = __hip_atomic_load(F.ctl + CW_CNT + (layer * NCLS + tid) * 64, __ATOMIC_RELAXED, __HIP_MEMORY_SCOPE_AGENT);
    __syncthreads();
    if (tid == 0) { unsigned run = 0; for (int c = 0; c < NCLS; ++c) { F.MISC[16 + c] = run; run += (F.MISC[48 + c] + 255u) >> 8; } F.MISC[16 + NCLS] = run; }
    __syncthreads();
}
DI void cls_experts(int cls, int& elo, int& ehi) { const int g = cls / 6, pr = cls % 6; const int lo = pr < 3 ? 0 : (pr < 5 ? 1 : 2), hi = pr < 3 ? pr + 1 : (pr < 5 ? pr - 1 : 3); elo = g * 4 + lo; ehi = g * 4 + hi; }
DI bool moe_next(const volatile LAS unsigned* MISC, int G, int c, int i, int& cp, int& pn, int& cls) {
    const int npan = __builtin_amdgcn_readfirstlane((int)MISC[16 + NCLS]); const long L = (long)i * G + c; if (L >= 4L * npan) return false;
    cp = (int)(L >> 2); pn = (int)(L & 3); cls = 0;
    for (int k = 1; k < NCLS; ++k) if (__builtin_amdgcn_readfirstlane((int)MISC[16 + k]) <= cp) cls = k;
    return true;
}
struct MoeUp {
    static constexpr bool GATHER = true, SPLITB = false; static constexpr int KSPLIT = 0, K = 1024, lda = 1024, ldb = 1024;
    const GAS bf16* A; int G, c, layer; GAS unsigned char* ws; const volatile LAS unsigned* MISC;
    DI bool next(int i, pg8::Unit& u) const { int cp, pn, cls; if (!moe_next(MISC, G, c, i, cp, pn, cls)) return false;
        int elo, ehi; cls_experts(cls, elo, ehi); const int e = pn < 2 ? elo : ehi;
        u.pm = cp; u.pn = pn; u.aux = cls; u.B0 = (const GAS char*)((const GAS bf16*)(ws + WS_WGU) + ((size_t)(layer * 16 + e) * 512 + (pn & 1) * 256) * 1024); u.B1 = u.B0; return true; }
    DI unsigned a_row(const pg8::Unit& u, int r) const { const int cls = u.aux, cnt = __builtin_amdgcn_readfirstlane((int)MISC[48 + cls]); int slot = (u.pm - __builtin_amdgcn_readfirstlane((int)MISC[16 + cls])) * 256 + r; slot = slot < cnt ? slot : cnt - 1;
        const int tok = ((const GAS int*)(ws + WS_TOK))[(size_t)cls * CLS_CAP + slot]; return (unsigned)tok * 2048u; }
    DI void epi(const AccT& acc, const pg8::Unit& u, int wr, int wc, int fr, int fq) const {
        asm volatile("" : "+v"(fr), "+v"(fq));
        const int cls = u.aux, cnt = __builtin_amdgcn_readfirstlane((int)MISC[48 + cls]), sbase = (u.pm - __builtin_amdgcn_readfirstlane((int)MISC[16 + cls])) * 256;
        GAS bf16* H = (GAS bf16*)(ws + WS_H);
        int tok8[8]; float gate8[8];
#pragma unroll
        for (int i = 0; i < 8; ++i) { const int r = (i >> 2) * 128 + wr * 64 + (i & 3) * 16 + fr; int slot = sbase + r; slot = slot < cnt ? slot : cnt - 1; tok8[i] = ((const GAS int*)(ws + WS_TOK))[(unsigned)cls * CLS_CAP + slot]; }
#pragma unroll
        for (int i = 0; i < 8; ++i) gate8[i] = ((const GAS float*)(ws + WS_GATE))[(unsigned)tok8[i] * 2 + (u.pn >> 1)];
#pragma unroll
        for (int ai = 0; ai < 2; ++ai)
#pragma unroll
            for (int m = 0; m < 4; ++m) { const int r = ai * 128 + wr * 64 + m * 16 + fr; const float gate = gate8[ai * 4 + m];
#pragma unroll
                for (int n = 0; n < 2; ++n) { const f32x4 gv = acc[ai][0][m][n], uv = acc[ai][1][m][n]; u32x2 o;
                    o.x = pk2(siluf_(gv[0]) * uv[0] * gate, siluf_(gv[1]) * uv[1] * gate); o.y = pk2(siluf_(gv[2]) * uv[2] * gate, siluf_(gv[3]) * uv[3] * gate);
                    *(GAS u32x2*)(H + (unsigned)(u.pm * 256 + r) * 512 + u.pn * 128 + wc * 32 + n * 16 + 4 * fq) = o; } }
    }
};
struct MoeDown {
    static constexpr bool GATHER = false, SPLITB = true; static constexpr int KSPLIT = 4, K = 512, lda = 512, ldb = 256;
    const GAS bf16* A; int G, c, layer; GAS unsigned char* ws; const volatile LAS unsigned* MISC;
    DI bool next(int i, pg8::Unit& u) const { int cp, pn, cls; if (!moe_next(MISC, G, c, i, cp, pn, cls)) return false;
        int elo, ehi; cls_experts(cls, elo, ehi);
        u.pm = cp; u.pn = pn; u.aux = cls; const GAS bf16* WD = (const GAS bf16*)(ws + WS_WD);
        u.B0 = (const GAS char*)(WD + ((size_t)(layer * 16 + elo) * 1024 + pn * 256) * 256); u.B1 = (const GAS char*)(WD + ((size_t)(layer * 16 + ehi) * 1024 + pn * 256) * 256) - 4 * 128; return true; }
    DI void epi(const AccT& acc, const pg8::Unit& u, int wr, int wc, int fr, int fq) const {
        asm volatile("" : "+v"(fr), "+v"(fq));
        const int cls = u.aux, cnt = __builtin_amdgcn_readfirstlane((int)MISC[48 + cls]), sbase = (u.pm - __builtin_amdgcn_readfirstlane((int)MISC[16 + cls])) * 256;
        GAS bf16* Dd = (GAS bf16*)(ws + WS_D);
        int tok8[8];
#pragma unroll
        for (int i = 0; i < 8; ++i) { const int r = (i >> 2) * 128 + wr * 64 + (i & 3) * 16 + fr; int slot = sbase + r; slot = slot < cnt ? slot : cnt - 1; tok8[i] = ((const GAS int*)(ws + WS_TOK))[(unsigned)cls * CLS_CAP + slot]; }
#pragma unroll
        for (int ai = 0; ai < 2; ++ai)
#pragma unroll
            for (int m = 0; m < 4; ++m) { const int r = ai * 128 + wr * 64 + m * 16 + fr, slot = sbase + r;
                if (slot < cnt) { const int tok = tok8[ai * 4 + m]; GAS bf16* rp = Dd + (unsigned)tok * D + u.pn * 256 + wc * 32 + 4 * fq;
#pragma unroll
                    for (int bj = 0; bj < 2; ++bj)
#pragma unroll
                        for (int n = 0; n < 2; ++n) { const f32x4 v = acc[ai][bj][m][n]; u32x2 o; o.x = pk2(v[0], v[1]); o.y = pk2(v[2], v[3]); *(GAS u32x2*)(rp + bj * 128 + n * 16) = o; } } }
    }
};

struct OddIn {
    static constexpr bool GATHER = false, SPLITB = false; static constexpr int KSPLIT = 0, K = 1024, lda = 1024, ldb = 1024;
    const GAS bf16* A; const GAS bf16* Bt; int G, c, li; GAS unsigned char* ws; GAS float* out;
    DI bool next(int i, pg8::Unit& u) const { if (!pg8::static_next<M / 256, ODD_IN / 256>(G, c, i, u.pm, u.pn)) return false;
        u.B0 = (const GAS char*)(Bt + (size_t)u.pn * 256 * 1024); u.B1 = u.B0; u.aux = 0; return true; }
    DI void epi(const AccT& acc, const pg8::Unit& u, int wr, int wc, int fr, int fq) const {
        asm volatile("" : "+v"(fr), "+v"(fq));
        const int pn = u.pn;
#pragma unroll
        for (int ai = 0; ai < 2; ++ai)
#pragma unroll
            for (int m = 0; m < 4; ++m) {
                const int row = u.pm * 256 + ai * 128 + wr * 64 + m * 16 + fr;
                int b = 0, t = 0, sidx = 0; const bool pr = row < NPR; if (pr) { b = row / T; t = row % T; } else sidx = row - NPR;
                if (pn < 4) {
                    GAS float* so = nullptr;
                    if (pr) { if (t >= T - 30) so = out + O_CP + ((unsigned)(b * 2 + li) * 30 + (t - (T - 30))) * 512; } else so = out + O_CS + ((unsigned)(sidx * 2 + li) * 30 + 29) * 512;
#pragma unroll
                    for (int n = 0; n < 2; ++n) { const int ch = 128 * pn + wc * 32 + n * 16 + 4 * fq; const f32x4 a = acc[ai][0][m][n], g = acc[ai][1][m][n]; f32x4 uv;
#pragma unroll
                        for (int j = 0; j < 4; ++j) uv[j] = a[j] * sigmoidf_(g[j]);
                        u32x2 o; o.x = pk2(uv[0], uv[1]); o.y = pk2(uv[2], uv[3]); *(GAS u32x2*)((GAS bf16*)(ws + WS_A0) + (unsigned)row * 512 + ch) = o;
                        if (so) *(GAS f32x4*)(so + ch) = uv; }
                } else if (pn < 6) {
                    GAS float* so = nullptr;
                    if (pr) { if (t >= T - 3) so = out + O_DP + ((unsigned)(b * 2 + li) * 3 + (t - (T - 3))) * 512; } else so = out + O_DS + ((unsigned)(sidx * 2 + li) * 3 + 2) * 512;
#pragma unroll
                    for (int bj = 0; bj < 2; ++bj)
#pragma unroll
                        for (int n = 0; n < 2; ++n) { const int ch = (pn - 4) * 256 + bj * 128 + wc * 32 + n * 16 + 4 * fq; const f32x4 v = acc[ai][bj][m][n];
                            u32x2 o; o.x = pk2(v[0], v[1]); o.y = pk2(v[2], v[3]); *(GAS u32x2*)((GAS bf16*)(ws + WS_A1) + (unsigned)row * 512 + ch) = o;
                            if (so) *(GAS f32x4*)(so + ch) = v; }
                } else {
#pragma unroll
                    for (int bj = 0; bj < 2; ++bj)
#pragma unroll
                        for (int n = 0; n < 2; ++n) { const int ch = (pn - 6) * 256 + bj * 128 + wc * 32 + n * 16 + 4 * fq; const f32x4 v = acc[ai][bj][m][n];
                            u32x2 o; o.x = pk2(gelu_tanh(v[0]), gelu_tanh(v[1])); o.y = pk2(gelu_tanh(v[2]), gelu_tanh(v[3])); *(GAS u32x2*)((GAS bf16*)(ws + WS_A2) + (unsigned)row * 512 + ch) = o; }
                }
            }
    }
};

DI float lru_sp8(float lam) { return 8.0f * log1pf(__expf(-lam)); }
DI void lru_chain_item(Frame& F, int li, int b, int n) {
    int tid_ = F.tid; asm volatile("" : "+v"(tid_)); LAUNDER_F(F);
    const int tid = tid_, lane = tid & 63, w = __builtin_amdgcn_readfirstlane(tid >> 6), l15 = lane & 15, l4 = lane >> 4;
    LAS bf16* XC = (LAS bf16*)(F.lds + 0);
    LAS bf16* WB = (LAS bf16*)(F.lds + 9216);
    LAS float* GT = (LAS float*)(F.lds + 27648);
    LAS float* AA = (LAS float*)(F.lds + 61440);
    LAS float* UU = (LAS float*)(F.lds + 77824);
    LAS float* SEGP = (LAS float*)(F.lds + 94208);
    LAS float* SEGH = (LAS float*)(F.lds + 96256);
    LAS float* HC = (LAS float*)(F.lds + 98304);
    const GAS bf16* DX = (const GAS bf16*)(F.ws + WS_A1); const GAS bf16* DG = (const GAS bf16*)(F.ws + WS_A2); GAS bf16* MIX = (GAS bf16*)(F.ws + WS_MIX);
    const GAS float* wa = GIN(23) + ((size_t)(li * 8 + n) * 64) * 64; const GAS float* wx = GIN(25) + ((size_t)(li * 8 + n) * 64) * 64;
    __syncthreads();
    for (int e = tid; e < 4096; e += 512) { const int i = e >> 6, j = e & 63; WB[j * 72 + i] = (bf16)f2bf(wa[e]); WB[(64 + j) * 72 + i] = (bf16)f2bf(wx[e]); }
    if (tid < 64) HC[tid] = 0.f;
    const int t = tid >> 3, c8 = tid & 7, cb = 64 * n + 8 * c8;
    float dw[4][8], dbv[8], bav[8], bxv[8], sp[8];
#pragma unroll
    for (int j = 0; j < 8; ++j) { dbv[j] = GIN(22)[li * 512 + cb + j]; bav[j] = GIN(24)[li * 512 + cb + j]; bxv[j] = GIN(26)[li * 512 + cb + j]; sp[j] = lru_sp8(GIN(27)[li * 512 + cb + j]);
#pragma unroll
        for (int q = 0; q < 4; ++q) dw[q][j] = GIN(21)[(li * 4 + q) * 512 + cb + j]; }
    constexpr int NCH = (T + 63) / 64;
    u32x4 ndx[4], ndg;
#define LC_LOAD(c) do { const int tgl = 64 * (c) + t; _Pragma("unroll") for (int q = 0; q < 4; ++q) { const int ts = tgl - 3 + q; const int tsc = ts < 0 ? 0 : (ts < T ? ts : T - 1); \
        ndx[q] = *(const GAS u32x4*)(DX + (unsigned)(b * T + tsc) * 512u + (unsigned)cb); } \
        ndg = *(const GAS u32x4*)(DG + (unsigned)(b * T + (tgl < T ? tgl : T - 1)) * 512u + (unsigned)cb); } while (0)
    __syncthreads();
    LC_LOAD(0);
    for (int c = 0; c < NCH; ++c) {
        const int tg = 64 * c + t;
        float xc[8];
#pragma unroll
        for (int j = 0; j < 8; ++j) xc[j] = dbv[j];
#pragma unroll
        for (int q = 0; q < 4; ++q) { const int ts = tg - 3 + q; const bool ok = ts >= 0 && ts < T; const unsigned rw[4] = {ndx[q].x, ndx[q].y, ndx[q].z, ndx[q].w};
#pragma unroll
            for (int j = 0; j < 8; ++j) xc[j] += ok ? dw[q][j] * bf2f((rw[j >> 1] >> (16 * (j & 1))) & 0xffffu) : 0.f; }
        const u32x4 dgc = ndg;
        if (c + 1 < NCH) LC_LOAD(c + 1);
        *(LAS bf16x8*)(XC + t * 72 + 8 * c8) = pack8(xc);
        LDS_BAR();
        {
            const bf16x8 b0 = *(const LAS bf16x8*)(WB + (16 * w + l15) * 72 + 8 * l4), b1 = *(const LAS bf16x8*)(WB + (16 * w + l15) * 72 + 32 + 8 * l4);
#pragma unroll
            for (int tt = 0; tt < 4; ++tt) { f32x4 a = {0.f, 0.f, 0.f, 0.f};
                a = MFMA16(*(const LAS bf16x8*)(XC + (16 * tt + l15) * 72 + 8 * l4), b0, a); a = MFMA16(*(const LAS bf16x8*)(XC + (16 * tt + l15) * 72 + 32 + 8 * l4), b1, a);
#pragma unroll
                for (int r = 0; r < 4; ++r) GT[(16 * tt + 4 * l4 + r) * 132 + 16 * w + l15] = a[r]; }
        }
        LDS_BAR();
#pragma unroll
        for (int j = 0; j < 8; ++j) { const float r = sigmoidf_(GT[t * 132 + 8 * c8 + j] + bav[j]), ig = sigmoidf_(GT[t * 132 + 64 + 8 * c8 + j] + bxv[j]);
            const float la = -r * sp[j]; float a = __expf(la); const float x2 = 2.0f * la; const float om = x2 > -0.25f ? neg_expm1_small(x2) : 1.0f - a * a; float dr = sqrtf(fmaxf(om, 0.f)) * ig * xc[j];
            if (tg >= T) { a = 1.0f; dr = 0.f; }
            AA[t * 64 + 8 * c8 + j] = a; UU[t * 64 + 8 * c8 + j] = dr; }
        LDS_BAR();
        {
            const int ch = tid & 63, sg = tid >> 6;
            float av[8], uv[8]; float P = 1.0f, H = 0.f;
#pragma unroll
            for (int i = 0; i < 8; ++i) { av[i] = AA[(8 * sg + i) * 64 + ch]; uv[i] = UU[(8 * sg + i) * 64 + ch]; H = av[i] * H + uv[i]; P *= av[i]; }
            SEGP[sg * 64 + ch] = P; SEGH[sg * 64 + ch] = H;
            LDS_BAR();
            float h = HC[(c & 1) * 64 + ch];
            for (int q = 0; q < sg; ++q) h = SEGP[q * 64 + ch] * h + SEGH[q * 64 + ch];
#pragma unroll
            for (int i = 0; i < 8; ++i) { h = av[i] * h + uv[i]; UU[(8 * sg + i) * 64 + ch] = h; }
            if (sg == 7) HC[((c + 1) & 1) * 64 + ch] = h;
        }
        LDS_BAR();
        if (tg < T) { const unsigned rw[4] = {dgc.x, dgc.y, dgc.z, dgc.w}; float y[8];
#pragma unroll
            for (int j = 0; j < 8; ++j) y[j] = UU[t * 64 + 8 * c8 + j] * bf2f((rw[j >> 1] >> (16 * (j & 1))) & 0xffffu);
            *(GAS bf16x8*)(MIX + (unsigned)(b * T + tg) * 1024u + 512u + (unsigned)cb) = pack8(y); }
    }
#undef LC_LOAD
    __syncthreads();
    if (tid < 64) F.out[O_LP + (size_t)(b * 2 + li) * 512 + 64 * n + tid] = HC[(NCH & 1) * 64 + tid];
}

template <int NV> DI void block_sum2(float (&a)[NV], float (&bq)[NV], LAS float* RED, int wv, int lane) {
#pragma unroll
    for (int i = 0; i < NV; ++i) { a[i] = wave_sum(a[i]); bq[i] = wave_sum(bq[i]); }
    __syncthreads();
    if (lane == 0) {
#pragma unroll
        for (int i = 0; i < NV; ++i) { RED[wv * 2 * NV + i] = a[i]; RED[wv * 2 * NV + NV + i] = bq[i]; } }
    __syncthreads();
#pragma unroll
    for (int i = 0; i < NV; ++i) { float x = 0.f, y = 0.f;
#pragma unroll
        for (int q = 0; q < 8; ++q) { x += RED[q * 2 * NV + i]; y += RED[q * 2 * NV + NV + i]; }
        a[i] = x; bq[i] = y; }
}
DI void convc_item(Frame& F, int li, int b, int blk) {
    int tid_ = F.tid; asm volatile("" : "+v"(tid_)); LAUNDER_F(F);
    const int tid = tid_, lane = tid & 63, wv = __builtin_amdgcn_readfirstlane(tid >> 6), c = tid;
    LAS float* RED = (LAS float*)(F.lds + 0);
    const GAS bf16* U = (const GAS bf16*)(F.ws + WS_A0); GAS bf16* MIX = (GAS bf16*)(F.ws + WS_MIX);
    float cw[31];
#pragma unroll
    for (int j = 0; j < 31; ++j) cw[j] = GIN(17)[(size_t)(li * 31 + j) * 512 + c];
    const float cbv = GIN(18)[li * 512 + c], gln = GIN(19)[li * 512 + c], bln = GIN(20)[li * 512 + c];
    for (int g8 = 0; g8 < 8; ++g8) {
        const int t0 = 64 * blk + 8 * g8; if (t0 >= T) break;
        float val[38];
#pragma unroll
        for (int i = 0; i < 38; ++i) { const int ts = t0 - 30 + i; const bool ok = ts >= 0 && ts < T; const unsigned raw = U[(unsigned)(b * T + (ts < 0 ? 0 : (ts < T ? ts : T - 1))) * 512u + (unsigned)c]; val[i] = ok ? bf2f(raw) : 0.f; }
        float y[8], y2[8];
#pragma unroll
        for (int o = 0; o < 8; ++o) { float a = cbv;
#pragma unroll
            for (int j = 0; j < 31; ++j) a += cw[j] * val[o + j];
            y[o] = a; y2[o] = a * a; }
        float s1[8];
#pragma unroll
        for (int o = 0; o < 8; ++o) s1[o] = y[o];
        block_sum2<8>(s1, y2, RED, wv, lane);
#pragma unroll
        for (int o = 0; o < 8; ++o) { const int tg = t0 + o; if (tg < T) { const float mean = s1[o] * (1.0f / 512.0f); const float var = fmaxf(y2[o] * (1.0f / 512.0f) - mean * mean, 0.f);
            const float z = (y[o] - mean) * rsqrtf(var + LN_EPS) * gln + bln; MIX[(size_t)(b * T + tg) * 1024 + c] = (bf16)f2bf(siluf_(z)); } }
    }
}
DI void odd_sample_item(Frame& F, int li, int s) {
    int tid_ = F.tid; asm volatile("" : "+v"(tid_)); LAUNDER_F(F);
    const int tid = tid_, lane = tid & 63, wv = __builtin_amdgcn_readfirstlane(tid >> 6), c = tid, row = NPR + s;
    LAS float* RED = (LAS float*)(F.lds + 0); LAS float* XS = (LAS float*)(F.lds + 1024);
    GAS bf16* MIX = (GAS bf16*)(F.ws + WS_MIX);
    const GAS float* st = GIN(6) + ((size_t)(s * 2 + li) * 30) * 512 + c; GAS float* so = F.out + O_CS + ((size_t)(s * 2 + li) * 30) * 512 + c;
    float a = GIN(18)[li * 512 + c];
#pragma unroll
    for (int j = 0; j < 30; ++j) { const float v = st[(size_t)j * 512]; a += GIN(17)[(size_t)(li * 31 + j) * 512 + c] * v; if (j >= 1) so[(size_t)(j - 1) * 512] = v; }
    a += GIN(17)[(size_t)(li * 31 + 30) * 512 + c] * so[(size_t)29 * 512];
    float s1[1] = {a}, s2[1] = {a * a};
    block_sum2<1>(s1, s2, RED, wv, lane);
    { const float mean = s1[0] * (1.0f / 512.0f), var = fmaxf(s2[0] * (1.0f / 512.0f) - mean * mean, 0.f);
      const float z = (a - mean) * rsqrtf(var + LN_EPS) * GIN(19)[li * 512 + c] + GIN(20)[li * 512 + c]; MIX[(size_t)row * 1024 + c] = (bf16)f2bf(siluf_(z)); }
    const GAS float* sd = GIN(7) + ((size_t)(s * 2 + li) * 3) * 512 + c; GAS float* sdo = F.out + O_DS + ((size_t)(s * 2 + li) * 3) * 512 + c;
    const float d0 = sd[0], d1 = sd[512], d2 = sd[1024], d3 = sdo[1024];
    sdo[0] = d1; sdo[512] = d2;
    const float xc = GIN(22)[li * 512 + c] + GIN(21)[(li * 4 + 0) * 512 + c] * d0 + GIN(21)[(li * 4 + 1) * 512 + c] * d1 + GIN(21)[(li * 4 + 2) * 512 + c] * d2 + GIN(21)[(li * 4 + 3) * 512 + c] * d3;
    __syncthreads();
    XS[c] = xc;
    __syncthreads();
    const int n = c >> 6, j = c & 63; const GAS float* wa = GIN(23) + ((size_t)(li * 8 + n) * 64) * 64 + j; const GAS float* wx = GIN(25) + ((size_t)(li * 8 + n) * 64) * 64 + j;
    float ra = GIN(24)[li * 512 + c], ia = GIN(26)[li * 512 + c];
#pragma unroll 8
    for (int i = 0; i < 64; ++i) { const float xv = XS[64 * n + i]; ra += xv * wa[(size_t)i * 64]; ia += xv * wx[(size_t)i * 64]; }
    const float r = sigmoidf_(ra), ig = sigmoidf_(ia), la = -r * lru_sp8(GIN(27)[li * 512 + c]);
    const float h = __expf(la) * GIN(8)[(size_t)(s * 2 + li) * 512 + c] + sqrtf(fmaxf(-expm1f(2.0f * la), 0.f)) * ig * xc;
    F.out[O_LS + (size_t)(s * 2 + li) * 512 + c] = h;
    MIX[(size_t)row * 1024 + 512 + c] = (bf16)f2bf(h * bf2f(((const GAS bf16*)(F.ws + WS_A2))[(size_t)row * 512 + c]));
}
NOINL void ph_prologue(Frame F) { frame_fix(F); p_prologue(F); }
DI void ph_evenin(Frame F, int li) { LAUNDER_F(F);
    { EvenIn<false> P; P.A = (const GAS bf16*)(F.ws + WS_XB); P.Bt = (const GAS bf16*)(F.ws + WS_WINE) + (size_t)li * EVEN_PAD * 1024; P.G = F.G; P.c = F.vcu; P.li = li; P.ws = F.ws; P.out = F.out;
      pg8::gemm_phase(F.lds, P); }
    LAUNDER_F(F);
    { EvenIn<true> P; P.A = (const GAS bf16*)(F.ws + WS_XB); P.Bt = (const GAS bf16*)(F.ws + WS_WINE) + (size_t)li * EVEN_PAD * 1024; P.G = F.G; P.c = F.vcu; P.li = li; P.ws = F.ws; P.out = F.out;
      pg8::gemm_phase(F.lds, P); } }
DI void ph_oddin(Frame F, int li) { LAUNDER_F(F);
    OddIn P; P.A = (const GAS bf16*)(F.ws + WS_XB); P.Bt = (const GAS bf16*)(F.ws + WS_WINO) + (size_t)li * ODD_IN * 1024; P.G = F.G; P.c = F.vcu; P.li = li; P.ws = F.ws; P.out = F.out;
    pg8::gemm_phase(F.lds, P); }
DI void ph_outproj(Frame F, int layer) { LAUNDER_F(F);
    OutProj P; P.A = (const GAS bf16*)(F.ws + WS_MIX); P.Bt = (const GAS bf16*)(F.ws + ((layer & 1) ? WS_WOUTO : WS_WOUTE)) + (size_t)(layer >> 1) * 1024 * 1024; P.G = F.G; P.c = F.vcu; P.Dd = (GAS bf16*)(F.ws + WS_D);
    pg8::gemm_phase(F.lds, P); }
DI void ph_moeup(Frame F, int layer) { LAUNDER_F(F); moe_setup(F, layer);
    MoeUp P; P.A = (const GAS bf16*)(F.ws + WS_XB); P.G = F.G; P.c = F.vcu; P.layer = layer; P.ws = F.ws; P.MISC = F.MISC;
    pg8::gemm_phase(F.lds, P); }
DI void ph_moedown(Frame F, int layer) { LAUNDER_F(F); moe_setup(F, layer);
    MoeDown P; P.A = (const GAS bf16*)(F.ws + WS_H); P.G = F.G; P.c = F.vcu; P.layer = layer; P.ws = F.ws; P.MISC = F.MISC;
    pg8::gemm_phase(F.lds, P); }
DI void ph_ln1(Frame F, int layer) { LAUNDER_F(F); p_ln(F, layer, false, false); }
NOINL void ph_ln2(Frame F, int layer, int fin) { frame_fix(F); p_ln(F, rfl(layer), true, rfl(fin) != 0); }
DI void it_hgrn_prompt(Frame F, int li, int b, int h) { hgrn_prompt_item(F, li, b, h); }
NOINL void it_hgrn_sample(Frame F, int li, int sq, int h) { frame_fix(F); hgrn_sample_item(F, rfl(li), rfl(sq), rfl(h)); }
DI void it_dsa_prompt(Frame F, int b, int q0, int nqh) { dsa_prompt_item(F, b, q0, nqh); }
DI void it_dsa_sample(Frame F, int li, int sq) { dsa_sample_item(F, li, sq); }
DI void it_lru_chain(Frame F, int li, int b, int n) { lru_chain_item(F, li, b, n); }
DI void it_convc(Frame F, int li, int b, int blk) { convc_item(F, li, b, blk); }
NOINL void it_odd_sample(Frame F, int li, int sq) { frame_fix(F); odd_sample_item(F, rfl(li), rfl(sq)); }
#if PROBE_TS
#define PT_MARK(slot) do { const unsigned long long _t = __builtin_amdgcn_s_memrealtime(); if (F.tid == 0 && qidx == 0) atomicMax(F.ctl + 20000 + (slot), (unsigned)(_t - _t0)); } while (0)
#else
#define PT_MARK(slot) do { } while (0)
#endif
DI void p_even_mixer(Frame& F, int li, int qidx) {
    constexpr int E0 = 32, E1 = E0 + 8 * 33, E2 = E1 + NSM, E3 = E2 + 8 * 16, E4 = E3 + NSM * 4;
#if PROBE_TS
    const unsigned long long _t0 = __builtin_amdgcn_s_memrealtime();
#endif
    int it = q_pop(F, qidx);
#if PROBE_TS == 3
#define PT_SUM(slot, stmt) do { const unsigned long long _a = __builtin_amdgcn_s_memrealtime(); stmt; __syncthreads(); if (F.tid == 0) atomicAdd(F.ctl + 20000 + (slot), (unsigned)(__builtin_amdgcn_s_memrealtime() - _a)); } while (0)
#else
#define PT_SUM(slot, stmt) do { stmt; } while (0)
#endif
    while (it < E0) { PT_SUM(5, it_hgrn_prompt(F, li, it >> 2, it & 3)); it = q_pop(F, qidx); PT_MARK(0); }
    while (it < E3) {
        if (it >= E1 && it < E2) { PT_SUM(3, it_dsa_sample(F, li, it - E1)); PT_MARK(2); }
        else if (it < E1) { const int j = it - E0; it_dsa_prompt(F, j & 7, 1024 + 32 * (32 - (j >> 3)), 1); PT_MARK(1); }
        else { const int j = it - E2; it_dsa_prompt(F, j & 7, 64 * (15 - (j >> 3)), 2); PT_MARK(1); }
        it = q_pop(F, qidx);
    }
    while (it < E4) { PT_SUM(4, it_hgrn_sample(F, li, (it - E3) >> 2, (it - E3) & 3)); it = q_pop(F, qidx); PT_MARK(3); }
}
DI void p_odd_mixer(Frame& F, int li, int qidx) {
    constexpr int E0 = 64, E1 = E0 + 8 * 33, E2 = E1 + NSM;
#if PROBE_TS
    const unsigned long long _t0 = __builtin_amdgcn_s_memrealtime();
#endif
    int it = q_pop(F, qidx);
#if PROBE_TS
    if (F.tid == 0 && qidx == 1) atomicMax(F.ctl + 20000 + 4, 0u);
#define PT_MARK2(slot) do { const unsigned long long _t = __builtin_amdgcn_s_memrealtime(); if (F.tid == 0 && qidx == 1) atomicMax(F.ctl + 20000 + (slot), (unsigned)(_t - _t0)); } while (0)
#else
#define PT_MARK2(slot) do { } while (0)
#endif
    while (it < E0) { it_lru_chain(F, li, it >> 3, it & 7); it = q_pop(F, qidx); PT_MARK2(4); }
    while (it < E1) { const int j = it - E0; it_convc(F, li, j & 7, j >> 3); it = q_pop(F, qidx); PT_MARK2(5); }
    while (it < E2) { it_odd_sample(F, li, it - E1); it = q_pop(F, qidx); PT_MARK2(6); }
}

constexpr int NPHASE = 29;
__global__ void __launch_bounds__(512, 2) mega(Args args) {
    Frame F;
    F.lds = (LAS unsigned char*)lds_raw; F.MISC = (volatile LAS unsigned*)(F.lds + MISC_OFF);
    F.tid = threadIdx.x; F.lane = F.tid & 63; F.wave = __builtin_amdgcn_readfirstlane(F.tid >> 6);
    F.G = gridDim.x; F.wg = blockIdx.x; F.vcu = (F.G % 8 == 0) ? (F.wg % 8) * (F.G / 8) + F.wg / 8 : F.wg;
    F.in = ((const Args*)__builtin_amdgcn_kernarg_segment_ptr())->in; F.out = (GAS float*)args.out; F.ws = (GAS unsigned char*)args.ws; F.ctl = (unsigned*)(args.ws + WS_CTL);
    for (int u = F.tid; u < (LDS_BYTES - MISC_OFF) / 4; u += 512) ((LAS unsigned*)(F.lds + MISC_OFF))[u] = 0u;
    __syncthreads();
    const int lo = args.ph_lo, hi = args.ph_hi;
    const bool multi = (hi - lo) > 1;
    XcdBarrier bar; bar.bar = F.ctl + CW_BAR; bar.x = 0; bar.st = nullptr;
    if (multi) bar = xcd_barrier_post(F.ctl + CW_BAR, F.MISC + 8);
#define IN(k) (lo <= (k) && (k) < hi)
#if PROBE_TS
    const unsigned fillv = __builtin_bit_cast(unsigned, args.out[O_END - 1]);
    const unsigned long long t00 = __builtin_amdgcn_s_memrealtime();
#define SEAM(k) do { if (IN(k) && IN((k) + 1)) xcd_barrier_call(bar.bar, bar.x, bar.st); if (F.tid == 0) F.MISC[128 + (k)] = (unsigned)(__builtin_amdgcn_s_memrealtime() - t00); } while (0)
#else
#define SEAM(k) do { if (IN(k) && IN((k) + 1)) xcd_barrier_call(bar.bar, bar.x, bar.st); } while (0)
#endif
    if (IN(0)) ph_prologue(F);
    SEAM(0);
    for (int layer = 0; layer < 4; ++layer) {
        const int pb = 1 + layer * 7, li = layer >> 1;
        if (IN(pb + 0)) { if (!(layer & 1)) ph_evenin(F, li); else ph_oddin(F, li); }
        SEAM(pb + 0);
        if (IN(pb + 1)) { if (!(layer & 1)) p_even_mixer(F, li, layer); else p_odd_mixer(F, li, layer); }
        SEAM(pb + 1);
        if (IN(pb + 2)) ph_outproj(F, layer);
        SEAM(pb + 2);
        if (IN(pb + 3)) ph_ln1(F, layer);
        SEAM(pb + 3);
        if (IN(pb + 4)) ph_moeup(F, layer);
        SEAM(pb + 4);
        if (IN(pb + 5)) ph_moedown(F, layer);
        SEAM(pb + 5);
        if (IN(pb + 6)) ph_ln2(F, layer, layer == 3 ? 1 : 0);
        SEAM(pb + 6);
    }
#if PROBE_TS
    xcd_barrier_call(bar.bar, bar.x, bar.st);
    if (F.wg == 0) {
        __syncthreads();
        const size_t offs[7] = {O_YP, O_KP, O_VP, O_IP, O_HP, O_HS, O_CS};
        for (int i = 0; i < 7; ++i) {
            const int k = PROBE_BASE + i; if (k >= NPHASE) break;
            unsigned t1 = F.MISC[128 + k], t0 = k > 0 ? F.MISC[128 + k - 1] : 0u;
            if (PROBE_TS == 2 || PROBE_TS == 4) { t0 = 0u; t1 = __hip_atomic_load(F.ctl + 20000 + i, __ATOMIC_RELAXED, __HIP_MEMORY_SCOPE_AGENT); }
            unsigned n = (t1 - t0) / 1600u;
            if (PROBE_TS == 3) n = __hip_atomic_load(F.ctl + 20000 + i, __ATOMIC_RELAXED, __HIP_MEMORY_SCOPE_AGENT) / (256u * 400u); if (n > 60000u) n = 60000u; if (n < 1u) n = 1u;
            for (unsigned j = F.tid; j < n; j += 512) ((unsigned*)args.out)[offs[i] + j] = fillv;
        }
        for (unsigned j = F.tid; j < (unsigned)(NSM * 2 * 512); j += 512) ((unsigned*)args.out)[O_LS + j] = fillv;
    }
#endif
}

extern "C" void kernel_launch(void* const* d_in, const int* in_sizes, int n_in, void* d_out, int out_size, void* d_ws, size_t ws_size, hipStream_t stream) {
    static int grid = 0;
    if (!grid) {
        int dev = 0, cus = 0, per_cu = 0;
        (void)hipGetDevice(&dev); (void)hipDeviceGetAttribute(&cus, hipDeviceAttributeMultiprocessorCount, dev);
        (void)hipFuncSetAttribute((const void*)mega, hipFuncAttributeMaxDynamicSharedMemorySize, LDS_BYTES);
        (void)hipOccupancyMaxActiveBlocksPerMultiprocessor(&per_cu, (const void*)mega, 512, LDS_BYTES);
        if (per_cu < 1) fprintf(stderr, "occupancy query says %d\n", per_cu);
        grid = cus > 0 ? cus : 256;
        if (n_in != 39 || (size_t)out_size != O_END || ws_size < WS_END) fprintf(stderr, "kernel_launch: unexpected sizes n_in %d out %d ws %zu (need %zu)\n", n_in, out_size, ws_size, (size_t)WS_END);
    }
    (void)hipMemsetAsync((char*)d_ws + WS_CTL, 0, CTL_BYTES, stream);
    Args a; memset(&a, 0, sizeof(a));
    for (int i = 0; i < 39; ++i) a.in[i] = (const float*)d_in[i];
    a.out = (float*)d_out; a.ws = (unsigned char*)d_ws;
    a.ph_lo = 0; a.ph_hi = NPHASE;
    hipLaunchKernelGGL(mega, dim3(grid), dim3(512), LDS_BYTES, stream, a);
}
```

```cpp
#include <hip/hip_runtime.h>
#include <cstdio>
#include <cstdint>
#include <cstring>
#ifndef PROBE_TS
#define PROBE_TS 0
#endif
#ifndef PROBE_BASE
#define PROBE_BASE 0
#endif

#define GAS __attribute__((address_space(1)))
#define LAS __attribute__((address_space(3)))
typedef unsigned short bf16;
typedef short bf16x8 __attribute__((ext_vector_type(8)));
typedef float f32x4 __attribute__((ext_vector_type(4)));
typedef float f32x2 __attribute__((ext_vector_type(2)));
typedef float f32x16 __attribute__((ext_vector_type(16)));
typedef unsigned u32x4 __attribute__((ext_vector_type(4)));
typedef unsigned u32x2 __attribute__((ext_vector_type(2)));
typedef unsigned long long u64;
#define DI __device__ __forceinline__

constexpr int D = 1024, NB = 8, SEQ = 2048, NMETA = 16, T = NMETA + SEQ  , NPR = NB * T  , NSM = 128, M = NPR + NSM  ;
constexpr int PAST = 2048, PAGE = 128, NPAGES = 16, NPHYS = 2560;
constexpr int EVEN_IN = 3400, EVEN_PAD = 3584, ODD_IN = 2048;
constexpr int NCLS = 24, CLS_CAP = M, MAXPAN = 96;
constexpr float DN_ALPHA = 1.681792830507429f;
constexpr float LN_EPS = 1e-5f, RMS_EPS = 1e-6f;

constexpr size_t O_YP = 0, O_YS = O_YP + (size_t)NB * SEQ * D, O_KP = O_YS + (size_t)NSM * D, O_VP = O_KP + (size_t)NPR * 256, O_IP = O_VP + (size_t)NPR * 256,
    O_HP = O_IP + (size_t)NPR * 128, O_CP = O_HP + (size_t)NB * 2 * 4 * 128 * 128, O_DP = O_CP + (size_t)NB * 2 * 30 * 512, O_LP = O_DP + (size_t)NB * 2 * 3 * 512,
    O_KS = O_LP + (size_t)NB * 2 * 512, O_VS = O_KS + (size_t)NSM * 256, O_IS = O_VS + (size_t)NSM * 256, O_HS = O_IS + (size_t)NSM * 128,
    O_CS = O_HS + (size_t)NSM * 2 * 4 * 128 * 128, O_DS = O_CS + (size_t)NSM * 2 * 30 * 512, O_LS = O_DS + (size_t)NSM * 2 * 3 * 512, O_END = O_LS + (size_t)NSM * 2 * 512;

constexpr size_t MiB = 1u << 20;
constexpr size_t WS_CTL = 0, CTL_BYTES = 1 * MiB;
constexpr size_t WS_WINE = 2 * MiB;
constexpr size_t WS_WOUTE = WS_WINE + 2ull * EVEN_PAD * 1024 * 2;
constexpr size_t WS_WINO = WS_WOUTE + 2ull * 1024 * 1024 * 2;
constexpr size_t WS_WOUTO = WS_WINO + 2ull * 2048 * 1024 * 2;
constexpr size_t WS_WGU = WS_WOUTO + 2ull * 1024 * 1024 * 2;
constexpr size_t WS_WD = WS_WGU + 64ull * 512 * 1024 * 2;
constexpr size_t WS_X = WS_WD + 64ull * 1024 * 256 * 2;
constexpr size_t WS_XB = WS_X + (size_t)M * D * 4;
constexpr size_t WS_MIX = WS_XB + (size_t)M * D * 2;
constexpr size_t WS_A0 = WS_MIX + (size_t)M * D * 2;
constexpr size_t WS_A1 = WS_A0 + (size_t)M * 512 * 2;
constexpr size_t WS_A2 = WS_A1 + (size_t)M * 512 * 2;
constexpr size_t WS_A3 = WS_A2 + (size_t)M * 512 * 2;
constexpr size_t WS_LF = WS_A3 + (size_t)M * 512 * 2;
constexpr size_t WS_QB = WS_LF + (size_t)M * 512 * 4;
constexpr size_t WS_QI = WS_QB + (size_t)M * 512 * 2;
constexpr size_t WS_KBB = WS_QI + (size_t)M * 512 * 2;
constexpr size_t WS_KIB = WS_KBB + (size_t)M * 128 * 2;
constexpr size_t WS_WI = WS_KIB + (size_t)M * 64 * 2;
constexpr int TP = 2112;
constexpr size_t WS_VT = WS_WI + (size_t)M * 8 * 4;
constexpr size_t WS_ROPE = WS_VT + 8ull * 2 * 64 * TP * 2;
constexpr size_t WS_LB = WS_ROPE + 2ull * T * 32 * 4;
constexpr size_t WS_H = WS_LB + 2ull * 3 * 512 * 4;
constexpr size_t WS_TOK = WS_H + (size_t)MAXPAN * 256 * 512 * 2;
constexpr size_t WS_GATE = WS_TOK + (size_t)NCLS * CLS_CAP * 4;
constexpr size_t WS_D = (WS_GATE + (size_t)M * 2 * 4 + 4095) / 4096 * 4096;
constexpr size_t WS_SC = WS_D + (size_t)M * D * 2;
constexpr size_t WS_END = WS_SC + 256ull * 64 * TP * 4;

constexpr int CW_BAR = 4096;
constexpr int CW_Q = 8192;
constexpr int CW_CNT = 12288;

constexpr int RING_BYTES = 131072, MISC_OFF = RING_BYTES, LDS_BYTES = 147456;

typedef __bf16 bf16v2 __attribute__((ext_vector_type(2)));
DI unsigned pk2(float lo, float hi) { const f32x2 v = {lo, hi}; return __builtin_bit_cast(unsigned, __builtin_convertvector(v, bf16v2)); }
DI unsigned f2bf(float f) { return pk2(f, 0.f) & 0xffffu; }
DI float bf2f(unsigned b) { return __builtin_bit_cast(float, b << 16); }
DI float frcp(float x) { return __builtin_amdgcn_rcpf(x); }
DI float sigmoidf_(float x) { return frcp(1.0f + __expf(-x)); }
DI float siluf_(float x) { return x * frcp(1.0f + __expf(-x)); }
DI float gelu_tanh(float x) { const float u = 0.7978845608028654f * (x + 0.044715f * x * x * x); const float e = __expf(2.0f * u); const float th = 1.0f - 2.0f * frcp(e + 1.0f); return 0.5f * x * (1.0f + th); }
DI float neg_expm1_small(float x) { const float p = 1.0f + x * (0.5f + x * (0.16666667f + x * (0.041666668f + x * (0.0083333338f + x * 0.0013888889f)))); return -x * p; }
DI float dppf(float v, int ctrl_sel) {
    const int x = __builtin_bit_cast(int, v);
    const int r = ctrl_sel == 0 ? __builtin_amdgcn_update_dpp(0, x, 0xB1, 0xf, 0xf, false) : ctrl_sel == 1 ? __builtin_amdgcn_update_dpp(0, x, 0x4E, 0xf, 0xf, false)
                : ctrl_sel == 2 ? __builtin_amdgcn_update_dpp(0, x, 0x141, 0xf, 0xf, false) : __builtin_amdgcn_update_dpp(0, x, 0x140, 0xf, 0xf, false);
    return __builtin_bit_cast(float, r);
}
DI float row_sum16(float v) { v += dppf(v, 0); v += dppf(v, 1); v += dppf(v, 2); v += dppf(v, 3); return v; }
DI float rlf(float v, int l) { return __builtin_bit_cast(float, __builtin_amdgcn_readlane(__builtin_bit_cast(int, v), l)); }
DI float wave_sum(float v) { v = row_sum16(v); return (rlf(v, 0) + rlf(v, 16)) + (rlf(v, 32) + rlf(v, 48)); }

#define XB_TMO      128
#define XB_XCNT(j)  (256  + 64 * (j))
#define XB_XSUB(j)  (1280 + 64 * (j))
#define XB_XGEN(j)  (2304 + 64 * (j))
#define XB_TOP      3328
#define XB_TOPGEN   3392
#define XCD_BAR_WORDS 3456
#define XB_SPIN_CAP (1u << 18)
__device__ __forceinline__ unsigned xb_ld(unsigned* p)              { return __hip_atomic_load(p, __ATOMIC_RELAXED, __HIP_MEMORY_SCOPE_AGENT); }
__device__ __forceinline__ unsigned xb_add(unsigned* p, unsigned v) { return __hip_atomic_fetch_add(p, v, __ATOMIC_RELAXED, __HIP_MEMORY_SCOPE_AGENT); }
__device__ __forceinline__ unsigned xb_xcc_id() { return (unsigned)__builtin_amdgcn_s_getreg((3 << 11) | 20) & 0xFu; }
#define XB_SPIN(cond, bar) do { unsigned _sp = 0; while (cond) { __builtin_amdgcn_s_sleep(1); \
    if ((++_sp & 255u) == 0u) { if (xb_ld(&(bar)[XB_TMO])) break; if (_sp > XB_SPIN_CAP) { atomicAdd(&(bar)[XB_TMO], 1u); break; } } } } while (0)
struct XcdBarrier { unsigned* bar; unsigned x; volatile LAS unsigned* st; };
__device__ __forceinline__ XcdBarrier xcd_barrier_post(unsigned* bar, volatile LAS unsigned* st) {
    XcdBarrier b; b.bar = bar; b.x = xb_xcc_id(); b.st = st;
    if (threadIdx.x == 0) (void)xb_add(&bar[XB_XCNT(b.x)], 1u);
    return b;
}
__device__ __forceinline__ void xcd_barrier_complete(unsigned* bar, unsigned x, unsigned& nloc, unsigned& nx) {
    const unsigned G = gridDim.x * gridDim.y * gridDim.z;
    unsigned sum, cnt, mine, sp = 0u;
    for (;;) {
        sum = 0u; cnt = 0u; mine = 0u;
#pragma unroll
        for (unsigned j = 0; j < 16; ++j) { const unsigned c = xb_ld(&bar[XB_XCNT(j)]); sum += c; cnt += (c > 0u) ? 1u : 0u; mine = (j == x) ? c : mine; }
        if (sum == G) break;
        __builtin_amdgcn_s_sleep(1);
        if ((++sp & 255u) == 0u) { if (xb_ld(&bar[XB_TMO])) break; if (sp > XB_SPIN_CAP) { atomicAdd(&bar[XB_TMO], 1u); break; } }
    }
    nloc = mine > 0u ? mine : 1u; nx = cnt > 0u ? cnt : 1u;
}
__device__ __forceinline__ void xcd_barrier(const XcdBarrier& b) {
    asm volatile("s_waitcnt vmcnt(0)" ::: "memory");
    __syncthreads();
    if (threadIdx.x == 0) {
        unsigned* bar = b.bar;
        __builtin_amdgcn_s_waitcnt(0);
        unsigned nloc = b.st[0], nx = b.st[1];
        if (nloc == 0u) { xcd_barrier_complete(bar, b.x, nloc, nx); b.st[0] = nloc; b.st[1] = nx; }
        const unsigned old = xb_add(&bar[XB_XSUB(b.x)], 1u);
        const unsigned gen = old / nloc;
        if (old + 1u == (gen + 1u) * nloc) {
            __builtin_amdgcn_fence(__ATOMIC_RELEASE, "agent");
            asm volatile("s_waitcnt vmcnt(0)" ::: "memory");
            const unsigned og = xb_add(&bar[XB_TOP], 1u);
            const unsigned tg = og / nx;
            if (og + 1u == (tg + 1u) * nx) xb_add(&bar[XB_TOPGEN], 1u);
            else XB_SPIN(xb_ld(&bar[XB_TOPGEN]) == tg, bar);
            __builtin_amdgcn_fence(__ATOMIC_ACQUIRE, "agent");
            xb_add(&bar[XB_XGEN(b.x)], 1u);
            asm volatile("s_waitcnt vmcnt(0)" ::: "memory");
        } else {
            XB_SPIN(xb_ld(&bar[XB_XGEN(b.x)]) == gen, bar);
            __builtin_amdgcn_fence(__ATOMIC_ACQUIRE, "agent");
            asm volatile("s_waitcnt vmcnt(0)" ::: "memory");
        }
    }
    __syncthreads();
}

__device__ __attribute__((noinline)) void xcd_barrier_call(unsigned* bar, unsigned x, volatile LAS unsigned* st) { XcdBarrier b; b.bar = bar; b.x = x; b.st = st; xcd_barrier(b); }
struct Args { const float* in[39]; float* out; unsigned char* ws; int ph_lo, ph_hi; };
#define GIN(k) ((const GAS float*)F.in[(k)])
#define PROBE_CTL ((unsigned*)(((const Args*)__builtin_amdgcn_kernarg_segment_ptr())->ws))
#define LAUNDER_F(F) asm volatile("" : "+s"((F).in), "+s"((F).ws), "+s"((F).out), "+s"((F).ctl), "+s"((F).vcu), "+s"((F).G), "+s"((F).wg))
struct Frame {
    LAS unsigned char* lds; volatile LAS unsigned* MISC; unsigned* ctl;
    int tid, lane, wave, G, wg, vcu;
    const float* const* in; GAS float* out; GAS unsigned char* ws;
};
extern __shared__ __attribute__((aligned(16))) unsigned char lds_raw[];
#define NOINL __device__ __attribute__((noinline))
DI int rfl(int v) { return __builtin_amdgcn_readfirstlane(v); }
template <class Pt> DI Pt rfl_ptr(Pt p) { const u64 v = (u64)p; const unsigned lo = (unsigned)rfl((int)(unsigned)v), hi = (unsigned)rfl((int)(unsigned)(v >> 32)); return (Pt)(((u64)hi << 32) | lo); }
DI void frame_fix(Frame& F) {
    F.lds = (LAS unsigned char*)lds_raw; F.MISC = (volatile LAS unsigned*)(F.lds + MISC_OFF);
    F.tid = threadIdx.x; F.lane = F.tid & 63; F.wave = rfl(F.tid >> 6);
    F.G = rfl(F.G); F.wg = rfl(F.wg); F.vcu = rfl(F.vcu);
    F.ctl = rfl_ptr(F.ctl); F.in = rfl_ptr(F.in); F.out = rfl_ptr(F.out); F.ws = rfl_ptr(F.ws);
}

namespace pg8 {
constexpr int BM = 256, BK = 64, HALF = 128, HTB = HALF * BK * 2, STAGE_BYTES = 8 * HTB, NXCD = 8, WGM = 8;
__host__ __device__ __forceinline__ int lds_byte(int r, int c) { const int st = (r >> 4) * 2 + (c >> 5), rr = r & 15, cc = c & 31, ob = rr * 64 + cc * 2; return st * 1024 + (ob ^ (((ob >> 9) & 1) << 5)); }
__host__ __device__ __forceinline__ void stage_rc(int b, int& R, int& C) { const int st = b / 1024, sb = b % 1024, swz = sb ^ (((sb >> 9) & 1) << 5); R = (st >> 1) * 16 + swz / 64; C = (st & 1) * 32 + (swz % 64) / 2; }
struct Unit { int pm, pn; const GAS char* B0; const GAS char* B1; int aux; };
template <int nM, int nN> DI bool static_next(int G, int c, int i, int& pm, int& pn) {
    const int L = i * G + c; if (L >= nM * nN) return false;
    pm = L / nN; pn = L % nN; return true;
}
template <class P>
__device__ __forceinline__ void gemm_phase(LAS unsigned char* lds, const P& pb) {
    int tid_ = threadIdx.x; asm volatile("" : "+v"(tid_));
    const int tid = tid_, wid = __builtin_amdgcn_readfirstlane(tid >> 6), lane = tid & 63, wr = wid >> 2, wc = wid & 3, fr = lane & 15, fq = lane >> 4;
    constexpr int K = P::K, nt = K / BK;
    int sR[2], sC[2]; unsigned voffA[2], voffB[2];
#pragma unroll
    for (int i = 0; i < 2; ++i) { stage_rc(tid * 16 + i * 8192, sR[i], sC[i]); voffB[i] = (unsigned)(sR[i] * P::ldb + sC[i]) * 2u; voffA[i] = (unsigned)(sR[i] * P::lda + sC[i]) * 2u; }
    constexpr size_t kstep = (size_t)(BK * 2);
    constexpr size_t hstepB = (size_t)HALF * P::ldb * 2, hstepA = (size_t)HALF * P::lda * 2, tstepA = 2 * hstepA;
    const unsigned ldsw = (unsigned)wid * 1024u;
    const int aoff = lds_byte(wr * 64 + fr, fq * 8), boff = lds_byte(wc * 32 + fr, fq * 8);
#define PG8_SA(b, h) (((b) * 2 + (h)) * HTB)
#define PG8_SB(b, h) ((4 + (b) * 2 + (h)) * HTB)
#define PG8_STAGE(bufoff, gbase, voff) do { _Pragma("unroll") for (int _i = 0; _i < 2; ++_i) \
        __builtin_amdgcn_global_load_lds((const GAS unsigned*)((const GAS char*)(gbase) + (voff)[_i]), (LAS unsigned*)(lds + (bufoff) + ldsw + _i * 8192), 16, 0, 0); } while (0)
#define PG8_STAGE_A(bufoff, gbase, h, G_) do { if constexpr (P::GATHER) { PG8_STAGE(bufoff, gbase, (G_)[h]); } else { PG8_STAGE(bufoff, (gbase) + (h) * hstepA, voffA); } } while (0)
#define PG8_LDA(dst, b, h) do { _Pragma("unroll") for (int m = 0; m < 4; ++m) _Pragma("unroll") for (int k = 0; k < 2; ++k) dst[m][k] = *(const LAS bf16x8*)(lds + PG8_SA(b, h) + aoff + m * 2048 + k * 1024); } while (0)
#define PG8_LDB(dst, b, h) do { _Pragma("unroll") for (int n = 0; n < 2; ++n) _Pragma("unroll") for (int k = 0; k < 2; ++k) dst[n][k] = *(const LAS bf16x8*)(lds + PG8_SB(b, h) + boff + n * 2048 + k * 1024); } while (0)
#define PG8_MMA(ai, bj, At, Bt) do { __builtin_amdgcn_s_setprio(1); _Pragma("unroll") for (int m = 0; m < 4; ++m) _Pragma("unroll") for (int n = 0; n < 2; ++n) _Pragma("unroll") for (int k = 0; k < 2; ++k) \
        acc[ai][bj][m][n] = __builtin_amdgcn_mfma_f32_16x16x32_bf16(Bt[n][k], At[m][k], acc[ai][bj][m][n], 0, 0, 0); __builtin_amdgcn_s_setprio(0); } while (0)
#define PG8_WAIT_V(n) asm volatile("s_waitcnt vmcnt(" #n ")" ::: "memory")
#define PG8_WAIT_L(n) asm volatile("s_waitcnt lgkmcnt(" #n ")" ::: "memory")
#define PG8_BAR __builtin_amdgcn_s_barrier()
#define PG8_SCHED __builtin_amdgcn_sched_barrier(0)
    Unit cur, nxt; int ui = 0;
#if PROBE_TS == 5
    unsigned long long _ks = __builtin_amdgcn_s_memrealtime(); unsigned _kacc = 0, _eacc = 0;
#endif
    if (!pb.next(0, cur)) return;
    f32x4 acc[2][2][4][2];
#pragma unroll
    for (int a = 0; a < 2; ++a)
#pragma unroll
        for (int b = 0; b < 2; ++b)
#pragma unroll
            for (int m = 0; m < 4; ++m)
#pragma unroll
                for (int n = 0; n < 2; ++n) acc[a][b][m][n] = (f32x4){0.f, 0.f, 0.f, 0.f};
    bf16x8 At[4][2], B0[2][2], B1[2][2];
    unsigned gA[2][2] = {{0u, 0u}, {0u, 0u}};
    if constexpr (P::GATHER) {
#pragma unroll
        for (int h = 0; h < 2; ++h)
#pragma unroll
            for (int i = 0; i < 2; ++i) gA[h][i] = pb.a_row(cur, 128 * h + sR[i]) + (unsigned)sC[i] * 2u;
    }
#if PROBE_TS == 6
    const GAS char* _B00 = cur.B0; const GAS char* _B01 = cur.B1;
    const GAS char* cA = (const GAS char*)pb.A;
#else
    const GAS char* cA = (const GAS char*)pb.A + (P::GATHER ? (size_t)0 : (size_t)cur.pm * tstepA);
#endif
    PG8_STAGE(PG8_SB(0, 0), cur.B0, voffB); PG8_STAGE_A(PG8_SA(0, 0), cA, 0, gA); PG8_STAGE(PG8_SB(0, 1), cur.B0 + hstepB, voffB); PG8_STAGE_A(PG8_SA(0, 1), cA, 1, gA);
    if (wr == 1) PG8_BAR;
    PG8_WAIT_V(4); PG8_BAR;
    PG8_STAGE(PG8_SB(1, 0), cur.B0 + kstep, voffB); PG8_STAGE_A(PG8_SA(1, 0), cA + kstep, 0, gA); PG8_STAGE(PG8_SB(1, 1), cur.B0 + hstepB + kstep, voffB);
    PG8_WAIT_V(6); PG8_BAR;
    for (;;) {
        const bool has_next = pb.next(ui + 1, nxt);
        if (!has_next) nxt = cur;
#if PROBE_TS == 6
        nxt.B0 = _B00; nxt.B1 = _B01;
        const GAS char* nA = (const GAS char*)pb.A;
#else
        const GAS char* nA = (const GAS char*)pb.A + (P::GATHER ? (size_t)0 : (size_t)nxt.pm * tstepA);
#endif
#pragma unroll 1
        for (int t = 0; t < nt; t += 2) {
            const bool last = (t == nt - 2);
            const GAS char* a1 = cA + (size_t)(t + 1) * kstep;
            const GAS char* a2 = last ? nA : cA + (size_t)(t + 2) * kstep;
            const GAS char* a3 = a2 + kstep;
            const GAS char* b2;
            if constexpr (P::SPLITB) b2 = last ? nxt.B0 : ((t + 2 < pb.KSPLIT) ? cur.B0 : cur.B1) + (size_t)(t + 2) * kstep;
            else b2 = last ? nxt.B0 : cur.B0 + (size_t)(t + 2) * kstep;
            const GAS char* b3 = b2 + kstep;
            PG8_LDB(B0, 0, 0); PG8_SCHED; PG8_LDA(At, 0, 0); PG8_STAGE_A(PG8_SA(1, 1), a1, 1, gA);
            PG8_WAIT_L(8); PG8_BAR; PG8_WAIT_L(0); PG8_MMA(0, 0, At, B0); PG8_BAR; PG8_SCHED;
            if constexpr (P::GATHER) { if (last) {
#pragma unroll
                for (int h = 0; h < 2; ++h)
#pragma unroll
                    for (int i = 0; i < 2; ++i) gA[h][i] = pb.a_row(nxt, 128 * h + sR[i]) + (unsigned)sC[i] * 2u; } }
            PG8_LDB(B1, 0, 1); PG8_STAGE(PG8_SB(0, 0), b2, voffB);
            PG8_BAR; PG8_WAIT_L(0); PG8_MMA(0, 1, At, B1); PG8_BAR;
            PG8_LDA(At, 0, 1); PG8_STAGE_A(PG8_SA(0, 0), a2, 0, gA);
            PG8_BAR; PG8_WAIT_L(0); PG8_MMA(1, 0, At, B0); PG8_BAR; PG8_SCHED;
            PG8_STAGE(PG8_SB(0, 1), b2 + hstepB, voffB);
            PG8_WAIT_V(6); PG8_BAR; PG8_MMA(1, 1, At, B1); PG8_BAR;
            PG8_LDB(B0, 1, 0); PG8_SCHED; PG8_LDA(At, 1, 0); PG8_STAGE_A(PG8_SA(0, 1), a2, 1, gA);
            PG8_WAIT_L(8); PG8_BAR; PG8_WAIT_L(0); PG8_MMA(0, 0, At, B0); PG8_BAR; PG8_SCHED;
            PG8_LDB(B1, 1, 1); PG8_STAGE(PG8_SB(1, 0), b3, voffB);
            PG8_BAR; PG8_WAIT_L(0); PG8_MMA(0, 1, At, B1); PG8_BAR;
            PG8_LDA(At, 1, 1); PG8_STAGE_A(PG8_SA(1, 0), a3, 0, gA);
            PG8_BAR; PG8_WAIT_L(0); PG8_MMA(1, 0, At, B0); PG8_BAR; PG8_SCHED;
            PG8_STAGE(PG8_SB(1, 1), b3 + hstepB, voffB);
            PG8_WAIT_V(6); PG8_BAR; PG8_MMA(1, 1, At, B1); PG8_BAR;
        }
#if PROBE_TS == 5
        const unsigned long long _ke = __builtin_amdgcn_s_memrealtime();
#endif
        pb.epi(acc, cur, wr, wc, fr, fq);
#if PROBE_TS == 5
        { const unsigned long long _ee = __builtin_amdgcn_s_memrealtime(); _kacc += (unsigned)(_ke - _ks); _eacc += (unsigned)(_ee - _ke); _ks = _ee; }
#endif
        if (!has_next) break;
#pragma unroll
        for (int a = 0; a < 2; ++a)
#pragma unroll
            for (int b = 0; b < 2; ++b)
#pragma unroll
                for (int m = 0; m < 4; ++m)
#pragma unroll
                    for (int n = 0; n < 2; ++n) acc[a][b][m][n] = (f32x4){0.f, 0.f, 0.f, 0.f};
        cur = nxt; cA = nA; ++ui;
    }
    PG8_WAIT_V(0);
    if (wr == 0) PG8_BAR;
    PG8_BAR;
#if PROBE_TS == 5
    if (tid == 0 && P::PID >= 0) { atomicMax(PROBE_CTL + 20000 + 2 * P::PID, _kacc); atomicMax(PROBE_CTL + 20001 + 2 * P::PID, _eacc); }
#endif
#undef PG8_SA
#undef PG8_SB
#undef PG8_STAGE
#undef PG8_STAGE_A
#undef PG8_LDA
#undef PG8_LDB
#undef PG8_MMA
#undef PG8_WAIT_V
#undef PG8_WAIT_L
#undef PG8_BAR
#undef PG8_SCHED
}
}
typedef f32x4 AccT[2][2][4][2];

DI int swap45(int s) { return (s & ~48) | ((s & 16) << 1) | ((s & 32) >> 1); }
DI int map_even(int s) {
    if (s < 2048) return s;
    if (s < 2688) { const int r = s - 2048; return 2048 + (r & ~63) + swap45(r & 63); }
    if (s < 2816) return s;
    if (s < 3392) { const int r = s - 2816; return 2816 + (r & ~63) + swap45(r & 63); }
    if (s < EVEN_IN) return s;
    return -1;
}
DI int map_odd(int s) {
    if (s >= 1024) return s;
    const int u = s >> 8, r = s & 255; return r < 128 ? 128 * u + r : 512 + 128 * u + (r - 128);
}
struct TItem { const GAS float* wp; GAS bf16* dst; int ldn, K; bool okc; };
DI TItem transpose_decode(Frame& F, int it, int lane) {
    constexpr int I_WINE = 2 * 16 * (EVEN_PAD / 32), I_WOUT = 2 * 16 * 32, I_WINO = 2 * 16 * 64, I_WGU = 64 * 16 * 16;
    int r = it; asm volatile("" : "+v"(r));
    const GAS float* W; GAS bf16* WT; int ldn, K, k0, n0, mode = 0, coloff = 0;
    if (r < I_WINE) { const int li = r / (I_WINE / 2); r %= (I_WINE / 2); const int kb = r / (EVEN_PAD / 32), nb = r % (EVEN_PAD / 32);
        W = GIN(11) + (size_t)li * 1024 * EVEN_IN; ldn = EVEN_IN; K = 1024; WT = (GAS bf16*)(F.ws + WS_WINE) + (size_t)li * EVEN_PAD * 1024; k0 = 64 * kb; n0 = 32 * nb; mode = 1; }
    else if ((r -= I_WINE) < I_WOUT) { const int li = r / (I_WOUT / 2); r %= (I_WOUT / 2); const int kb = r / 32, nb = r % 32;
        W = GIN(12) + (size_t)li * 1024 * 1024; ldn = 1024; K = 1024; WT = (GAS bf16*)(F.ws + WS_WOUTE) + (size_t)li * 1024 * 1024; k0 = 64 * kb; n0 = 32 * nb; }
    else if ((r -= I_WOUT) < I_WINO) { const int li = r / (I_WINO / 2); r %= (I_WINO / 2); const int kb = r / 64, nb = r % 64;
        W = GIN(15) + (size_t)li * 1024 * 2048; ldn = 2048; K = 1024; WT = (GAS bf16*)(F.ws + WS_WINO) + (size_t)li * 2048 * 1024; k0 = 64 * kb; n0 = 32 * nb; mode = 2; }
    else if ((r -= I_WINO) < I_WOUT) { const int li = r / (I_WOUT / 2); r %= (I_WOUT / 2); const int kb = r / 32, nb = r % 32;
        W = GIN(16) + (size_t)li * 1024 * 1024; ldn = 1024; K = 1024; WT = (GAS bf16*)(F.ws + WS_WOUTO) + (size_t)li * 1024 * 1024; k0 = 64 * kb; n0 = 32 * nb; }
    else if ((r -= I_WOUT) < I_WGU) { const int le = r / 256; r %= 256; const int kb = r / 16, nb = r % 16;
        const int s0 = 32 * nb, jj = s0 >> 8, rr = s0 & 255; const bool up = rr >= 128; const int c0 = 128 * jj + (up ? rr - 128 : rr);
        W = (up ? GIN(37) : GIN(36)) + (size_t)le * 1024 * 256; ldn = 256; K = 1024; WT = (GAS bf16*)(F.ws + WS_WGU) + (size_t)le * 512 * 1024; k0 = 64 * kb; n0 = s0; coloff = c0 - s0; }
    else { r -= I_WGU; const int le = r / 128; r %= 128; const int kb = r / 32, nb = r % 32;
        W = GIN(38) + (size_t)le * 256 * 1024; ldn = 1024; K = 256; WT = (GAS bf16*)(F.ws + WS_WD) + (size_t)le * 1024 * 256; k0 = 64 * kb; n0 = 32 * nb; }
    int col = n0 + (lane & 31);
    if (mode == 1) col = map_even(col); else if (mode == 2) col = map_odd(col); else col += coloff;
    TItem t; t.okc = col >= 0; t.wp = W + (size_t)(k0 + (lane >> 5)) * ldn + (t.okc ? col : 0); t.ldn = ldn; t.K = K; t.dst = WT + (size_t)n0 * K + k0;
    return t;
}
DI void transpose_finish(const TItem& t, const float (&tv)[32], LAS float* scr, int lane) {
#pragma unroll
    for (int i = 0; i < 32; ++i) { const int kk = 2 * i + (lane >> 5); scr[kk * 33 + (lane & 31)] = t.okc ? tv[i] : 0.f; }
    asm volatile("s_waitcnt lgkmcnt(0)" ::: "memory");
    const int c = lane & 7;
#pragma unroll
    for (int j = 0; j < 4; ++j) { const int n = (lane >> 3) + 8 * j; const LAS float* sp = scr + (8 * c) * 33 + n;
        u32x4 o; o.x = pk2(sp[0 * 33], sp[1 * 33]); o.y = pk2(sp[2 * 33], sp[3 * 33]); o.z = pk2(sp[4 * 33], sp[5 * 33]); o.w = pk2(sp[6 * 33], sp[7 * 33]);
        *(GAS u32x4*)(t.dst + (size_t)n * t.K + 8 * c) = o; }
    asm volatile("s_waitcnt lgkmcnt(0)" ::: "memory");
}
DI void p_prologue(Frame& F) {
    LAUNDER_F(F);
#if PROBE_TS == 4
    const unsigned long long _tp0 = __builtin_amdgcn_s_memrealtime();
#endif
    LAS float* scr = (LAS float*)(F.lds + F.wave * 16384);
    const int gw = F.wg * 8 + F.wave, NGW = F.G * 8, lane = F.lane;
    constexpr int I_WINE = 2 * 16 * (EVEN_PAD / 32), I_WOUT = 2 * 16 * 32, I_WINO = 2 * 16 * 64, I_WGU = 64 * 16 * 16, I_WD = 64 * 4 * 32;
    constexpr int NIT = I_WINE + I_WOUT + I_WINO + I_WOUT + I_WGU + I_WD;
    {
        float tvn[32]; TItem tn = transpose_decode(F, gw < NIT ? gw : 0, lane);
#pragma unroll
        for (int i = 0; i < 32; ++i) tvn[i] = tn.wp[(size_t)(2 * i) * tn.ldn];
        for (int it = gw; it < NIT; it += NGW) {
            asm volatile("" ::: "memory");
            float tv[32]; const TItem tc = tn;
#pragma unroll
            for (int i = 0; i < 32; ++i) tv[i] = tvn[i];
            if (it + NGW < NIT) { tn = transpose_decode(F, it + NGW, lane);
#pragma unroll
                for (int i = 0; i < 32; ++i) tvn[i] = tn.wp[(size_t)(2 * i) * tn.ldn]; }
            transpose_finish(tc, tv, scr, lane);
        }
    }
#if PROBE_TS == 4
    if (F.tid == 0) atomicMax(F.ctl + 20000, (unsigned)(__builtin_amdgcn_s_memrealtime() - _tp0));
#endif
    GAS bf16* XB = (GAS bf16*)(F.ws + WS_XB);
    for (int m = gw; m < M; m += NGW) {
        const GAS float* src;
        if (m < NPR) { const int b = m / T, t = m % T; src = t < NMETA ? GIN(10) + (size_t)t * D : GIN(0) + ((size_t)b * SEQ + (t - NMETA)) * D; }
        else src = GIN(1) + (size_t)(m - NPR) * D;
#pragma unroll
        for (int j = 0; j < 4; ++j) { const f32x4 v = *((const GAS f32x4*)src + lane + 64 * j);
            u32x2 o; o.x = pk2(v.x, v.y); o.y = pk2(v.z, v.w); *((GAS u32x2*)(XB + (size_t)m * D) + lane + 64 * j) = o; }
    }
#if PROBE_TS == 4
    if (F.tid == 0) atomicMax(F.ctl + 20001, (unsigned)(__builtin_amdgcn_s_memrealtime() - _tp0));
#endif
    GAS float* RC = (GAS float*)(F.ws + WS_ROPE); GAS float* RS = RC + T * 32;
    for (int e = F.wg * 512 + F.tid; e < T * 32; e += F.G * 512) {
        const int pos = e >> 5, i = e & 31;
        const float inv = exp2f(-(float)i * (13.287712379549449f / 32.0f));
        const double ang = (double)((float)pos * inv);
        const double kq = rint(ang * 0.15915494309189535);
        const double rr = fma(-kq, 6.283185307179586, ang) - kq * 2.4492935982947064e-16;
        const float rf = (float)rr;
        RC[e] = cosf(rf); RS[e] = sinf(rf);
    }
#if PROBE_TS == 4
    if (F.tid == 0) atomicMax(F.ctl + 20002, (unsigned)(__builtin_amdgcn_s_memrealtime() - _tp0));
#endif
    GAS float* LB = (GAS float*)(F.ws + WS_LB);
    for (int e = F.wg * 512 + F.tid; e < 2 * 512; e += F.G * 512) {
        const int li = e >> 9, c = e & 511;
        const float l0 = GIN(13)[c], l1 = GIN(13)[512 + c];
        const float lb = li == 0 ? 0.f : 1.0f / (1.0f + expf(l0 - l1));
        LB[(li * 3 + 0) * 512 + c] = logf(fmaxf(lb, 1e-30f)); LB[(li * 3 + 1) * 512 + c] = log1pf(-lb); LB[(li * 3 + 2) * 512 + c] = 1.0f - lb;
    }
}

template <bool ROPE> struct EvenIn {
    static constexpr int PID = ROPE ? -1 : 3;
    static constexpr bool GATHER = false, SPLITB = false; static constexpr int KSPLIT = 0, K = 1024, lda = 1024, ldb = 1024;
    const GAS bf16* A; const GAS bf16* Bt; int G, c, li; GAS unsigned char* ws; GAS float* out;
    DI bool next(int i, pg8::Unit& u) const { if (!pg8::static_next<M / 256, 7>(G, c, i, u.pm, u.pn)) return false;
        if (ROPE) u.pn += 7;
        u.B0 = (const GAS char*)(Bt + (size_t)u.pn * 256 * 1024); u.B1 = u.B0; u.aux = 0; return true; }
    DI void epi(const AccT& acc, const pg8::Unit& u, int wr, int wc, int fr, int fq) const {
        asm volatile("" : "+v"(fr), "+v"(fq));
        const int pn = u.pn;
        const int rbase = u.pm * 256 + wr * 64 + fr;
        if constexpr (!ROPE) {
            GAS bf16* dst = (GAS bf16*)(ws + (pn < 2 ? WS_A0 : pn < 4 ? WS_A1 : pn < 6 ? WS_A2 : WS_A3));
            GAS float* LF = (GAS float*)(ws + WS_LF); const GAS float* LB = (const GAS float*)(ws + WS_LB) + li * 3 * 512;
#pragma unroll
            for (int bj = 0; bj < 2; ++bj)
#pragma unroll
                for (int n = 0; n < 2; ++n) {
                    const int col = (pn & 1) * 256 + bj * 128 + wc * 32 + n * 16 + 4 * fq;
                    f32x4 la = {0, 0, 0, 0}, lb1 = {0, 0, 0, 0}, lc = {0, 0, 0, 0};
                    if (pn == 2 || pn == 3) { la = *(const GAS f32x4*)(LB + col); lb1 = *(const GAS f32x4*)(LB + 512 + col); lc = *(const GAS f32x4*)(LB + 1024 + col); }
#pragma unroll
                    for (int ai = 0; ai < 2; ++ai)
#pragma unroll
                        for (int m = 0; m < 4; ++m) {
                            const int row = rbase + ai * 128 + m * 16; const f32x4 v = acc[ai][bj][m][n]; float o[4];
                            if (pn < 2 || pn >= 6) {
#pragma unroll
                                for (int j = 0; j < 4; ++j) o[j] = siluf_(v[j]);
                            } else if (pn < 4) {
                                f32x4 lf;
#pragma unroll
                                for (int j = 0; j < 4; ++j) { const float z = v[j]; const float e = __expf(-fabsf(z)); const float l1p = __logf(1.0f + e);
                                    const float ls = fminf(z, 0.f) - l1p;
                                    const float bb = lb1[j] + ls, aa = la[j]; const float mx = fmaxf(aa, bb);
                                    lf[j] = mx + __logf(1.0f + __expf(-fabsf(aa - bb)));
                                    const float sg = (z >= 0.f ? e : 1.0f) * frcp(1.0f + e);
                                    o[j] = lc[j] * sg; }
                                *(GAS f32x4*)(LF + (unsigned)row * 512 + col) = lf;
                            } else {
#pragma unroll
                                for (int j = 0; j < 4; ++j) o[j] = v[j];
                            }
                            u32x2 w; w.x = pk2(o[0], o[1]); w.y = pk2(o[2], o[3]); *(GAS u32x2*)(dst + (unsigned)row * 512 + col) = w;
                        }
                    asm volatile("" ::: "memory");
                }
        } else if (pn == 7) {
            GAS bf16* dst = (GAS bf16*)(ws + WS_A3);
#pragma unroll
            for (int bj = 0; bj < 2; ++bj)
#pragma unroll
                for (int n = 0; n < 2; ++n) { const int col = 256 + bj * 128 + wc * 32 + n * 16 + 4 * fq;
#pragma unroll
                    for (int ai = 0; ai < 2; ++ai)
#pragma unroll
                        for (int m = 0; m < 4; ++m) { const int row = rbase + ai * 128 + m * 16; const f32x4 v = acc[ai][bj][m][n];
                            u32x2 w; w.x = pk2(siluf_(v[0]), siluf_(v[1])); w.y = pk2(siluf_(v[2]), siluf_(v[3])); *(GAS u32x2*)(dst + (unsigned)row * 512 + col) = w; } }
        } else {
        const GAS float* RC = (const GAS float*)(ws + WS_ROPE); const GAS float* RS = RC + T * 32;
        const int i0 = 16 * (wc & 1) + 4 * fq;
#pragma unroll
        for (int ai = 0; ai < 2; ++ai)
#pragma unroll
            for (int m = 0; m < 4; ++m) {
                const int row = rbase + ai * 128 + m * 16;
                const int pos = row < NPR ? row % T : PAST;
                const f32x4 cs = *(const GAS f32x4*)(RC + pos * 32 + i0), sn = *(const GAS f32x4*)(RS + pos * 32 + i0);
#pragma unroll
                for (int bj = 0; bj < 2; ++bj) {
                    const f32x4 x1 = acc[ai][bj][m][0], x2 = acc[ai][bj][m][1];
                    const f32x4 r1 = x1 * cs - x2 * sn, r2 = x2 * cs + x1 * sn;
                    const int hd = bj * 2 + (wc >> 1);
                    if (pn == 8 || pn == 9) {
                        GAS bf16* Q = (GAS bf16*)(ws + WS_QB) + (unsigned)row * 512 + (pn - 8) * 256 + hd * 64 + i0;
                        u32x2 w; w.x = pk2(r1[0] * 0.125f, r1[1] * 0.125f); w.y = pk2(r1[2] * 0.125f, r1[3] * 0.125f); *(GAS u32x2*)Q = w;
                        w.x = pk2(r2[0] * 0.125f, r2[1] * 0.125f); w.y = pk2(r2[2] * 0.125f, r2[3] * 0.125f); *(GAS u32x2*)(Q + 32) = w;
                    } else if (pn == 11 || pn == 12) {
                        GAS bf16* Q = (GAS bf16*)(ws + WS_QI) + (unsigned)row * 512 + (pn - 11) * 256 + hd * 64 + i0;
                        u32x2 w; w.x = pk2(r1[0], r1[1]); w.y = pk2(r1[2], r1[3]); *(GAS u32x2*)Q = w;
                        w.x = pk2(r2[0], r2[1]); w.y = pk2(r2[2], r2[3]); *(GAS u32x2*)(Q + 32) = w;
                    } else if (pn == 10) {
                        if (bj == 0) {
                            const int g = wc >> 1;
                            GAS float* KO = row < NPR ? out + O_KP + ((unsigned)row * 2 + li) * 128 + g * 64 + i0 : out + O_KS + ((unsigned)(row - NPR) * 2 + li) * 128 + g * 64 + i0;
                            *(GAS f32x4*)KO = r1; *(GAS f32x4*)(KO + 32) = r2;
                            GAS bf16* KB = (GAS bf16*)(ws + WS_KBB) + (unsigned)row * 128 + g * 64 + i0;
                            u32x2 w; w.x = pk2(r1[0], r1[1]); w.y = pk2(r1[2], r1[3]); *(GAS u32x2*)KB = w;
                            w.x = pk2(r2[0], r2[1]); w.y = pk2(r2[2], r2[3]); *(GAS u32x2*)(KB + 32) = w;
                        } else {
#pragma unroll
                            for (int n = 0; n < 2; ++n) {
                                const int sl = wc * 32 + n * 16 + 4 * fq; const f32x4 v = n ? x2 : x1;
                                GAS float* VO = row < NPR ? out + O_VP + ((unsigned)row * 2 + li) * 128 + sl : out + O_VS + ((unsigned)(row - NPR) * 2 + li) * 128 + sl;
                                *(GAS f32x4*)VO = v;
                                if (row < NPR) { const int b = row / T, t = row % T; GAS bf16* VT = (GAS bf16*)(ws + WS_VT) + ((unsigned)(b * 2 + (sl >> 6)) * 64 + (sl & 63)) * TP + t;
#pragma unroll
                                    for (int j = 0; j < 4; ++j) VT[(unsigned)j * TP] = (bf16)f2bf(v[j]); }
                            }
                        }
                    } else {
                        if (bj == 0 && wc < 2) {
                            GAS float* KO = row < NPR ? out + O_IP + ((unsigned)row * 2 + li) * 64 + i0 : out + O_IS + ((unsigned)(row - NPR) * 2 + li) * 64 + i0;
                            *(GAS f32x4*)KO = r1; *(GAS f32x4*)(KO + 32) = r2;
                            GAS bf16* KB = (GAS bf16*)(ws + WS_KIB) + (unsigned)row * 64 + i0;
                            u32x2 w; w.x = pk2(r1[0], r1[1]); w.y = pk2(r1[2], r1[3]); *(GAS u32x2*)KB = w;
                            w.x = pk2(r2[0], r2[1]); w.y = pk2(r2[2], r2[3]); *(GAS u32x2*)(KB + 32) = w;
                        } else if (bj == 0 && wc == 2 && fq < 2) {
                            const float sc = 0.125f * 0.35355339059327373f;
                            *(GAS f32x4*)((GAS float*)(ws + WS_WI) + (unsigned)row * 8 + 4 * fq) = x1 * sc;
                        }
                    }
                }
                if (m & 1) asm volatile("" ::: "memory");
            }
        }
    }
};

DI int q_pop(Frame& F, int qidx) {
    __syncthreads();
    if (F.tid == 0) F.MISC[0] = __hip_atomic_fetch_add(F.ctl + CW_Q + 64 * qidx, 1u, __ATOMIC_RELAXED, __HIP_MEMORY_SCOPE_AGENT);
    __syncthreads();
    return (int)F.MISC[0];
}
#define MFMA16(a, b, c) __builtin_amdgcn_mfma_f32_16x16x32_bf16((a), (b), (c), 0, 0, 0)
#define MFMA32(a, b, c) __builtin_amdgcn_mfma_f32_32x32x16_bf16((a), (b), (c), 0, 0, 0)
DI bf16x8 pack8(const float (&v)[8]) { u32x4 p; p.x = pk2(v[0], v[1]); p.y = pk2(v[2], v[3]); p.z = pk2(v[4], v[5]); p.w = pk2(v[6], v[7]); return __builtin_bit_cast(bf16x8, p); }

#define LDS_BAR() do { asm volatile("s_waitcnt lgkmcnt(0)" ::: "memory"); __builtin_amdgcn_s_barrier(); asm volatile("" ::: "memory"); } while (0)
DI void hgrn_prompt_item(Frame& F, int li, int b, int h) {
    constexpr int P1 = 136, P2 = 40;
    LAS bf16* QS = (LAS bf16*)(F.lds + 0);
    LAS bf16* KH = (LAS bf16*)(F.lds + 8704);
    LAS bf16* KDT = (LAS bf16*)(F.lds + 17408);
    LAS bf16* VTL = (LAS bf16*)(F.lds + 27648);
    LAS bf16* PM = (LAS bf16*)(F.lds + 37888);
    LAS bf16* ST = (LAS bf16*)(F.lds + 40448);
    LAS float* OF = (LAS float*)(F.lds + 75264);
    LAS float* BSEG = (LAS float*)(F.lds + 92160);
    LAS float* DF = (LAS float*)(F.lds + 94208);
    int tid_ = F.tid; asm volatile("" : "+v"(tid_)); LAUNDER_F(F);
    const int tid = tid_, lane = tid & 63, w = __builtin_amdgcn_readfirstlane(tid >> 6), k = (w & 1) * 64 + lane, seg = w >> 1  , l15 = lane & 15, l4 = lane >> 4;
    const GAS bf16* QA = (const GAS bf16*)(F.ws + WS_A0); const GAS bf16* KA = (const GAS bf16*)(F.ws + WS_A1); const GAS bf16* VA = (const GAS bf16*)(F.ws + WS_A2); const GAS bf16* GA = (const GAS bf16*)(F.ws + WS_A3);
    const GAS float* LF = (const GAS float*)(F.ws + WS_LF); GAS bf16* MIX = (GAS bf16*)(F.ws + WS_MIX);
    const int t4 = tid >> 4, part = tid & 15;
    float ng[8];
#pragma unroll
    for (int j = 0; j < 8; ++j) ng[j] = GIN(14)[li * 128 + 8 * part + j];
    f32x4 S[8];
#pragma unroll
    for (int i = 0; i < 8; ++i) S[i] = (f32x4){0.f, 0.f, 0.f, 0.f};
    float clf[8], cq[8], ck[8], cv[8], nlf[8]; unsigned nq[8], nk[8], nv[8]; u32x4 gcur, gnext;
    const unsigned colb = (unsigned)(h * 128 + k);
    const unsigned gcol = (unsigned)(h * 128 + 8 * part);
#define HG_LOAD(c) do { _Pragma("unroll") for (int i = 0; i < 8; ++i) { const int t = 32 * (c) + 8 * seg + i; const unsigned o = (unsigned)(b * T + (t < T ? t : T - 1)) * 512u + colb; \
        nlf[i] = LF[o]; nq[i] = QA[o]; nk[i] = KA[o]; nv[i] = VA[o]; } \
        { const int t = 32 * (c) + t4; gnext = *(const GAS u32x4*)(GA + (unsigned)(b * T + (t < T ? t : T - 1)) * 512u + gcol); } } while (0)
#define HG_TAKE(c) do { _Pragma("unroll") for (int i = 0; i < 8; ++i) { const bool ok = 32 * (c) + 8 * seg + i < T; clf[i] = ok ? nlf[i] : 0.f; cq[i] = ok ? bf2f(nq[i]) : 0.f; ck[i] = ok ? bf2f(nk[i]) : 0.f; cv[i] = ok ? bf2f(nv[i]) : 0.f; } gcur = gnext; } while (0)
    __syncthreads();
    HG_LOAD(0);
    constexpr int NCH = (T + 31) / 32;
    for (int c = 0; c < NCH; ++c) {
        HG_TAKE(c);
        if (c + 1 < NCH) HG_LOAD(c + 1);
        float cs[8]; float run = 0.f;
#pragma unroll
        for (int i = 0; i < 8; ++i) { run += clf[i]; cs[i] = run; }
        BSEG[seg * 128 + k] = run;
        LDS_BAR();
        float pre = 0.f, tot = 0.f;
#pragma unroll
        for (int sgi = 0; sgi < 4; ++sgi) { const float v = BSEG[sgi * 128 + k]; tot += v; if (sgi < seg) pre += v; }
        float kd[8];
#pragma unroll
        for (int i = 0; i < 8; ++i) { const float bb = pre + cs[i]; const int t = 8 * seg + i;
            QS[t * P1 + k] = (bf16)f2bf(cq[i] * __expf(bb)); KH[t * P1 + k] = (bf16)f2bf(ck[i] * __expf(-bb)); kd[i] = ck[i] * __expf(tot - bb); }
        *(LAS bf16x8*)(KDT + k * P2 + 8 * seg) = pack8(kd);
        *(LAS bf16x8*)(VTL + k * P2 + 8 * seg) = pack8(cv);
        if (seg == 0) DF[k] = __expf(tot);
#pragma unroll
        for (int i = 0; i < 8; ++i) { u32x2 o; o.x = pk2(S[i][0], S[i][1]); o.y = pk2(S[i][2], S[i][3]); *(LAS u32x2*)(ST + (16 * w + l15) * P1 + 16 * i + 4 * l4) = o; }
        LDS_BAR();
        if (w < 4) {
            const int ti = w >> 1, tj = w & 1; f32x4 pacc = {0.f, 0.f, 0.f, 0.f};
            if (tj <= ti) {
#pragma unroll
                for (int ks = 0; ks < 4; ++ks) { const bf16x8 a = *(const LAS bf16x8*)(QS + (16 * ti + l15) * P1 + 32 * ks + 8 * l4); const bf16x8 bb = *(const LAS bf16x8*)(KH + (16 * tj + l15) * P1 + 32 * ks + 8 * l4); pacc = MFMA16(a, bb, pacc); }
            }
#pragma unroll
            for (int r = 0; r < 4; ++r) { const int t = 16 * ti + 4 * l4 + r, sidx = 16 * tj + l15; PM[t * P2 + sidx] = (bf16)f2bf(sidx <= t ? pacc[r] : 0.f); }
        }
        LDS_BAR();
        {
            const bf16x8 bv = *(const LAS bf16x8*)(VTL + (16 * w + l15) * P2 + 8 * l4);
#pragma unroll
            for (int ti = 0; ti < 2; ++ti) {
                f32x4 o = {0.f, 0.f, 0.f, 0.f};
                o = MFMA16(*(const LAS bf16x8*)(PM + (16 * ti + l15) * P2 + 8 * l4), bv, o);
#pragma unroll
                for (int ks = 0; ks < 4; ++ks) o = MFMA16(*(const LAS bf16x8*)(QS + (16 * ti + l15) * P1 + 32 * ks + 8 * l4), *(const LAS bf16x8*)(ST + (16 * w + l15) * P1 + 32 * ks + 8 * l4), o);
#pragma unroll
                for (int r = 0; r < 4; ++r) OF[(16 * ti + 4 * l4 + r) * 132 + 16 * w + l15] = o[r];
            }
#pragma unroll
            for (int i = 0; i < 8; ++i) { const f32x4 d = *(const LAS f32x4*)(DF + 16 * i + 4 * l4); f32x4 sc = S[i] * d;
                S[i] = MFMA16(*(const LAS bf16x8*)(KDT + (16 * i + l15) * P2 + 8 * l4), bv, sc); }
        }
        LDS_BAR();
        {
            const int tg = 32 * c + t4;
            float o[8]; float ss = 0.f;
            { const f32x4 o0 = *(const LAS f32x4*)(OF + t4 * 132 + 8 * part), o1 = *(const LAS f32x4*)(OF + t4 * 132 + 8 * part + 4); o[0] = o0[0]; o[1] = o0[1]; o[2] = o0[2]; o[3] = o0[3]; o[4] = o1[0]; o[5] = o1[1]; o[6] = o1[2]; o[7] = o1[3]; }
#pragma unroll
            for (int j = 0; j < 8; ++j) ss += o[j] * o[j];
            ss += __shfl_xor(ss, 1); ss += __shfl_xor(ss, 2); ss += __shfl_xor(ss, 4); ss += __shfl_xor(ss, 8);
            if (tg < T) { const float rs = rsqrtf(ss * (1.0f / 128.0f) + RMS_EPS);
                const unsigned gw[4] = {gcur.x, gcur.y, gcur.z, gcur.w}; float r8[8];
#pragma unroll
                for (int j = 0; j < 8; ++j) { const float gv = bf2f((gw[j >> 1] >> (16 * (j & 1))) & 0xffffu); r8[j] = o[j] * rs * ng[j] * gv; }
                *(GAS bf16x8*)(MIX + (unsigned)(b * T + tg) * 1024u + gcol) = pack8(r8); }
        }
    }
#undef HG_LOAD
#undef HG_TAKE
    GAS float* HO = F.out + O_HP + ((size_t)((b * 2 + li) * 4 + h) * 128) * 128;
#pragma unroll
    for (int i = 0; i < 8; ++i)
#pragma unroll
        for (int r = 0; r < 4; ++r) HO[(size_t)(16 * i + 4 * l4 + r) * 128 + 16 * w + l15] = S[i][r];
}

DI void hgrn_sample_item(Frame& F, int li, int s, int h) {
    LAS float* RED = (LAS float*)(F.lds + 0);
    int tid_ = F.tid; asm volatile("" : "+v"(tid_)); LAUNDER_F(F);
    const int tid = tid_, lane = tid & 63, kg = tid >> 5, v4 = tid & 31, row = NPR + s;
    const GAS bf16* QA = (const GAS bf16*)(F.ws + WS_A0); const GAS bf16* KA = (const GAS bf16*)(F.ws + WS_A1); const GAS bf16* VA = (const GAS bf16*)(F.ws + WS_A2); const GAS bf16* GA = (const GAS bf16*)(F.ws + WS_A3);
    const GAS float* LF = (const GAS float*)(F.ws + WS_LF); GAS bf16* MIX = (GAS bf16*)(F.ws + WS_MIX); const GAS float* NG = GIN(14) + li * 128;
    {
        const GAS float* S0 = GIN(5) + ((size_t)((s * 2 + li) * 4 + h) * 128) * 128; GAS float* S1 = F.out + O_HS + ((size_t)((s * 2 + li) * 4 + h) * 128) * 128;
        const size_t ro = (size_t)row * 512 + h * 128;
        f32x4 vv; { const u32x2 vr = *(const GAS u32x2*)(VA + ro + 4 * v4); vv = (f32x4){bf2f(vr.x & 0xffffu), bf2f(vr.x >> 16), bf2f(vr.y & 0xffffu), bf2f(vr.y >> 16)}; }
        f32x4 o4 = {0.f, 0.f, 0.f, 0.f};
#pragma unroll
        for (int kk = 0; kk < 8; ++kk) { const int k = 8 * kg + kk; const float dec = __expf(LF[ro + k]), ka = bf2f(KA[ro + k]), q = bf2f(QA[ro + k]);
            const f32x4 sv = *(const GAS f32x4*)(S0 + (size_t)k * 128 + 4 * v4); const f32x4 nv = sv * dec + vv * ka; *(GAS f32x4*)(S1 + (size_t)k * 128 + 4 * v4) = nv; o4 += nv * q; }
        __syncthreads();
        *(LAS f32x4*)(RED + kg * 128 + 4 * v4) = o4;
        __syncthreads();
        if (tid < 64) {
            float oa = 0.f, ob = 0.f;
#pragma unroll
            for (int g = 0; g < 16; ++g) { oa += RED[g * 128 + lane]; ob += RED[g * 128 + 64 + lane]; }
            const float ss = wave_sum(oa * oa + ob * ob); const float rs = rsqrtf(ss * (1.0f / 128.0f) + RMS_EPS);
            MIX[(size_t)row * 1024 + h * 128 + lane] = (bf16)f2bf(oa * rs * NG[lane] * bf2f(GA[ro + lane]));
            MIX[(size_t)row * 1024 + h * 128 + 64 + lane] = (bf16)f2bf(ob * rs * NG[64 + lane] * bf2f(GA[ro + 64 + lane]));
        }
    }
}

DI unsigned ord_key(float v) { const unsigned bits = __builtin_bit_cast(unsigned, v); return (bits & 0x80000000u) ? ~bits : (bits | 0x80000000u); }
DI int dpp_row_sum(int v) {
    v += __builtin_amdgcn_update_dpp(0, v, 0xB1, 0xf, 0xf, false);
    v += __builtin_amdgcn_update_dpp(0, v, 0x4E, 0xf, 0xf, false);
    v += __builtin_amdgcn_update_dpp(0, v, 0x141, 0xf, 0xf, false);
    v += __builtin_amdgcn_update_dpp(0, v, 0x140, 0xf, 0xf, false);
    return v;
}
DI int wave_sum_i(int v) { v = dpp_row_sum(v); return __builtin_amdgcn_readlane(v, 0) + __builtin_amdgcn_readlane(v, 16) + __builtin_amdgcn_readlane(v, 32) + __builtin_amdgcn_readlane(v, 48); }
template <int NJ> DI int count_ge(const unsigned (&u)[NJ], unsigned cand) {
    int c0 = 0, c1 = 0, c2 = 0, c3 = 0;
#pragma unroll
    for (int j = 0; j + 3 < NJ; j += 4) { c0 += (u[j] >= cand) ? 1 : 0; c1 += (u[j + 1] >= cand) ? 1 : 0; c2 += (u[j + 2] >= cand) ? 1 : 0; c3 += (u[j + 3] >= cand) ? 1 : 0; }
#pragma unroll
    for (int j = NJ & ~3; j < NJ; ++j) c0 += (u[j] >= cand) ? 1 : 0;
    return wave_sum_i((c0 + c1) + (c2 + c3));
}
template <int NJ> DI u64 select256(const unsigned (&u)[NJ], int lane, LAS unsigned* scr) {
    unsigned Tv = 0u; int c_lo = NJ * 64, c_hi = 0, bit = 31;
    for (; bit >= 1; bit -= 2) {
        if (c_lo - c_hi <= 64) break;
        const unsigned s1 = Tv | (1u << (bit - 1)), s2 = Tv | (2u << (bit - 1)), s3 = Tv | (3u << (bit - 1));
        int a1 = 0, a2 = 0, a3 = 0;
#pragma unroll
        for (int j = 0; j < NJ; ++j) { a1 += (u[j] >= s1) ? 1 : 0; a2 += (u[j] >= s2) ? 1 : 0; a3 += (u[j] >= s3) ? 1 : 0; }
        a1 = dpp_row_sum(a1); a2 = dpp_row_sum(a2); a3 = dpp_row_sum(a3);
        const int n1 = (__builtin_amdgcn_readlane(a1, 0) + __builtin_amdgcn_readlane(a1, 16)) + (__builtin_amdgcn_readlane(a1, 32) + __builtin_amdgcn_readlane(a1, 48));
        const int n2 = (__builtin_amdgcn_readlane(a2, 0) + __builtin_amdgcn_readlane(a2, 16)) + (__builtin_amdgcn_readlane(a2, 32) + __builtin_amdgcn_readlane(a2, 48));
        const int n3 = (__builtin_amdgcn_readlane(a3, 0) + __builtin_amdgcn_readlane(a3, 16)) + (__builtin_amdgcn_readlane(a3, 32) + __builtin_amdgcn_readlane(a3, 48));
        if (n3 >= 256) { Tv = s3; c_lo = n3; }
        else if (n2 >= 256) { Tv = s2; c_lo = n2; c_hi = n3; }
        else if (n1 >= 256) { Tv = s1; c_lo = n1; c_hi = n2; }
        else c_hi = n1;
    }
    for (; bit >= 0; --bit) {
        if (c_lo - c_hi <= 64) break;
        const unsigned cand = Tv | (1u << bit);
        const int c = count_ge<NJ>(u, cand);
        if (c >= 256) { Tv = cand; c_lo = c; } else c_hi = c;
    }
    int cT = c_lo;
    if (bit >= 0) {
        const unsigned width = 2u << bit; int base = 0;
        const u64 ltmask = (1ull << lane) - 1ull;
#pragma unroll
        for (int j = 0; j < NJ; ++j) { const bool in = (u[j] - Tv) < width; const u64 m = __ballot(in);
            const int pos = in ? base + __builtin_popcountll(m & ltmask) : 65;
            scr[pos] = u[j];
            base += __builtin_popcountll(m); }
        asm volatile("s_waitcnt lgkmcnt(0)" ::: "memory");
        const unsigned cv = lane < (c_lo - c_hi) ? scr[lane] : 0u;
        for (; bit >= 0; --bit) { const unsigned cand = Tv | (1u << bit); if (c_hi + __builtin_popcountll(__ballot(cv >= cand)) >= 256) Tv = cand; }
        cT = c_hi + __builtin_popcountll(__ballot(cv >= Tv));
    }
    u64 my = 0ull;
    if (cT == 256) {
#pragma unroll
        for (int j = 0; j < NJ; ++j) { const u64 wd = __ballot(u[j] >= Tv); my = (lane == j) ? wd : my; }
        return my;
    }
    int need = 256 - count_ge<NJ>(u, Tv + 1u);
#pragma unroll
    for (int j = 0; j < NJ; ++j) {
        const u64 gt = __ballot(u[j] > Tv), eq = __ballot(u[j] == Tv); const int c = __builtin_popcountll(eq); u64 take;
        if (c <= need) { take = eq; need -= c; }
        else { take = 0ull; u64 e = eq; for (int z = 0; z < need; ++z) { const u64 low = e & (~e + 1ull); take |= low; e ^= low; } need = 0; }
        const u64 wd = gt | take; my = (lane == j) ? wd : my;
    }
    return my;
}
template <int NJ> DI void dsa_select_rows(const GAS float* SC, LAS u64* MASK, LAS unsigned* scr, int w, int lane, int q0, int rpw) {
    float nx[NJ];
#pragma unroll
    for (int j = 0; j < NJ; ++j) nx[j] = SC[(size_t)(w * rpw) * TP + 64 * j + lane];
    for (int i = 0; i < rpw; ++i) {
        const int q = w * rpw + i, t = q0 + q; LAS u64* mrow = MASK + q * 34;
        unsigned u[NJ];
#pragma unroll
        for (int j = 0; j < NJ; ++j) { const int sidx = 64 * j + lane; u[j] = sidx <= t ? ord_key(nx[j]) : 0u; }
        if (i + 1 < rpw) {
#pragma unroll
            for (int j = 0; j < NJ; ++j) nx[j] = SC[(size_t)(q + 1) * TP + 64 * j + lane]; }
        if (t >= T) { if (lane < 34) mrow[lane] = 0ull; continue; }
        const int jfull = t >> 6, rem = t & 63;
        if (t + 1 <= 256) { if (lane < 34) mrow[lane] = lane < jfull ? ~0ull : (lane == jfull ? ((2ull << rem) - 1ull) : 0ull); continue; }
        const u64 my = select256<NJ>(u, lane, scr);
        if (lane < 34) mrow[lane] = lane < NJ ? my : 0ull;
    }
}

DI float xhalf_max(float x) { const auto r = __builtin_amdgcn_permlane32_swap(__builtin_bit_cast(unsigned, x), __builtin_bit_cast(unsigned, x), false, false); return fmaxf(__builtin_bit_cast(float, r[0]), __builtin_bit_cast(float, r[1])); }
DI float xhalf_sum(float x) { const auto r = __builtin_amdgcn_permlane32_swap(__builtin_bit_cast(unsigned, x), __builtin_bit_cast(unsigned, x), false, false); return __builtin_bit_cast(float, r[0]) + __builtin_bit_cast(float, r[1]); }
DI void dsa_prompt_item(Frame& F, int b, int q0, int nqh) {
    constexpr int QP = 520;
    LAS bf16* QIL = (LAS bf16*)(F.lds + 0);
    LAS u64* MASK = (LAS u64*)(F.lds + 66560);
    int tid_ = F.tid; asm volatile("" : "+v"(tid_)); LAUNDER_F(F);
    const int tid = tid_, lane = tid & 63, w = __builtin_amdgcn_readfirstlane(tid >> 6), l31 = lane & 31, hh = lane >> 5;
    const int nq = (T - q0) < 32 * nqh ? (T - q0) : 32 * nqh, tmax = q0 + nq - 1, nkt = tmax / 32 + 1;
    const GAS bf16* QI = (const GAS bf16*)(F.ws + WS_QI); const GAS bf16* KIB = (const GAS bf16*)(F.ws + WS_KIB); const GAS float* WI = (const GAS float*)(F.ws + WS_WI);
    const GAS bf16* QB = (const GAS bf16*)(F.ws + WS_QB); const GAS bf16* KBB = (const GAS bf16*)(F.ws + WS_KBB); const GAS bf16* VT = (const GAS bf16*)(F.ws + WS_VT); GAS bf16* MIX = (GAS bf16*)(F.ws + WS_MIX);
    GAS float* SC = (GAS float*)(F.ws + WS_SC) + (size_t)F.wg * 64 * TP;
    const size_t rb = (size_t)b * T;
#pragma unroll
    for (int i = 0; i < 8; ++i) { const int e = tid + 512 * i, r = e >> 6, c8 = e & 63; const int t = q0 + r < T ? q0 + r : T - 1;
        *(LAS u32x4*)(QIL + r * QP + 8 * c8) = *(const GAS u32x4*)(QI + (rb + t) * 512 + 8 * c8); }
    __syncthreads();
#if PROBE_TS == 3
    const unsigned long long _ta = __builtin_amdgcn_s_memrealtime();
#endif
    {
        const int qh = nqh == 2 ? (w & 1) : 0, kt0 = nqh == 2 ? (w >> 1) : w, kts = nqh == 2 ? 4 : 8, tq = q0 + 32 * qh + l31, tqc = tq < T ? tq : T - 1;
        float wq[8]; { const f32x4 a = *(const GAS f32x4*)(WI + (rb + tqc) * 8), c = *(const GAS f32x4*)(WI + (rb + tqc) * 8 + 4); wq[0] = a[0]; wq[1] = a[1]; wq[2] = a[2]; wq[3] = a[3]; wq[4] = c[0]; wq[5] = c[1]; wq[6] = c[2]; wq[7] = c[3]; }
        const int tlast = (q0 + 32 * qh + 31) < tmax ? (q0 + 32 * qh + 31) : tmax;
        if (q0 + 32 * qh <= tmax) {
        bf16x8 kan[4];
        { const int key = 32 * kt0 + l31, keyc = key < T ? key : T - 1;
#pragma unroll
          for (int ks = 0; ks < 4; ++ks) kan[ks] = *(const GAS bf16x8*)(KIB + (rb + keyc) * 64 + 16 * ks + 8 * hh); }
        for (int kt = kt0; 32 * kt <= tlast; kt += kts) {
            bf16x8 ka[4];
#pragma unroll
            for (int ks = 0; ks < 4; ++ks) ka[ks] = kan[ks];
            { const int key = 32 * (kt + kts) + l31, keyc = key < T ? key : T - 1;
#pragma unroll
              for (int ks = 0; ks < 4; ++ks) kan[ks] = *(const GAS bf16x8*)(KIB + (rb + keyc) * 64 + 16 * ks + 8 * hh); }
            f32x16 tot;
#pragma unroll
            for (int r = 0; r < 16; ++r) tot[r] = 0.f;
#pragma unroll
            for (int hd = 0; hd < 8; ++hd) {
                asm volatile("" ::: "memory");
                f32x16 a;
#pragma unroll
                for (int r = 0; r < 16; ++r) a[r] = 0.f;
#pragma unroll
                for (int ks = 0; ks < 4; ++ks) a = MFMA32(ka[ks], *(const LAS bf16x8*)(QIL + (32 * qh + l31) * QP + hd * 64 + 16 * ks + 8 * hh), a);
#pragma unroll
                for (int r = 0; r < 16; ++r) tot[r] += wq[hd] * fmaxf(a[r], 0.f);
            }
            if (tq < T) {
#pragma unroll
                for (int g = 0; g < 4; ++g) *(GAS f32x4*)(SC + (size_t)(32 * qh + l31) * TP + 32 * kt + 8 * g + 4 * hh) = (f32x4){tot[4 * g], tot[4 * g + 1], tot[4 * g + 2], tot[4 * g + 3]};
            }
        }
        }
    }
    __syncthreads();
#if PROBE_TS == 3
    const unsigned long long _tb = __builtin_amdgcn_s_memrealtime();
#endif
    {
        LAS unsigned* scr = (LAS unsigned*)(F.lds + 84480) + w * 80;
        const int njn = (tmax >> 6) + 1;
        const int rpw = 4 * nqh;
        if (njn <= 9) dsa_select_rows<9>(SC, MASK, scr, w, lane, q0, rpw);
        else if (njn <= 17) dsa_select_rows<17>(SC, MASK, scr, w, lane, q0, rpw);
        else if (njn <= 25) dsa_select_rows<25>(SC, MASK, scr, w, lane, q0, rpw);
        else dsa_select_rows<33>(SC, MASK, scr, w, lane, q0, rpw);
    }
    __syncthreads();
#if PROBE_TS == 3
    const unsigned long long _tc = __builtin_amdgcn_s_memrealtime();
#endif
    {
        const int hd = w, g = hd >> 2;
        constexpr int KP = 136, VP = 40;
        LAS bf16* KL = (LAS bf16*)(F.lds + 87040);
        LAS bf16* VL = (LAS bf16*)(F.lds + 104448);
        const LAS unsigned* M32 = (const LAS unsigned*)MASK;
        bf16x8 qf[2][4];
#pragma unroll
        for (int qh = 0; qh < 2; ++qh) { const int tq = q0 + 32 * qh + l31, tqc = tq < T ? tq : T - 1;
#pragma unroll
            for (int ks = 0; ks < 4; ++ks) qf[qh][ks] = *(const GAS bf16x8*)(QB + (rb + tqc) * 512 + hd * 64 + 16 * ks + 8 * hh); }
        f32x16 O[2][2]; float mrun[2], lrun[2];
#pragma unroll
        for (int qh = 0; qh < 2; ++qh) { mrun[qh] = -INFINITY; lrun[qh] = 0.f;
#pragma unroll
            for (int dt = 0; dt < 2; ++dt)
#pragma unroll
                for (int r = 0; r < 16; ++r) O[qh][dt][r] = 0.f; }
        const int krow = tid >> 4, kch = tid & 15, vrow = tid >> 2, vch = tid & 3;
        u32x4 sk, sv;
#define DC_LOAD(kt_) do { const int key_ = 32 * (kt_) + krow, keyc_ = key_ < T ? key_ : T - 1; sk = *(const GAS u32x4*)(KBB + (rb + keyc_) * 128 + 8 * kch); \
            sv = *(const GAS u32x4*)(VT + ((size_t)(b * 128 + vrow)) * TP + 32 * (kt_) + 8 * vch); } while (0)
#define DC_STORE(buf_) do { *(LAS u32x4*)(KL + ((buf_) * 32 + krow) * KP + 8 * kch) = sk; *(LAS u32x4*)(VL + ((buf_) * 128 + vrow) * VP + 8 * vch) = sv; } while (0)
        DC_LOAD(0); DC_STORE(0);
        __syncthreads();
        for (int kt = 0; kt < nkt; ++kt) {
            const int buf = kt & 1;
            if (kt + 1 < nkt) DC_LOAD(kt + 1);
#pragma unroll
            for (int qh = 0; qh < 2; ++qh) {
                if (qh >= nqh || 32 * kt > q0 + 32 * qh + 31 || q0 + 32 * qh > tmax) continue;
                f32x16 sa;
#pragma unroll
                for (int r = 0; r < 16; ++r) sa[r] = 0.f;
#pragma unroll
                for (int ks = 0; ks < 4; ++ks) sa = MFMA32(*(const LAS bf16x8*)(KL + (buf * 32 + l31) * KP + g * 64 + 16 * ks + 8 * hh), qf[qh][ks], sa);
                const unsigned mw = M32[(32 * qh + l31) * 68 + kt] >> (4 * hh);
                float mx = -INFINITY;
#pragma unroll
                for (int r = 0; r < 16; ++r) { const bool on = (mw >> ((r & 3) + 8 * (r >> 2))) & 1u; sa[r] = on ? sa[r] : -INFINITY; mx = fmaxf(mx, sa[r]); }
                mx = xhalf_max(mx);
                const float mnew = fmaxf(mrun[qh], mx);
                const float msafe = mnew == -INFINITY ? 0.f : mnew;
                const float alpha = __expf(mrun[qh] - msafe);
                float pr[16]; float rs = 0.f;
#pragma unroll
                for (int r = 0; r < 16; ++r) { pr[r] = __expf(sa[r] - msafe); rs += pr[r]; }
                rs = xhalf_sum(rs);
                lrun[qh] = lrun[qh] * alpha + rs; mrun[qh] = mnew;
                if (!__all(alpha == 1.0f)) {
#pragma unroll
                    for (int dt = 0; dt < 2; ++dt)
#pragma unroll
                        for (int r = 0; r < 16; ++r) O[qh][dt][r] *= alpha;
                }
#pragma unroll
                for (int s2 = 0; s2 < 2; ++s2) {
                    const float pv[8] = {pr[8 * s2], pr[8 * s2 + 1], pr[8 * s2 + 2], pr[8 * s2 + 3], pr[8 * s2 + 4], pr[8 * s2 + 5], pr[8 * s2 + 6], pr[8 * s2 + 7]};
                    const bf16x8 pf = pack8(pv);
#pragma unroll
                    for (int dt = 0; dt < 2; ++dt) { const LAS bf16* vp = VL + (buf * 128 + g * 64 + 32 * dt + l31) * VP + 16 * s2 + 4 * hh;
                        const u32x2 lo = *(const LAS u32x2*)vp, hi = *(const LAS u32x2*)(vp + 8); u32x4 pk; pk.x = lo.x; pk.y = lo.y; pk.z = hi.x; pk.w = hi.y;
                        O[qh][dt] = MFMA32(__builtin_bit_cast(bf16x8, pk), pf, O[qh][dt]); }
                }
            }
            if (kt + 1 < nkt) DC_STORE(buf ^ 1);
            LDS_BAR();
        }
#undef DC_LOAD
#undef DC_STORE
#pragma unroll
        for (int qh = 0; qh < 2; ++qh) { const int tq = q0 + 32 * qh + l31;
            if (qh < nqh && tq < T) { const float inv = frcp(lrun[qh]);
#pragma unroll
                for (int dt = 0; dt < 2; ++dt)
#pragma unroll
                    for (int g4 = 0; g4 < 4; ++g4) { u32x2 o; o.x = pk2(O[qh][dt][4 * g4] * inv, O[qh][dt][4 * g4 + 1] * inv); o.y = pk2(O[qh][dt][4 * g4 + 2] * inv, O[qh][dt][4 * g4 + 3] * inv);
                        *(GAS u32x2*)(MIX + (rb + tq) * 1024 + 512 + hd * 64 + 32 * dt + 8 * g4 + 4 * hh) = o; } } }
    }
#if PROBE_TS == 3
    __syncthreads();
    if (tid == 0) { const unsigned long long _td = __builtin_amdgcn_s_memrealtime(); atomicAdd(F.ctl + 20000, (unsigned)(_tb - _ta)); atomicAdd(F.ctl + 20001, (unsigned)(_tc - _tb)); atomicAdd(F.ctl + 20002, (unsigned)(_td - _tc)); }
#endif
}

DI void dsa_sample_item(Frame& F, int li, int s) {
    LAS float* QIF = (LAS float*)(F.lds + 0);
    LAS float* QBF = (LAS float*)(F.lds + 2048);
    LAS float* WIF = (LAS float*)(F.lds + 4096);
    LAS float* SCL = (LAS float*)(F.lds + 4352);
    LAS int* SEL = (LAS int*)(F.lds + 12800);
    LAS float* LG = (LAS float*)(F.lds + 13824);
    int tid_ = F.tid; asm volatile("" : "+v"(tid_)); LAUNDER_F(F);
    const int tid = tid_, lane = tid & 63, wv = __builtin_amdgcn_readfirstlane(tid >> 6), row = NPR + s;
    const GAS int* PT = (const GAS int*)GIN(9) + s * NPAGES;
    QIF[tid] = bf2f(((const GAS bf16*)(F.ws + WS_QI))[(size_t)row * 512 + tid]);
    QBF[tid] = bf2f(((const GAS bf16*)(F.ws + WS_QB))[(size_t)row * 512 + tid]);
    if (tid < 8) WIF[tid] = ((const GAS float*)(F.ws + WS_WI))[(size_t)row * 8 + tid];
    LAS int* PTL = (LAS int*)(F.lds + 23040);
    if (tid >= 64 && tid < 64 + NPAGES) PTL[tid - 64] = PT[tid - 64];
    __syncthreads();
    {
        const int sub = lane & 15, kq = lane >> 4;
        f32x4 qs[8];
#pragma unroll
        for (int hd = 0; hd < 8; ++hd) qs[hd] = *(const LAS f32x4*)(QIF + hd * 64 + 4 * sub);
        float wv8[8];
#pragma unroll
        for (int hd = 0; hd < 8; ++hd) wv8[hd] = WIF[hd];
        const GAS float* kbase = GIN(4) + (size_t)li * 64 + 4 * sub;
        for (int g0 = 0; g0 < 64; g0 += 8) {
            f32x4 kv[8];
#pragma unroll
            for (int i = 0; i < 8; ++i) { const int n = 256 * wv + 4 * (g0 + i) + kq; const int pg = PTL[n >> 7]; kv[i] = *(const GAS f32x4*)(kbase + (size_t)(pg * PAGE + (n & 127)) * 128); }
#pragma unroll
            for (int i = 0; i < 8; ++i) { float sc = 0.f;
#pragma unroll
                for (int hd = 0; hd < 8; ++hd) { float d = kv[i][0] * qs[hd][0] + kv[i][1] * qs[hd][1] + kv[i][2] * qs[hd][2] + kv[i][3] * qs[hd][3]; d = row_sum16(d); sc += wv8[hd] * fmaxf(d, 0.f); }
                if (sub == 0) SCL[256 * wv + 4 * (g0 + i) + kq] = sc; }
        }
        if (tid < 64) {
            const float kvn = F.out[O_IS + ((size_t)s * 2 + li) * 64 + lane]; float sc = 0.f;
#pragma unroll
            for (int hd = 0; hd < 8; ++hd) { const float d = wave_sum(kvn * QIF[hd * 64 + lane]); sc += WIF[hd] * fmaxf(d, 0.f); }
            if (lane == 0) SCL[2048] = sc;
        }
    }
    __syncthreads();
    if (wv == 0) {
        unsigned u[33];
#pragma unroll
        for (int j = 0; j < 33; ++j) { const int sidx = 64 * j + lane; u[j] = sidx <= PAST ? ord_key(SCL[sidx]) : 0u; }
        const u64 my = select256<33>(u, lane, (LAS unsigned*)(F.lds + 24576));
        int base = 0;
#pragma unroll
        for (int j = 0; j < 33; ++j) { const u64 wd = __shfl(my, j); const bool on = (wd >> lane) & 1ull; const int pos = base + __builtin_popcountll(wd & ((1ull << lane) - 1ull));
            if (on && pos < 256) SEL[pos] = 64 * j + lane; base += __builtin_popcountll(wd); }
    }
    __syncthreads();
    LAS int* ROWID = (LAS int*)(F.lds + 22016);
    if (tid < 256) { const int idx = SEL[tid]; ROWID[tid] = idx < PAST ? PTL[idx >> 7] * PAGE + (idx & 127) : -1; }
    __syncthreads();
    {
        const int n = tid >> 1, g = tid & 1, rid = ROWID[n];
        const GAS float* kp = rid >= 0 ? GIN(2) + ((size_t)rid * 2 + li) * 128 + g * 64 : F.out + O_KS + ((size_t)s * 2 + li) * 128 + g * 64;
        f32x4 kv[16];
#pragma unroll
        for (int dq = 0; dq < 16; ++dq) kv[dq] = *(const GAS f32x4*)(kp + 4 * dq);
        float a4[4] = {0.f, 0.f, 0.f, 0.f};
#pragma unroll
        for (int dq = 0; dq < 16; ++dq) {
#pragma unroll
            for (int i = 0; i < 4; ++i) { const f32x4 qv = *(const LAS f32x4*)(QBF + (4 * g + i) * 64 + 4 * dq); a4[i] += kv[dq][0] * qv[0] + kv[dq][1] * qv[1] + kv[dq][2] * qv[2] + kv[dq][3] * qv[3]; } }
#pragma unroll
        for (int i = 0; i < 4; ++i) LG[(4 * g + i) * 256 + n] = a4[i];
    }
    __syncthreads();
    {
        const int hd = wv; float v[4]; float mx = -INFINITY;
#pragma unroll
        for (int i = 0; i < 4; ++i) { v[i] = LG[hd * 256 + lane + 64 * i]; mx = fmaxf(mx, v[i]); }
#pragma unroll
        for (int o = 1; o < 64; o <<= 1) mx = fmaxf(mx, __shfl_xor(mx, o));
        float sm = 0.f;
#pragma unroll
        for (int i = 0; i < 4; ++i) { v[i] = __expf(v[i] - mx); sm += v[i]; }
        sm = wave_sum(sm); const float inv = frcp(sm);
#pragma unroll
        for (int i = 0; i < 4; ++i) LG[hd * 256 + lane + 64 * i] = v[i] * inv;
    }
    __syncthreads();
    {
        LAS float* PO = (LAS float*)(F.lds + 32768);
        const GAS float* vnew = F.out + O_VS + ((size_t)s * 2 + li) * 128 + lane;
        const GAS float* vbase = GIN(3) + (size_t)li * 128 + lane;
        float v0[32], v1[32];
#pragma unroll
        for (int i = 0; i < 32; ++i) { const int rid = ROWID[32 * wv + i]; const GAS float* vp = rid >= 0 ? vbase + (size_t)rid * 256 : vnew; v0[i] = vp[0]; v1[i] = vp[64]; }
        float o[8];
#pragma unroll
        for (int hd = 0; hd < 8; ++hd) o[hd] = 0.f;
#pragma unroll
        for (int i = 0; i < 32; ++i) {
#pragma unroll
            for (int hd = 0; hd < 8; ++hd) o[hd] += LG[hd * 256 + 32 * wv + i] * (hd < 4 ? v0[i] : v1[i]); }
#pragma unroll
        for (int hd = 0; hd < 8; ++hd) PO[(wv * 8 + hd) * 64 + lane] = o[hd];
        __syncthreads();
        { const int hd = tid >> 6; float a = 0.f;
#pragma unroll
          for (int q = 0; q < 8; ++q) a += PO[(q * 8 + hd) * 64 + lane];
          ((GAS bf16*)(F.ws + WS_MIX))[(size_t)row * 1024 + 512 + hd * 64 + lane] = (bf16)f2bf(a); }
    }
}

struct OutProj {
    static constexpr int PID = 0;
    static constexpr bool GATHER = false, SPLITB = false; static constexpr int KSPLIT = 0, K = 1024, lda = 1024, ldb = 1024;
    const GAS bf16* A; const GAS bf16* Bt; int G, c; GAS bf16* Dd;
    DI bool next(int i, pg8::Unit& u) const { if (!pg8::static_next<M / 256, 4>(G, c, i, u.pm, u.pn)) return false;
        u.B0 = (const GAS char*)(Bt + (size_t)u.pn * 256 * 1024); u.B1 = u.B0; u.aux = 0; return true; }
    DI void epi(const AccT& acc, const pg8::Unit& u, int wr, int wc, int fr, int fq) const {
        asm volatile("" : "+v"(fr), "+v"(fq));
#pragma unroll
        for (int ai = 0; ai < 2; ++ai)
#pragma unroll
            for (int m = 0; m < 4; ++m) { GAS bf16* rp = Dd + (unsigned)(u.pm * 256 + ai * 128 + wr * 64 + m * 16 + fr) * D + u.pn * 256 + wc * 32 + 4 * fq;
#pragma unroll
                for (int bj = 0; bj < 2; ++bj)
#pragma unroll
                    for (int n = 0; n < 2; ++n) { const f32x4 v = acc[ai][bj][m][n]; u32x2 o; o.x = pk2(v[0], v[1]); o.y = pk2(v[2], v[3]); *(GAS u32x2*)(rp + bj * 128 + n * 16) = o; } }
    }
};

DI void p_ln(Frame& F, int layer, bool second, bool final_) {
    int tid_ = F.tid; asm volatile("" : "+v"(tid_)); LAUNDER_F(F);
    const int tid = tid_, lane = tid & 63, wv = __builtin_amdgcn_readfirstlane(tid >> 6);
    const bool route = !second;
    LAS float* RW = (LAS float*)(F.lds + 0);
    volatile LAS unsigned* LCNT = (volatile LAS unsigned*)(F.lds + 81920);
    volatile LAS unsigned* ROWC = (volatile LAS unsigned*)(F.lds + 82432);
    int nrow = 0;
    if (route) {
        if (tid < 64) LCNT[tid] = 0u;
        const GAS float* gw = GIN(32) + (size_t)layer * 1024 * 4; const GAS float* ew = GIN(34) + (size_t)layer * 1024 * 16;
#pragma unroll 1
        for (int i = 0; i < 2; ++i) { const int k = tid + 512 * i; f32x4 st[5]; st[0] = *(const GAS f32x4*)(gw + k * 4);
#pragma unroll
            for (int q = 0; q < 4; ++q) st[1 + q] = *(const GAS f32x4*)(ew + k * 16 + 4 * q);
#pragma unroll
            for (int q = 0; q < 5; ++q) *(LAS f32x4*)(RW + k * 20 + 4 * q) = st[q]; }
        __syncthreads();
        asm volatile("" ::: "memory");
    }
    const GAS float* lg = GIN(second ? 30 : 28) + layer * D; const GAS float* lb = GIN(second ? 31 : 29) + layer * D;
    f32x4 g4[4], b4[4];
#pragma unroll
    for (int j = 0; j < 4; ++j) { g4[j] = *((const GAS f32x4*)lg + lane + 64 * j); b4[j] = *((const GAS f32x4*)lb + lane + 64 * j); }
    GAS bf16* XB = (GAS bf16*)(F.ws + WS_XB);
    const GAS bf16* Dd = (const GAS bf16*)(F.ws + WS_D);
    u32x2 nv[4], nd[4];
    { const int m0 = F.wg * 8 + wv;
#pragma unroll
      for (int j = 0; j < 4; ++j) { nv[j] = *((const GAS u32x2*)(XB + (size_t)(m0 < M ? m0 : 0) * D) + lane + 64 * j); nd[j] = *((const GAS u32x2*)(Dd + (size_t)(m0 < M ? m0 : 0) * D) + lane + 64 * j); } }
    for (int m = F.wg * 8 + wv; m < M; m += F.G * 8) {
        asm volatile("" ::: "memory");
        f32x4 v[4]; float sm = 0.f;
#pragma unroll
        for (int j = 0; j < 4; ++j) { const f32x4 dd = {bf2f(nd[j].x & 0xffffu), bf2f(nd[j].x >> 16), bf2f(nd[j].y & 0xffffu), bf2f(nd[j].y >> 16)};
            const f32x4 xx = {bf2f(nv[j].x & 0xffffu), bf2f(nv[j].x >> 16), bf2f(nv[j].y & 0xffffu), bf2f(nv[j].y >> 16)};
            v[j] = xx * DN_ALPHA + dd; sm += (v[j][0] + v[j][1]) + (v[j][2] + v[j][3]); }
        { const int mn = m + F.G * 8 < M ? m + F.G * 8 : m;
#pragma unroll
          for (int j = 0; j < 4; ++j) { nv[j] = *((const GAS u32x2*)(XB + (size_t)mn * D) + lane + 64 * j); nd[j] = *((const GAS u32x2*)(Dd + (size_t)mn * D) + lane + 64 * j); } }
        const float mean = wave_sum(sm) * (1.0f / D); float s2 = 0.f;
#pragma unroll
        for (int j = 0; j < 4; ++j) { v[j] = v[j] - mean; s2 += (v[j][0] * v[j][0] + v[j][1] * v[j][1]) + (v[j][2] * v[j][2] + v[j][3] * v[j][3]); }
        const float rstd = rsqrtf(wave_sum(s2) * (1.0f / D) + LN_EPS);
#pragma unroll
        for (int j = 0; j < 4; ++j) v[j] = v[j] * rstd * g4[j] + b4[j];
        if (final_) {
            GAS float* dst = nullptr;
            if (m < NPR) { const int b = m / T, t = m % T; if (t >= NMETA) dst = F.out + O_YP + ((size_t)b * SEQ + (t - NMETA)) * D; }
            else dst = F.out + O_YS + (size_t)(m - NPR) * D;
            if (dst) {
#pragma unroll
                for (int j = 0; j < 4; ++j) *((GAS f32x4*)dst + lane + 64 * j) = v[j]; }
        } else {
#pragma unroll
            for (int j = 0; j < 4; ++j) { u32x2 o; o.x = pk2(v[j][0], v[j][1]); o.y = pk2(v[j][2], v[j][3]); *((GAS u32x2*)(XB + (size_t)m * D) + lane + 64 * j) = o; }
        }
        if (route) {
            float pg[4] = {0.f, 0.f, 0.f, 0.f};
#pragma unroll
            for (int j = 0; j < 4; ++j)
#pragma unroll
                for (int i = 0; i < 4; ++i) { const f32x4 wq = *(const LAS f32x4*)(RW + (4 * lane + 256 * j + i) * 20); const float xv = v[j][i];
                    pg[0] += xv * wq[0]; pg[1] += xv * wq[1]; pg[2] += xv * wq[2]; pg[3] += xv * wq[3]; }
#pragma unroll
            for (int e = 0; e < 4; ++e) pg[e] = wave_sum(pg[e]);
            const GAS float* gb = GIN(33) + layer * 4; const GAS float* eb = GIN(35) + layer * 16;
            float l0 = pg[0] + gb[0], l1 = pg[1] + gb[1], l2 = pg[2] + gb[2], l3 = pg[3] + gb[3];
            int g = 0; float lm = l0; if (l1 > lm) { lm = l1; g = 1; } if (l2 > lm) { lm = l2; g = 2; } if (l3 > lm) { lm = l3; g = 3; }
            g = __builtin_amdgcn_readfirstlane(g);
            const float gval = frcp(__expf(l0 - lm) + __expf(l1 - lm) + __expf(l2 - lm) + __expf(l3 - lm));
            float le[4] = {0.f, 0.f, 0.f, 0.f};
#pragma unroll
            for (int j = 0; j < 4; ++j)
#pragma unroll
                for (int i = 0; i < 4; ++i) { const f32x4 wq = *(const LAS f32x4*)(RW + (4 * lane + 256 * j + i) * 20 + 4 + 4 * g); const float xv = v[j][i];
                    le[0] += xv * wq[0]; le[1] += xv * wq[1]; le[2] += xv * wq[2]; le[3] += xv * wq[3]; }
#pragma unroll
            for (int i = 0; i < 4; ++i) le[i] = wave_sum(le[i]) + eb[4 * g + i];
            int ea = 0; float la = le[0];
#pragma unroll
            for (int i = 1; i < 4; ++i) if (le[i] > la) { la = le[i]; ea = i; }
            int e2 = -1; float l2b = -INFINITY;
#pragma unroll
            for (int i = 0; i < 4; ++i) if (i != ea && le[i] > l2b) { l2b = le[i]; e2 = i; }
            const float p1 = frcp(1.0f + __expf(l2b - la)), p2 = 1.0f - p1;
            const int lo = ea < e2 ? ea : e2, hi = ea < e2 ? e2 : ea;
            const float glo = gval * (ea < e2 ? p1 : p2), ghi = gval * (ea < e2 ? p2 : p1);
            const int pr = lo == 0 ? hi - 1 : (lo == 1 ? hi + 1 : 5), cls = g * 6 + pr;
            if (lane == 0) {
                const unsigned lp = __hip_atomic_fetch_add((LAS unsigned*)LCNT + cls, 1u, __ATOMIC_RELAXED, __HIP_MEMORY_SCOPE_WORKGROUP);
                ROWC[wv * 12 + nrow] = (unsigned)cls | (lp << 8);
                *(GAS f32x2*)((GAS float*)(F.ws + WS_GATE) + (size_t)m * 2) = (f32x2){glo, ghi};
            }
            ++nrow;
        }
    }
    if (route) {
        __syncthreads();
        if (tid < NCLS) { const unsigned n = LCNT[tid]; LCNT[32 + tid] = n ? __hip_atomic_fetch_add(F.ctl + CW_CNT + (layer * NCLS + tid) * 64, n, __ATOMIC_RELAXED, __HIP_MEMORY_SCOPE_AGENT) : 0u; }
        __syncthreads();
        if (lane == 0) { int r = 0;
            for (int m = F.wg * 8 + wv; m < M; m += F.G * 8, ++r) { const unsigned e = ROWC[wv * 12 + r]; const unsigned cls = e & 255u, lp = e >> 8;
                ((GAS int*)(F.ws + WS_TOK))[(size_t)cls * CLS_CAP + LCNT[32 + cls] + lp] = m; } }
    }
}

DI void moe_setup(Frame& F, int layer) {
    int tid = F.tid; asm volatile("" : "+v"(tid));
    __syncthreads();
    if (tid < NCLS) F.MISC[48 + tid] = __hip_atomic_load(F.ctl + CW_CNT + (layer * NCLS + tid) * 64, __ATOMIC_RELAXED, __HIP_MEMORY_SCOPE_AGENT);
    __syncthreads();
    if (tid == 0) { unsigned run = 0; for (int c = 0; c < NCLS; ++c) { F.MISC[16 + c] = run; run += (F.MISC[48 + c] + 255u) >> 8; } F.MISC[16 + NCLS] = run; }
    __syncthreads();
    if (tid < MAXPAN) { int cls = 0; for (int k = 1; k < NCLS; ++k) if ((int)F.MISC[16 + k] <= tid) cls = k; F.MISC[80 + tid] = (unsigned)cls; }
    __syncthreads();
}
DI void cls_experts(int cls, int& elo, int& ehi) { const int g = cls / 6, pr = cls % 6; const int lo = pr < 3 ? 0 : (pr < 5 ? 1 : 2), hi = pr < 3 ? pr + 1 : (pr < 5 ? pr - 1 : 3); elo = g * 4 + lo; ehi = g * 4 + hi; }
DI bool moe_next(const volatile LAS unsigned* MISC, int G, int c, int i, int& cp, int& pn, int& cls) {
    const int npan = __builtin_amdgcn_readfirstlane((int)MISC[16 + NCLS]); const long L = (long)i * G + c; if (L >= 4L * npan) return false;
    cp = (int)(L >> 2); pn = (int)(L & 3); cls = __builtin_amdgcn_readfirstlane((int)MISC[80 + cp]);
    return true;
}
struct MoeUp {
    static constexpr int PID = 2;
    static constexpr bool GATHER = true, SPLITB = false; static constexpr int KSPLIT = 0, K = 1024, lda = 1024, ldb = 1024;
    const GAS bf16* A; int G, c, layer; GAS unsigned char* ws; const volatile LAS unsigned* MISC;
    DI bool next(int i, pg8::Unit& u) const { int cp, pn, cls; if (!moe_next(MISC, G, c, i, cp, pn, cls)) return false;
        int elo, ehi; cls_experts(cls, elo, ehi); const int e = pn < 2 ? elo : ehi;
        u.pm = cp; u.pn = pn; u.aux = cls; u.B0 = (const GAS char*)((const GAS bf16*)(ws + WS_WGU) + ((size_t)(layer * 16 + e) * 512 + (pn & 1) * 256) * 1024); u.B1 = u.B0; return true; }
    DI unsigned a_row(const pg8::Unit& u, int r) const { const int cls = u.aux, cnt = __builtin_amdgcn_readfirstlane((int)MISC[48 + cls]); int slot = (u.pm - __builtin_amdgcn_readfirstlane((int)MISC[16 + cls])) * 256 + r; slot = slot < cnt ? slot : cnt - 1;
        const int tok = ((const GAS int*)(ws + WS_TOK))[(size_t)cls * CLS_CAP + slot]; return (unsigned)tok * 2048u; }
    DI void epi(const AccT& acc, const pg8::Unit& u, int wr, int wc, int fr, int fq) const {
        asm volatile("" : "+v"(fr), "+v"(fq));
        const int cls = u.aux, cnt = __builtin_amdgcn_readfirstlane((int)MISC[48 + cls]), sbase = (u.pm - __builtin_amdgcn_readfirstlane((int)MISC[16 + cls])) * 256;
        GAS bf16* H = (GAS bf16*)(ws + WS_H);
        int tok8[8]; float gate8[8];
#pragma unroll
        for (int i = 0; i < 8; ++i) { const int r = (i >> 2) * 128 + wr * 64 + (i & 3) * 16 + fr; int slot = sbase + r; slot = slot < cnt ? slot : cnt - 1; tok8[i] = ((const GAS int*)(ws + WS_TOK))[(unsigned)cls * CLS_CAP + slot]; }
#pragma unroll
        for (int i = 0; i < 8; ++i) gate8[i] = ((const GAS float*)(ws + WS_GATE))[(unsigned)tok8[i] * 2 + (u.pn >> 1)];
#pragma unroll
        for (int ai = 0; ai < 2; ++ai)
#pragma unroll
            for (int m = 0; m < 4; ++m) { const int r = ai * 128 + wr * 64 + m * 16 + fr; const float gate = gate8[ai * 4 + m];
#pragma unroll
                for (int n = 0; n < 2; ++n) { const f32x4 gv = acc[ai][0][m][n], uv = acc[ai][1][m][n]; u32x2 o;
                    o.x = pk2(siluf_(gv[0]) * uv[0] * gate, siluf_(gv[1]) * uv[1] * gate); o.y = pk2(siluf_(gv[2]) * uv[2] * gate, siluf_(gv[3]) * uv[3] * gate);
                    *(GAS u32x2*)(H + (unsigned)(u.pm * 256 + r) * 512 + u.pn * 128 + wc * 32 + n * 16 + 4 * fq) = o; } }
    }
};
struct MoeDown {
    static constexpr int PID = 1;
    static constexpr bool GATHER = false, SPLITB = true; static constexpr int KSPLIT = 4, K = 512, lda = 512, ldb = 256;
    const GAS bf16* A; int G, c, layer; GAS unsigned char* ws; const volatile LAS unsigned* MISC;
    DI bool next(int i, pg8::Unit& u) const { int cp, pn, cls; if (!moe_next(MISC, G, c, i, cp, pn, cls)) return false;
        int elo, ehi; cls_experts(cls, elo, ehi);
        u.pm = cp; u.pn = pn; u.aux = cls; const GAS bf16* WD = (const GAS bf16*)(ws + WS_WD);
        u.B0 = (const GAS char*)(WD + ((size_t)(layer * 16 + elo) * 1024 + pn * 256) * 256); u.B1 = (const GAS char*)(WD + ((size_t)(layer * 16 + ehi) * 1024 + pn * 256) * 256) - 4 * 128; return true; }
    DI void epi(const AccT& acc, const pg8::Unit& u, int wr, int wc, int fr, int fq) const {
        asm volatile("" : "+v"(fr), "+v"(fq));
        const int cls = u.aux, cnt = __builtin_amdgcn_readfirstlane((int)MISC[48 + cls]), sbase = (u.pm - __builtin_amdgcn_readfirstlane((int)MISC[16 + cls])) * 256;
        GAS bf16* Dd = (GAS bf16*)(ws + WS_D);
        int tok8[8];
#pragma unroll
        for (int i = 0; i < 8; ++i) { const int r = (i >> 2) * 128 + wr * 64 + (i & 3) * 16 + fr; int slot = sbase + r; slot = slot < cnt ? slot : cnt - 1; tok8[i] = ((const GAS int*)(ws + WS_TOK))[(unsigned)cls * CLS_CAP + slot]; }
#pragma unroll
        for (int ai = 0; ai < 2; ++ai)
#pragma unroll
            for (int m = 0; m < 4; ++m) { const int r = ai * 128 + wr * 64 + m * 16 + fr, slot = sbase + r;
                if (slot < cnt) { const int tok = tok8[ai * 4 + m]; GAS bf16* rp = Dd + (unsigned)tok * D + u.pn * 256 + wc * 32 + 4 * fq;
#pragma unroll
                    for (int bj = 0; bj < 2; ++bj)
#pragma unroll
                        for (int n = 0; n < 2; ++n) { const f32x4 v = acc[ai][bj][m][n]; u32x2 o; o.x = pk2(v[0], v[1]); o.y = pk2(v[2], v[3]); *(GAS u32x2*)(rp + bj * 128 + n * 16) = o; } } }
    }
};

struct OddIn {
    static constexpr int PID = -1;
    static constexpr bool GATHER = false, SPLITB = false; static constexpr int KSPLIT = 0, K = 1024, lda = 1024, ldb = 1024;
    const GAS bf16* A; const GAS bf16* Bt; int G, c, li; GAS unsigned char* ws; GAS float* out;
    DI bool next(int i, pg8::Unit& u) const { if (!pg8::static_next<M / 256, ODD_IN / 256>(G, c, i, u.pm, u.pn)) return false;
        u.B0 = (const GAS char*)(Bt + (size_t)u.pn * 256 * 1024); u.B1 = u.B0; u.aux = 0; return true; }
    DI void epi(const AccT& acc, const pg8::Unit& u, int wr, int wc, int fr, int fq) const {
        asm volatile("" : "+v"(fr), "+v"(fq));
        const int pn = u.pn;
#pragma unroll
        for (int ai = 0; ai < 2; ++ai)
#pragma unroll
            for (int m = 0; m < 4; ++m) {
                const int row = u.pm * 256 + ai * 128 + wr * 64 + m * 16 + fr;
                int b = 0, t = 0, sidx = 0; const bool pr = row < NPR; if (pr) { b = row / T; t = row % T; } else sidx = row - NPR;
                if (pn < 4) {
                    GAS float* so = nullptr;
                    if (pr) { if (t >= T - 30) so = out + O_CP + ((unsigned)(b * 2 + li) * 30 + (t - (T - 30))) * 512; } else so = out + O_CS + ((unsigned)(sidx * 2 + li) * 30 + 29) * 512;
#pragma unroll
                    for (int n = 0; n < 2; ++n) { const int ch = 128 * pn + wc * 32 + n * 16 + 4 * fq; const f32x4 a = acc[ai][0][m][n], g = acc[ai][1][m][n]; f32x4 uv;
#pragma unroll
                        for (int j = 0; j < 4; ++j) uv[j] = a[j] * sigmoidf_(g[j]);
                        u32x2 o; o.x = pk2(uv[0], uv[1]); o.y = pk2(uv[2], uv[3]); *(GAS u32x2*)((GAS bf16*)(ws + WS_A0) + (unsigned)row * 512 + ch) = o;
                        if (so) *(GAS f32x4*)(so + ch) = uv; }
                } else if (pn < 6) {
                    GAS float* so = nullptr;
                    if (pr) { if (t >= T - 3) so = out + O_DP + ((unsigned)(b * 2 + li) * 3 + (t - (T - 3))) * 512; } else so = out + O_DS + ((unsigned)(sidx * 2 + li) * 3 + 2) * 512;
#pragma unroll
                    for (int bj = 0; bj < 2; ++bj)
#pragma unroll
                        for (int n = 0; n < 2; ++n) { const int ch = (pn - 4) * 256 + bj * 128 + wc * 32 + n * 16 + 4 * fq; const f32x4 v = acc[ai][bj][m][n];
                            u32x2 o; o.x = pk2(v[0], v[1]); o.y = pk2(v[2], v[3]); *(GAS u32x2*)((GAS bf16*)(ws + WS_A1) + (unsigned)row * 512 + ch) = o;
                            if (so) *(GAS f32x4*)(so + ch) = v; }
                } else {
#pragma unroll
                    for (int bj = 0; bj < 2; ++bj)
#pragma unroll
                        for (int n = 0; n < 2; ++n) { const int ch = (pn - 6) * 256 + bj * 128 + wc * 32 + n * 16 + 4 * fq; const f32x4 v = acc[ai][bj][m][n];
                            u32x2 o; o.x = pk2(gelu_tanh(v[0]), gelu_tanh(v[1])); o.y = pk2(gelu_tanh(v[2]), gelu_tanh(v[3])); *(GAS u32x2*)((GAS bf16*)(ws + WS_A2) + (unsigned)row * 512 + ch) = o; }
                }
            }
    }
};

DI float lru_sp8(float lam) { return 8.0f * log1pf(__expf(-lam)); }
DI void lru_chain_item(Frame& F, int li, int b, int n) {
    int tid_ = F.tid; asm volatile("" : "+v"(tid_)); LAUNDER_F(F);
    const int tid = tid_, lane = tid & 63, w = __builtin_amdgcn_readfirstlane(tid >> 6), l15 = lane & 15, l4 = lane >> 4;
    constexpr int SEG = 258, NSUB = 17;
    LAS bf16* WB = (LAS bf16*)(F.lds + 0);
    LAS bf16* XC = (LAS bf16*)(F.lds + 18432 + w * 2304);
    LAS float* GT = (LAS float*)(F.lds + 36864 + w * 8448);
    LAS float* SEGP = (LAS float*)(F.lds + 104448);
    LAS float* SEGH = (LAS float*)(F.lds + 106496);
    const GAS bf16* DX = (const GAS bf16*)(F.ws + WS_A1); const GAS bf16* DG = (const GAS bf16*)(F.ws + WS_A2); GAS bf16* MIX = (GAS bf16*)(F.ws + WS_MIX); GAS bf16* QS_ = (GAS bf16*)(F.ws + WS_A3);
    const GAS float* wa = GIN(23) + ((size_t)(li * 8 + n) * 64) * 64; const GAS float* wx = GIN(25) + ((size_t)(li * 8 + n) * 64) * 64;
    __syncthreads();
    {
        float ta[8], tx[8];
#pragma unroll
        for (int q = 0; q < 8; ++q) { ta[q] = wa[tid + 512 * q]; tx[q] = wx[tid + 512 * q]; }
#pragma unroll
        for (int q = 0; q < 8; ++q) { const int e = tid + 512 * q, i = e >> 6, j = e & 63; WB[j * 72 + i] = (bf16)f2bf(ta[q]); WB[(64 + j) * 72 + i] = (bf16)f2bf(tx[q]); }
    }
    const int ch = 64 * n + lane;
    const float dw0 = GIN(21)[(li * 4 + 0) * 512 + ch], dw1 = GIN(21)[(li * 4 + 1) * 512 + ch], dw2 = GIN(21)[(li * 4 + 2) * 512 + ch], dw3 = GIN(21)[(li * 4 + 3) * 512 + ch];
    const float dbv = GIN(22)[li * 512 + ch], bav = GIN(24)[li * 512 + ch], bxv = GIN(26)[li * 512 + ch], sp = lru_sp8(GIN(27)[li * 512 + ch]);
    __syncthreads();
    const int t0 = SEG * w;
    const unsigned rowb = (unsigned)(b * T);
    float x3 = 0.f, x2 = 0.f, x1 = 0.f;
    if (w > 0) { x3 = bf2f(DX[(rowb + t0 - 3) * 512u + ch]); x2 = bf2f(DX[(rowb + t0 - 2) * 512u + ch]); x1 = bf2f(DX[(rowb + t0 - 1) * 512u + ch]); }
    float H = 0.f, P = 1.0f;
    unsigned ndx[16], ndg[16];
#define LR_LOAD(sc) do { _Pragma("unroll") for (int i = 0; i < 16; ++i) { const int tl = 16 * (sc) + i; const unsigned r = rowb + (unsigned)(t0 + (tl < SEG ? tl : SEG - 1)); ndx[i] = DX[r * 512u + ch]; ndg[i] = DG[r * 512u + ch]; } } while (0)
    LR_LOAD(0);
    for (int sc = 0; sc < NSUB; ++sc) {
        float xc[16], gg[16];
#pragma unroll
        for (int i = 0; i < 16; ++i) { const float xn = bf2f(ndx[i]); xc[i] = dbv + dw0 * x3 + dw1 * x2 + dw2 * x1 + dw3 * xn; x3 = x2; x2 = x1; x1 = xn; gg[i] = bf2f(ndg[i]); XC[i * 72 + lane] = (bf16)f2bf(xc[i]); }
        if (sc + 1 < NSUB) LR_LOAD(sc + 1);
        asm volatile("s_waitcnt lgkmcnt(0)" ::: "memory");
        {
            const bf16x8 a0 = *(const LAS bf16x8*)(XC + l15 * 72 + 8 * l4), a1 = *(const LAS bf16x8*)(XC + l15 * 72 + 32 + 8 * l4);
#pragma unroll
            for (int jt = 0; jt < 8; ++jt) { f32x4 g = {0.f, 0.f, 0.f, 0.f};
                g = MFMA16(a0, *(const LAS bf16x8*)(WB + (16 * jt + l15) * 72 + 8 * l4), g); g = MFMA16(a1, *(const LAS bf16x8*)(WB + (16 * jt + l15) * 72 + 32 + 8 * l4), g);
#pragma unroll
                for (int r = 0; r < 4; ++r) GT[(4 * l4 + r) * 132 + 16 * jt + l15] = g[r]; }
        }
        asm volatile("s_waitcnt lgkmcnt(0)" ::: "memory");
        float ya[16], yq[16];
#pragma unroll
        for (int i = 0; i < 16; ++i) {
            const bool ok = 16 * sc + i < SEG;
            const float r = sigmoidf_(GT[i * 132 + lane] + bav), ig = sigmoidf_(GT[i * 132 + 64 + lane] + bxv);
            const float la = -r * sp; float a = __expf(la); const float x2_ = 2.0f * la; const float om = x2_ > -0.25f ? neg_expm1_small(x2_) : 1.0f - a * a;
            float dr = sqrtf(fmaxf(om, 0.f)) * ig * xc[i];
            if (!ok) { a = 1.0f; dr = 0.f; }
            H = a * H + dr; P *= a; ya[i] = H * gg[i]; yq[i] = P * gg[i];
        }
#pragma unroll
        for (int i = 0; i < 16; ++i) { if (16 * sc + i < SEG) { const unsigned r = rowb + (unsigned)(t0 + 16 * sc + i); MIX[r * 1024u + 512u + ch] = (bf16)f2bf(ya[i]); QS_[r * 512u + ch] = (bf16)f2bf(yq[i]); } }
    }
#undef LR_LOAD
    SEGP[w * 64 + lane] = P; SEGH[w * 64 + lane] = H;
    __syncthreads();
    float c = 0.f;
    for (int q = 0; q < w; ++q) c = SEGP[q * 64 + lane] * c + SEGH[q * 64 + lane];
    if (w == 7) F.out[O_LP + (size_t)(b * 2 + li) * 512 + ch] = P * c + H;
    if (w > 0) {
        LAS float* CL = (LAS float*)(F.lds + 108544) + w * 64;
        CL[lane] = c;
        asm volatile("s_waitcnt lgkmcnt(0)" ::: "memory");
        const int tr = lane >> 3, pc = lane & 7;
        float cc[8];
#pragma unroll
        for (int j = 0; j < 8; ++j) cc[j] = CL[8 * pc + j];
        for (int it = 0; it < (SEG + 7) / 8; ++it) { const int tl = 8 * it + tr;
            if (tl < SEG) { const unsigned r = rowb + (unsigned)(t0 + tl);
                const u32x4 ya = *(const GAS u32x4*)(MIX + r * 1024u + 512u + 64u * n + 8u * pc), yq = *(const GAS u32x4*)(QS_ + r * 512u + 64u * n + 8u * pc);
                const unsigned aw[4] = {ya.x, ya.y, ya.z, ya.w}, qw[4] = {yq.x, yq.y, yq.z, yq.w}; float y[8];
#pragma unroll
                for (int j = 0; j < 8; ++j) y[j] = bf2f((aw[j >> 1] >> (16 * (j & 1))) & 0xffffu) + bf2f((qw[j >> 1] >> (16 * (j & 1))) & 0xffffu) * cc[j];
                *(GAS bf16x8*)(MIX + r * 1024u + 512u + 64u * n + 8u * pc) = pack8(y); } }
    }
}

template <int NV> DI void block_sum2(float (&a)[NV], float (&bq)[NV], LAS float* RED, int wv, int lane) {
#pragma unroll
    for (int i = 0; i < NV; ++i) { a[i] = wave_sum(a[i]); bq[i] = wave_sum(bq[i]); }
    LDS_BAR();
    if (lane == 0) {
#pragma unroll
        for (int i = 0; i < NV; ++i) { RED[wv * 2 * NV + i] = a[i]; RED[wv * 2 * NV + NV + i] = bq[i]; } }
    LDS_BAR();
#pragma unroll
    for (int i = 0; i < NV; ++i) { float x = 0.f, y = 0.f;
#pragma unroll
        for (int q = 0; q < 8; ++q) { x += RED[q * 2 * NV + i]; y += RED[q * 2 * NV + NV + i]; }
        a[i] = x; bq[i] = y; }
}
DI void convc_item(Frame& F, int li, int b, int blk) {
    int tid_ = F.tid; asm volatile("" : "+v"(tid_)); LAUNDER_F(F);
    const int tid = tid_, lane = tid & 63, wv = __builtin_amdgcn_readfirstlane(tid >> 6), c = tid;
    LAS float* RED = (LAS float*)(F.lds + 0);
    const GAS bf16* U = (const GAS bf16*)(F.ws + WS_A0); GAS bf16* MIX = (GAS bf16*)(F.ws + WS_MIX);
    float cw[31];
#pragma unroll
    for (int j = 0; j < 31; ++j) cw[j] = GIN(17)[(size_t)(li * 31 + j) * 512 + c];
    const float cbv = GIN(18)[li * 512 + c], gln = GIN(19)[li * 512 + c], bln = GIN(20)[li * 512 + c];
    unsigned nraw[38];
#define CC_LOAD(t0_) do { _Pragma("unroll") for (int i = 0; i < 38; ++i) { const int ts = (t0_) - 30 + i; nraw[i] = U[(unsigned)(b * T + (ts < 0 ? 0 : (ts < T ? ts : T - 1))) * 512u + (unsigned)c]; } } while (0)
    __syncthreads();
    CC_LOAD(64 * blk);
    for (int g8 = 0; g8 < 8; ++g8) {
        const int t0 = 64 * blk + 8 * g8; if (t0 >= T) break;
        float val[38];
#pragma unroll
        for (int i = 0; i < 38; ++i) { const int ts = t0 - 30 + i; const bool ok = ts >= 0 && ts < T; val[i] = ok ? bf2f(nraw[i]) : 0.f; }
        if (g8 + 1 < 8) CC_LOAD(t0 + 8);
        float y[8], y2[8];
#pragma unroll
        for (int o = 0; o < 8; ++o) { float a = cbv;
#pragma unroll
            for (int j = 0; j < 31; ++j) a += cw[j] * val[o + j];
            y[o] = a; y2[o] = a * a; }
        float s1[8];
#pragma unroll
        for (int o = 0; o < 8; ++o) s1[o] = y[o];
        block_sum2<8>(s1, y2, RED, wv, lane);
#pragma unroll
        for (int o = 0; o < 8; ++o) { const int tg = t0 + o; if (tg < T) { const float mean = s1[o] * (1.0f / 512.0f); const float var = fmaxf(y2[o] * (1.0f / 512.0f) - mean * mean, 0.f);
            const float z = (y[o] - mean) * rsqrtf(var + LN_EPS) * gln + bln; MIX[(size_t)(b * T + tg) * 1024 + c] = (bf16)f2bf(siluf_(z)); } }
    }
}
DI void odd_sample_item(Frame& F, int li, int s) {
    int tid_ = F.tid; asm volatile("" : "+v"(tid_)); LAUNDER_F(F);
    const int tid = tid_, lane = tid & 63, wv = __builtin_amdgcn_readfirstlane(tid >> 6), c = tid, row = NPR + s;
    LAS float* RED = (LAS float*)(F.lds + 0); LAS float* XS = (LAS float*)(F.lds + 1024);
    GAS bf16* MIX = (GAS bf16*)(F.ws + WS_MIX);
    const GAS float* st = GIN(6) + ((size_t)(s * 2 + li) * 30) * 512 + c; GAS float* so = F.out + O_CS + ((size_t)(s * 2 + li) * 30) * 512 + c;
    float a = GIN(18)[li * 512 + c];
#pragma unroll
    for (int j = 0; j < 30; ++j) { const float v = st[(size_t)j * 512]; a += GIN(17)[(size_t)(li * 31 + j) * 512 + c] * v; if (j >= 1) so[(size_t)(j - 1) * 512] = v; }
    a += GIN(17)[(size_t)(li * 31 + 30) * 512 + c] * so[(size_t)29 * 512];
    float s1[1] = {a}, s2[1] = {a * a};
    block_sum2<1>(s1, s2, RED, wv, lane);
    { const float mean = s1[0] * (1.0f / 512.0f), var = fmaxf(s2[0] * (1.0f / 512.0f) - mean * mean, 0.f);
      const float z = (a - mean) * rsqrtf(var + LN_EPS) * GIN(19)[li * 512 + c] + GIN(20)[li * 512 + c]; MIX[(size_t)row * 1024 + c] = (bf16)f2bf(siluf_(z)); }
    const GAS float* sd = GIN(7) + ((size_t)(s * 2 + li) * 3) * 512 + c; GAS float* sdo = F.out + O_DS + ((size_t)(s * 2 + li) * 3) * 512 + c;
    const float d0 = sd[0], d1 = sd[512], d2 = sd[1024], d3 = sdo[1024];
    sdo[0] = d1; sdo[512] = d2;
    const float xc = GIN(22)[li * 512 + c] + GIN(21)[(li * 4 + 0) * 512 + c] * d0 + GIN(21)[(li * 4 + 1) * 512 + c] * d1 + GIN(21)[(li * 4 + 2) * 512 + c] * d2 + GIN(21)[(li * 4 + 3) * 512 + c] * d3;
    __syncthreads();
    XS[c] = xc;
    __syncthreads();
    const int n = c >> 6, j = c & 63; const GAS float* wa = GIN(23) + ((size_t)(li * 8 + n) * 64) * 64 + j; const GAS float* wx = GIN(25) + ((size_t)(li * 8 + n) * 64) * 64 + j;
    float ra = GIN(24)[li * 512 + c], ia = GIN(26)[li * 512 + c];
#pragma unroll 8
    for (int i = 0; i < 64; ++i) { const float xv = XS[64 * n + i]; ra += xv * wa[(size_t)i * 64]; ia += xv * wx[(size_t)i * 64]; }
    const float r = sigmoidf_(ra), ig = sigmoidf_(ia), la = -r * lru_sp8(GIN(27)[li * 512 + c]);
    const float h = __expf(la) * GIN(8)[(size_t)(s * 2 + li) * 512 + c] + sqrtf(fmaxf(-expm1f(2.0f * la), 0.f)) * ig * xc;
    F.out[O_LS + (size_t)(s * 2 + li) * 512 + c] = h;
    MIX[(size_t)row * 1024 + 512 + c] = (bf16)f2bf(h * bf2f(((const GAS bf16*)(F.ws + WS_A2))[(size_t)row * 512 + c]));
}
NOINL void ph_prologue(Frame F) { frame_fix(F); p_prologue(F); }
DI void ph_evenin(Frame F, int li) { LAUNDER_F(F);
    { EvenIn<false> P; P.A = (const GAS bf16*)(F.ws + WS_XB); P.Bt = (const GAS bf16*)(F.ws + WS_WINE) + (size_t)li * EVEN_PAD * 1024; P.G = F.G; P.c = F.vcu; P.li = li; P.ws = F.ws; P.out = F.out;
      pg8::gemm_phase(F.lds, P); }
    LAUNDER_F(F);
    { EvenIn<true> P; P.A = (const GAS bf16*)(F.ws + WS_XB); P.Bt = (const GAS bf16*)(F.ws + WS_WINE) + (size_t)li * EVEN_PAD * 1024; P.G = F.G; P.c = F.vcu; P.li = li; P.ws = F.ws; P.out = F.out;
      pg8::gemm_phase(F.lds, P); } }
DI void ph_oddin(Frame F, int li) { LAUNDER_F(F);
    OddIn P; P.A = (const GAS bf16*)(F.ws + WS_XB); P.Bt = (const GAS bf16*)(F.ws + WS_WINO) + (size_t)li * ODD_IN * 1024; P.G = F.G; P.c = F.vcu; P.li = li; P.ws = F.ws; P.out = F.out;
    pg8::gemm_phase(F.lds, P); }
DI void ph_outproj(Frame F, int layer) { LAUNDER_F(F);
    OutProj P; P.A = (const GAS bf16*)(F.ws + WS_MIX); P.Bt = (const GAS bf16*)(F.ws + ((layer & 1) ? WS_WOUTO : WS_WOUTE)) + (size_t)(layer >> 1) * 1024 * 1024; P.G = F.G; P.c = F.vcu; P.Dd = (GAS bf16*)(F.ws + WS_D);
    pg8::gemm_phase(F.lds, P); }
DI void ph_moeup(Frame F, int layer) { LAUNDER_F(F); moe_setup(F, layer);
    MoeUp P; P.A = (const GAS bf16*)(F.ws + WS_XB); P.G = F.G; P.c = F.vcu; P.layer = layer; P.ws = F.ws; P.MISC = F.MISC;
    pg8::gemm_phase(F.lds, P); }
DI void ph_moedown(Frame F, int layer) { LAUNDER_F(F); moe_setup(F, layer);
    MoeDown P; P.A = (const GAS bf16*)(F.ws + WS_H); P.G = F.G; P.c = F.vcu; P.layer = layer; P.ws = F.ws; P.MISC = F.MISC;
    pg8::gemm_phase(F.lds, P); }
DI void ph_ln1(Frame F, int layer) { LAUNDER_F(F); p_ln(F, layer, false, false); }
NOINL void ph_ln2(Frame F, int layer, int fin) { frame_fix(F); p_ln(F, rfl(layer), true, rfl(fin) != 0); }
DI void it_hgrn_prompt(Frame F, int li, int b, int h) { hgrn_prompt_item(F, li, b, h); }
NOINL void it_hgrn_sample(Frame F, int li, int sq, int h) { frame_fix(F); hgrn_sample_item(F, rfl(li), rfl(sq), rfl(h)); }
DI void it_dsa_prompt(Frame F, int b, int q0, int nqh) { dsa_prompt_item(F, b, q0, nqh); }
DI void it_dsa_sample(Frame F, int li, int sq) { dsa_sample_item(F, li, sq); }
DI void it_lru_chain(Frame F, int li, int b, int n) { lru_chain_item(F, li, b, n); }
DI void it_convc(Frame F, int li, int b, int blk) { convc_item(F, li, b, blk); }
NOINL void it_odd_sample(Frame F, int li, int sq) { frame_fix(F); odd_sample_item(F, rfl(li), rfl(sq)); }
#if PROBE_TS == 2
#define PT_MARK(slot) do { const unsigned long long _t = __builtin_amdgcn_s_memrealtime(); if (F.tid == 0 && qidx == 0) atomicMax(F.ctl + 20000 + (slot), (unsigned)(_t - _t0)); } while (0)
#else
#define PT_MARK(slot) do { } while (0)
#endif
DI void p_even_mixer(Frame& F, int li, int qidx) {
    constexpr int E0 = 32, E1 = E0 + 8 * 33, E2 = E1 + NSM, E3 = E2 + 8 * 16, E4 = E3 + NSM * 4;
#if PROBE_TS
    const unsigned long long _t0 = __builtin_amdgcn_s_memrealtime();
#endif
    int it = q_pop(F, qidx);
#if PROBE_TS == 3
#define PT_SUM(slot, stmt) do { const unsigned long long _a = __builtin_amdgcn_s_memrealtime(); stmt; __syncthreads(); if (F.tid == 0) atomicAdd(F.ctl + 20000 + (slot), (unsigned)(__builtin_amdgcn_s_memrealtime() - _a)); } while (0)
#else
#define PT_SUM(slot, stmt) do { stmt; } while (0)
#endif
    while (it < E0) { PT_SUM(5, it_hgrn_prompt(F, li, it >> 2, it & 3)); it = q_pop(F, qidx); PT_MARK(0); }
    while (it < E3) {
        if (it >= E1 && it < E2) { PT_SUM(3, it_dsa_sample(F, li, it - E1)); PT_MARK(2); }
        else if (it < E1) { const int j = it - E0; it_dsa_prompt(F, j & 7, 1024 + 32 * (32 - (j >> 3)), 1); PT_MARK(1); }
        else { const int j = it - E2; it_dsa_prompt(F, j & 7, 64 * (15 - (j >> 3)), 2); PT_MARK(1); }
        it = q_pop(F, qidx);
    }
    while (it < E4) { PT_SUM(4, it_hgrn_sample(F, li, (it - E3) >> 2, (it - E3) & 3)); it = q_pop(F, qidx); PT_MARK(3); }
}
DI void p_odd_mixer(Frame& F, int li, int qidx) {
    constexpr int E0 = 64, E1 = E0 + 8 * 33, E2 = E1 + NSM;
#if PROBE_TS
    const unsigned long long _t0 = __builtin_amdgcn_s_memrealtime();
#endif
    int it = q_pop(F, qidx);
#if PROBE_TS == 2
    if (F.tid == 0 && qidx == 1) atomicMax(F.ctl + 20000 + 4, 0u);
#define PT_MARK2(slot) do { const unsigned long long _t = __builtin_amdgcn_s_memrealtime(); if (F.tid == 0 && qidx == 1) atomicMax(F.ctl + 20000 + (slot), (unsigned)(_t - _t0)); } while (0)
#else
#define PT_MARK2(slot) do { } while (0)
#endif
    while (it < E0) { it_lru_chain(F, li, it >> 3, it & 7); it = q_pop(F, qidx); PT_MARK2(4); }
    while (it < E1) { const int j = it - E0; it_convc(F, li, j & 7, j >> 3); it = q_pop(F, qidx); PT_MARK2(5); }
    while (it < E2) { it_odd_sample(F, li, it - E1); it = q_pop(F, qidx); PT_MARK2(6); }
}

constexpr int NPHASE = 29;
__global__ void __launch_bounds__(512, 2) mega(Args args) {
    Frame F;
    F.lds = (LAS unsigned char*)lds_raw; F.MISC = (volatile LAS unsigned*)(F.lds + MISC_OFF);
    F.tid = threadIdx.x; F.lane = F.tid & 63; F.wave = __builtin_amdgcn_readfirstlane(F.tid >> 6);
    F.G = gridDim.x; F.wg = blockIdx.x; F.vcu = (F.G % 8 == 0) ? (F.wg % 8) * (F.G / 8) + F.wg / 8 : F.wg;
    F.in = ((const Args*)__builtin_amdgcn_kernarg_segment_ptr())->in; F.out = (GAS float*)args.out; F.ws = (GAS unsigned char*)args.ws; F.ctl = (unsigned*)(args.ws + WS_CTL);
    for (int u = F.tid; u < (LDS_BYTES - MISC_OFF) / 4; u += 512) ((LAS unsigned*)(F.lds + MISC_OFF))[u] = 0u;
    __syncthreads();
    const int lo = args.ph_lo, hi = args.ph_hi;
    const bool multi = (hi - lo) > 1;
    XcdBarrier bar; bar.bar = F.ctl + CW_BAR; bar.x = 0; bar.st = nullptr;
    if (multi) bar = xcd_barrier_post(F.ctl + CW_BAR, F.MISC + 8);
#define IN(k) (lo <= (k) && (k) < hi)
#if PROBE_TS
    const unsigned fillv = __builtin_bit_cast(unsigned, args.out[O_END - 1]);
    const unsigned long long t00 = __builtin_amdgcn_s_memrealtime();
#define SEAM(k) do { if (IN(k) && IN((k) + 1)) xcd_barrier_call(bar.bar, bar.x, bar.st); if (F.tid == 0) F.MISC[1024 + (k)] = (unsigned)(__builtin_amdgcn_s_memrealtime() - t00); } while (0)
#else
#define SEAM(k) do { if (IN(k) && IN((k) + 1)) xcd_barrier_call(bar.bar, bar.x, bar.st); } while (0)
#endif
    if (IN(0)) ph_prologue(F);
    SEAM(0);
    for (int layer = 0; layer < 4; ++layer) {
        const int pb = 1 + layer * 7, li = layer >> 1;
        if (IN(pb + 0)) { if (!(layer & 1)) ph_evenin(F, li); else ph_oddin(F, li); }
        SEAM(pb + 0);
        if (IN(pb + 1)) { if (!(layer & 1)) p_even_mixer(F, li, layer); else p_odd_mixer(F, li, layer); }
        SEAM(pb + 1);
        if (IN(pb + 2)) ph_outproj(F, layer);
        SEAM(pb + 2);
        if (IN(pb + 3)) ph_ln1(F, layer);
        SEAM(pb + 3);
        if (IN(pb + 4)) ph_moeup(F, layer);
        SEAM(pb + 4);
        if (IN(pb + 5)) ph_moedown(F, layer);
        SEAM(pb + 5);
        if (IN(pb + 6)) ph_ln2(F, layer, layer == 3 ? 1 : 0);
        SEAM(pb + 6);
    }
#if PROBE_TS
    xcd_barrier_call(bar.bar, bar.x, bar.st);
#if PROBE_TS == 6
    for (size_t j = (size_t)F.wg * 512 + F.tid; j < O_END; j += (size_t)F.G * 512) args.out[j] = 1.0f;
    xcd_barrier_call(bar.bar, bar.x, bar.st);
#endif
    if (F.wg == 0) {
        __syncthreads();
        const size_t offs[7] = {O_YP, O_KP, O_VP, O_IP, O_HP, O_HS, O_CS};
        for (int i = 0; i < 7; ++i) {
            const int k = PROBE_BASE + i; if (k >= NPHASE) break;
            unsigned t1 = F.MISC[1024 + k], t0 = k > 0 ? F.MISC[1024 + k - 1] : 0u;
            if (PROBE_TS == 2 || PROBE_TS == 4) { t0 = 0u; t1 = __hip_atomic_load(F.ctl + 20000 + i, __ATOMIC_RELAXED, __HIP_MEMORY_SCOPE_AGENT); }
            unsigned n = (t1 - t0) / 1600u;
            if (PROBE_TS == 5) n = __hip_atomic_load(F.ctl + 20000 + i, __ATOMIC_RELAXED, __HIP_MEMORY_SCOPE_AGENT) / 200u;
            if (PROBE_TS == 3) n = __hip_atomic_load(F.ctl + 20000 + i, __ATOMIC_RELAXED, __HIP_MEMORY_SCOPE_AGENT) / (256u * 400u); if (n > 60000u) n = 60000u; if (n < 1u) n = 1u;
            for (unsigned j = F.tid; j < n; j += 512) ((unsigned*)args.out)[offs[i] + j] = fillv;
        }
        for (unsigned j = F.tid; j < (unsigned)(NSM * 2 * 512); j += 512) ((unsigned*)args.out)[O_LS + j] = fillv;
    }
#endif
}

extern "C" void kernel_launch(void* const* d_in, const int* in_sizes, int n_in, void* d_out, int out_size, void* d_ws, size_t ws_size, hipStream_t stream) {
    static int grid = 0;
    if (!grid) {
        int dev = 0, cus = 0, per_cu = 0;
        (void)hipGetDevice(&dev); (void)hipDeviceGetAttribute(&cus, hipDeviceAttributeMultiprocessorCount, dev);
        (void)hipFuncSetAttribute((const void*)mega, hipFuncAttributeMaxDynamicSharedMemorySize, LDS_BYTES);
        (void)hipOccupancyMaxActiveBlocksPerMultiprocessor(&per_cu, (const void*)mega, 512, LDS_BYTES);
        if (per_cu < 1) fprintf(stderr, "occupancy query says %d\n", per_cu);
        grid = cus > 0 ? cus : 256;
        if (n_in != 39 || (size_t)out_size != O_END || ws_size < WS_END) fprintf(stderr, "kernel_launch: unexpected sizes n_in %d out %d ws %zu (need %zu)\n", n_in, out_size, ws_size, (size_t)WS_END);
    }
    (void)hipMemsetAsync((char*)d_ws + WS_CTL, 0, CTL_BYTES, stream);
    Args a; memset(&a, 0, sizeof(a));
    for (int i = 0; i < 39; ++i) a.in[i] = (const float*)d_in[i];
    a.out = (float*)d_out; a.ws = (unsigned char*)d_ws;
    a.ph_lo = 0; a.ph_hi = NPHASE;
    hipLaunchKernelGGL(mega, dim3(grid), dim3(512), LDS_BYTES, stream, a);
}
```
